# Optimizing an MI355X kernel written in HIP

```python
import jax
import jax.numpy as jnp
from jax import lax
import numpy as np

D_MODEL = 2048
BATCH = 4
SEQ = 8192
DEPTH = 2

GRID_W = 64
CTX_LEN = 256
N_EVEN = (DEPTH + 1) // 2
N_ODD = DEPTH // 2
EPS = 1e-6
D_FF = 5632
FFN_STEP = 0.5
LRU_WIDTH = D_MODEL // 2
LRU_BLOCKS = 8
LRU_BLOCK = LRU_WIDTH // LRU_BLOCKS
LRU_C = 8.0
CONV_W = 4
CONV_LEFT = 2
RET_HEADS = 4
RET_DK = 256
RET_DV = 256
RET_QK = RET_HEADS * RET_DK
RET_V = RET_HEADS * RET_DV
RET_CHUNK = 128
RET_THETA = 10000.0
EV_IN = 2 * LRU_WIDTH + 2 * RET_QK + 2 * RET_V
EV_MIX = LRU_WIDTH + RET_V
POOL_WINDOWS = (2, 4, 8, 16)
POOL_GROUP = 128
POOL_WIDTH = POOL_GROUP * len(POOL_WINDOWS)
ATT_HEADS = 12
KV_HEADS = 4
GROUP = ATT_HEADS // KV_HEADS
HEAD_DIM = 128
ATT_QW = ATT_HEADS * HEAD_DIM
ATT_KVW = KV_HEADS * HEAD_DIM
Q_BLOCK = 128
ROPE_THETA = 10000.0
OD_IN = POOL_WIDTH + ATT_QW + 2 * ATT_KVW
OD_MIX = POOL_WIDTH + ATT_QW

kernel_name = "hybrid_lru_retention_pool_gqa_diffusion_block"


def rmsnorm(x, g):
    xf = x.astype(jnp.float32)
    y = xf * lax.rsqrt(jnp.mean(xf * xf, axis=-1, keepdims=True) + EPS)
    return (y * g.astype(jnp.float32)).astype(x.dtype)


def modulate(x, g, shift, scale):
    return rmsnorm(x, g) * (1 + scale) + shift


def residual(x, y, g_post, gate, w):
    return x + w * gate * rmsnorm(y, g_post)


def swiglu(h, w_gate, w_up, w_down):
    return (jax.nn.silu(h @ w_gate) * (h @ w_up)) @ w_down


def split_heads(t, h, d):
    return t.reshape(t.shape[0], t.shape[1], h, d)


def apply_rotary(x, cos, sin):
    x1, x2 = jnp.split(x, 2, axis=-1)
    c = cos[:, None, :]
    s = sin[:, None, :]
    return jnp.concatenate([x1 * c - x2 * s, x1 * s + x2 * c], axis=-1).astype(x.dtype)


def dwconv(x, w, b):
    L = x.shape[1]
    xp = jnp.pad(x, ((0, 0), (CONV_LEFT, CONV_W - 1 - CONV_LEFT), (0, 0)))
    y = xp[:, 0:L] * w[0]
    for k in range(1, CONV_W):
        y = y + xp[:, k:k + L] * w[k]
    return y + b


def blockdiag(x, w, b):
    B_, L, _ = x.shape
    xb = x.reshape(B_, L, LRU_BLOCKS, LRU_BLOCK)
    return jnp.einsum('blnc,ncd->blnd', xb, w).reshape(B_, L, LRU_WIDTH) + b


def linear_scan(a, b, h0):
    def comb(l, r):
        return r[0] * l[0], r[0] * l[1] + r[1]
    a_cum, b_cum = lax.associative_scan(comb, (a, b), axis=1)
    if h0 is None:
        return b_cum
    return b_cum + a_cum * h0[:, None, :]


def rglru_coeffs(u, wa, ba, wx, bx, lam):
    r = jax.nn.sigmoid(blockdiag(u, wa, ba))
    i = jax.nn.sigmoid(blockdiag(u, wx, bx))
    log_a = -LRU_C * r * jax.nn.softplus(-lam.astype(jnp.float32))
    a = jnp.exp(log_a)
    bterm = jnp.sqrt(-jnp.expm1(2.0 * log_a)) * (i * u)
    return a, bterm


def rglru_bidir(ul, uc, wa, ba, wx, bx, lam):
    outs_l, outs_c = [], []
    for d in range(2):
        al, bl = rglru_coeffs(ul, wa[d], ba[d], wx[d], bx[d], lam[d])
        ac, bc = rglru_coeffs(uc, wa[d], ba[d], wx[d], bx[d], lam[d])
        if d == 1:
            al, bl, ac, bc = [jnp.flip(t, axis=1) for t in (al, bl, ac, bc)]
        h_c = linear_scan(ac, bc, None)
        h_l = linear_scan(al, bl, h_c[:, -1])
        if d == 1:
            h_c = jnp.flip(h_c, axis=1)
            h_l = jnp.flip(h_l, axis=1)
        outs_l.append(h_l)
        outs_c.append(h_c)
    return outs_l[0] + outs_l[1], outs_c[0] + outs_c[1]


def retention_scan(q, k, v, log_g, s0):
    B_, H, L, _ = q.shape
    C = RET_CHUNK
    n = L // C
    idx = jnp.arange(C, dtype=jnp.float32)
    diff = idx[:, None] - idx[None, :]
    lg = log_g[:, None, None]
    intra = jnp.where(diff >= 0, jnp.exp(lg * jnp.maximum(diff, 0.0)), 0.0)
    q_dec = jnp.exp(log_g[:, None] * (idx + 1.0))
    k_dec = jnp.exp(log_g[:, None] * (C - 1.0 - idx))
    s_dec = jnp.exp(log_g * C)

    def to_chunks(t):
        return t.reshape(B_, H, n, C, t.shape[-1]).transpose(2, 0, 1, 3, 4)

    def step(s, qkv):
        qc, kc, vc = qkv
        scores = jnp.einsum('bhid,bhjd->bhij', qc, kc) * intra
        o = (jnp.einsum('bhij,bhje->bhie', scores, vc)
             + jnp.einsum('bhid,bhde->bhie', qc * q_dec[..., None], s))
        s_new = s * s_dec[:, None, None] + jnp.einsum('bhjd,bhje->bhde', kc * k_dec[..., None], vc)
        return s_new, o

    s_fin, o = lax.scan(step, s0, (to_chunks(q), to_chunks(k), to_chunks(v)))
    o = o.transpose(1, 2, 0, 3, 4).reshape(B_, H, L, o.shape[-1])
    return o, s_fin


def retention_bidir(ql, kl, vl, qc, kc, vc, log_g):
    B_, H = ql.shape[0], ql.shape[1]
    s0 = jnp.zeros((B_, H, RET_DK, RET_DV), jnp.float32)
    outs_l, outs_c = [], []
    for d in range(2):
        seqs = (ql, kl, vl, qc, kc, vc)
        if d == 1:
            seqs = tuple(jnp.flip(t, axis=2) for t in seqs)
        o_c, s_c = retention_scan(seqs[3], seqs[4], seqs[5], log_g[d], s0)
        o_l, _ = retention_scan(seqs[0], seqs[1], seqs[2], log_g[d], s_c)
        if d == 1:
            o_c = jnp.flip(o_c, axis=2)
            o_l = jnp.flip(o_l, axis=2)
        outs_l.append(o_l)
        outs_c.append(o_c)
    return outs_l[0] + outs_l[1], outs_c[0] + outs_c[1]


def head_groupnorm(o, g):
    mu = jnp.mean(o, axis=-1, keepdims=True)
    var = jnp.mean(jnp.square(o - mu), axis=-1, keepdims=True)
    y = (o - mu) * lax.rsqrt(var + EPS)
    B_, H, L, dv = y.shape
    return y.transpose(0, 2, 1, 3).reshape(B_, L, H * dv) * g


def to_bhld(t):
    return t.astype(jnp.float32).transpose(0, 2, 1, 3)


def even_mixer(hl, hc, w_in, w_out, conv_w, conv_b, wa, ba, wx, bx, lam, decay_logit, gn_g, cos, sin):
    splits = [LRU_WIDTH, 2 * LRU_WIDTH, 2 * LRU_WIDTH + RET_QK, 2 * LRU_WIDTH + 2 * RET_QK,
              2 * LRU_WIDTH + 2 * RET_QK + RET_V]
    gl, rl, ql, kl, vl, ol = jnp.split(hl @ w_in, splits, axis=-1)
    gc, rc, qc, kc, vc, oc = jnp.split(hc @ w_in, splits, axis=-1)
    ul = dwconv(rl, conv_w, conv_b).astype(jnp.float32)
    uc = dwconv(rc, conv_w, conv_b).astype(jnp.float32)
    hl_lru, hc_lru = rglru_bidir(ul, uc, wa, ba, wx, bx, lam)
    lru_l = jax.nn.gelu(gl.astype(jnp.float32)) * hl_lru
    lru_c = jax.nn.gelu(gc.astype(jnp.float32)) * hc_lru
    k_scale = RET_DK ** -0.5
    ql = to_bhld(apply_rotary(split_heads(ql, RET_HEADS, RET_DK), cos, sin))
    kl = to_bhld(apply_rotary(split_heads(kl, RET_HEADS, RET_DK), cos, sin)) * k_scale
    vl = to_bhld(split_heads(vl, RET_HEADS, RET_DV))
    qc = to_bhld(split_heads(qc, RET_HEADS, RET_DK))
    kc = to_bhld(split_heads(kc, RET_HEADS, RET_DK)) * k_scale
    vc = to_bhld(split_heads(vc, RET_HEADS, RET_DV))
    log_g = -jax.nn.softplus(-decay_logit.astype(jnp.float32))
    rl_out, rc_out = retention_bidir(ql, kl, vl, qc, kc, vc, log_g)
    ret_l = head_groupnorm(rl_out, gn_g) * jax.nn.silu(ol.astype(jnp.float32))
    ret_c = head_groupnorm(rc_out, gn_g) * jax.nn.silu(oc.astype(jnp.float32))
    yl = jnp.concatenate([lru_l, ret_l], axis=-1).astype(hl.dtype) @ w_out
    yc = jnp.concatenate([lru_c, ret_c], axis=-1).astype(hc.dtype) @ w_out
    return yl, yc


def multiscale_pool(x, pool_w, pool_scale):
    B_, L, _ = x.shape
    xf = x.astype(jnp.float32)
    cs = jnp.concatenate([jnp.zeros((B_, 1, POOL_WIDTH), jnp.float32), jnp.cumsum(xf, axis=1)], axis=1)
    t = jnp.arange(L)
    outs = []
    for gi, w in enumerate(POOL_WINDOWS):
        lo = jnp.clip(t - w // 2, 0, L)
        hi = jnp.clip(t + w // 2, 0, L)
        sl = slice(gi * POOL_GROUP, (gi + 1) * POOL_GROUP)
        csg = cs[..., sl]
        cnt = (hi - lo).astype(jnp.float32)[None, :, None]
        mean = (csg[:, hi] - csg[:, lo]) / cnt
        outs.append(jnp.einsum('blc,cd->bld', mean - xf[..., sl], pool_w[gi].astype(jnp.float32)))
    return (jnp.concatenate(outs, axis=-1) * pool_scale).astype(x.dtype)


def attend(q, k, v):
    B_, Lq = q.shape[0], q.shape[1]
    nb = Lq // Q_BLOCK
    qb = q.reshape(B_, nb, Q_BLOCK, KV_HEADS, GROUP, HEAD_DIM).transpose(1, 0, 3, 4, 2, 5)
    kt = k.transpose(0, 2, 1, 3)
    vt = v.transpose(0, 2, 1, 3)
    scale = HEAD_DIM ** -0.5

    def blk(qi):
        s = jnp.einsum('bkgqd,bksd->bkgqs', qi, kt, preferred_element_type=jnp.float32) * scale
        p = jax.nn.softmax(s, axis=-1)
        return jnp.einsum('bkgqs,bksd->bkgqd', p.astype(vt.dtype), vt)

    o = lax.map(blk, qb)
    return o.transpose(1, 0, 4, 2, 3, 5).reshape(B_, Lq, ATT_QW)


def odd_mixer(hl, hc, w_in, w_out, pool_w, pool_scale, q_g, k_g, cos, sin, with_ctx):
    splits = [POOL_WIDTH, POOL_WIDTH + ATT_QW, POOL_WIDTH + ATT_QW + ATT_KVW]
    pool_l, ql, kl, vl = jnp.split(hl @ w_in, splits, axis=-1)
    ql = apply_rotary(rmsnorm(split_heads(ql, ATT_HEADS, HEAD_DIM), q_g), cos, sin)
    kl = apply_rotary(rmsnorm(split_heads(kl, KV_HEADS, HEAD_DIM), k_g), cos, sin)
    vl = split_heads(vl, KV_HEADS, HEAD_DIM)
    if with_ctx:
        pool_c, qc, kc, vc = jnp.split(hc @ w_in, splits, axis=-1)
    else:
        kc, vc = jnp.split(hc @ w_in[:, POOL_WIDTH + ATT_QW:], [ATT_KVW], axis=-1)
    kc = rmsnorm(split_heads(kc, KV_HEADS, HEAD_DIM), k_g)
    vc = split_heads(vc, KV_HEADS, HEAD_DIM)
    att_l = attend(ql, jnp.concatenate([kc, kl], axis=1), jnp.concatenate([vc, vl], axis=1))
    yl = jnp.concatenate([multiscale_pool(pool_l, pool_w, pool_scale), att_l.astype(hl.dtype)], axis=-1) @ w_out
    if not with_ctx:
        return yl, None
    qc = rmsnorm(split_heads(qc, ATT_HEADS, HEAD_DIM), q_g)
    att_c = attend(qc, kc, vc)
    yc = jnp.concatenate([multiscale_pool(pool_c, pool_w, pool_scale), att_c.astype(hc.dtype)], axis=-1) @ w_out
    return yl, yc


def setup_inputs(seed: int = 0) -> dict:
    key = jax.random.key(seed)
    ks = list(jax.random.split(key, 28))

    def nrm(i, shape, s):
        return jax.random.normal(ks[i], shape, jnp.float32) * s

    D = D_MODEL
    u = jax.random.uniform(ks[19], (N_EVEN, 2, LRU_WIDTH), jnp.float32, 0.9, 0.999)
    a = u ** (1.0 / LRU_C)
    lam = jnp.log(a) - jnp.log1p(-a)
    gam = 1.0 - 2.0 ** (-5.0 - jnp.arange(RET_HEADS, dtype=jnp.float32))
    decay_base = jnp.log(gam) - jnp.log1p(-gam)
    return {
        "x": nrm(0, (BATCH, SEQ, D), 1.0),
        "c": nrm(1, (BATCH, D), 1.0),
        "ctx": nrm(2, (BATCH, CTX_LEN, D), 1.0),
        "c_ctx": nrm(3, (D,), 1.0),
        "mod_w": nrm(4, (DEPTH, D, 9 * D), 0.5 * D ** -0.5),
        "mod_b": nrm(5, (DEPTH, 9 * D), 0.02),
        "norm_pre": 1.0 + nrm(6, (DEPTH, 3, D), 0.02),
        "norm_post": 1.0 + nrm(7, (DEPTH, 3, D), 0.02),
        "ffn_gate": nrm(8, (DEPTH, 2, D, D_FF), D ** -0.5),
        "ffn_up": nrm(9, (DEPTH, 2, D, D_FF), D ** -0.5),
        "ffn_down": nrm(10, (DEPTH, 2, D_FF, D), D_FF ** -0.5),
        "ev_w_in": nrm(11, (N_EVEN, D, EV_IN), D ** -0.5),
        "ev_w_out": nrm(12, (N_EVEN, EV_MIX, D), EV_MIX ** -0.5),
        "lru_conv_w": nrm(13, (N_EVEN, CONV_W, LRU_WIDTH), CONV_W ** -0.5),
        "lru_conv_b": nrm(14, (N_EVEN, LRU_WIDTH), 0.01),
        "lru_wa": nrm(15, (N_EVEN, 2, LRU_BLOCKS, LRU_BLOCK, LRU_BLOCK), LRU_BLOCK ** -0.5),
        "lru_ba": nrm(16, (N_EVEN, 2, LRU_WIDTH), 0.01),
        "lru_wx": nrm(17, (N_EVEN, 2, LRU_BLOCKS, LRU_BLOCK, LRU_BLOCK), LRU_BLOCK ** -0.5),
        "lru_bx": nrm(18, (N_EVEN, 2, LRU_WIDTH), 0.01),
        "lru_lambda": lam,
        "ret_decay_logit": decay_base + nrm(20, (N_EVEN, 2, RET_HEADS), 0.05),
        "ret_gn": 1.0 + nrm(21, (N_EVEN, RET_V), 0.02),
        "od_w_in": nrm(22, (N_ODD, D, OD_IN), D ** -0.5),
        "od_w_out": nrm(23, (N_ODD, OD_MIX, D), OD_MIX ** -0.5),
        "pool_w": nrm(24, (N_ODD, len(POOL_WINDOWS), POOL_GROUP, POOL_GROUP), POOL_GROUP ** -0.5),
        "pool_scale": 1.0 + nrm(25, (N_ODD, POOL_WIDTH), 0.1),
        "q_norm": 1.0 + nrm(26, (N_ODD, HEAD_DIM), 0.02),
        "k_norm": 1.0 + nrm(27, (N_ODD, HEAD_DIM), 0.02),
    }


def reference(x, c, ctx, c_ctx, mod_w, mod_b, norm_pre, norm_post, ffn_gate, ffn_up, ffn_down,
              ev_w_in, ev_w_out, lru_conv_w, lru_conv_b, lru_wa, lru_ba, lru_wx, lru_bx, lru_lambda,
              ret_decay_logit, ret_gn, od_w_in, od_w_out, pool_w, pool_scale, q_norm, k_norm):
    D = D_MODEL
    S = x.shape[1]
    rows = S // GRID_W
    row = jnp.repeat(jnp.arange(rows, dtype=jnp.float32), GRID_W)
    col = jnp.tile(jnp.arange(GRID_W, dtype=jnp.float32), rows)
    n_ax = HEAD_DIM // 4
    f_ax = ROPE_THETA ** (-jnp.arange(n_ax, dtype=jnp.float32) / n_ax)
    ang2 = jnp.concatenate([row[:, None] * f_ax, col[:, None] * f_ax], axis=-1)
    cos2, sin2 = jnp.cos(ang2), jnp.sin(ang2)
    n_r = RET_DK // 2
    f_r = RET_THETA ** (-jnp.arange(n_r, dtype=jnp.float32) / n_r)
    ang1 = jnp.arange(S, dtype=jnp.float32)[:, None] * f_r
    cos1, sin1 = jnp.cos(ang1), jnp.sin(ang1)

    sc = jax.nn.silu(c)
    scc = jax.nn.silu(c_ctx)
    xl, xc = x, ctx
    for li in range(DEPTH):
        last = li == DEPTH - 1
        n_ctx_sub = 2 if last else 3
        mod_l = (sc @ mod_w[li] + mod_b[li]).reshape(-1, 3, 3, 1, D)
        mod_c = (scc @ mod_w[li][:, :n_ctx_sub * 3 * D] + mod_b[li, :n_ctx_sub * 3 * D]).reshape(n_ctx_sub, 3, D)

        hl = modulate(xl, norm_pre[li, 0], mod_l[:, 0, 0], mod_l[:, 0, 1])
        hc = modulate(xc, norm_pre[li, 0], mod_c[0, 0], mod_c[0, 1])
        xl = residual(xl, swiglu(hl, ffn_gate[li, 0], ffn_up[li, 0], ffn_down[li, 0]), norm_post[li, 0], mod_l[:, 0, 2], FFN_STEP)
        xc = residual(xc, swiglu(hc, ffn_gate[li, 0], ffn_up[li, 0], ffn_down[li, 0]), norm_post[li, 0], mod_c[0, 2], FFN_STEP)

        hl = modulate(xl, norm_pre[li, 1], mod_l[:, 1, 0], mod_l[:, 1, 1])
        hc = modulate(xc, norm_pre[li, 1], mod_c[1, 0], mod_c[1, 1])
        if li % 2 == 0:
            e = li // 2
            yl, yc = even_mixer(hl, hc, ev_w_in[e], ev_w_out[e], lru_conv_w[e], lru_conv_b[e],
                                lru_wa[e], lru_ba[e], lru_wx[e], lru_bx[e], lru_lambda[e],
                                ret_decay_logit[e], ret_gn[e], cos1, sin1)
        else:
            o = li // 2
            yl, yc = odd_mixer(hl, hc, od_w_in[o], od_w_out[o], pool_w[o], pool_scale[o],
                               q_norm[o], k_norm[o], cos2, sin2, not last)
        xl = residual(xl, yl, norm_post[li, 1], mod_l[:, 1, 2], 1.0)
        if not last:
            xc = residual(xc, yc, norm_post[li, 1], mod_c[1, 2], 1.0)

        hl = modulate(xl, norm_pre[li, 2], mod_l[:, 2, 0], mod_l[:, 2, 1])
        xl = residual(xl, swiglu(hl, ffn_gate[li, 1], ffn_up[li, 1], ffn_down[li, 1]), norm_post[li, 2], mod_l[:, 2, 2], FFN_STEP)
        if not last:
            hc = modulate(xc, norm_pre[li, 2], mod_c[2, 0], mod_c[2, 1])
            xc = residual(xc, swiglu(hc, ffn_gate[li, 1], ffn_up[li, 1], ffn_down[li, 1]), norm_post[li, 2], mod_c[2, 2], FFN_STEP)
    return xl
```

```cpp
#include <hip/hip_runtime.h>
#include <cstdio>
#include <cstdint>

#ifndef MK_N_LAUNCHES
#define MK_N_LAUNCHES 1
#endif
#ifndef MK_STOP_AFTER
#define MK_STOP_AFTER 1000
#endif

#define DEV __device__ __forceinline__
#define LAS __attribute__((address_space(3)))
typedef unsigned short bf16;
typedef float f32x4 __attribute__((ext_vector_type(4)));
typedef float f32x2 __attribute__((ext_vector_type(2)));
typedef float f32x16 __attribute__((ext_vector_type(16)));
typedef short bf16x8 __attribute__((ext_vector_type(8)));
typedef short s16x4 __attribute__((ext_vector_type(4)));
typedef unsigned u32x4 __attribute__((ext_vector_type(4)));
typedef unsigned u32x2 __attribute__((ext_vector_type(2)));

constexpr int NB = 4, SEQ = 8192, DM = 2048, CTXL = 256, DFF = 5632;
constexpr int ML = NB * SEQ, MC = NB * CTXL, MT = ML + MC;
constexpr float EPS = 1e-6f;
constexpr int EVN = 6144, ODN = 3072;
constexpr int EC_G = 0, EC_O = 1024, EC_Q = 2048, EC_K = 3072, EC_V = 4096, EC_R = 5120;
constexpr int NCH64 = (CTXL + SEQ) / 64;
constexpr int NCH128 = (CTXL + SEQ) / 128;
constexpr int KVL = CTXL + SEQ;

constexpr size_t MiB = 1u << 20;
constexpr size_t WS_CTL = 0, CTL_ZERO_BYTES = 1 * MiB;
constexpr size_t WS_MOD = 1 * MiB;
constexpr size_t WS_COS1 = 2 * MiB, WS_SIN1 = 6 * MiB;
constexpr size_t WS_COS2 = 10 * MiB, WS_SIN2 = 12 * MiB;
constexpr size_t WS_LRUW = 14 * MiB;
constexpr size_t WS_POOLW = 15 * MiB;
constexpr size_t WS_AGG = 16 * MiB;
constexpr size_t WS_CAR = 25 * MiB;
constexpr size_t WS_XC = 30 * MiB;
constexpr size_t WS_W = 40 * MiB;
constexpr size_t WS_WGU = WS_W;
constexpr size_t WS_WD = WS_W + 176 * MiB;
constexpr size_t WS_WEVIN = WS_W + 264 * MiB;
constexpr size_t WS_WEVOUT = WS_W + 288 * MiB;
constexpr size_t WS_WODIN = WS_W + 296 * MiB;
constexpr size_t WS_WODOUT = WS_W + 308 * MiB;
constexpr size_t WS_H = 356 * MiB;
constexpr size_t WS_BIG = 488 * MiB;
constexpr size_t WS_ACT = WS_BIG;
constexpr size_t WS_E = WS_BIG;
constexpr size_t WS_SBUF = WS_BIG + 396 * MiB;
constexpr size_t WS_E2 = WS_BIG;
constexpr size_t WS_QB = WS_BIG + 198 * MiB;
constexpr size_t WS_KB = WS_BIG + 294 * MiB;
constexpr size_t WS_VB = WS_BIG + 327 * MiB;
constexpr size_t WS_MIX2 = WS_BIG + 360 * MiB;
constexpr size_t WS_END = 1148 * MiB;
constexpr int CW_BAR = 4096;

constexpr int LDS_BYTES = 159744;
constexpr int MISC_OFF = LDS_BYTES - 256;

DEV float bflo(unsigned w) { return __uint_as_float(w << 16); }
DEV float bfhi(unsigned w) { return __uint_as_float(w & 0xffff0000u); }
DEV float bf2f(bf16 b) { return __uint_as_float((unsigned)b << 16); }
DEV unsigned pkbf(float lo, float hi) { unsigned r; asm volatile("v_cvt_pk_bf16_f32 %0, %1, %2" : "=v"(r) : "v"(lo), "v"(hi)); return r; }
DEV bf16 f2bf(float f) { return (bf16)(pkbf(f, 0.f) & 0xffffu); }
DEV float fexp(float x) { return __builtin_amdgcn_exp2f(x * 1.4426950408889634f); }
DEV float fsigmoid(float x) { return __builtin_amdgcn_rcpf(1.f + fexp(-x)); }
DEV float fsilu(float x) { return x * fsigmoid(x); }
DEV float fgelu_tanh(float x) { const float z = 0.7978845608028654f * (x + 0.044715f * x * x * x); return x * fsigmoid(2.f * z); }
DEV float wave_sum(float v) {
#pragma unroll
    for (int o = 1; o < 64; o <<= 1) v += __shfl_xor(v, o);
    return v;
}
DEV int crow(int r, int hi) { return (r & 3) + 8 * (r >> 2) + 4 * hi; }
typedef short v4i16_t __attribute__((ext_vector_type(4)));
DEV s16x4 ds_tr(const LAS unsigned char* p) { return __builtin_bit_cast(s16x4, __builtin_amdgcn_ds_read_tr16_b64_v4i16((LAS v4i16_t*)p)); }
DEV bf16x8 tr_frag(const LAS unsigned char* X, int ld, int k0, int n0, int lane) {
    const int h = lane >> 5, blk = (lane >> 4) & 1, q = (lane & 15) >> 2, p = lane & 3;
    const LAS unsigned char* a = X + (k0 + 8 * h + q) * ld + (n0 + 16 * blk + 4 * p) * 2;
    const s16x4 lo = ds_tr(a), hi = ds_tr(a + 4 * ld);
    return (bf16x8){lo[0], lo[1], lo[2], lo[3], hi[0], hi[1], hi[2], hi[3]};
}
DEV bf16x8 pack8(const float* v) { u32x4 w = {pkbf(v[0], v[1]), pkbf(v[2], v[3]), pkbf(v[4], v[5]), pkbf(v[6], v[7])}; return __builtin_bit_cast(bf16x8, w); }

namespace pg8 {
typedef unsigned short bf16_t;
constexpr int BM = 256, BK = 64, HALF = 128, HTB = HALF * BK * 2, STAGE_BYTES = 8 * HTB, NXCD = 8, WGM = 8;
__host__ __device__ __forceinline__ int lds_byte(int r, int c) { const int st = (r >> 4) * 2 + (c >> 5), rr = r & 15, cc = c & 31, ob = rr * 64 + cc * 2; return st * 1024 + (ob ^ (((ob >> 9) & 1) << 5)); }
__host__ __device__ __forceinline__ void stage_rc(int b, int& R, int& C) { const int st = b / 1024, sb = b % 1024, swz = sb ^ (((sb >> 9) & 1) << 5); R = (st >> 1) * 16 + swz / 64; C = (st & 1) * 32 + (swz % 64) / 2; }
__host__ __device__ __forceinline__ int perm32(int rho) { const int n = rho >> 4, i = rho & 15; return 8 * (i >> 2) + 4 * n + (i & 3); }
struct Unit { int pm, pn; };
struct Gemm { const bf16_t* A; const bf16_t* Bt; int M, N, K, lda; };
struct StaticOrder {
    int nM, nN, nwg, G, c;
    __host__ __device__ void init(int M, int N, int G_, int c_) { nM = M / BM; nN = N / BM; nwg = nM * nN; G = G_; c = c_; }
    __host__ __device__ bool next(int i, Unit& u) const {
        const long L = (long)i * G + c; if (L >= nwg) return false;
        int wgid = (int)L; { const int q = nwg / NXCD, r = nwg % NXCD, xcd = wgid % NXCD, off = wgid / NXCD; wgid = (xcd < r ? xcd * (q + 1) : r * (q + 1) + (xcd - r) * q) + off; }
        const int nig = WGM * nN, gid = wgid / nig, fm = gid * WGM, gsz = (nM - fm) < WGM ? (nM - fm) : WGM;
        u.pm = fm + ((wgid % nig) % gsz); u.pn = (wgid % nig) / gsz; return true;
    }
    __device__ __forceinline__ void a_ready(const Unit&) const {}
    __device__ __forceinline__ void done(const Unit&) const {}
};
struct EpiPlain {
    static constexpr bool PERM = true, AFTER_DRAIN = false;
    bf16_t* O; int ldc;
    __device__ __forceinline__ void operator()(const f32x4 (&acc)[2][2][4][2], const Unit& u, int wr, int wc, int fr, int fq) const {
        const int row0 = u.pm * BM + wr * 64 + fr, col0 = u.pn * BM + wc * 32 + 8 * fq;
#pragma unroll
        for (int ai = 0; ai < 2; ++ai)
#pragma unroll
            for (int m = 0; m < 4; ++m) { bf16_t* rowp = O + (size_t)(row0 + ai * HALF + m * 16) * ldc + col0;
#pragma unroll
                for (int bj = 0; bj < 2; ++bj) { const f32x4 v0 = acc[ai][bj][m][0], v1 = acc[ai][bj][m][1];
                    u32x4 w; w.x = pkbf(v0[0], v0[1]); w.y = pkbf(v0[2], v0[3]); w.z = pkbf(v1[0], v1[1]); w.w = pkbf(v1[2], v1[3]);
                    *(u32x4*)(rowp + bj * HALF) = w; } }
    }
};
struct EpiSwiGLU {
    static constexpr bool PERM = true, AFTER_DRAIN = false;
    bf16_t* O; int ldc;
    __device__ __forceinline__ void operator()(const f32x4 (&acc)[2][2][4][2], const Unit& u, int wr, int wc, int fr, int fq) const {
        const int row0 = u.pm * BM + wr * 64 + fr, col0 = u.pn * HALF + wc * 32 + 8 * fq;
#pragma unroll
        for (int ai = 0; ai < 2; ++ai)
#pragma unroll
            for (int m = 0; m < 4; ++m) { bf16_t* rowp = O + (size_t)(row0 + ai * HALF + m * 16) * ldc + col0;
                f32x4 a0, a1;
#pragma unroll
                for (int j = 0; j < 4; ++j) { a0[j] = fsilu(acc[ai][0][m][0][j]) * acc[ai][1][m][0][j]; a1[j] = fsilu(acc[ai][0][m][1][j]) * acc[ai][1][m][1][j]; }
                u32x4 w; w.x = pkbf(a0[0], a0[1]); w.y = pkbf(a0[2], a0[3]); w.z = pkbf(a1[0], a1[1]); w.w = pkbf(a1[2], a1[3]);
                *(u32x4*)rowp = w; }
    }
};
struct EpiEvIn {
    static constexpr bool PERM = true, AFTER_DRAIN = false;
    bf16_t* O; const float* cs; const float* sn;
    __device__ __forceinline__ void operator()(const f32x4 (&acc)[2][2][4][2], const Unit& u, int wr, int wc, int fr, int fq) const {
        const int ldc = EVN; const int row0 = u.pm * BM + wr * 64 + fr, col0 = u.pn * BM + wc * 32 + 8 * fq;
        const bool qk = (u.pn >= 8 && u.pn < 16), rot = qk && (u.pm < ML / BM); const float ksc = (u.pn >= 12 && u.pn < 16) ? 0.0625f : 1.f;
#pragma unroll
        for (int ai = 0; ai < 2; ++ai)
#pragma unroll
            for (int m = 0; m < 4; ++m) { const int row = row0 + ai * HALF + m * 16; bf16_t* rowp = O + (size_t)row * ldc + col0;
                f32x4 o1[2], o2[2];
#pragma unroll
                for (int n = 0; n < 2; ++n) { const f32x4 x1 = acc[ai][0][m][n], x2 = acc[ai][1][m][n];
                    if (rot) { const int t = row & (SEQ - 1); const int i0 = wc * 32 + 8 * fq + 4 * n;
                        const f32x4 c4 = *(const f32x4*)(cs + (size_t)t * 128 + i0), s4 = *(const f32x4*)(sn + (size_t)t * 128 + i0);
                        o1[n] = (x1 * c4 - x2 * s4) * ksc; o2[n] = (x1 * s4 + x2 * c4) * ksc; }
                    else { o1[n] = x1 * ksc; o2[n] = x2 * ksc; } }
                u32x4 w; w.x = pkbf(o1[0][0], o1[0][1]); w.y = pkbf(o1[0][2], o1[0][3]); w.z = pkbf(o1[1][0], o1[1][1]); w.w = pkbf(o1[1][2], o1[1][3]);
                *(u32x4*)rowp = w;
                w.x = pkbf(o2[0][0], o2[0][1]); w.y = pkbf(o2[0][2], o2[0][3]); w.z = pkbf(o2[1][0], o2[1][1]); w.w = pkbf(o2[1][2], o2[1][3]);
                *(u32x4*)(rowp + HALF) = w; }
    }
};

template <class Epi, class Sched, bool ALIGN_EPI = false, bool SP2 = false>
__device__ __forceinline__ void gemm_phase(LAS unsigned char* lds, const Gemm g, const Sched& S, const Epi& E) {
    const int tid = threadIdx.x, wid = __builtin_amdgcn_readfirstlane(tid >> 6), lane = tid & 63, wr = wid >> 2, wc = wid & 3, fr = lane & 15, fq = lane >> 4;
    const int K = g.K, nt = K / BK, lda = g.lda;
    unsigned voffA[2], voffB[2];
#pragma unroll
    for (int i = 0; i < 2; ++i) { int R, C; stage_rc(tid * 16 + i * 8192, R, C); const int Rb = Epi::PERM ? ((R & ~31) + perm32(R & 31)) : R;
        voffA[i] = (unsigned)(R * lda + C) * 2u; voffB[i] = (unsigned)(Rb * K + C) * 2u; }
    const size_t kstep = (size_t)(BK * 2);
    const size_t hstepA = (size_t)HALF * lda * 2, hstepB = (size_t)HALF * K * 2;
    const size_t tstepA = 2 * hstepA, tstepB = 2 * hstepB;
    const unsigned ldsw = (unsigned)wid * 1024u;
    const int aoff = lds_byte(wr * 64 + fr, fq * 8), boff = lds_byte(wc * 32 + fr, fq * 8);
#define PG8_SA(b, h) (((b) * 2 + (h)) * HTB)
#define PG8_SB(b, h) ((4 + (b) * 2 + (h)) * HTB)
#define PG8_STAGE(bufoff, gbase, voff) do { _Pragma("unroll") for (int _i = 0; _i < 2; ++_i) \
        __builtin_amdgcn_global_load_lds((const unsigned*)((const char*)(gbase) + (voff)[_i]), (LAS unsigned*)(lds + (bufoff) + ldsw + _i * 8192), 16, 0, 0); } while (0)
#define PG8_LDA(dst, b, h) do { _Pragma("unroll") for (int m = 0; m < 4; ++m) _Pragma("unroll") for (int k = 0; k < 2; ++k) dst[m][k] = *(const LAS bf16x8*)(lds + PG8_SA(b, h) + aoff + m * 2048 + k * 1024); } while (0)
#define PG8_LDB(dst, b, h) do { _Pragma("unroll") for (int n = 0; n < 2; ++n) _Pragma("unroll") for (int k = 0; k < 2; ++k) dst[n][k] = *(const LAS bf16x8*)(lds + PG8_SB(b, h) + boff + n * 2048 + k * 1024); } while (0)
#define PG8_MMA(ai, bj, At, Bt) do { __builtin_amdgcn_s_setprio(1); _Pragma("unroll") for (int m = 0; m < 4; ++m) _Pragma("unroll") for (int n = 0; n < 2; ++n) _Pragma("unroll") for (int k = 0; k < 2; ++k) \
        acc[ai][bj][m][n] = __builtin_amdgcn_mfma_f32_16x16x32_bf16(Bt[n][k], At[m][k], acc[ai][bj][m][n], 0, 0, 0); __builtin_amdgcn_s_setprio(0); } while (0)
#define PG8_WAIT_V(n) asm volatile("s_waitcnt vmcnt(" #n ")" ::: "memory")
#define PG8_WAIT_L(n) asm volatile("s_waitcnt lgkmcnt(" #n ")" ::: "memory")
#define PG8_BAR __builtin_amdgcn_s_barrier()
#define PG8_SCHED __builtin_amdgcn_sched_barrier(0)
    Unit cur, nxt; int ui = 0;
    if (!S.next(0, cur)) return;
    f32x4 acc[2][2][4][2];
#pragma unroll
    for (int a = 0; a < 2; ++a)
#pragma unroll
        for (int b = 0; b < 2; ++b)
#pragma unroll
            for (int m = 0; m < 4; ++m)
#pragma unroll
                for (int n = 0; n < 2; ++n) acc[a][b][m][n] = (f32x4){0.f, 0.f, 0.f, 0.f};
    bf16x8 At[4][2], B0[2][2], B1[2][2];
    const char* cA = (const char*)g.A + (size_t)cur.pm * tstepA; const char* cB = (const char*)g.Bt + (size_t)cur.pn * tstepB;
    S.a_ready(cur);
    if constexpr (SP2) {
        PG8_STAGE(PG8_SB(0, 0), cB, voffB); PG8_STAGE(PG8_SB(0, 1), cB + hstepB, voffB); PG8_STAGE(PG8_SA(0, 0), cA, voffA); PG8_STAGE(PG8_SA(0, 1), cA + hstepA, voffA);
        if (wr == 1) PG8_BAR;
        PG8_WAIT_V(2); PG8_BAR;
        PG8_STAGE(PG8_SB(1, 0), cB + kstep, voffB); PG8_STAGE(PG8_SA(1, 0), cA + kstep, voffA); PG8_STAGE(PG8_SB(1, 1), cB + hstepB + kstep, voffB);
        PG8_WAIT_V(6); PG8_BAR;
    } else {
        PG8_STAGE(PG8_SB(0, 0), cB, voffB); PG8_STAGE(PG8_SA(0, 0), cA, voffA); PG8_STAGE(PG8_SB(0, 1), cB + hstepB, voffB); PG8_STAGE(PG8_SA(0, 1), cA + hstepA, voffA);
        if (wr == 1) PG8_BAR;
        PG8_WAIT_V(4); PG8_BAR;
        PG8_STAGE(PG8_SB(1, 0), cB + kstep, voffB); PG8_STAGE(PG8_SA(1, 0), cA + kstep, voffA); PG8_STAGE(PG8_SB(1, 1), cB + hstepB + kstep, voffB);
        PG8_WAIT_V(6); PG8_BAR;
    }
    for (;;) {
        const bool has_next = S.next(ui + 1, nxt);
        const char* nA = has_next ? (const char*)g.A + (size_t)nxt.pm * tstepA : cA; const char* nB = has_next ? (const char*)g.Bt + (size_t)nxt.pn * tstepB : cB;
        for (int t = 0; t < nt; t += 2) {
            const bool last = (t == nt - 2);
            const char* a1 = cA + (size_t)(t + 1) * kstep;
            const char* a2 = last ? nA : cA + (size_t)(t + 2) * kstep; const char* b2 = last ? nB : cB + (size_t)(t + 2) * kstep;
            const char* a3 = a2 + kstep; const char* b3 = b2 + kstep;
            if (last && has_next) S.a_ready(nxt);
            if constexpr (SP2) {
            PG8_LDB(B0, 0, 0); PG8_LDB(B1, 0, 1); PG8_SCHED; PG8_LDA(At, 0, 0); PG8_STAGE(PG8_SA(1, 1), a1 + hstepA, voffA);
            PG8_WAIT_V(8); PG8_WAIT_L(0); PG8_BAR; PG8_MMA(0, 0, At, B0); PG8_MMA(0, 1, At, B1); PG8_BAR; PG8_SCHED;
            PG8_LDA(At, 0, 1); PG8_STAGE(PG8_SB(0, 0), b2, voffB); PG8_STAGE(PG8_SB(0, 1), b2 + hstepB, voffB); PG8_STAGE(PG8_SA(0, 0), a2, voffA);
            PG8_WAIT_V(8); PG8_WAIT_L(0); PG8_BAR; PG8_MMA(1, 0, At, B0); PG8_MMA(1, 1, At, B1); PG8_BAR; PG8_SCHED;
            PG8_LDB(B0, 1, 0); PG8_LDB(B1, 1, 1); PG8_SCHED; PG8_LDA(At, 1, 0); PG8_STAGE(PG8_SA(0, 1), a2 + hstepA, voffA);
            PG8_WAIT_V(8); PG8_WAIT_L(0); PG8_BAR; PG8_MMA(0, 0, At, B0); PG8_MMA(0, 1, At, B1); PG8_BAR; PG8_SCHED;
            PG8_LDA(At, 1, 1); PG8_STAGE(PG8_SB(1, 0), b3, voffB); PG8_STAGE(PG8_SB(1, 1), b3 + hstepB, voffB); PG8_STAGE(PG8_SA(1, 0), a3, voffA);
            PG8_WAIT_V(8); PG8_WAIT_L(0); PG8_BAR; PG8_MMA(1, 0, At, B0); PG8_MMA(1, 1, At, B1); PG8_BAR; PG8_SCHED;
            } else {
            PG8_LDB(B0, 0, 0); PG8_SCHED; PG8_LDA(At, 0, 0); PG8_STAGE(PG8_SA(1, 1), a1 + hstepA, voffA);
            PG8_WAIT_L(8); PG8_BAR; PG8_WAIT_L(0); PG8_MMA(0, 0, At, B0); PG8_BAR; PG8_SCHED;
            PG8_LDB(B1, 0, 1); PG8_STAGE(PG8_SB(0, 0), b2, voffB);
            PG8_BAR; PG8_WAIT_L(0); PG8_MMA(0, 1, At, B1); PG8_BAR;
            PG8_LDA(At, 0, 1); PG8_STAGE(PG8_SA(0, 0), a2, voffA);
            PG8_BAR; PG8_WAIT_L(0); PG8_MMA(1, 0, At, B0); PG8_BAR; PG8_SCHED;
            PG8_STAGE(PG8_SB(0, 1), b2 + hstepB, voffB);
            PG8_WAIT_V(6); PG8_BAR; PG8_MMA(1, 1, At, B1); PG8_BAR;
            PG8_LDB(B0, 1, 0); PG8_SCHED; PG8_LDA(At, 1, 0); PG8_STAGE(PG8_SA(0, 1), a2 + hstepA, voffA);
            PG8_WAIT_L(8); PG8_BAR; PG8_WAIT_L(0); PG8_MMA(0, 0, At, B0); PG8_BAR; PG8_SCHED;
            PG8_LDB(B1, 1, 1); PG8_STAGE(PG8_SB(1, 0), b3, voffB);
            PG8_BAR; PG8_WAIT_L(0); PG8_MMA(0, 1, At, B1); PG8_BAR;
            PG8_LDA(At, 1, 1); PG8_STAGE(PG8_SA(1, 0), a3, voffA);
            PG8_BAR; PG8_WAIT_L(0); PG8_MMA(1, 0, At, B0); PG8_BAR; PG8_SCHED;
            PG8_STAGE(PG8_SB(1, 1), b3 + hstepB, voffB);
            PG8_WAIT_V(6); PG8_BAR; PG8_MMA(1, 1, At, B1); PG8_BAR;
            }
        }
        if constexpr (ALIGN_EPI) { if (wr == 0) PG8_BAR; }
        if constexpr (!Epi::AFTER_DRAIN) { E(acc, cur, wr, wc, fr, fq); S.done(cur); }
        if (!has_next) break;
#pragma unroll
        for (int a = 0; a < 2; ++a)
#pragma unroll
            for (int b = 0; b < 2; ++b)
#pragma unroll
                for (int m = 0; m < 4; ++m)
#pragma unroll
                    for (int n = 0; n < 2; ++n) acc[a][b][m][n] = (f32x4){0.f, 0.f, 0.f, 0.f};
        cur = nxt; cA = nA; cB = nB; ++ui;
        if constexpr (ALIGN_EPI) { if (wr == 1) PG8_BAR; }
    }
    PG8_WAIT_V(0);
    if constexpr (!ALIGN_EPI) { if (wr == 0) PG8_BAR; }
    PG8_BAR;
#undef PG8_SA
#undef PG8_SB
#undef PG8_STAGE
#undef PG8_LDA
#undef PG8_LDB
#undef PG8_MMA
#undef PG8_WAIT_V
#undef PG8_WAIT_L
#undef PG8_BAR
#undef PG8_SCHED
}
}
#define PG8_SP2 true
#define PG8_ALIGN true

namespace att {
constexpr int D = 128, NW = 8, QBLK = 32, KVBLK = 64;
constexpr float SCALE = 0.088388347648318440f;
constexpr float THR = 8.f;
constexpr size_t SHM_V = KVBLK * D * 2, SHM_K = KVBLK * D * 2, SHM_ATTN = 2 * SHM_V + 2 * SHM_K + NW * 64 * 4;
#define KSWZ(row, colB) ((row) * 256 + ((colB) ^ (((row) & 7) << 4)))
#define SBAR() __builtin_amdgcn_sched_barrier(0)
DEV void partialSM(f32x16& p0, f32x16& p1, float& m_reg, float& mn, float& alpha) {
  constexpr float C = SCALE * 1.4426950408889634f;
  float pmax = p0[0]; for (int r = 1; r < 16; ++r) pmax = fmaxf(pmax, p0[r]); for (int r = 0; r < 16; ++r) pmax = fmaxf(pmax, p1[r]);
  { auto rr = __builtin_amdgcn_permlane32_swap(__float_as_uint(pmax), __float_as_uint(pmax), false, false);
    pmax = fmaxf(__uint_as_float(rr[0]), __uint_as_float(rr[1])); }
  if (__builtin_expect(__all(pmax - m_reg <= THR / SCALE), 1)) { mn = m_reg; alpha = 1.f; }
  else { mn = fmaxf(m_reg, pmax); alpha = __builtin_amdgcn_exp2f((m_reg - mn) * C); m_reg = mn; }
  float mnC = -mn * C;
  for (int r = 0; r < 16; ++r) p0[r] = fmaf(p0[r], C, mnC); for (int r = 0; r < 16; ++r) p1[r] = fmaf(p1[r], C, mnC);
  for (int r = 0; r < 16; ++r) p0[r] = __builtin_amdgcn_exp2f(p0[r]);
}
DEV void finishSM(f32x16& p0, f32x16& p1, float alpha, float& l_reg, bf16x8& pa0, bf16x8& pa1, bf16x8& pa2, bf16x8& pa3) {
  for (int r = 0; r < 16; ++r) p1[r] = __builtin_amdgcn_exp2f(p1[r]);
  float ps = 0; for (int r = 0; r < 16; ++r) ps += p0[r]; for (int r = 0; r < 16; ++r) ps += p1[r];
  { auto rr = __builtin_amdgcn_permlane32_swap(__float_as_uint(ps), __float_as_uint(ps), false, false);
    ps = __uint_as_float(rr[0]) + __uint_as_float(rr[1]); }
  l_reg = l_reg * alpha + ps;
#define PK4(P, BASE, OUT) do { unsigned a0 = pkbf(P[BASE + 0], P[BASE + 1]), a1 = pkbf(P[BASE + 2], P[BASE + 3]);   \
    unsigned b0 = pkbf(P[BASE + 4], P[BASE + 5]), b1 = pkbf(P[BASE + 6], P[BASE + 7]);                              \
    auto r0 = __builtin_amdgcn_permlane32_swap(a0, b0, false, false); auto r1 = __builtin_amdgcn_permlane32_swap(a1, b1, false, false); \
    u32x4 w = {r0[0], r1[0], r0[1], r1[1]}; OUT = __builtin_bit_cast(bf16x8, w); } while (0)
  PK4(p0, 0, pa0); PK4(p0, 8, pa1); PK4(p1, 0, pa2); PK4(p1, 8, pa3);
#undef PK4
}
DEV void qkt(f32x16& p0, f32x16& p1, const bf16* Ks, const bf16x8* qr, int r32, int hi) {
  p0 = f32x16{}; p1 = f32x16{};
  for (int d0 = 0; d0 < 8; ++d0) { int cb = (d0 * 16 + hi * 8) * 2;
    bf16x8 b0 = *reinterpret_cast<const bf16x8*>((const char*)Ks + KSWZ(r32, cb));
    bf16x8 b1 = *reinterpret_cast<const bf16x8*>((const char*)Ks + KSWZ(32 + r32, cb));
    p0 = __builtin_amdgcn_mfma_f32_32x32x16_bf16(b0, qr[d0], p0, 0, 0, 0);
    p1 = __builtin_amdgcn_mfma_f32_32x32x16_bf16(b1, qr[d0], p1, 0, 0, 0); }
}
DEV int v_st(int k, int c) { const int kk = (k & ~0xC) | ((k & 4) << 1) | ((k & 8) >> 1); return ((kk >> 3) * 4 + (c >> 5)) * 512 + ((kk & 7) * 32 + (c & 31)) * 2; }
DEV int v_rd_base(int lane) { return ((lane & 3) << 3) | (((lane >> 2) & 3) << 6) | (((lane >> 4) & 1) << 5) | (((lane >> 5) & 1) << 8); }
constexpr int v_rd_off(int d0, int ks, int half) { return d0 * 512 + ks * 4096 + half * 2048; }
template <int OFF> DEV s16x4 tr_read(int vb) {
  s16x4 r; asm volatile("ds_read_b64_tr_b16 %0, %1 offset:%2" : "=&v"(r) : "v"(vb), "i"(OFF) : "memory"); return r;
}
template <int D0> DEV void pv_one(f32x16& od, int vb, bf16x8 pa0, bf16x8 pa1, bf16x8 pa2, bf16x8 pa3) {
  const s16x4 l0 = tr_read<v_rd_off(D0, 0, 0)>(vb), h0 = tr_read<v_rd_off(D0, 0, 1)>(vb), l1 = tr_read<v_rd_off(D0, 1, 0)>(vb), h1 = tr_read<v_rd_off(D0, 1, 1)>(vb);
  const s16x4 l2 = tr_read<v_rd_off(D0, 2, 0)>(vb), h2 = tr_read<v_rd_off(D0, 2, 1)>(vb), l3 = tr_read<v_rd_off(D0, 3, 0)>(vb), h3 = tr_read<v_rd_off(D0, 3, 1)>(vb);
  asm volatile("s_waitcnt lgkmcnt(0)" ::: "memory"); SBAR();
#define PK(L, H) (bf16x8){L[0], L[1], L[2], L[3], H[0], H[1], H[2], H[3]}
  od = __builtin_amdgcn_mfma_f32_32x32x16_bf16(pa0, PK(l0, h0), od, 0, 0, 0);
  od = __builtin_amdgcn_mfma_f32_32x32x16_bf16(pa1, PK(l1, h1), od, 0, 0, 0);
  od = __builtin_amdgcn_mfma_f32_32x32x16_bf16(pa2, PK(l2, h2), od, 0, 0, 0);
  od = __builtin_amdgcn_mfma_f32_32x32x16_bf16(pa3, PK(l3, h3), od, 0, 0, 0);
#undef PK
}
DEV void pv_d0(f32x16* o, int vb, bf16x8 pa0, bf16x8 pa1, bf16x8 pa2, bf16x8 pa3) {
  pv_one<0>(o[0], vb, pa0, pa1, pa2, pa3); pv_one<1>(o[1], vb, pa0, pa1, pa2, pa3); pv_one<2>(o[2], vb, pa0, pa1, pa2, pa3); pv_one<3>(o[3], vb, pa0, pa1, pa2, pa3);
}
template <int LDQ, int LDK, int LDO>
DEV void attn_dense_body(const bf16* __restrict__ Qb, const bf16* __restrict__ Kh, const bf16* __restrict__ Vh, bf16* __restrict__ Ob, int seq, char* lds) {
  const int tid = threadIdx.x, wid = tid >> 6, lane = tid & 63, r32 = lane & 31, hi = lane >> 5;
  bf16* V_lds = (bf16*)lds; bf16* K_lds = (bf16*)(lds + 2 * SHM_V);
  float* ws = (float*)(lds + 2 * SHM_V + 2 * SHM_K) + wid * 64; float* li_l = ws; float* al_l = ws + 32;
  float m_reg = -1e30f, l_reg = 0; f32x16 o[4] = {}; bf16x8 qr[8];
  const bf16* Qw = Qb + (long)(wid * QBLK + r32) * LDQ + hi * 8;
#pragma unroll
  for (int d0 = 0; d0 < 8; ++d0) qr[d0] = *reinterpret_cast<const bf16x8*>(Qw + d0 * 16);
  const int sr = tid >> 4, sc = (tid & 15) * 8, vst0 = v_st(sr, sc), vst1 = v_st(32 + sr, sc);
  const int vb0 = (int)(uintptr_t)V_lds + v_rd_base(lane);
  struct { bf16x8 vs0, vs1, ks0, ks1; } sr_[2];
#define SLOAD(i, k0) do { sr_[i].vs0 = *reinterpret_cast<const bf16x8*>(&Vh[(long)((k0) + sr) * LDK + sc]); sr_[i].vs1 = *reinterpret_cast<const bf16x8*>(&Vh[(long)((k0) + 32 + sr) * LDK + sc]); \
    sr_[i].ks0 = *reinterpret_cast<const bf16x8*>(&Kh[(long)((k0) + sr) * LDK + sc]); sr_[i].ks1 = *reinterpret_cast<const bf16x8*>(&Kh[(long)((k0) + 32 + sr) * LDK + sc]); } while (0)
#define SWRITE(b, i) do { *(bf16x8*)((char*)V_lds + (b) * SHM_V + vst0) = sr_[i].vs0;          \
    *(bf16x8*)((char*)V_lds + (b) * SHM_V + vst1) = sr_[i].vs1; int kc = sc * 2;               \
    *(bf16x8*)((char*)K_lds + (b) * SHM_K + KSWZ(sr, kc)) = sr_[i].ks0;                       \
    *(bf16x8*)((char*)K_lds + (b) * SHM_K + KSWZ(32 + sr, kc)) = sr_[i].ks1; } while (0)
#define SWAIT() asm volatile("s_waitcnt vmcnt(4)" ::: "memory")
#define RESC(a) do { if (__any((a) < 1.f)) { if (hi == 0) al_l[r32] = (a); asm volatile("s_waitcnt lgkmcnt(0)" ::: "memory"); \
    for (int d = 0; d < 4; ++d) for (int r = 0; r < 16; ++r) o[d][r] *= al_l[crow(r, hi)]; } } while (0)
  f32x16 pA0, pA1, pB0, pB1; float mnA, mnB, alA, alB; bf16x8 pa0, pa1, pa2, pa3; const int NT = seq / KVBLK;
  constexpr int SE = 0, SO = 1;
  SLOAD(SE, 0); asm volatile("s_waitcnt vmcnt(0)" ::: "memory"); SWRITE(0, SE); __syncthreads();
  qkt(pA0, pA1, K_lds, qr, r32, hi); partialSM(pA0, pA1, m_reg, mnA, alA);
  SLOAD(SO, KVBLK); if (2 < NT) SLOAD(SE, 2 * KVBLK);
  SWAIT(); SWRITE(1, SO); __syncthreads();
  for (int j = 1; j + 1 < NT; j += 2) {
    SBAR(); qkt(pB0, pB1, (bf16*)((char*)K_lds + SHM_K), qr, r32, hi);
    finishSM(pA0, pA1, alA, l_reg, pa0, pa1, pa2, pa3); SBAR();
    SLOAD(SO, (j + 2) * KVBLK); SBAR();
    pv_d0(o, vb0, pa0, pa1, pa2, pa3); partialSM(pB0, pB1, m_reg, mnB, alB);
    __syncthreads(); SWAIT(); SWRITE(0, SE);
    RESC(alB); __syncthreads();
    SBAR(); qkt(pA0, pA1, K_lds, qr, r32, hi);
    finishSM(pB0, pB1, alB, l_reg, pa0, pa1, pa2, pa3); SBAR();
    if (j + 3 < NT) SLOAD(SE, (j + 3) * KVBLK); SBAR();
    pv_d0(o, vb0 + (int)SHM_V, pa0, pa1, pa2, pa3); partialSM(pA0, pA1, m_reg, mnA, alA);
    __syncthreads(); SWAIT(); SWRITE(1, SO);
    RESC(alA); __syncthreads();
  }
  SBAR(); qkt(pB0, pB1, (bf16*)((char*)K_lds + SHM_K), qr, r32, hi);
  finishSM(pA0, pA1, alA, l_reg, pa0, pa1, pa2, pa3); SBAR();
  pv_d0(o, vb0, pa0, pa1, pa2, pa3); partialSM(pB0, pB1, m_reg, mnB, alB);
  __syncthreads(); RESC(alB);
  finishSM(pB0, pB1, alB, l_reg, pa0, pa1, pa2, pa3); SBAR();
  pv_d0(o, vb0 + (int)SHM_V, pa0, pa1, pa2, pa3);
  if (hi == 0) li_l[r32] = l_reg; asm volatile("s_waitcnt lgkmcnt(0)" ::: "memory");
  float rli[16];
#pragma unroll
  for (int r = 0; r < 16; ++r) rli[r] = __builtin_amdgcn_rcpf(li_l[crow(r, hi)]);
  bf16* Ow = Ob + (long)(wid * QBLK) * LDO;
#pragma unroll
  for (int r = 0; r < 16; ++r) { int orow = crow(r, hi);
    for (int d0 = 0; d0 < 4; ++d0) Ow[(long)orow * LDO + d0 * 32 + r32] = f2bf(o[d0][r] * rli[r]); }
  __syncthreads();
#undef SLOAD
#undef SWRITE
#undef SWAIT
#undef RESC
}
#undef KSWZ
}

#define XB_TMO      128
#define XB_XCNT(j)  (256  + 64 * (j))
#define XB_XSUB(j)  (1280 + 64 * (j))
#define XB_XGEN(j)  (2304 + 64 * (j))
#define XB_TOP      3328
#define XB_TOPGEN   3392
#define XCD_BAR_WORDS 3456
#define XB_SPIN_CAP (1u << 18)
DEV unsigned xb_ld(unsigned* p)              { return __hip_atomic_load(p, __ATOMIC_RELAXED, __HIP_MEMORY_SCOPE_AGENT); }
DEV unsigned xb_add(unsigned* p, unsigned v) { return __hip_atomic_fetch_add(p, v, __ATOMIC_RELAXED, __HIP_MEMORY_SCOPE_AGENT); }
DEV unsigned xb_xcc_id() { return (unsigned)__builtin_amdgcn_s_getreg((3 << 11) | 20) & 0xFu; }
#define XB_SPIN(cond, bar) do { unsigned _sp = 0; while (cond) { __builtin_amdgcn_s_sleep(1); \
    if ((++_sp & 255u) == 0u) { if (xb_ld(&(bar)[XB_TMO])) break; if (_sp > XB_SPIN_CAP) { atomicAdd(&(bar)[XB_TMO], 1u); break; } } } } while (0)
struct XcdBarrier { unsigned* bar; unsigned x; volatile LAS unsigned* st; };
DEV XcdBarrier xcd_barrier_post(unsigned* bar, volatile LAS unsigned* st) {
    XcdBarrier b; b.bar = bar; b.x = xb_xcc_id(); b.st = st;
    if (threadIdx.x == 0) (void)xb_add(&bar[XB_XCNT(b.x)], 1u);
    return b;
}
DEV void xcd_barrier_complete(unsigned* bar, unsigned x, unsigned& nloc, unsigned& nx) {
    const unsigned G = gridDim.x * gridDim.y * gridDim.z;
    unsigned sum, cnt, mine, sp = 0u;
    for (;;) {
        sum = 0u; cnt = 0u; mine = 0u;
#pragma unroll
        for (unsigned j = 0; j < 16; ++j) { const unsigned c = xb_ld(&bar[XB_XCNT(j)]); sum += c; cnt += (c > 0u) ? 1u : 0u; mine = (j == x) ? c : mine; }
        if (sum == G) break;
        __builtin_amdgcn_s_sleep(1);
        if ((++sp & 255u) == 0u) { if (xb_ld(&bar[XB_TMO])) break; if (sp > XB_SPIN_CAP) { atomicAdd(&bar[XB_TMO], 1u); break; } }
    }
    nloc = mine > 0u ? mine : 1u; nx = cnt > 0u ? cnt : 1u;
}
DEV void xcd_barrier(const XcdBarrier& b) {
    asm volatile("s_waitcnt vmcnt(0)" ::: "memory");
    __syncthreads();
    if (threadIdx.x == 0) {
        unsigned* bar = b.bar;
        __builtin_amdgcn_s_waitcnt(0);
        unsigned nloc = b.st[0], nx = b.st[1];
        if (nloc == 0u) { xcd_barrier_complete(bar, b.x, nloc, nx); b.st[0] = nloc; b.st[1] = nx; }
        const unsigned old = xb_add(&bar[XB_XSUB(b.x)], 1u);
        const unsigned gen = old / nloc;
        if (old + 1u == (gen + 1u) * nloc) {
            __builtin_amdgcn_fence(__ATOMIC_RELEASE, "agent");
            asm volatile("s_waitcnt vmcnt(0)" ::: "memory");
            const unsigned og = xb_add(&bar[XB_TOP], 1u);
            const unsigned tg = og / nx;
            if (og + 1u == (tg + 1u) * nx) xb_add(&bar[XB_TOPGEN], 1u);
            else XB_SPIN(xb_ld(&bar[XB_TOPGEN]) == tg, bar);
            __builtin_amdgcn_fence(__ATOMIC_ACQUIRE, "agent");
            xb_add(&bar[XB_XGEN(b.x)], 1u);
            asm volatile("s_waitcnt vmcnt(0)" ::: "memory");
        } else {
            XB_SPIN(xb_ld(&bar[XB_XGEN(b.x)]) == gen, bar);
            __builtin_amdgcn_fence(__ATOMIC_ACQUIRE, "agent");
            asm volatile("s_waitcnt vmcnt(0)" ::: "memory");
        }
    }
    __syncthreads();
}

struct Args { const float* in[28]; float* out; unsigned char* ws; int ph_lo, ph_hi; };
enum { I_X = 0, I_C, I_CTX, I_CCTX, I_MODW, I_MODB, I_NPRE, I_NPOST, I_FG, I_FU, I_FD, I_EVIN, I_EVOUT, I_CONVW, I_CONVB, I_WA, I_BA, I_WX, I_BX, I_LAM, I_DECAY, I_GN,
       I_ODIN, I_ODOUT, I_POOLW, I_POOLS, I_QN, I_KN };
struct Frame {
    LAS unsigned char* lds; int tid, lane, wave, G, bid;
    const Args* a;
};
#define LDS_WAIT() asm volatile("s_waitcnt lgkmcnt(0)" ::: "memory")

DEV void transpose_item(const float* W, int K, int N, bf16* WT, int drow0, LAS float* scr, int kb, int nb, int lane) {
    const int k0 = 64 * kb, n0 = 32 * nb;
#pragma unroll 8
    for (int i = 0; i < 32; ++i) { const int kk = 2 * i + (lane >> 5); scr[kk * 33 + (lane & 31)] = W[(size_t)(k0 + kk) * N + n0 + (lane & 31)]; }
    LDS_WAIT(); asm volatile("" ::: "memory");
    const int c = lane & 7;
#pragma unroll
    for (int j = 0; j < 4; ++j) { const int n = (lane >> 3) + 8 * j; const LAS float* s = scr + (8 * c) * 33 + n;
        u32x4 o; o.x = pkbf(s[0 * 33], s[1 * 33]); o.y = pkbf(s[2 * 33], s[3 * 33]); o.z = pkbf(s[4 * 33], s[5 * 33]); o.w = pkbf(s[6 * 33], s[7 * 33]);
        *(u32x4*)(WT + (size_t)(drow0 + n) * K + k0 + 8 * c) = o; }
    LDS_WAIT(); asm volatile("" ::: "memory");
}
DEV void p0_prologue(const Frame& F) {
    const Args& A = *F.a; unsigned char* ws = A.ws;
    {
        LAS float* ssc = (LAS float*)F.lds;
        LAS float* red = (LAS float*)(F.lds + 40960);
        for (int i = F.tid; i < 5 * DM; i += 512) { const int r = i / DM, k = i % DM; const float v = (r < 4) ? A.in[I_C][r * DM + k] : A.in[I_CCTX][k]; ssc[i] = fsilu(v); }
        __syncthreads();
        float* MOD = (float*)(ws + WS_MOD);
        for (int it = F.bid; it < 288; it += F.G) {
            const int li = it / 144, col0 = (it % 144) * 128;
            const float* Wp = A.in[I_MODW] + (size_t)li * DM * 18432 + (size_t)(F.wave * 256) * 18432 + col0 + 2 * F.lane;
            f32x2 acc[5];
#pragma unroll
            for (int r = 0; r < 5; ++r) acc[r] = (f32x2){0.f, 0.f};
#pragma unroll 8
            for (int kk = 0; kk < 256; ++kk) { const f32x2 wv = *(const f32x2*)(Wp + (size_t)kk * 18432);
#pragma unroll
                for (int r = 0; r < 5; ++r) { const float s = ssc[r * DM + F.wave * 256 + kk]; acc[r] += wv * s; } }
#pragma unroll
            for (int r = 0; r < 5; ++r) { red[(F.wave * 5 + r) * 128 + 2 * F.lane] = acc[r].x; red[(F.wave * 5 + r) * 128 + 2 * F.lane + 1] = acc[r].y; }
            __syncthreads();
            for (int o = F.tid; o < 640; o += 512) { const int r = o >> 7, c = o & 127; float s = A.in[I_MODB][li * 18432 + col0 + c];
#pragma unroll
                for (int w = 0; w < 8; ++w) s += red[(w * 5 + r) * 128 + c];
                MOD[(size_t)(li * 5 + r) * 18432 + col0 + c] = s; }
            __syncthreads();
        }
    }
    {
        LAS float* scr = (LAS float*)(F.lds + F.wave * 16384);
        const int gw = F.bid * 8 + F.wave, NGW = F.G * 8;
        constexpr int I_FFN = 5632, N_FFN = 12 * I_FFN, I_EI = 32 * 192, I_EO = 32 * 64, I_OI = 32 * 96, I_OO = 32 * 64, I_SM = 8 * 36;
        constexpr int NITEMS = N_FFN + I_EI + I_EO + I_OI + I_OO + I_SM;
        for (int it = gw; it < NITEMS; it += NGW) {
            int r = it;
            if (r < N_FFN) { const int idx = r / I_FFN, item = r % I_FFN, lf = idx / 3, kind = idx % 3;
                if (kind < 2) { const float* W = A.in[kind == 0 ? I_FG : I_FU] + (size_t)lf * DM * DFF; const int nb = item % 176, kb = item / 176, n0 = 32 * nb;
                    transpose_item(W, DM, DFF, (bf16*)(ws + WS_WGU + (size_t)lf * 44 * MiB), 256 * (n0 / 128) + 128 * kind + (n0 % 128), scr, kb, nb, F.lane); }
                else { const float* W = A.in[I_FD] + (size_t)lf * DFF * DM; const int nb = item % 64, kb = item / 64;
                    transpose_item(W, DFF, DM, (bf16*)(ws + WS_WD + (size_t)lf * 22 * MiB), 32 * nb, scr, kb, nb, F.lane); }
                continue; }
            r -= N_FFN;
            if (r < I_EI) { const int nb = r % 192, kb = r / 192, n0 = 32 * nb, blk = n0 / 1024;
                const int dblk = (blk == 1) ? 5 : (blk == 5) ? 1 : blk;
                transpose_item(A.in[I_EVIN], DM, EVN, (bf16*)(ws + WS_WEVIN), dblk * 1024 + (n0 % 1024), scr, kb, nb, F.lane); continue; }
            r -= I_EI;
            if (r < I_EO) { const int nb = r % 64, kb = r / 64; transpose_item(A.in[I_EVOUT], DM, DM, (bf16*)(ws + WS_WEVOUT), 32 * nb, scr, kb, nb, F.lane); continue; }
            r -= I_EO;
            if (r < I_OI) { const int nb = r % 96, kb = r / 96; transpose_item(A.in[I_ODIN], DM, ODN, (bf16*)(ws + WS_WODIN), 32 * nb, scr, kb, nb, F.lane); continue; }
            r -= I_OI;
            if (r < I_OO) { const int nb = r % 64, kb = r / 64; transpose_item(A.in[I_ODOUT], DM, DM, (bf16*)(ws + WS_WODOUT), 32 * nb, scr, kb, nb, F.lane); continue; }
            r -= I_OO;
            { const int mat = r / 8, item = r % 8, nb = item % 4, kb = item / 4;
                const float* W; bf16* dst;
                if (mat < 16) { W = A.in[I_WA] + (size_t)mat * 16384; dst = (bf16*)(ws + WS_LRUW) + (size_t)mat * 16384; }
                else if (mat < 32) { W = A.in[I_WX] + (size_t)(mat - 16) * 16384; dst = (bf16*)(ws + WS_LRUW) + (size_t)mat * 16384; }
                else { W = A.in[I_POOLW] + (size_t)(mat - 32) * 16384; dst = (bf16*)(ws + WS_POOLW) + (size_t)(mat - 32) * 16384; }
                transpose_item(W, 128, 128, dst, 32 * nb, scr, kb, nb, F.lane); }
        }
    }
    {
        const int gt = F.bid * 512 + F.tid, NT = F.G * 512;
        float* c1 = (float*)(ws + WS_COS1); float* s1 = (float*)(ws + WS_SIN1); float* c2 = (float*)(ws + WS_COS2); float* s2 = (float*)(ws + WS_SIN2);
        for (int i = gt; i < SEQ * 128 + SEQ * 64; i += NT) {
            float pos, f; float* cd; float* sd;
            if (i < SEQ * 128) { const int t = i >> 7, k = i & 127; pos = (float)t; f = exp2f(-(float)k * (13.287712379549449f / 128.f)); cd = c1 + i; sd = s1 + i; }
            else { const int j = i - SEQ * 128, t = j >> 6, k = j & 63; pos = (k < 32) ? (float)(t >> 6) : (float)(t & 63); f = exp2f(-(float)(k & 31) * (13.287712379549449f / 32.f)); cd = c2 + j; sd = s2 + j; }
            const float ang = pos * f;
            double rev = (double)ang * 0.15915494309189535; rev -= __builtin_rint(rev);
            const float fr = (float)rev;
            *cd = __builtin_amdgcn_cosf(fr); *sd = __builtin_amdgcn_sinf(fr);
        }
    }
}

struct ResCfg { int has_res, has_next, li, sub, li2, sub2, nrows; float wres; const float* xold_l; const float* xold_c; float* xnew_l; float* xnew_c; };
DEV void res_rows(const Frame& F, const ResCfg& C, int m0, int cnt, int prow) {
    const Args& A = *F.a; const float* MOD = (const float*)(A.ws + WS_MOD); bf16* H = (bf16*)(A.ws + WS_H);
    f32x4 Ca[8], Cb[8], Cs[8];
    int e0 = 4 * F.lane; asm volatile("" : "+v"(e0));
    if (C.has_res) {
        const float* gate = MOD + (size_t)(C.li * 5 + prow) * 18432 + C.sub * 6144 + 4096; const float* gp = A.in[I_NPOST] + (C.li * 3 + C.sub) * DM;
#pragma unroll
        for (int j = 0; j < 8; ++j) Ca[j] = *(const f32x4*)(gate + 256 * j + e0) * *(const f32x4*)(gp + 256 * j + e0) * C.wres;
    }
    if (C.has_next) {
        const float* sh = MOD + (size_t)(C.li2 * 5 + prow) * 18432 + C.sub2 * 6144; const float* sc = sh + 2048; const float* gp = A.in[I_NPRE] + (C.li2 * 3 + C.sub2) * DM;
#pragma unroll
        for (int j = 0; j < 8; ++j) { Cb[j] = *(const f32x4*)(gp + 256 * j + e0) * (*(const f32x4*)(sc + 256 * j + e0) + 1.f); Cs[j] = *(const f32x4*)(sh + 256 * j + e0); }
    }
    for (int m = m0; m < m0 + cnt; ++m) {
        const float* xo = (m < ML) ? C.xold_l + (size_t)m * DM : C.xold_c + (size_t)(m - ML) * DM;
        f32x4 x[8];
#pragma unroll
        for (int j = 0; j < 8; ++j) x[j] = *(const f32x4*)(xo + 256 * j + e0);
        if (C.has_res) {
            u32x2 yv[8]; const bf16* yr = H + (size_t)m * DM;
#pragma unroll
            for (int j = 0; j < 8; ++j) yv[j] = *(const u32x2*)(yr + 256 * j + e0);
            float ss = 0.f;
#pragma unroll
            for (int j = 0; j < 8; ++j) { const float a = bflo(yv[j].x), b = bfhi(yv[j].x), c = bflo(yv[j].y), d = bfhi(yv[j].y); ss += (a * a + b * b) + (c * c + d * d); }
            const float rs = __builtin_amdgcn_rsqf(wave_sum(ss) * (1.f / DM) + EPS);
            float* xn = (m < ML) ? C.xnew_l + (size_t)m * DM : C.xnew_c + (size_t)(m - ML) * DM;
#pragma unroll
            for (int j = 0; j < 8; ++j) { const f32x4 yy = (f32x4){bflo(yv[j].x), bfhi(yv[j].x), bflo(yv[j].y), bfhi(yv[j].y)}; x[j] = x[j] + Ca[j] * (yy * rs); *(f32x4*)(xn + 256 * j + e0) = x[j]; }
        }
        if (C.has_next) {
            float ss = 0.f;
#pragma unroll
            for (int j = 0; j < 8; ++j) ss += (x[j].x * x[j].x + x[j].y * x[j].y) + (x[j].z * x[j].z + x[j].w * x[j].w);
            const float rs = __builtin_amdgcn_rsqf(wave_sum(ss) * (1.f / DM) + EPS);
            bf16* hr = H + (size_t)m * DM;
#pragma unroll
            for (int j = 0; j < 8; ++j) { const f32x4 h = x[j] * rs * Cb[j] + Cs[j]; u32x2 w; w.x = pkbf(h.x, h.y); w.y = pkbf(h.z, h.w); *(u32x2*)(hr + 256 * j + e0) = w; }
        }
    }
}
DEV void res_phase(const Frame& F, const ResCfg& C) {
    const int gw = F.bid * 8 + F.wave, NGW = F.G * 8;
    for (int blk = gw; blk < ML / 16; blk += NGW) res_rows(F, C, blk * 16, 16, (blk * 16) / SEQ);
    if (C.nrows > ML) {
        if (NGW >= 2 * MC) { if ((gw & 1) == 0 && (gw >> 1) < MC) res_rows(F, C, ML + (gw >> 1), 1, 4); }
        else { const int per = (MC + NGW - 1) / NGW, r0 = gw * per, cnt = (MC - r0) < per ? (MC - r0) : per; if (cnt > 0) res_rows(F, C, ML + r0, cnt, 4); }
    }
}

constexpr int LRU_UB = 0, LRU_UB_LD = 272, LRU_ARR = 17408, LRU_ARR_SZ = 32768;
DEV int lru_chunk_row0(int b, int ck) { return (ck < 4) ? ML + b * CTXL + 64 * ck : b * SEQ + 64 * (ck - 4); }
template <bool FINAL> DEV void lru_phase(const Frame& F) {
    const Args& A = *F.a; unsigned char* ws = A.ws; bf16* E = (bf16*)(ws + WS_E);
    const int tid = F.tid, lane = F.lane, wave = F.wave, r32 = lane & 31, hh = lane >> 5;
    LAS unsigned char* UB = F.lds + LRU_UB; LAS float* ARR = (LAS float*)(F.lds + LRU_ARR); LAS unsigned char* RS = F.lds + LRU_ARR;
    for (int it = F.bid; it < NB * 8 * NCH64; it += F.G) {
        const int ck = it % NCH64, bn = it / NCH64, n = bn & 7, b = bn >> 3;
        const int L = (ck < 4) ? CTXL : SEQ, p0 = (ck < 4) ? 64 * ck : 64 * (ck - 4), rowbase = (ck < 4) ? ML + b * CTXL : b * SEQ;
        for (int pc = tid; pc < 67 * 16; pc += 512) { const int rr = pc >> 4, c8 = pc & 15, pos = p0 - 2 + rr;
            u32x4 v = {0u, 0u, 0u, 0u}; if (pos >= 0 && pos < L) v = *(const u32x4*)(E + (size_t)(rowbase + pos) * EVN + EC_R + 128 * n + 8 * c8);
            *(LAS u32x4*)(RS + rr * 256 + c8 * 16) = v; }
        __syncthreads();
        for (int pc = tid; pc < 64 * 16; pc += 512) { const int tt = pc >> 4, c8 = pc & 15, ch = 128 * n + 8 * c8;
            float u[8];
#pragma unroll
            for (int i = 0; i < 8; ++i) u[i] = A.in[I_CONVB][ch + i];
#pragma unroll
            for (int k = 0; k < 4; ++k) { const u32x4 rv = *(const LAS u32x4*)(RS + (tt + k) * 256 + c8 * 16); const float* wk = A.in[I_CONVW] + k * 1024 + ch;
                u[0] += wk[0] * bflo(rv.x); u[1] += wk[1] * bfhi(rv.x); u[2] += wk[2] * bflo(rv.y); u[3] += wk[3] * bfhi(rv.y);
                u[4] += wk[4] * bflo(rv.z); u[5] += wk[5] * bfhi(rv.z); u[6] += wk[6] * bflo(rv.w); u[7] += wk[7] * bfhi(rv.w); }
            u32x4 o = {pkbf(u[0], u[1]), pkbf(u[2], u[3]), pkbf(u[4], u[5]), pkbf(u[6], u[7])};
            *(LAS u32x4*)(UB + tt * LRU_UB_LD + c8 * 16) = o; }
        __syncthreads();
        {
            const int d = wave >> 2, gk = (wave >> 1) & 1, chh = wave & 1;
            const bf16* WT = (const bf16*)(ws + WS_LRUW) + (size_t)(gk * 16 + d * 8 + n) * 16384;
            f32x16 acc[2][2];
#pragma unroll
            for (int i = 0; i < 2; ++i)
#pragma unroll
                for (int j = 0; j < 2; ++j) acc[i][j] = f32x16{};
#pragma unroll
            for (int ks = 0; ks < 8; ++ks) {
                bf16x8 af[2], bfr[2];
#pragma unroll
                for (int rt = 0; rt < 2; ++rt) af[rt] = *(const LAS bf16x8*)(UB + (32 * rt + r32) * LRU_UB_LD + (16 * ks + 8 * hh) * 2);
#pragma unroll
                for (int ct = 0; ct < 2; ++ct) bfr[ct] = *(const bf16x8*)(WT + (size_t)(64 * chh + 32 * ct + r32) * 128 + 16 * ks + 8 * hh);
#pragma unroll
                for (int rt = 0; rt < 2; ++rt)
#pragma unroll
                    for (int ct = 0; ct < 2; ++ct) acc[rt][ct] = __builtin_amdgcn_mfma_f32_32x32x16_bf16(af[rt], bfr[ct], acc[rt][ct], 0, 0, 0);
            }
            LAS float* OUT = ARR + (size_t)(d * 2 + gk) * (LRU_ARR_SZ / 4);
#pragma unroll
            for (int ct = 0; ct < 2; ++ct) { const int col = 64 * chh + 32 * ct + r32, chn = 128 * n + col;
                if (gk == 0) { const float ba = A.in[I_BA][d * 1024 + chn]; const float lam = A.in[I_LAM][d * 1024 + chn]; const float sp = log1pf(expf(-lam));
#pragma unroll
                    for (int rt = 0; rt < 2; ++rt)
#pragma unroll
                        for (int r = 0; r < 16; ++r) OUT[(32 * rt + crow(r, hh)) * 128 + col] = -8.f * fsigmoid(acc[rt][ct][r] + ba) * sp; }
                else { const float bx = A.in[I_BX][d * 1024 + chn];
#pragma unroll
                    for (int rt = 0; rt < 2; ++rt)
#pragma unroll
                        for (int r = 0; r < 16; ++r) { const int row = 32 * rt + crow(r, hh); const float uv = bf2f(*(const LAS bf16*)(UB + row * LRU_UB_LD + col * 2));
                            OUT[row * 128 + col] = fsigmoid(acc[rt][ct][r] + bx) * uv; } }
            }
        }
        __syncthreads();
        if (tid < 256) { const int d = tid >> 7, c = tid & 127; LAS float* LA = ARR + (size_t)(d * 2) * (LRU_ARR_SZ / 4); const LAS float* IU = LA + LRU_ARR_SZ / 4;
            const size_t gi = ((size_t)(ck * NB + b) * 2 + d) * 1024 + 128 * n + c;
            if (!FINAL) { float h = 0.f, sl = 0.f;
                for (int s = 0; s < 64; ++s) { const int tt = d ? 63 - s : s; const float la = LA[tt * 128 + c]; const float a = expf(la), mlt = sqrtf(-expm1f(2.f * la));
                    h = a * h + mlt * IU[tt * 128 + c]; sl += la; }
                ((f32x2*)(ws + WS_AGG))[gi] = (f32x2){expf(sl), h}; }
            else { float h = ((const float*)(ws + WS_CAR))[gi];
                for (int s = 0; s < 64; ++s) { const int tt = d ? 63 - s : s; const float la = LA[tt * 128 + c]; const float a = expf(la), mlt = sqrtf(-expm1f(2.f * la));
                    h = a * h + mlt * IU[tt * 128 + c]; LA[tt * 128 + c] = h; } }
        }
        __syncthreads();
        if (FINAL) {
            const LAS float* H0 = ARR; const LAS float* H1 = ARR + 2 * (LRU_ARR_SZ / 4);
            for (int pc = tid; pc < 64 * 16; pc += 512) { const int tt = pc >> 4, c8 = pc & 15;
                bf16* gp = E + (size_t)(rowbase + p0 + tt) * EVN + EC_G + 128 * n + 8 * c8; const u32x4 gv = *(const u32x4*)gp;
                float o[8]; const float g[8] = {bflo(gv.x), bfhi(gv.x), bflo(gv.y), bfhi(gv.y), bflo(gv.z), bfhi(gv.z), bflo(gv.w), bfhi(gv.w)};
#pragma unroll
                for (int i = 0; i < 8; ++i) o[i] = fgelu_tanh(g[i]) * (H0[tt * 128 + 8 * c8 + i] + H1[tt * 128 + 8 * c8 + i]);
                u32x4 w = {pkbf(o[0], o[1]), pkbf(o[2], o[3]), pkbf(o[4], o[5]), pkbf(o[6], o[7])}; *(u32x4*)gp = w; }
            __syncthreads();
        }
    }
}
DEV void lru_carry_phase(const Frame& F) {
    unsigned char* ws = F.a->ws; const f32x2* AGG = (const f32x2*)(ws + WS_AGG); float* CAR = (float*)(ws + WS_CAR);
    const int gw = F.bid * 8 + F.wave, NGW = F.G * 8;
    for (int it = gw; it < NB * 2 * 16; it += NGW) { const int cg = it & 15, d = (it >> 4) & 1, b = it >> 5;
        float h = 0.f;
#pragma unroll 12
        for (int idx = 0; idx < NCH64; ++idx) { const int ck = d ? (idx < 4 ? 3 - idx : NCH64 + 3 - idx) : idx;
            const size_t gi = ((size_t)(ck * NB + b) * 2 + d) * 1024 + 64 * cg + F.lane; const f32x2 v = AGG[gi]; CAR[gi] = h; h = v.x * h + v.y; }
    }
}

DEV int ret_chunk_row0(int b, int cid) { return (cid < 2) ? ML + b * CTXL + 128 * cid : b * SEQ + 128 * (cid - 2); }
DEV int ret_chain(int d, int idx) { return d ? (idx < 2 ? 1 - idx : NCH128 + 1 - idx) : idx; }
DEV float ret_logg(const Args& A, int d, int h) { const float lg = A.in[I_DECAY][d * 4 + h]; return -log1pf(expf(-lg)); }
constexpr int RET_LD = 528, RET_VLD = 80;
DEV void ret_state_phase(const Frame& F) {
    const Args& A = *F.a; unsigned char* ws = A.ws; const bf16* E = (const bf16*)(ws + WS_E); bf16* SB = (bf16*)(ws + WS_SBUF);
    const int tid = F.tid, lane = F.lane, wave = F.wave, r32 = lane & 31, hh = lane >> 5;
    LAS unsigned char* KS = F.lds; LAS unsigned char* VS = F.lds + 128 * RET_LD;
    for (int it = F.bid; it < 256; it += F.G) {
        const int es = it & 7, d = (it >> 3) & 1, h = (it >> 4) & 3, b = it >> 6;
        const float lg = ret_logg(A, d, h), sdec = expf(lg * 128.f);
        const int vrow = tid >> 2, vc4 = tid & 3; const float vw = expf(lg * (float)(d ? vrow : 127 - vrow));
        u32x4 kreg[8], vreg;
        f32x16 acc = f32x16{};
#define RS_LOAD(cid_) do { const int m0_ = ret_chunk_row0(b, cid_); \
            _Pragma("unroll") for (int i = 0; i < 8; ++i) { const int id = tid + 512 * i, row = id >> 5, c16 = id & 31; kreg[i] = *(const u32x4*)(E + (size_t)(m0_ + row) * EVN + EC_K + 256 * h + 8 * c16); } \
            vreg = *(const u32x4*)(E + (size_t)(m0_ + vrow) * EVN + EC_V + 256 * h + 32 * es + 8 * vc4); } while (0)
        RS_LOAD(ret_chain(d, 0));
        for (int idx = 0; idx < NCH128; ++idx) {
            const int cid = ret_chain(d, idx);
#pragma unroll
            for (int i = 0; i < 8; ++i) { const int id = tid + 512 * i, row = id >> 5, c16 = id & 31; *(LAS u32x4*)(KS + row * RET_LD + c16 * 16) = kreg[i]; }
            { u32x4 w; w.x = pkbf(bflo(vreg.x) * vw, bfhi(vreg.x) * vw); w.y = pkbf(bflo(vreg.y) * vw, bfhi(vreg.y) * vw); w.z = pkbf(bflo(vreg.z) * vw, bfhi(vreg.z) * vw); w.w = pkbf(bflo(vreg.w) * vw, bfhi(vreg.w) * vw);
              *(LAS u32x4*)(VS + vrow * RET_VLD + vc4 * 16) = w; }
            __syncthreads();
            if (idx + 1 < NCH128) RS_LOAD(ret_chain(d, idx + 1));
            { bf16* sp = SB + ((size_t)(((b * 4 + h) * 2 + d) * NCH128 + cid) * 256 + 32 * es + r32) * 256 + 32 * wave + 4 * hh;
#pragma unroll
              for (int g = 0; g < 4; ++g) { u32x2 w; w.x = pkbf(acc[4 * g], acc[4 * g + 1]); w.y = pkbf(acc[4 * g + 2], acc[4 * g + 3]); *(u32x2*)(sp + 8 * g) = w; } }
#pragma unroll
            for (int r = 0; r < 16; ++r) acc[r] *= sdec;
#pragma unroll
            for (int ks = 0; ks < 8; ++ks) { const bf16x8 af = tr_frag(KS, RET_LD, 16 * ks, 32 * wave, lane); const bf16x8 bfr = tr_frag(VS, RET_VLD, 16 * ks, 0, lane);
                acc = __builtin_amdgcn_mfma_f32_32x32x16_bf16(af, bfr, acc, 0, 0, 0); }
            __syncthreads();
        }
#undef RS_LOAD
    }
}
DEV void ret_out_phase(const Frame& F) {
    const Args& A = *F.a; unsigned char* ws = A.ws; bf16* E = (bf16*)(ws + WS_E); const bf16* SB = (const bf16*)(ws + WS_SBUF);
    const int tid = F.tid, wave = F.wave, ib = wave & 3, eh = wave >> 2;
    LAS unsigned char* KS = F.lds; LAS unsigned char* VS = F.lds + 128 * RET_LD; LAS float* GX = (LAS float*)(F.lds + 2 * 128 * RET_LD);
    for (int it = F.bid; it < 16 * NCH128; it += F.G) {
        int lane = F.lane; asm volatile("" : "+v"(lane));
        const int r32 = lane & 31, hh = lane >> 5;
        const int cid = it % NCH128, bh = it / NCH128, h = bh & 3, b = bh >> 2, m0 = ret_chunk_row0(b, cid);
        const float lg0 = ret_logg(A, 0, h), lg1 = ret_logg(A, 1, h);
#pragma unroll
        for (int i = 0; i < 8; ++i) { const int id = tid + 512 * i, row = id >> 5, c16 = id & 31;
            *(LAS u32x4*)(KS + row * RET_LD + c16 * 16) = *(const u32x4*)(E + (size_t)(m0 + row) * EVN + EC_K + 256 * h + 8 * c16);
            *(LAS u32x4*)(VS + row * RET_LD + c16 * 16) = *(const u32x4*)(E + (size_t)(m0 + row) * EVN + EC_V + 256 * h + 8 * c16); }
        const bf16* qp = E + (size_t)(m0 + 32 * ib + r32) * EVN + EC_Q + 256 * h + 8 * hh;
        __syncthreads();
        f32x16 o[4];
#pragma unroll
        for (int d = 0; d < 2; ++d) {
            const bf16* sp = SB + ((size_t)((bh * 2 + d) * NCH128 + cid) * 256 + 128 * eh + r32) * 256 + 8 * hh;
            f32x16 T[4];
#pragma unroll
            for (int et = 0; et < 4; ++et) T[et] = f32x16{};
#pragma unroll 2
            for (int ks = 0; ks < 16; ++ks) { const bf16x8 qf = *(const bf16x8*)(qp + 16 * ks);
#pragma unroll
                for (int et = 0; et < 4; ++et) { const bf16x8 bfr = *(const bf16x8*)(sp + (size_t)(32 * et) * 256 + 16 * ks); T[et] = __builtin_amdgcn_mfma_f32_32x32x16_bf16(qf, bfr, T[et], 0, 0, 0); } }
#pragma unroll
            for (int r = 0; r < 16; ++r) { const int i = 32 * ib + crow(r, hh); const float rs = d ? fexp(lg1 * (float)(128 - i)) : fexp(lg0 * (float)(i + 1));
#pragma unroll
                for (int et = 0; et < 4; ++et) o[et][r] = d ? o[et][r] + T[et][r] * rs : T[et][r] * rs; }
        }
        { const int i = 32 * ib + r32;
#pragma unroll 1
          for (int jt = 0; jt < 4; ++jt) {
            f32x16 X = f32x16{};
#pragma unroll 4
            for (int ks = 0; ks < 16; ++ks) { const bf16x8 af = *(const LAS bf16x8*)(KS + (32 * jt + r32) * RET_LD + (16 * ks + 8 * hh) * 2); const bf16x8 qf = *(const bf16x8*)(qp + 16 * ks); X = __builtin_amdgcn_mfma_f32_32x32x16_bf16(af, qf, X, 0, 0, 0); }
            float pv[16];
#pragma unroll
            for (int r = 0; r < 16; ++r) { const int j = 32 * jt + crow(r, hh); const int dl = i - j; const float f = (dl > 0) ? fexp(lg0 * (float)dl) : (dl < 0) ? fexp(-lg1 * (float)dl) : 2.f; pv[r] = X[r] * f; }
#pragma unroll
            for (int s = 0; s < 2; ++s) { const bf16x8 pa = pack8(pv + 8 * s);
                const int q = (lane & 15) >> 2, p = lane & 3, blk = (lane >> 4) & 1;
                const LAS unsigned char* vb = VS + (32 * jt + 16 * s + 4 * hh + q) * RET_LD + (128 * eh + 16 * blk + 4 * p) * 2;
#pragma unroll
                for (int et = 0; et < 4; ++et) { const s16x4 lo = ds_tr(vb + et * 64), hi = ds_tr(vb + et * 64 + 8 * RET_LD);
                    const bf16x8 bfr = (bf16x8){lo[0], lo[1], lo[2], lo[3], hi[0], hi[1], hi[2], hi[3]};
                    o[et] = __builtin_amdgcn_mfma_f32_32x32x16_bf16(pa, bfr, o[et], 0, 0, 0); } }
          } }
#pragma unroll
        for (int r = 0; r < 16; ++r) { float a = 0.f, q = 0.f;
#pragma unroll
            for (int et = 0; et < 4; ++et) { a += o[et][r]; q += o[et][r] * o[et][r]; }
#pragma unroll
            for (int off = 1; off < 32; off <<= 1) { a += __shfl_xor(a, off); q += __shfl_xor(q, off); }
            if (r32 == 0) { GX[(wave * 32 + crow(r, hh)) * 2] = a; GX[(wave * 32 + crow(r, hh)) * 2 + 1] = q; } }
        __syncthreads();
        { const float* gn = A.in[I_GN] + 256 * h + 128 * eh;
#pragma unroll
          for (int r = 0; r < 16; ++r) { const int rw = crow(r, hh); const float a = GX[(wave * 32 + rw) * 2] + GX[((wave ^ 4) * 32 + rw) * 2], q = GX[(wave * 32 + rw) * 2 + 1] + GX[((wave ^ 4) * 32 + rw) * 2 + 1];
            const float mean = a * (1.f / 256.f), var = q * (1.f / 256.f) - mean * mean, rstd = __builtin_amdgcn_rsqf(var + EPS);
            bf16* op = E + (size_t)(m0 + 32 * ib + rw) * EVN + EC_O + 256 * h + 128 * eh + r32;
#pragma unroll
            for (int et = 0; et < 4; ++et) { const float og = bf2f(op[32 * et]); op[32 * et] = f2bf((o[et][r] - mean) * rstd * gn[32 * et + r32] * fsilu(og)); } } }
        __syncthreads();
    }
}

DEV void odd_post_phase(const Frame& F) {
    const Args& A = *F.a; unsigned char* ws = A.ws; const bf16* E2 = (const bf16*)(ws + WS_E2);
    bf16* QB = (bf16*)(ws + WS_QB); bf16* KB = (bf16*)(ws + WS_KB); bf16* VB = (bf16*)(ws + WS_VB); bf16* MIX = (bf16*)(ws + WS_MIX2);
    const float* c2 = (const float*)(ws + WS_COS2); const float* s2 = (const float*)(ws + WS_SIN2);
    const int tid = F.tid, wave = F.wave;
    {
        const int gw = F.bid * 8 + F.wave, NGW = F.G * 8; const int lane0 = F.lane;
        const float qg1 = A.in[I_QN][lane0], qg2 = A.in[I_QN][64 + lane0], kg1 = A.in[I_KN][lane0], kg2 = A.in[I_KN][64 + lane0];
        for (int m = gw; m < MT; m += NGW) {
            int lane = F.lane; asm volatile("" : "+v"(lane));
            const bool lat = m < ML; const int b = lat ? m / SEQ : (m - ML) / CTXL, t = lat ? m % SEQ : 0, kpos = lat ? CTXL + t : (m - ML) % CTXL;
            const bf16* er = E2 + (size_t)m * ODN;
            float cs = 1.f, sn = 0.f; if (lat) { cs = c2[t * 64 + lane]; sn = s2[t * 64 + lane]; }
            if (lat) {
#pragma unroll 4
                for (int hq = 0; hq < 12; ++hq) { const float x1 = bf2f(er[512 + 128 * hq + lane]), x2 = bf2f(er[512 + 128 * hq + 64 + lane]);
                    const float rs = __builtin_amdgcn_rsqf(wave_sum(x1 * x1 + x2 * x2) * (1.f / 128.f) + EPS); const float y1 = x1 * rs * qg1, y2 = x2 * rs * qg2;
                    bf16* qo = QB + (size_t)m * 1536 + 128 * hq; qo[lane] = f2bf(y1 * cs - y2 * sn); qo[64 + lane] = f2bf(y1 * sn + y2 * cs); }
            }
            bf16* ko = KB + ((size_t)b * KVL + kpos) * 512; bf16* vo = VB + ((size_t)b * KVL + kpos) * 512;
#pragma unroll
            for (int hk = 0; hk < 4; ++hk) { const float x1 = bf2f(er[2048 + 128 * hk + lane]), x2 = bf2f(er[2048 + 128 * hk + 64 + lane]);
                const float rs = __builtin_amdgcn_rsqf(wave_sum(x1 * x1 + x2 * x2) * (1.f / 128.f) + EPS); const float y1 = x1 * rs * kg1, y2 = x2 * rs * kg2;
                ko[128 * hk + lane] = f2bf(y1 * cs - y2 * sn); ko[128 * hk + 64 + lane] = f2bf(y1 * sn + y2 * cs); }
            *(u32x4*)(vo + 8 * lane) = *(const u32x4*)(er + 2560 + 8 * lane);
        }
    }
    {
        const int lane = F.lane, r32 = lane & 31, hh = lane >> 5;
        LAS unsigned char* XS = F.lds; LAS unsigned char* DS = F.lds + 144 * 256; constexpr int DLD = 272;
        for (int it = F.bid; it < (ML / 128) * 4; it += F.G) {
            const int gi = it & 3, rt = it >> 2, b = (rt * 128) / SEQ, t0 = (rt * 128) % SEQ, half = 1 << gi;
            __syncthreads();
            for (int pc = tid; pc < 144 * 16; pc += 512) { const int rr = pc >> 4, c8 = pc & 15, pos = t0 - 8 + rr;
                u32x4 v = {0u, 0u, 0u, 0u}; if (pos >= 0 && pos < SEQ) v = *(const u32x4*)(E2 + (size_t)(b * SEQ + pos) * ODN + 128 * gi + 8 * c8);
                *(LAS u32x4*)(XS + rr * 256 + c8 * 16) = v; }
            __syncthreads();
            for (int pc = tid; pc < 128 * 16; pc += 512) { const int tt = pc >> 4, c8 = pc & 15, t = t0 + tt;
                const int lo = (t - half) < 0 ? 0 : t - half, hi = (t + half) > SEQ ? SEQ : t + half; const float inv = 1.f / (float)(hi - lo);
                float s[8] = {0.f, 0.f, 0.f, 0.f, 0.f, 0.f, 0.f, 0.f};
                for (int p = lo; p < hi; ++p) { const u32x4 v = *(const LAS u32x4*)(XS + (p - t0 + 8) * 256 + c8 * 16);
                    s[0] += bflo(v.x); s[1] += bfhi(v.x); s[2] += bflo(v.y); s[3] += bfhi(v.y); s[4] += bflo(v.z); s[5] += bfhi(v.z); s[6] += bflo(v.w); s[7] += bfhi(v.w); }
                const u32x4 xv = *(const LAS u32x4*)(XS + (tt + 8) * 256 + c8 * 16);
                u32x4 o; o.x = pkbf(s[0] * inv - bflo(xv.x), s[1] * inv - bfhi(xv.x)); o.y = pkbf(s[2] * inv - bflo(xv.y), s[3] * inv - bfhi(xv.y));
                o.z = pkbf(s[4] * inv - bflo(xv.z), s[5] * inv - bfhi(xv.z)); o.w = pkbf(s[6] * inv - bflo(xv.w), s[7] * inv - bfhi(xv.w));
                *(LAS u32x4*)(DS + tt * DLD + c8 * 16) = o; }
            __syncthreads();
            { const int rb = wave & 3, chh = wave >> 2; const bf16* WT = (const bf16*)(ws + WS_POOLW) + (size_t)gi * 16384;
              f32x16 acc[2] = {f32x16{}, f32x16{}};
#pragma unroll
              for (int ks = 0; ks < 8; ++ks) { const bf16x8 af = *(const LAS bf16x8*)(DS + (32 * rb + r32) * DLD + (16 * ks + 8 * hh) * 2);
#pragma unroll
                  for (int ct = 0; ct < 2; ++ct) { const bf16x8 bfr = *(const bf16x8*)(WT + (size_t)(64 * chh + 32 * ct + r32) * 128 + 16 * ks + 8 * hh);
                      acc[ct] = __builtin_amdgcn_mfma_f32_32x32x16_bf16(af, bfr, acc[ct], 0, 0, 0); } }
#pragma unroll
              for (int ct = 0; ct < 2; ++ct) { const int col = 128 * gi + 64 * chh + 32 * ct + r32; const float ps = A.in[I_POOLS][col];
#pragma unroll
                  for (int r = 0; r < 16; ++r) MIX[(size_t)(b * SEQ + t0 + 32 * rb + crow(r, hh)) * DM + col] = f2bf(acc[ct][r] * ps); } }
        }
        __syncthreads();
    }
}
DEV void attn_phase(const Frame& F) {
    unsigned char* ws = F.a->ws; const bf16* QB = (const bf16*)(ws + WS_QB); const bf16* KB = (const bf16*)(ws + WS_KB); const bf16* VB = (const bf16*)(ws + WS_VB); bf16* MIX = (bf16*)(ws + WS_MIX2);
    for (int u = F.bid; u < NB * 12 * (SEQ / 256); u += F.G) {
        const int qb = u & 31, g = (u >> 5) % 3, kvh = ((u >> 5) / 3) & 3, b = (u >> 5) / 12, hq = kvh * 3 + g;
        att::attn_dense_body<1536, 512, DM>(QB + (size_t)(b * SEQ + 256 * qb) * 1536 + 128 * hq, KB + (size_t)b * KVL * 512 + 128 * kvh, VB + (size_t)b * KVL * 512 + 128 * kvh,
                                           MIX + (size_t)(b * SEQ + 256 * qb) * DM + 512 + 128 * hq, KVL, (char*)F.lds);
    }
}

constexpr int NPH = 25;
__global__ void __launch_bounds__(512, 2) mk_fwd(Args args) {
    extern __shared__ __attribute__((aligned(16))) unsigned char lds_raw[];
    Frame F; F.lds = (LAS unsigned char*)lds_raw; F.tid = threadIdx.x; F.lane = F.tid & 63; F.wave = __builtin_amdgcn_readfirstlane(F.tid >> 6); F.G = gridDim.x; F.bid = blockIdx.x; F.a = &args;
    unsigned char* ws = args.ws;
    volatile LAS unsigned* MISC = (volatile LAS unsigned*)(F.lds + MISC_OFF);
    if (F.tid < 64) MISC[F.tid] = 0u;
    __syncthreads();
    XcdBarrier bar; bar.bar = (unsigned*)(ws + WS_CTL) + CW_BAR; bar.x = 0; bar.st = nullptr;
    const int lo = args.ph_lo, hi = args.ph_hi;
    if (hi - lo > 1) bar = xcd_barrier_post((unsigned*)(ws + WS_CTL) + CW_BAR, MISC + 8);
#ifndef MK_MASK
#define MK_MASK 0xFFFFFFFFu
#endif
#define IN(k) (((MK_MASK >> (k)) & 1u) && lo <= (k) && (k) < hi && (k) <= MK_STOP_AFTER)
#define SEAM(k) do { if (IN(k) && (k) + 1 < hi) xcd_barrier(bar); } while (0)
    bf16* H = (bf16*)(ws + WS_H); bf16* ACT = (bf16*)(ws + WS_ACT); bf16* E = (bf16*)(ws + WS_E); bf16* E2 = (bf16*)(ws + WS_E2); bf16* MIX2 = (bf16*)(ws + WS_MIX2);
    float* XC = (float*)(ws + WS_XC);
#define GEMM_GU(lf, M_) do { pg8::Gemm g{H, (const bf16*)(ws + WS_WGU + (size_t)(lf) * 44 * MiB), (M_), 2 * DFF, DM, DM}; pg8::StaticOrder S; S.init((M_), 2 * DFF, F.G, F.bid); \
        pg8::EpiSwiGLU Ep{ACT, DFF}; pg8::gemm_phase<pg8::EpiSwiGLU, pg8::StaticOrder, PG8_ALIGN, PG8_SP2>(F.lds, g, S, Ep); } while (0)
#define GEMM_DN(lf, M_) do { pg8::Gemm g{ACT, (const bf16*)(ws + WS_WD + (size_t)(lf) * 22 * MiB), (M_), DM, DFF, DFF}; pg8::StaticOrder S; S.init((M_), DM, F.G, F.bid); \
        pg8::EpiPlain Ep{H, DM}; pg8::gemm_phase<pg8::EpiPlain, pg8::StaticOrder, PG8_ALIGN, PG8_SP2>(F.lds, g, S, Ep); } while (0)
#define RES(hr, hn, li_, sub_, li2_, sub2_, nrows_, w_, xol, xoc) do { ResCfg C{(hr), (hn), (li_), (sub_), (li2_), (sub2_), (nrows_), (w_), (xol), (xoc), args.out, XC}; res_phase(F, C); } while (0)

    if (IN(0)) p0_prologue(F);
    SEAM(0);
    if (IN(1)) RES(0, 1, 0, 0, 0, 0, MT, 0.f, args.in[I_X], args.in[I_CTX]);
    SEAM(1);
    if (IN(2)) GEMM_GU(0, MT);
    SEAM(2);
    if (IN(3)) GEMM_DN(0, MT);
    SEAM(3);
    if (IN(4)) RES(1, 1, 0, 0, 0, 1, MT, 0.5f, args.in[I_X], args.in[I_CTX]);
    SEAM(4);
    if (IN(5)) { pg8::Gemm g{H, (const bf16*)(ws + WS_WEVIN), MT, EVN, DM, DM}; pg8::StaticOrder S; S.init(MT, EVN, F.G, F.bid);
        pg8::EpiEvIn Ep{E, (const float*)(ws + WS_COS1), (const float*)(ws + WS_SIN1)}; pg8::gemm_phase<pg8::EpiEvIn, pg8::StaticOrder, PG8_ALIGN, PG8_SP2>(F.lds, g, S, Ep); }
    SEAM(5);
    if (IN(6)) lru_phase<false>(F);
    SEAM(6);
    if (IN(7)) { lru_carry_phase(F); ret_state_phase(F); }
    SEAM(7);
#ifndef MK_P8
#define MK_P8 3
#endif
    if (IN(8)) { if (MK_P8 & 1) lru_phase<true>(F); if (MK_P8 & 2) ret_out_phase(F); }
    SEAM(8);
    if (IN(9)) { pg8::Gemm g{E, (const bf16*)(ws + WS_WEVOUT), MT, DM, DM, EVN}; pg8::StaticOrder S; S.init(MT, DM, F.G, F.bid);
        pg8::EpiPlain Ep{H, DM}; pg8::gemm_phase<pg8::EpiPlain, pg8::StaticOrder, PG8_ALIGN, PG8_SP2>(F.lds, g, S, Ep); }
    SEAM(9);
    if (IN(10)) RES(1, 1, 0, 1, 0, 2, MT, 1.0f, args.out, XC);
    SEAM(10);
    if (IN(11)) GEMM_GU(1, MT);
    SEAM(11);
    if (IN(12)) GEMM_DN(1, MT);
    SEAM(12);
    if (IN(13)) RES(1, 1, 0, 2, 1, 0, MT, 0.5f, args.out, XC);
    SEAM(13);
    if (IN(14)) GEMM_GU(2, MT);
    SEAM(14);
    if (IN(15)) GEMM_DN(2, MT);
    SEAM(15);
    if (IN(16)) RES(1, 1, 1, 0, 1, 1, MT, 0.5f, args.out, XC);
    SEAM(16);
    if (IN(17)) { pg8::Gemm g{H, (const bf16*)(ws + WS_WODIN), MT, ODN, DM, DM}; pg8::StaticOrder S; S.init(MT, ODN, F.G, F.bid);
        pg8::EpiPlain Ep{E2, ODN}; pg8::gemm_phase<pg8::EpiPlain, pg8::StaticOrder, PG8_ALIGN, PG8_SP2>(F.lds, g, S, Ep); }
    SEAM(17);
    if (IN(18)) odd_post_phase(F);
    SEAM(18);
    if (IN(19)) attn_phase(F);
    SEAM(19);
    if (IN(20)) { pg8::Gemm g{MIX2, (const bf16*)(ws + WS_WODOUT), ML, DM, DM, DM}; pg8::StaticOrder S; S.init(ML, DM, F.G, F.bid);
        pg8::EpiPlain Ep{H, DM}; pg8::gemm_phase<pg8::EpiPlain, pg8::StaticOrder, PG8_ALIGN, PG8_SP2>(F.lds, g, S, Ep); }
    SEAM(20);
    if (IN(21)) RES(1, 1, 1, 1, 1, 2, ML, 1.0f, args.out, XC);
    SEAM(21);
    if (IN(22)) GEMM_GU(3, ML);
    SEAM(22);
    if (IN(23)) GEMM_DN(3, ML);
    SEAM(23);
    if (IN(24)) RES(1, 0, 1, 2, 0, 0, ML, 0.5f, args.out, XC);
#undef IN
#undef SEAM
}

extern "C" void kernel_launch(void* const* d_in, const int* in_sizes, int n_in, void* d_out, int out_size, void* d_ws, size_t ws_size, hipStream_t stream) {
    static int grid = 0;
    if (grid == 0) {
        if (n_in != 28 || out_size != ML * DM || ws_size < WS_END) { fprintf(stderr, "kernel_launch: unexpected shapes (n_in %d out %d ws %zu, need ws >= %zu)\n", n_in, out_size, ws_size, (size_t)WS_END); grid = -1; return; }
        int dev = 0, cus = 0, per_cu = 0;
        if (hipGetDevice(&dev) != hipSuccess || hipDeviceGetAttribute(&cus, hipDeviceAttributeMultiprocessorCount, dev) != hipSuccess) { grid = -1; return; }
        if (hipFuncSetAttribute((const void*)mk_fwd, hipFuncAttributeMaxDynamicSharedMemorySize, LDS_BYTES) != hipSuccess) { fprintf(stderr, "kernel_launch: hipFuncSetAttribute failed\n"); grid = -1; return; }
        if (hipOccupancyMaxActiveBlocksPerMultiprocessor(&per_cu, (const void*)mk_fwd, 512, LDS_BYTES) != hipSuccess || per_cu < 1) fprintf(stderr, "kernel_launch: occupancy query says %d\n", per_cu);
        (void)hipGetLastError();
        grid = cus;
    }
    if (grid < 0) return;
    (void)hipMemsetAsync((char*)d_ws + WS_CTL, 0, CTL_ZERO_BYTES, stream);
    Args a{};
    for (int i = 0; i < 28; ++i) a.in[i] = (const float*)d_in[i];
    a.out = (float*)d_out; a.ws = (unsigned char*)d_ws;
#if MK_N_LAUNCHES == 1
    a.ph_lo = 0; a.ph_hi = NPH;
    hipLaunchKernelGGL(mk_fwd, dim3(grid), dim3(512), LDS_BYTES, stream, a);
#else
    for (int p = 0; p < NPH && p <= MK_STOP_AFTER; ++p) { a.ph_lo = p; a.ph_hi = p + 1; hipLaunchKernelGGL(mk_fwd, dim3(grid), dim3(512), LDS_BYTES, stream, a); }
#endif
    const hipError_t le = hipPeekAtLastError();
    if (le != hipSuccess) fprintf(stderr, "kernel_launch: launch failed: %s\n", hipGetErrorName(le));
}
```

```cpp
#include <hip/hip_runtime.h>
#include <cstdio>
#include <cstdint>

#ifndef MK_N_LAUNCHES
#define MK_N_LAUNCHES 1
#endif
#ifndef MK_STOP_AFTER
#define MK_STOP_AFTER 1000
#endif

#define DEV __device__ __forceinline__
#define LAS __attribute__((address_space(3)))
typedef unsigned short bf16;
typedef float f32x4 __attribute__((ext_vector_type(4)));
typedef float f32x2 __attribute__((ext_vector_type(2)));
typedef float f32x16 __attribute__((ext_vector_type(16)));
typedef short bf16x8 __attribute__((ext_vector_type(8)));
typedef short s16x4 __attribute__((ext_vector_type(4)));
typedef unsigned u32x4 __attribute__((ext_vector_type(4)));
typedef unsigned u32x2 __attribute__((ext_vector_type(2)));

constexpr int NB = 4, SEQ = 8192, DM = 2048, CTXL = 256, DFF = 5632;
constexpr int ML = NB * SEQ, MC = NB * CTXL, MT = ML + MC;
constexpr float EPS = 1e-6f;
constexpr int EVN = 6144, ODN = 3072;
constexpr int EC_G = 0, EC_O = 1024, EC_Q = 2048, EC_K = 3072, EC_V = 4096, EC_R = 5120;
constexpr int NCH64 = (CTXL + SEQ) / 64;
constexpr int NCH128 = (CTXL + SEQ) / 128;
constexpr int KVL = CTXL + SEQ;

constexpr size_t MiB = 1u << 20;
constexpr size_t WS_CTL = 0, CTL_ZERO_BYTES = 1 * MiB;
constexpr size_t WS_MOD = 1 * MiB;
constexpr size_t WS_COS1 = 2 * MiB, WS_SIN1 = 6 * MiB;
constexpr size_t WS_COS2 = 10 * MiB, WS_SIN2 = 12 * MiB;
constexpr size_t WS_LRUW = 14 * MiB;
constexpr size_t WS_POOLW = 15 * MiB;
constexpr size_t WS_AGG = 16 * MiB;
constexpr size_t WS_CAR = 25 * MiB;
constexpr size_t WS_XC = 30 * MiB;
constexpr size_t WS_W = 40 * MiB;
constexpr size_t WS_WGU = WS_W;
constexpr size_t WS_WD = WS_W + 176 * MiB;
constexpr size_t WS_WEVIN = WS_W + 264 * MiB;
constexpr size_t WS_WEVOUT = WS_W + 288 * MiB;
constexpr size_t WS_WODIN = WS_W + 296 * MiB;
constexpr size_t WS_WODOUT = WS_W + 308 * MiB;
constexpr size_t WS_H = 356 * MiB;
constexpr size_t WS_BIG = 488 * MiB;
constexpr size_t WS_ACT = WS_BIG;
constexpr size_t WS_E = WS_BIG;
constexpr size_t WS_SBUF = WS_BIG + 396 * MiB;
constexpr size_t WS_E2 = WS_BIG;
constexpr size_t WS_QB = WS_BIG + 198 * MiB;
constexpr size_t WS_KB = WS_BIG + 294 * MiB;
constexpr size_t WS_VB = WS_BIG + 327 * MiB;
constexpr size_t WS_MIX2 = WS_BIG + 360 * MiB;
constexpr size_t WS_END = 1148 * MiB;
constexpr int CW_BAR = 4096;

constexpr int LDS_BYTES = 159744;
constexpr int MISC_OFF = LDS_BYTES - 256;

DEV float bflo(unsigned w) { return __uint_as_float(w << 16); }
DEV float bfhi(unsigned w) { return __uint_as_float(w & 0xffff0000u); }
DEV float bf2f(bf16 b) { return __uint_as_float((unsigned)b << 16); }
DEV unsigned pkbf(float lo, float hi) { unsigned r; asm volatile("v_cvt_pk_bf16_f32 %0, %1, %2" : "=v"(r) : "v"(lo), "v"(hi)); return r; }
DEV bf16 f2bf(float f) { return (bf16)(pkbf(f, 0.f) & 0xffffu); }
DEV float fexp(float x) { return __builtin_amdgcn_exp2f(x * 1.4426950408889634f); }
DEV float fsigmoid(float x) { return __builtin_amdgcn_rcpf(1.f + fexp(-x)); }
DEV float fsilu(float x) { return x * fsigmoid(x); }
DEV float fgelu_tanh(float x) { const float z = 0.7978845608028654f * (x + 0.044715f * x * x * x); return x * fsigmoid(2.f * z); }
DEV float wave_sum(float v) {
#pragma unroll
    for (int o = 1; o < 64; o <<= 1) v += __shfl_xor(v, o);
    return v;
}
DEV int crow(int r, int hi) { return (r & 3) + 8 * (r >> 2) + 4 * hi; }
typedef short v4i16_t __attribute__((ext_vector_type(4)));
DEV s16x4 ds_tr(const LAS unsigned char* p) { return __builtin_bit_cast(s16x4, __builtin_amdgcn_ds_read_tr16_b64_v4i16((LAS v4i16_t*)p)); }
DEV bf16x8 tr_frag(const LAS unsigned char* X, int ld, int k0, int n0, int lane) {
    const int h = lane >> 5, blk = (lane >> 4) & 1, q = (lane & 15) >> 2, p = lane & 3;
    const LAS unsigned char* a = X + (k0 + 8 * h + q) * ld + (n0 + 16 * blk + 4 * p) * 2;
    const s16x4 lo = ds_tr(a), hi = ds_tr(a + 4 * ld);
    return (bf16x8){lo[0], lo[1], lo[2], lo[3], hi[0], hi[1], hi[2], hi[3]};
}
DEV bf16x8 pack8(const float* v) { u32x4 w = {pkbf(v[0], v[1]), pkbf(v[2], v[3]), pkbf(v[4], v[5]), pkbf(v[6], v[7])}; return __builtin_bit_cast(bf16x8, w); }

namespace pg8 {
typedef unsigned short bf16_t;
constexpr int BM = 256, BK = 64, HALF = 128, HTB = HALF * BK * 2, STAGE_BYTES = 8 * HTB, NXCD = 8, WGM = 8;
__host__ __device__ __forceinline__ int lds_byte(int r, int c) { const int st = (r >> 4) * 2 + (c >> 5), rr = r & 15, cc = c & 31, ob = rr * 64 + cc * 2; return st * 1024 + (ob ^ (((ob >> 9) & 1) << 5)); }
__host__ __device__ __forceinline__ void stage_rc(int b, int& R, int& C) { const int st = b / 1024, sb = b % 1024, swz = sb ^ (((sb >> 9) & 1) << 5); R = (st >> 1) * 16 + swz / 64; C = (st & 1) * 32 + (swz % 64) / 2; }
__host__ __device__ __forceinline__ int perm32(int rho) { const int n = rho >> 4, i = rho & 15; return 8 * (i >> 2) + 4 * n + (i & 3); }
struct Unit { int pm, pn; };
struct Gemm { const bf16_t* A; const bf16_t* Bt; int M, N, K, lda; };
struct StaticOrder {
    int nM, nN, nwg, G, c;
    __host__ __device__ void init(int M, int N, int G_, int c_) { nM = M / BM; nN = N / BM; nwg = nM * nN; G = G_; c = c_; }
    __host__ __device__ bool next(int i, Unit& u) const {
        const long L = (long)i * G + c; if (L >= nwg) return false;
        int wgid = (int)L; { const int q = nwg / NXCD, r = nwg % NXCD, xcd = wgid % NXCD, off = wgid / NXCD; wgid = (xcd < r ? xcd * (q + 1) : r * (q + 1) + (xcd - r) * q) + off; }
        const int nig = WGM * nN, gid = wgid / nig, fm = gid * WGM, gsz = (nM - fm) < WGM ? (nM - fm) : WGM;
        u.pm = fm + ((wgid % nig) % gsz); u.pn = (wgid % nig) / gsz; return true;
    }
    __device__ __forceinline__ void a_ready(const Unit&) const {}
    __device__ __forceinline__ void done(const Unit&) const {}
};
struct EpiPlain {
    static constexpr bool PERM = true, AFTER_DRAIN = false;
    bf16_t* O; int ldc;
    __device__ __forceinline__ void operator()(const f32x4 (&acc)[2][2][4][2], const Unit& u, int wr, int wc, int fr, int fq) const {
        const int row0 = u.pm * BM + wr * 64 + fr, col0 = u.pn * BM + wc * 32 + 8 * fq;
#pragma unroll
        for (int ai = 0; ai < 2; ++ai)
#pragma unroll
            for (int m = 0; m < 4; ++m) { bf16_t* rowp = O + (size_t)(row0 + ai * HALF + m * 16) * ldc + col0;
#pragma unroll
                for (int bj = 0; bj < 2; ++bj) { const f32x4 v0 = acc[ai][bj][m][0], v1 = acc[ai][bj][m][1];
                    u32x4 w; w.x = pkbf(v0[0], v0[1]); w.y = pkbf(v0[2], v0[3]); w.z = pkbf(v1[0], v1[1]); w.w = pkbf(v1[2], v1[3]);
                    *(u32x4*)(rowp + bj * HALF) = w; } }
    }
};
struct EpiSwiGLU {
    static constexpr bool PERM = true, AFTER_DRAIN = false;
    bf16_t* O; int ldc;
    __device__ __forceinline__ void operator()(const f32x4 (&acc)[2][2][4][2], const Unit& u, int wr, int wc, int fr, int fq) const {
        const int row0 = u.pm * BM + wr * 64 + fr, col0 = u.pn * HALF + wc * 32 + 8 * fq;
#pragma unroll
        for (int ai = 0; ai < 2; ++ai)
#pragma unroll
            for (int m = 0; m < 4; ++m) { bf16_t* rowp = O + (size_t)(row0 + ai * HALF + m * 16) * ldc + col0;
                f32x4 a0, a1;
#pragma unroll
                for (int j = 0; j < 4; ++j) { a0[j] = fsilu(acc[ai][0][m][0][j]) * acc[ai][1][m][0][j]; a1[j] = fsilu(acc[ai][0][m][1][j]) * acc[ai][1][m][1][j]; }
                u32x4 w; w.x = pkbf(a0[0], a0[1]); w.y = pkbf(a0[2], a0[3]); w.z = pkbf(a1[0], a1[1]); w.w = pkbf(a1[2], a1[3]);
                *(u32x4*)rowp = w; }
    }
};
struct EpiEvIn {
    static constexpr bool PERM = true, AFTER_DRAIN = false;
    bf16_t* O; const float* cs; const float* sn;
    __device__ __forceinline__ void operator()(const f32x4 (&acc)[2][2][4][2], const Unit& u, int wr, int wc, int fr, int fq) const {
        const int ldc = EVN; const int row0 = u.pm * BM + wr * 64 + fr, col0 = u.pn * BM + wc * 32 + 8 * fq;
        const bool qk = (u.pn >= 8 && u.pn < 16), rot = qk && (u.pm < ML / BM); const float ksc = (u.pn >= 12 && u.pn < 16) ? 0.0625f : 1.f;
#pragma unroll
        for (int ai = 0; ai < 2; ++ai)
#pragma unroll
            for (int m = 0; m < 4; ++m) { const int row = row0 + ai * HALF + m * 16; bf16_t* rowp = O + (size_t)row * ldc + col0;
                f32x4 o1[2], o2[2];
#pragma unroll
                for (int n = 0; n < 2; ++n) { const f32x4 x1 = acc[ai][0][m][n], x2 = acc[ai][1][m][n];
                    if (rot) { const int t = row & (SEQ - 1); const int i0 = wc * 32 + 8 * fq + 4 * n;
                        const f32x4 c4 = *(const f32x4*)(cs + (size_t)t * 128 + i0), s4 = *(const f32x4*)(sn + (size_t)t * 128 + i0);
                        o1[n] = (x1 * c4 - x2 * s4) * ksc; o2[n] = (x1 * s4 + x2 * c4) * ksc; }
                    else { o1[n] = x1 * ksc; o2[n] = x2 * ksc; } }
                u32x4 w; w.x = pkbf(o1[0][0], o1[0][1]); w.y = pkbf(o1[0][2], o1[0][3]); w.z = pkbf(o1[1][0], o1[1][1]); w.w = pkbf(o1[1][2], o1[1][3]);
                *(u32x4*)rowp = w;
                w.x = pkbf(o2[0][0], o2[0][1]); w.y = pkbf(o2[0][2], o2[0][3]); w.z = pkbf(o2[1][0], o2[1][1]); w.w = pkbf(o2[1][2], o2[1][3]);
                *(u32x4*)(rowp + HALF) = w; }
    }
};

template <class Epi, class Sched, bool ALIGN_EPI = false, bool SP2 = false>
__device__ __forceinline__ void gemm_phase(LAS unsigned char* lds, const Gemm g, const Sched& S, const Epi& E) {
    const int tid = threadIdx.x, wid = __builtin_amdgcn_readfirstlane(tid >> 6), lane = tid & 63, wr = wid >> 2, wc = wid & 3, fr = lane & 15, fq = lane >> 4;
    const int K = g.K, nt = K / BK, lda = g.lda;
    unsigned voffA[2], voffB[2];
#pragma unroll
    for (int i = 0; i < 2; ++i) { int R, C; stage_rc(tid * 16 + i * 8192, R, C); const int Rb = Epi::PERM ? ((R & ~31) + perm32(R & 31)) : R;
        voffA[i] = (unsigned)(R * lda + C) * 2u; voffB[i] = (unsigned)(Rb * K + C) * 2u; }
    const size_t kstep = (size_t)(BK * 2);
    const size_t hstepA = (size_t)HALF * lda * 2, hstepB = (size_t)HALF * K * 2;
    const size_t tstepA = 2 * hstepA, tstepB = 2 * hstepB;
    const unsigned ldsw = (unsigned)wid * 1024u;
    const int aoff = lds_byte(wr * 64 + fr, fq * 8), boff = lds_byte(wc * 32 + fr, fq * 8);
#define PG8_SA(b, h) (((b) * 2 + (h)) * HTB)
#define PG8_SB(b, h) ((4 + (b) * 2 + (h)) * HTB)
#define PG8_STAGE(bufoff, gbase, voff) do { _Pragma("unroll") for (int _i = 0; _i < 2; ++_i) \
        __builtin_amdgcn_global_load_lds((const unsigned*)((const char*)(gbase) + (voff)[_i]), (LAS unsigned*)(lds + (bufoff) + ldsw + _i * 8192), 16, 0, 0); } while (0)
#define PG8_LDA(dst, b, h) do { _Pragma("unroll") for (int m = 0; m < 4; ++m) _Pragma("unroll") for (int k = 0; k < 2; ++k) dst[m][k] = *(const LAS bf16x8*)(lds + PG8_SA(b, h) + aoff + m * 2048 + k * 1024); } while (0)
#define PG8_LDB(dst, b, h) do { _Pragma("unroll") for (int n = 0; n < 2; ++n) _Pragma("unroll") for (int k = 0; k < 2; ++k) dst[n][k] = *(const LAS bf16x8*)(lds + PG8_SB(b, h) + boff + n * 2048 + k * 1024); } while (0)
#define PG8_MMA(ai, bj, At, Bt) do { __builtin_amdgcn_s_setprio(1); _Pragma("unroll") for (int m = 0; m < 4; ++m) _Pragma("unroll") for (int n = 0; n < 2; ++n) _Pragma("unroll") for (int k = 0; k < 2; ++k) \
        acc[ai][bj][m][n] = __builtin_amdgcn_mfma_f32_16x16x32_bf16(Bt[n][k], At[m][k], acc[ai][bj][m][n], 0, 0, 0); __builtin_amdgcn_s_setprio(0); } while (0)
#define PG8_WAIT_V(n) asm volatile("s_waitcnt vmcnt(" #n ")" ::: "memory")
#define PG8_WAIT_L(n) asm volatile("s_waitcnt lgkmcnt(" #n ")" ::: "memory")
#define PG8_BAR __builtin_amdgcn_s_barrier()
#define PG8_SCHED __builtin_amdgcn_sched_barrier(0)
    Unit cur, nxt; int ui = 0;
    if (!S.next(0, cur)) return;
    f32x4 acc[2][2][4][2];
#pragma unroll
    for (int a = 0; a < 2; ++a)
#pragma unroll
        for (int b = 0; b < 2; ++b)
#pragma unroll
            for (int m = 0; m < 4; ++m)
#pragma unroll
                for (int n = 0; n < 2; ++n) acc[a][b][m][n] = (f32x4){0.f, 0.f, 0.f, 0.f};
    bf16x8 At[4][2], B0[2][2], B1[2][2];
    const char* cA = (const char*)g.A + (size_t)cur.pm * tstepA; const char* cB = (const char*)g.Bt + (size_t)cur.pn * tstepB;
    S.a_ready(cur);
    if constexpr (SP2) {
        PG8_STAGE(PG8_SB(0, 0), cB, voffB); PG8_STAGE(PG8_SB(0, 1), cB + hstepB, voffB); PG8_STAGE(PG8_SA(0, 0), cA, voffA); PG8_STAGE(PG8_SA(0, 1), cA + hstepA, voffA);
        if (wr == 1) PG8_BAR;
        PG8_WAIT_V(2); PG8_BAR;
        PG8_STAGE(PG8_SB(1, 0), cB + kstep, voffB); PG8_STAGE(PG8_SA(1, 0), cA + kstep, voffA); PG8_STAGE(PG8_SB(1, 1), cB + hstepB + kstep, voffB);
        PG8_WAIT_V(6); PG8_BAR;
    } else {
        PG8_STAGE(PG8_SB(0, 0), cB, voffB); PG8_STAGE(PG8_SA(0, 0), cA, voffA); PG8_STAGE(PG8_SB(0, 1), cB + hstepB, voffB); PG8_STAGE(PG8_SA(0, 1), cA + hstepA, voffA);
        if (wr == 1) PG8_BAR;
        PG8_WAIT_V(4); PG8_BAR;
        PG8_STAGE(PG8_SB(1, 0), cB + kstep, voffB); PG8_STAGE(PG8_SA(1, 0), cA + kstep, voffA); PG8_STAGE(PG8_SB(1, 1), cB + hstepB + kstep, voffB);
        PG8_WAIT_V(6); PG8_BAR;
    }
    for (;;) {
        const bool has_next = S.next(ui + 1, nxt);
        const char* nA = has_next ? (const char*)g.A + (size_t)nxt.pm * tstepA : cA; const char* nB = has_next ? (const char*)g.Bt + (size_t)nxt.pn * tstepB : cB;
        for (int t = 0; t < nt; t += 2) {
            const bool last = (t == nt - 2);
            const char* a1 = cA + (size_t)(t + 1) * kstep;
            const char* a2 = last ? nA : cA + (size_t)(t + 2) * kstep; const char* b2 = last ? nB : cB + (size_t)(t + 2) * kstep;
            const char* a3 = a2 + kstep; const char* b3 = b2 + kstep;
            if (last && has_next) S.a_ready(nxt);
            if constexpr (SP2) {
            PG8_LDB(B0, 0, 0); PG8_LDB(B1, 0, 1); PG8_SCHED; PG8_LDA(At, 0, 0); PG8_STAGE(PG8_SA(1, 1), a1 + hstepA, voffA);
            PG8_WAIT_V(8); PG8_WAIT_L(0); PG8_BAR; PG8_MMA(0, 0, At, B0); PG8_MMA(0, 1, At, B1); PG8_BAR; PG8_SCHED;
            PG8_LDA(At, 0, 1); PG8_STAGE(PG8_SB(0, 0), b2, voffB); PG8_STAGE(PG8_SB(0, 1), b2 + hstepB, voffB); PG8_STAGE(PG8_SA(0, 0), a2, voffA);
            PG8_WAIT_V(8); PG8_WAIT_L(0); PG8_BAR; PG8_MMA(1, 0, At, B0); PG8_MMA(1, 1, At, B1); PG8_BAR; PG8_SCHED;
            PG8_LDB(B0, 1, 0); PG8_LDB(B1, 1, 1); PG8_SCHED; PG8_LDA(At, 1, 0); PG8_STAGE(PG8_SA(0, 1), a2 + hstepA, voffA);
            PG8_WAIT_V(8); PG8_WAIT_L(0); PG8_BAR; PG8_MMA(0, 0, At, B0); PG8_MMA(0, 1, At, B1); PG8_BAR; PG8_SCHED;
            PG8_LDA(At, 1, 1); PG8_STAGE(PG8_SB(1, 0), b3, voffB); PG8_STAGE(PG8_SB(1, 1), b3 + hstepB, voffB); PG8_STAGE(PG8_SA(1, 0), a3, voffA);
            PG8_WAIT_V(8); PG8_WAIT_L(0); PG8_BAR; PG8_MMA(1, 0, At, B0); PG8_MMA(1, 1, At, B1); PG8_BAR; PG8_SCHED;
            } else {
            PG8_LDB(B0, 0, 0); PG8_SCHED; PG8_LDA(At, 0, 0); PG8_STAGE(PG8_SA(1, 1), a1 + hstepA, voffA);
            PG8_WAIT_L(8); PG8_BAR; PG8_WAIT_L(0); PG8_MMA(0, 0, At, B0); PG8_BAR; PG8_SCHED;
            PG8_LDB(B1, 0, 1); PG8_STAGE(PG8_SB(0, 0), b2, voffB);
            PG8_BAR; PG8_WAIT_L(0); PG8_MMA(0, 1, At, B1); PG8_BAR;
            PG8_LDA(At, 0, 1); PG8_STAGE(PG8_SA(0, 0), a2, voffA);
            PG8_BAR; PG8_WAIT_L(0); PG8_MMA(1, 0, At, B0); PG8_BAR; PG8_SCHED;
            PG8_STAGE(PG8_SB(0, 1), b2 + hstepB, voffB);
            PG8_WAIT_V(6); PG8_BAR; PG8_MMA(1, 1, At, B1); PG8_BAR;
            PG8_LDB(B0, 1, 0); PG8_SCHED; PG8_LDA(At, 1, 0); PG8_STAGE(PG8_SA(0, 1), a2 + hstepA, voffA);
            PG8_WAIT_L(8); PG8_BAR; PG8_WAIT_L(0); PG8_MMA(0, 0, At, B0); PG8_BAR; PG8_SCHED;
            PG8_LDB(B1, 1, 1); PG8_STAGE(PG8_SB(1, 0), b3, voffB);
            PG8_BAR; PG8_WAIT_L(0); PG8_MMA(0, 1, At, B1); PG8_BAR;
            PG8_LDA(At, 1, 1); PG8_STAGE(PG8_SA(1, 0), a3, voffA);
            PG8_BAR; PG8_WAIT_L(0); PG8_MMA(1, 0, At, B0); PG8_BAR; PG8_SCHED;
            PG8_STAGE(PG8_SB(1, 1), b3 + hstepB, voffB);
            PG8_WAIT_V(6); PG8_BAR; PG8_MMA(1, 1, At, B1); PG8_BAR;
            }
        }
        if constexpr (ALIGN_EPI) { if (wr == 0) PG8_BAR; }
        if constexpr (!Epi::AFTER_DRAIN) { E(acc, cur, wr, wc, fr, fq); S.done(cur); }
        if (!has_next) break;
#pragma unroll
        for (int a = 0; a < 2; ++a)
#pragma unroll
            for (int b = 0; b < 2; ++b)
#pragma unroll
                for (int m = 0; m < 4; ++m)
#pragma unroll
                    for (int n = 0; n < 2; ++n) acc[a][b][m][n] = (f32x4){0.f, 0.f, 0.f, 0.f};
        cur = nxt; cA = nA; cB = nB; ++ui;
        if constexpr (ALIGN_EPI) { if (wr == 1) PG8_BAR; }
    }
    PG8_WAIT_V(0);
    if constexpr (!ALIGN_EPI) { if (wr == 0) PG8_BAR; }
    PG8_BAR;
#undef PG8_SA
#undef PG8_SB
#undef PG8_STAGE
#undef PG8_LDA
#undef PG8_LDB
#undef PG8_MMA
#undef PG8_WAIT_V
#undef PG8_WAIT_L
#undef PG8_BAR
#undef PG8_SCHED
}
}
#define PG8_SP2 true
#define PG8_ALIGN true

namespace att {
constexpr int D = 128, NW = 8, QBLK = 32, KVBLK = 64;
constexpr float SCALE = 0.088388347648318440f;
constexpr float THR = 8.f;
constexpr size_t SHM_V = KVBLK * D * 2, SHM_K = KVBLK * D * 2, SHM_ATTN = 2 * SHM_V + 2 * SHM_K + NW * 64 * 4;
#define KSWZ(row, colB) ((row) * 256 + ((colB) ^ (((row) & 7) << 4)))
#define SBAR() __builtin_amdgcn_sched_barrier(0)
DEV void partialSM(f32x16& p0, f32x16& p1, float& m_reg, float& mn, float& alpha) {
  constexpr float C = SCALE * 1.4426950408889634f;
  float pmax = p0[0]; for (int r = 1; r < 16; ++r) pmax = fmaxf(pmax, p0[r]); for (int r = 0; r < 16; ++r) pmax = fmaxf(pmax, p1[r]);
  { auto rr = __builtin_amdgcn_permlane32_swap(__float_as_uint(pmax), __float_as_uint(pmax), false, false);
    pmax = fmaxf(__uint_as_float(rr[0]), __uint_as_float(rr[1])); }
  if (__builtin_expect(__all(pmax - m_reg <= THR / SCALE), 1)) { mn = m_reg; alpha = 1.f; }
  else { mn = fmaxf(m_reg, pmax); alpha = __builtin_amdgcn_exp2f((m_reg - mn) * C); m_reg = mn; }
  float mnC = -mn * C;
  for (int r = 0; r < 16; ++r) p0[r] = fmaf(p0[r], C, mnC); for (int r = 0; r < 16; ++r) p1[r] = fmaf(p1[r], C, mnC);
  for (int r = 0; r < 16; ++r) p0[r] = __builtin_amdgcn_exp2f(p0[r]);
}
DEV void finishSM(f32x16& p0, f32x16& p1, float alpha, float& l_reg, bf16x8& pa0, bf16x8& pa1, bf16x8& pa2, bf16x8& pa3) {
  for (int r = 0; r < 16; ++r) p1[r] = __builtin_amdgcn_exp2f(p1[r]);
  float ps = 0; for (int r = 0; r < 16; ++r) ps += p0[r]; for (int r = 0; r < 16; ++r) ps += p1[r];
  { auto rr = __builtin_amdgcn_permlane32_swap(__float_as_uint(ps), __float_as_uint(ps), false, false);
    ps = __uint_as_float(rr[0]) + __uint_as_float(rr[1]); }
  l_reg = l_reg * alpha + ps;
#define PK4(P, BASE, OUT) do { unsigned a0 = pkbf(P[BASE + 0], P[BASE + 1]), a1 = pkbf(P[BASE + 2], P[BASE + 3]);   \
    unsigned b0 = pkbf(P[BASE + 4], P[BASE + 5]), b1 = pkbf(P[BASE + 6], P[BASE + 7]);                              \
    auto r0 = __builtin_amdgcn_permlane32_swap(a0, b0, false, false); auto r1 = __builtin_amdgcn_permlane32_swap(a1, b1, false, false); \
    u32x4 w = {r0[0], r1[0], r0[1], r1[1]}; OUT = __builtin_bit_cast(bf16x8, w); } while (0)
  PK4(p0, 0, pa0); PK4(p0, 8, pa1); PK4(p1, 0, pa2); PK4(p1, 8, pa3);
#undef PK4
}
DEV void qkt(f32x16& p0, f32x16& p1, const bf16* Ks, const bf16x8* qr, int r32, int hi) {
  p0 = f32x16{}; p1 = f32x16{};
  for (int d0 = 0; d0 < 8; ++d0) { int cb = (d0 * 16 + hi * 8) * 2;
    bf16x8 b0 = *reinterpret_cast<const bf16x8*>((const char*)Ks + KSWZ(r32, cb));
    bf16x8 b1 = *reinterpret_cast<const bf16x8*>((const char*)Ks + KSWZ(32 + r32, cb));
    p0 = __builtin_amdgcn_mfma_f32_32x32x16_bf16(b0, qr[d0], p0, 0, 0, 0);
    p1 = __builtin_amdgcn_mfma_f32_32x32x16_bf16(b1, qr[d0], p1, 0, 0, 0); }
}
DEV int v_st(int k, int c) { const int kk = (k & ~0xC) | ((k & 4) << 1) | ((k & 8) >> 1); return ((kk >> 3) * 4 + (c >> 5)) * 512 + ((kk & 7) * 32 + (c & 31)) * 2; }
DEV int v_rd_base(int lane) { return ((lane & 3) << 3) | (((lane >> 2) & 3) << 6) | (((lane >> 4) & 1) << 5) | (((lane >> 5) & 1) << 8); }
constexpr int v_rd_off(int d0, int ks, int half) { return d0 * 512 + ks * 4096 + half * 2048; }
template <int OFF> DEV s16x4 tr_read(int vb) {
  s16x4 r; asm volatile("ds_read_b64_tr_b16 %0, %1 offset:%2" : "=&v"(r) : "v"(vb), "i"(OFF) : "memory"); return r;
}
template <int D0> DEV void pv_one(f32x16& od, int vb, bf16x8 pa0, bf16x8 pa1, bf16x8 pa2, bf16x8 pa3) {
  const s16x4 l0 = tr_read<v_rd_off(D0, 0, 0)>(vb), h0 = tr_read<v_rd_off(D0, 0, 1)>(vb), l1 = tr_read<v_rd_off(D0, 1, 0)>(vb), h1 = tr_read<v_rd_off(D0, 1, 1)>(vb);
  const s16x4 l2 = tr_read<v_rd_off(D0, 2, 0)>(vb), h2 = tr_read<v_rd_off(D0, 2, 1)>(vb), l3 = tr_read<v_rd_off(D0, 3, 0)>(vb), h3 = tr_read<v_rd_off(D0, 3, 1)>(vb);
  asm volatile("s_waitcnt lgkmcnt(0)" ::: "memory"); SBAR();
#define PK(L, H) (bf16x8){L[0], L[1], L[2], L[3], H[0], H[1], H[2], H[3]}
  od = __builtin_amdgcn_mfma_f32_32x32x16_bf16(pa0, PK(l0, h0), od, 0, 0, 0);
  od = __builtin_amdgcn_mfma_f32_32x32x16_bf16(pa1, PK(l1, h1), od, 0, 0, 0);
  od = __builtin_amdgcn_mfma_f32_32x32x16_bf16(pa2, PK(l2, h2), od, 0, 0, 0);
  od = __builtin_amdgcn_mfma_f32_32x32x16_bf16(pa3, PK(l3, h3), od, 0, 0, 0);
#undef PK
}
DEV void pv_d0(f32x16* o, int vb, bf16x8 pa0, bf16x8 pa1, bf16x8 pa2, bf16x8 pa3) {
  pv_one<0>(o[0], vb, pa0, pa1, pa2, pa3); pv_one<1>(o[1], vb, pa0, pa1, pa2, pa3); pv_one<2>(o[2], vb, pa0, pa1, pa2, pa3); pv_one<3>(o[3], vb, pa0, pa1, pa2, pa3);
}
template <int LDQ, int LDK, int LDO>
DEV void attn_dense_body(const bf16* __restrict__ Qb, const bf16* __restrict__ Kh, const bf16* __restrict__ Vh, bf16* __restrict__ Ob, int seq, char* lds) {
  const int tid = threadIdx.x, wid = tid >> 6, lane = tid & 63, r32 = lane & 31, hi = lane >> 5;
  bf16* V_lds = (bf16*)lds; bf16* K_lds = (bf16*)(lds + 2 * SHM_V);
  float* ws = (float*)(lds + 2 * SHM_V + 2 * SHM_K) + wid * 64; float* li_l = ws; float* al_l = ws + 32;
  float m_reg = -1e30f, l_reg = 0; f32x16 o[4] = {}; bf16x8 qr[8];
  const bf16* Qw = Qb + (long)(wid * QBLK + r32) * LDQ + hi * 8;
#pragma unroll
  for (int d0 = 0; d0 < 8; ++d0) qr[d0] = *reinterpret_cast<const bf16x8*>(Qw + d0 * 16);
  const int sr = tid >> 4, sc = (tid & 15) * 8, vst0 = v_st(sr, sc), vst1 = v_st(32 + sr, sc);
  const int vb0 = (int)(uintptr_t)V_lds + v_rd_base(lane);
  struct { bf16x8 vs0, vs1, ks0, ks1; } sr_[2];
#define SLOAD(i, k0) do { sr_[i].vs0 = *reinterpret_cast<const bf16x8*>(&Vh[(long)((k0) + sr) * LDK + sc]); sr_[i].vs1 = *reinterpret_cast<const bf16x8*>(&Vh[(long)((k0) + 32 + sr) * LDK + sc]); \
    sr_[i].ks0 = *reinterpret_cast<const bf16x8*>(&Kh[(long)((k0) + sr) * LDK + sc]); sr_[i].ks1 = *reinterpret_cast<const bf16x8*>(&Kh[(long)((k0) + 32 + sr) * LDK + sc]); } while (0)
#define SWRITE(b, i) do { *(bf16x8*)((char*)V_lds + (b) * SHM_V + vst0) = sr_[i].vs0;          \
    *(bf16x8*)((char*)V_lds + (b) * SHM_V + vst1) = sr_[i].vs1; int kc = sc * 2;               \
    *(bf16x8*)((char*)K_lds + (b) * SHM_K + KSWZ(sr, kc)) = sr_[i].ks0;                       \
    *(bf16x8*)((char*)K_lds + (b) * SHM_K + KSWZ(32 + sr, kc)) = sr_[i].ks1; } while (0)
#define SWAIT() asm volatile("s_waitcnt vmcnt(4)" ::: "memory")
#define RESC(a) do { if (__any((a) < 1.f)) { if (hi == 0) al_l[r32] = (a); asm volatile("s_waitcnt lgkmcnt(0)" ::: "memory"); \
    for (int d = 0; d < 4; ++d) for (int r = 0; r < 16; ++r) o[d][r] *= al_l[crow(r, hi)]; } } while (0)
  f32x16 pA0, pA1, pB0, pB1; float mnA, mnB, alA, alB; bf16x8 pa0, pa1, pa2, pa3; const int NT = seq / KVBLK;
  constexpr int SE = 0, SO = 1;
  SLOAD(SE, 0); asm volatile("s_waitcnt vmcnt(0)" ::: "memory"); SWRITE(0, SE); __syncthreads();
  qkt(pA0, pA1, K_lds, qr, r32, hi); partialSM(pA0, pA1, m_reg, mnA, alA);
  SLOAD(SO, KVBLK); if (2 < NT) SLOAD(SE, 2 * KVBLK);
  SWAIT(); SWRITE(1, SO); __syncthreads();
  for (int j = 1; j + 1 < NT; j += 2) {
    SBAR(); qkt(pB0, pB1, (bf16*)((char*)K_lds + SHM_K), qr, r32, hi);
    finishSM(pA0, pA1, alA, l_reg, pa0, pa1, pa2, pa3); SBAR();
    SLOAD(SO, (j + 2) * KVBLK); SBAR();
    pv_d0(o, vb0, pa0, pa1, pa2, pa3); partialSM(pB0, pB1, m_reg, mnB, alB);
    __syncthreads(); SWAIT(); SWRITE(0, SE);
    RESC(alB); __syncthreads();
    SBAR(); qkt(pA0, pA1, K_lds, qr, r32, hi);
    finishSM(pB0, pB1, alB, l_reg, pa0, pa1, pa2, pa3); SBAR();
    if (j + 3 < NT) SLOAD(SE, (j + 3) * KVBLK); SBAR();
    pv_d0(o, vb0 + (int)SHM_V, pa0, pa1, pa2, pa3); partialSM(pA0, pA1, m_reg, mnA, alA);
    __syncthreads(); SWAIT(); SWRITE(1, SO);
    RESC(alA); __syncthreads();
  }
  SBAR(); qkt(pB0, pB1, (bf16*)((char*)K_lds + SHM_K), qr, r32, hi);
  finishSM(pA0, pA1, alA, l_reg, pa0, pa1, pa2, pa3); SBAR();
  pv_d0(o, vb0, pa0, pa1, pa2, pa3); partialSM(pB0, pB1, m_reg, mnB, alB);
  __syncthreads(); RESC(alB);
  finishSM(pB0, pB1, alB, l_reg, pa0, pa1, pa2, pa3); SBAR();
  pv_d0(o, vb0 + (int)SHM_V, pa0, pa1, pa2, pa3);
  if (hi == 0) li_l[r32] = l_reg; asm volatile("s_waitcnt lgkmcnt(0)" ::: "memory");
  float rli[16];
#pragma unroll
  for (int r = 0; r < 16; ++r) rli[r] = __builtin_amdgcn_rcpf(li_l[crow(r, hi)]);
  bf16* Ow = Ob + (long)(wid * QBLK) * LDO;
#pragma unroll
  for (int r = 0; r < 16; ++r) { int orow = crow(r, hi);
    for (int d0 = 0; d0 < 4; ++d0) Ow[(long)orow * LDO + d0 * 32 + r32] = f2bf(o[d0][r] * rli[r]); }
  __syncthreads();
#undef SLOAD
#undef SWRITE
#undef SWAIT
#undef RESC
}
#undef KSWZ
}

#define XB_TMO      128
#define XB_XCNT(j)  (256  + 64 * (j))
#define XB_XSUB(j)  (1280 + 64 * (j))
#define XB_XGEN(j)  (2304 + 64 * (j))
#define XB_TOP      3328
#define XB_TOPGEN   3392
#define XCD_BAR_WORDS 3456
#define XB_SPIN_CAP (1u << 18)
DEV unsigned xb_ld(unsigned* p)              { return __hip_atomic_load(p, __ATOMIC_RELAXED, __HIP_MEMORY_SCOPE_AGENT); }
DEV unsigned xb_add(unsigned* p, unsigned v) { return __hip_atomic_fetch_add(p, v, __ATOMIC_RELAXED, __HIP_MEMORY_SCOPE_AGENT); }
DEV unsigned xb_xcc_id() { return (unsigned)__builtin_amdgcn_s_getreg((3 << 11) | 20) & 0xFu; }
#define XB_SPIN(cond, bar) do { unsigned _sp = 0; while (cond) { __builtin_amdgcn_s_sleep(1); \
    if ((++_sp & 255u) == 0u) { if (xb_ld(&(bar)[XB_TMO])) break; if (_sp > XB_SPIN_CAP) { atomicAdd(&(bar)[XB_TMO], 1u); break; } } } } while (0)
struct XcdBarrier { unsigned* bar; unsigned x; volatile LAS unsigned* st; };
DEV XcdBarrier xcd_barrier_post(unsigned* bar, volatile LAS unsigned* st) {
    XcdBarrier b; b.bar = bar; b.x = xb_xcc_id(); b.st = st;
    if (threadIdx.x == 0) (void)xb_add(&bar[XB_XCNT(b.x)], 1u);
    return b;
}
DEV void xcd_barrier_complete(unsigned* bar, unsigned x, unsigned& nloc, unsigned& nx) {
    const unsigned G = gridDim.x * gridDim.y * gridDim.z;
    unsigned sum, cnt, mine, sp = 0u;
    for (;;) {
        sum = 0u; cnt = 0u; mine = 0u;
#pragma unroll
        for (unsigned j = 0; j < 16; ++j) { const unsigned c = xb_ld(&bar[XB_XCNT(j)]); sum += c; cnt += (c > 0u) ? 1u : 0u; mine = (j == x) ? c : mine; }
        if (sum == G) break;
        __builtin_amdgcn_s_sleep(1);
        if ((++sp & 255u) == 0u) { if (xb_ld(&bar[XB_TMO])) break; if (sp > XB_SPIN_CAP) { atomicAdd(&bar[XB_TMO], 1u); break; } }
    }
    nloc = mine > 0u ? mine : 1u; nx = cnt > 0u ? cnt : 1u;
}
DEV void xcd_barrier(const XcdBarrier& b) {
    asm volatile("s_waitcnt vmcnt(0)" ::: "memory");
    __syncthreads();
    if (threadIdx.x == 0) {
        unsigned* bar = b.bar;
        __builtin_amdgcn_s_waitcnt(0);
        unsigned nloc = b.st[0], nx = b.st[1];
        if (nloc == 0u) { xcd_barrier_complete(bar, b.x, nloc, nx); b.st[0] = nloc; b.st[1] = nx; }
        const unsigned old = xb_add(&bar[XB_XSUB(b.x)], 1u);
        const unsigned gen = old / nloc;
        if (old + 1u == (gen + 1u) * nloc) {
            __builtin_amdgcn_fence(__ATOMIC_RELEASE, "agent");
            asm volatile("s_waitcnt vmcnt(0)" ::: "memory");
            const unsigned og = xb_add(&bar[XB_TOP], 1u);
            const unsigned tg = og / nx;
            if (og + 1u == (tg + 1u) * nx) xb_add(&bar[XB_TOPGEN], 1u);
            else XB_SPIN(xb_ld(&bar[XB_TOPGEN]) == tg, bar);
            __builtin_amdgcn_fence(__ATOMIC_ACQUIRE, "agent");
            xb_add(&bar[XB_XGEN(b.x)], 1u);
            asm volatile("s_waitcnt vmcnt(0)" ::: "memory");
        } else {
            XB_SPIN(xb_ld(&bar[XB_XGEN(b.x)]) == gen, bar);
            __builtin_amdgcn_fence(__ATOMIC_ACQUIRE, "agent");
            asm volatile("s_waitcnt vmcnt(0)" ::: "memory");
        }
    }
    __syncthreads();
}

struct Args { const float* in[28]; float* out; unsigned char* ws; int ph_lo, ph_hi; };
enum { I_X = 0, I_C, I_CTX, I_CCTX, I_MODW, I_MODB, I_NPRE, I_NPOST, I_FG, I_FU, I_FD, I_EVIN, I_EVOUT, I_CONVW, I_CONVB, I_WA, I_BA, I_WX, I_BX, I_LAM, I_DECAY, I_GN,
       I_ODIN, I_ODOUT, I_POOLW, I_POOLS, I_QN, I_KN };
struct Frame {
    LAS unsigned char* lds; int tid, lane, wave, G, bid;
    const Args* a;
};
#define LDS_WAIT() asm volatile("s_waitcnt lgkmcnt(0)" ::: "memory")

DEV void transpose_item(const float* W, int K, int N, bf16* WT, int drow0, LAS float* scr, int kb, int nb, int lane) {
    const int k0 = 64 * kb, n0 = 32 * nb;
#pragma unroll 8
    for (int i = 0; i < 32; ++i) { const int kk = 2 * i + (lane >> 5); scr[kk * 33 + (lane & 31)] = W[(size_t)(k0 + kk) * N + n0 + (lane & 31)]; }
    LDS_WAIT(); asm volatile("" ::: "memory");
    const int c = lane & 7;
#pragma unroll
    for (int j = 0; j < 4; ++j) { const int n = (lane >> 3) + 8 * j; const LAS float* s = scr + (8 * c) * 33 + n;
        u32x4 o; o.x = pkbf(s[0 * 33], s[1 * 33]); o.y = pkbf(s[2 * 33], s[3 * 33]); o.z = pkbf(s[4 * 33], s[5 * 33]); o.w = pkbf(s[6 * 33], s[7 * 33]);
        *(u32x4*)(WT + (size_t)(drow0 + n) * K + k0 + 8 * c) = o; }
    LDS_WAIT(); asm volatile("" ::: "memory");
}
DEV void p0_prologue(const Frame& F) {
    const Args& A = *F.a; unsigned char* ws = A.ws;
    {
        LAS float* ssc = (LAS float*)F.lds;
        LAS float* red = (LAS float*)(F.lds + 40960);
        for (int i = F.tid; i < 5 * DM; i += 512) { const int r = i / DM, k = i % DM; const float v = (r < 4) ? A.in[I_C][r * DM + k] : A.in[I_CCTX][k]; ssc[i] = fsilu(v); }
        __syncthreads();
        float* MOD = (float*)(ws + WS_MOD);
        for (int it = F.bid; it < 288; it += F.G) {
            const int li = it / 144, col0 = (it % 144) * 128;
            const float* Wp = A.in[I_MODW] + (size_t)li * DM * 18432 + (size_t)(F.wave * 256) * 18432 + col0 + 2 * F.lane;
            f32x2 acc[5];
#pragma unroll
            for (int r = 0; r < 5; ++r) acc[r] = (f32x2){0.f, 0.f};
#pragma unroll 8
            for (int kk = 0; kk < 256; ++kk) { const f32x2 wv = *(const f32x2*)(Wp + (size_t)kk * 18432);
#pragma unroll
                for (int r = 0; r < 5; ++r) { const float s = ssc[r * DM + F.wave * 256 + kk]; acc[r] += wv * s; } }
#pragma unroll
            for (int r = 0; r < 5; ++r) { red[(F.wave * 5 + r) * 128 + 2 * F.lane] = acc[r].x; red[(F.wave * 5 + r) * 128 + 2 * F.lane + 1] = acc[r].y; }
            __syncthreads();
            for (int o = F.tid; o < 640; o += 512) { const int r = o >> 7, c = o & 127; float s = A.in[I_MODB][li * 18432 + col0 + c];
#pragma unroll
                for (int w = 0; w < 8; ++w) s += red[(w * 5 + r) * 128 + c];
                MOD[(size_t)(li * 5 + r) * 18432 + col0 + c] = s; }
            __syncthreads();
        }
    }
    {
        LAS float* scr = (LAS float*)(F.lds + F.wave * 16384);
        const int gw = F.bid * 8 + F.wave, NGW = F.G * 8;
        constexpr int I_FFN = 5632, N_FFN = 12 * I_FFN, I_EI = 32 * 192, I_EO = 32 * 64, I_OI = 32 * 96, I_OO = 32 * 64, I_SM = 8 * 36;
        constexpr int NITEMS = N_FFN + I_EI + I_EO + I_OI + I_OO + I_SM;
        for (int it = gw; it < NITEMS; it += NGW) {
            int r = it;
            if (r < N_FFN) { const int idx = r / I_FFN, item = r % I_FFN, lf = idx / 3, kind = idx % 3;
                if (kind < 2) { const float* W = A.in[kind == 0 ? I_FG : I_FU] + (size_t)lf * DM * DFF; const int nb = item % 176, kb = item / 176, n0 = 32 * nb;
                    transpose_item(W, DM, DFF, (bf16*)(ws + WS_WGU + (size_t)lf * 44 * MiB), 256 * (n0 / 128) + 128 * kind + (n0 % 128), scr, kb, nb, F.lane); }
                else { const float* W = A.in[I_FD] + (size_t)lf * DFF * DM; const int nb = item % 64, kb = item / 64;
                    transpose_item(W, DFF, DM, (bf16*)(ws + WS_WD + (size_t)lf * 22 * MiB), 32 * nb, scr, kb, nb, F.lane); }
                continue; }
            r -= N_FFN;
            if (r < I_EI) { const int nb = r % 192, kb = r / 192, n0 = 32 * nb, blk = n0 / 1024;
                const int dblk = (blk == 1) ? 5 : (blk == 5) ? 1 : blk;
                transpose_item(A.in[I_EVIN], DM, EVN, (bf16*)(ws + WS_WEVIN), dblk * 1024 + (n0 % 1024), scr, kb, nb, F.lane); continue; }
            r -= I_EI;
            if (r < I_EO) { const int nb = r % 64, kb = r / 64; transpose_item(A.in[I_EVOUT], DM, DM, (bf16*)(ws + WS_WEVOUT), 32 * nb, scr, kb, nb, F.lane); continue; }
            r -= I_EO;
            if (r < I_OI) { const int nb = r % 96, kb = r / 96; transpose_item(A.in[I_ODIN], DM, ODN, (bf16*)(ws + WS_WODIN), 32 * nb, scr, kb, nb, F.lane); continue; }
            r -= I_OI;
            if (r < I_OO) { const int nb = r % 64, kb = r / 64; transpose_item(A.in[I_ODOUT], DM, DM, (bf16*)(ws + WS_WODOUT), 32 * nb, scr, kb, nb, F.lane); continue; }
            r -= I_OO;
            { const int mat = r / 8, item = r % 8, nb = item % 4, kb = item / 4;
                const float* W; bf16* dst;
                if (mat < 16) { W = A.in[I_WA] + (size_t)mat * 16384; dst = (bf16*)(ws + WS_LRUW) + (size_t)mat * 16384; }
                else if (mat < 32) { W = A.in[I_WX] + (size_t)(mat - 16) * 16384; dst = (bf16*)(ws + WS_LRUW) + (size_t)mat * 16384; }
                else { W = A.in[I_POOLW] + (size_t)(mat - 32) * 16384; dst = (bf16*)(ws + WS_POOLW) + (size_t)(mat - 32) * 16384; }
                transpose_item(W, 128, 128, dst, 32 * nb, scr, kb, nb, F.lane); }
        }
    }
    {
        const int gt = F.bid * 512 + F.tid, NT = F.G * 512;
        float* c1 = (float*)(ws + WS_COS1); float* s1 = (float*)(ws + WS_SIN1); float* c2 = (float*)(ws + WS_COS2); float* s2 = (float*)(ws + WS_SIN2);
        for (int i = gt; i < SEQ * 128 + SEQ * 64; i += NT) {
            float pos, f; float* cd; float* sd;
            if (i < SEQ * 128) { const int t = i >> 7, k = i & 127; pos = (float)t; f = exp2f(-(float)k * (13.287712379549449f / 128.f)); cd = c1 + i; sd = s1 + i; }
            else { const int j = i - SEQ * 128, t = j >> 6, k = j & 63; pos = (k < 32) ? (float)(t >> 6) : (float)(t & 63); f = exp2f(-(float)(k & 31) * (13.287712379549449f / 32.f)); cd = c2 + j; sd = s2 + j; }
            const float ang = pos * f;
            double rev = (double)ang * 0.15915494309189535; rev -= __builtin_rint(rev);
            const float fr = (float)rev;
            *cd = __builtin_amdgcn_cosf(fr); *sd = __builtin_amdgcn_sinf(fr);
        }
    }
}

struct ResCfg { int has_res, has_next, li, sub, li2, sub2, nrows; float wres; const float* xold_l; const float* xold_c; float* xnew_l; float* xnew_c; };
DEV void res_rows(const Frame& F, const ResCfg& C, int m0, int cnt, int prow) {
    const Args& A = *F.a; const float* MOD = (const float*)(A.ws + WS_MOD); bf16* H = (bf16*)(A.ws + WS_H);
    f32x4 Ca[8], Cb[8], Cs[8];
    int e0 = 4 * F.lane; asm volatile("" : "+v"(e0));
    if (C.has_res) {
        const float* gate = MOD + (size_t)(C.li * 5 + prow) * 18432 + C.sub * 6144 + 4096; const float* gp = A.in[I_NPOST] + (C.li * 3 + C.sub) * DM;
#pragma unroll
        for (int j = 0; j < 8; ++j) Ca[j] = *(const f32x4*)(gate + 256 * j + e0) * *(const f32x4*)(gp + 256 * j + e0) * C.wres;
    }
    if (C.has_next) {
        const float* sh = MOD + (size_t)(C.li2 * 5 + prow) * 18432 + C.sub2 * 6144; const float* sc = sh + 2048; const float* gp = A.in[I_NPRE] + (C.li2 * 3 + C.sub2) * DM;
#pragma unroll
        for (int j = 0; j < 8; ++j) { Cb[j] = *(const f32x4*)(gp + 256 * j + e0) * (*(const f32x4*)(sc + 256 * j + e0) + 1.f); Cs[j] = *(const f32x4*)(sh + 256 * j + e0); }
    }
    for (int m = m0; m < m0 + cnt; ++m) {
        const float* xo = (m < ML) ? C.xold_l + (size_t)m * DM : C.xold_c + (size_t)(m - ML) * DM;
        f32x4 x[8];
#pragma unroll
        for (int j = 0; j < 8; ++j) x[j] = *(const f32x4*)(xo + 256 * j + e0);
        if (C.has_res) {
            u32x2 yv[8]; const bf16* yr = H + (size_t)m * DM;
#pragma unroll
            for (int j = 0; j < 8; ++j) yv[j] = *(const u32x2*)(yr + 256 * j + e0);
            float ss = 0.f;
#pragma unroll
            for (int j = 0; j < 8; ++j) { const float a = bflo(yv[j].x), b = bfhi(yv[j].x), c = bflo(yv[j].y), d = bfhi(yv[j].y); ss += (a * a + b * b) + (c * c + d * d); }
            const float rs = __builtin_amdgcn_rsqf(wave_sum(ss) * (1.f / DM) + EPS);
            float* xn = (m < ML) ? C.xnew_l + (size_t)m * DM : C.xnew_c + (size_t)(m - ML) * DM;
#pragma unroll
            for (int j = 0; j < 8; ++j) { const f32x4 yy = (f32x4){bflo(yv[j].x), bfhi(yv[j].x), bflo(yv[j].y), bfhi(yv[j].y)}; x[j] = x[j] + Ca[j] * (yy * rs); *(f32x4*)(xn + 256 * j + e0) = x[j]; }
        }
        if (C.has_next) {
            float ss = 0.f;
#pragma unroll
            for (int j = 0; j < 8; ++j) ss += (x[j].x * x[j].x + x[j].y * x[j].y) + (x[j].z * x[j].z + x[j].w * x[j].w);
            const float rs = __builtin_amdgcn_rsqf(wave_sum(ss) * (1.f / DM) + EPS);
            bf16* hr = H + (size_t)m * DM;
#pragma unroll
            for (int j = 0; j < 8; ++j) { const f32x4 h = x[j] * rs * Cb[j] + Cs[j]; u32x2 w; w.x = pkbf(h.x, h.y); w.y = pkbf(h.z, h.w); *(u32x2*)(hr + 256 * j + e0) = w; }
        }
    }
}
DEV void res_phase(const Frame& F, const ResCfg& C) {
    const int gw = F.bid * 8 + F.wave, NGW = F.G * 8;
    for (int blk = gw; blk < ML / 16; blk += NGW) res_rows(F, C, blk * 16, 16, (blk * 16) / SEQ);
    if (C.nrows > ML) {
        if (NGW >= 2 * MC) { if ((gw & 1) == 0 && (gw >> 1) < MC) res_rows(F, C, ML + (gw >> 1), 1, 4); }
        else { const int per = (MC + NGW - 1) / NGW, r0 = gw * per, cnt = (MC - r0) < per ? (MC - r0) : per; if (cnt > 0) res_rows(F, C, ML + r0, cnt, 4); }
    }
}

constexpr int LRU_UB = 0, LRU_UB_LD = 272, LRU_ARR = 17408, LRU_ARR_SZ = 32768;
DEV int lru_chunk_row0(int b, int ck) { return (ck < 4) ? ML + b * CTXL + 64 * ck : b * SEQ + 64 * (ck - 4); }
DEV float one_minus_exp(float t) {
    const float ser = -t * (1.f + t * 0.5f * (1.f + t * (1.f / 3.f) * (1.f + t * 0.25f * (1.f + t * 0.2f * (1.f + t * (1.f / 6.f))))));
    return (t > -0.25f) ? ser : 1.f - fexp(t);
}
template <bool FINAL> DEV void lru_phase(const Frame& F, bool dry = false) {
    const Args& A = *F.a; unsigned char* ws = A.ws; bf16* E = (bf16*)(ws + WS_E);
    const int tid = F.tid, wave = F.wave;
    LAS unsigned char* UB = F.lds + LRU_UB; LAS float* ARR = (LAS float*)(F.lds + LRU_ARR); LAS unsigned char* RS = F.lds + LRU_ARR;
    constexpr int NIT = NB * 8 * NCH64;
    u32x4 rp[3];
#define LRU_LOAD(it_) do { const int ck_ = (it_) % NCH64, bn_ = (it_) / NCH64, n_ = bn_ & 7, b_ = bn_ >> 3; \
        const int L_ = (ck_ < 4) ? CTXL : SEQ, p0_ = (ck_ < 4) ? 64 * ck_ : 64 * (ck_ - 4), rb_ = (ck_ < 4) ? ML + b_ * CTXL : b_ * SEQ; \
        _Pragma("unroll") for (int i_ = 0; i_ < 3; ++i_) { const int pc = tid + 512 * i_, rr = pc >> 4, c8 = pc & 15, pos = p0_ - 2 + rr; \
            rp[i_] = (u32x4){0u, 0u, 0u, 0u}; if (pc < 67 * 16 && pos >= 0 && pos < L_) rp[i_] = *(const u32x4*)(E + (size_t)(rb_ + pos) * EVN + EC_R + 128 * n_ + 8 * c8); } } while (0)
    if (F.bid < NIT) LRU_LOAD(F.bid);
    for (int it = F.bid; it < NIT; it += F.G) {
        int lane = F.lane; asm volatile("" : "+v"(lane));
        const int r32 = lane & 31, hh = lane >> 5;
        const int ck = it % NCH64, bn = it / NCH64, n = bn & 7, b = bn >> 3;
        const int p0 = (ck < 4) ? 64 * ck : 64 * (ck - 4), rowbase = (ck < 4) ? ML + b * CTXL : b * SEQ;
#pragma unroll
        for (int i = 0; i < 3; ++i) { const int pc = tid + 512 * i, rr = pc >> 4, c8 = pc & 15; if (pc < 67 * 16) *(LAS u32x4*)(RS + rr * 256 + c8 * 16) = rp[i]; }
        __syncthreads();
        for (int pc = tid; pc < 64 * 16; pc += 512) { const int tt = pc >> 4, c8 = pc & 15, ch = 128 * n + 8 * c8;
            float u[8];
            { const f32x4 b0 = *(const f32x4*)(A.in[I_CONVB] + ch), b1 = *(const f32x4*)(A.in[I_CONVB] + ch + 4); u[0] = b0.x; u[1] = b0.y; u[2] = b0.z; u[3] = b0.w; u[4] = b1.x; u[5] = b1.y; u[6] = b1.z; u[7] = b1.w; }
#pragma unroll
            for (int k = 0; k < 4; ++k) { const u32x4 rv = *(const LAS u32x4*)(RS + (tt + k) * 256 + c8 * 16); const f32x4 w0 = *(const f32x4*)(A.in[I_CONVW] + k * 1024 + ch), w1 = *(const f32x4*)(A.in[I_CONVW] + k * 1024 + ch + 4);
                u[0] += w0.x * bflo(rv.x); u[1] += w0.y * bfhi(rv.x); u[2] += w0.z * bflo(rv.y); u[3] += w0.w * bfhi(rv.y);
                u[4] += w1.x * bflo(rv.z); u[5] += w1.y * bfhi(rv.z); u[6] += w1.z * bflo(rv.w); u[7] += w1.w * bfhi(rv.w); }
            u32x4 o = {pkbf(u[0], u[1]), pkbf(u[2], u[3]), pkbf(u[4], u[5]), pkbf(u[6], u[7])};
            *(LAS u32x4*)(UB + tt * LRU_UB_LD + c8 * 16) = o; }
        __syncthreads();
        if (it + F.G < NIT) LRU_LOAD(it + F.G);
        {
            const int d = wave >> 2, cq = wave & 3, col = 32 * cq + r32, chn = 128 * n + col;
            const bf16* WA = (const bf16*)(ws + WS_LRUW) + (size_t)(d * 8 + n) * 16384 + (size_t)col * 128 + 8 * hh;
            const bf16* WX = WA + (size_t)16 * 16384;
            f32x16 aa[2] = {f32x16{}, f32x16{}}, ax[2] = {f32x16{}, f32x16{}};
#pragma unroll
            for (int ks = 0; ks < 8; ++ks) {
                const bf16x8 fa = *(const bf16x8*)(WA + 16 * ks), fx = *(const bf16x8*)(WX + 16 * ks);
#pragma unroll
                for (int rt = 0; rt < 2; ++rt) { const bf16x8 af = *(const LAS bf16x8*)(UB + (32 * rt + r32) * LRU_UB_LD + (16 * ks + 8 * hh) * 2);
                    aa[rt] = __builtin_amdgcn_mfma_f32_32x32x16_bf16(af, fa, aa[rt], 0, 0, 0); ax[rt] = __builtin_amdgcn_mfma_f32_32x32x16_bf16(af, fx, ax[rt], 0, 0, 0); }
            }
            const float ba = A.in[I_BA][d * 1024 + chn], bx = A.in[I_BX][d * 1024 + chn], sp8 = -8.f * log1pf(expf(-A.in[I_LAM][d * 1024 + chn]));
            LAS float* AO = ARR + (size_t)(d * 2) * (LRU_ARR_SZ / 4); LAS float* BO = AO + LRU_ARR_SZ / 4;
#pragma unroll
            for (int rt = 0; rt < 2; ++rt)
#pragma unroll
                for (int r = 0; r < 16; ++r) { const int row = 32 * rt + crow(r, hh);
                    const float la = sp8 * fsigmoid(aa[rt][r] + ba), av = fexp(la), mlt = __builtin_amdgcn_sqrtf(one_minus_exp(2.f * la));
                    const float uv = bf2f(*(const LAS bf16*)(UB + row * LRU_UB_LD + col * 2));
                    AO[row * 128 + col] = av; BO[row * 128 + col] = mlt * fsigmoid(ax[rt][r] + bx) * uv; }
        }
        __syncthreads();
        if (tid < 256) { const int d = tid >> 7, c = tid & 127; LAS float* AO = ARR + (size_t)(d * 2) * (LRU_ARR_SZ / 4); const LAS float* BO = AO + LRU_ARR_SZ / 4;
            const size_t gi = ((size_t)(ck * NB + b) * 2 + d) * 1024 + 128 * n + c;
            if (!FINAL) { float h = 0.f, P = 1.f;
#pragma unroll 8
                for (int s = 0; s < 64; ++s) { const int tt = d ? 63 - s : s; const float a = AO[tt * 128 + c]; h = a * h + BO[tt * 128 + c]; P *= a; }
                ((f32x2*)(ws + WS_AGG))[gi] = (f32x2){P, h}; }
            else { float h = ((const float*)(ws + WS_CAR))[gi];
#pragma unroll 8
                for (int s = 0; s < 64; ++s) { const int tt = d ? 63 - s : s; h = AO[tt * 128 + c] * h + BO[tt * 128 + c]; AO[tt * 128 + c] = h; } }
        }
        __syncthreads();
        if (FINAL) {
            const LAS float* H0 = ARR; const LAS float* H1 = ARR + 2 * (LRU_ARR_SZ / 4);
            for (int pc = tid; pc < 64 * 16; pc += 512) { const int tt = pc >> 4, c8 = pc & 15;
                bf16* gp = E + (size_t)(rowbase + p0 + tt) * EVN + EC_G + 128 * n + 8 * c8; const u32x4 gv = *(const u32x4*)gp;
                const f32x4 h0a = *(const LAS f32x4*)(H0 + tt * 128 + 8 * c8), h0b = *(const LAS f32x4*)(H0 + tt * 128 + 8 * c8 + 4), h1a = *(const LAS f32x4*)(H1 + tt * 128 + 8 * c8), h1b = *(const LAS f32x4*)(H1 + tt * 128 + 8 * c8 + 4);
                const f32x4 sa = h0a + h1a, sb = h0b + h1b;
                u32x4 w = {pkbf(fgelu_tanh(bflo(gv.x)) * sa.x, fgelu_tanh(bfhi(gv.x)) * sa.y), pkbf(fgelu_tanh(bflo(gv.y)) * sa.z, fgelu_tanh(bfhi(gv.y)) * sa.w),
                           pkbf(fgelu_tanh(bflo(gv.z)) * sb.x, fgelu_tanh(bfhi(gv.z)) * sb.y), pkbf(fgelu_tanh(bflo(gv.w)) * sb.z, fgelu_tanh(bfhi(gv.w)) * sb.w)};
                bf16* wp = dry ? (bf16*)(ws + WS_H) + (size_t)(rowbase + p0 + tt) * DM + 128 * n + 8 * c8 : gp; *(u32x4*)wp = w; }
            __syncthreads();
        }
    }
#undef LRU_LOAD
}
DEV void lru_carry_phase(const Frame& F) {
    unsigned char* ws = F.a->ws; const f32x2* AGG = (const f32x2*)(ws + WS_AGG); float* CAR = (float*)(ws + WS_CAR);
    const int gw = F.bid * 8 + F.wave, NGW = F.G * 8;
    for (int it = gw; it < NB * 2 * 16; it += NGW) { const int cg = it & 15, d = (it >> 4) & 1, b = it >> 5;
        float h = 0.f;
#pragma unroll 12
        for (int idx = 0; idx < NCH64; ++idx) { const int ck = d ? (idx < 4 ? 3 - idx : NCH64 + 3 - idx) : idx;
            const size_t gi = ((size_t)(ck * NB + b) * 2 + d) * 1024 + 64 * cg + F.lane; const f32x2 v = AGG[gi]; CAR[gi] = h; h = v.x * h + v.y; }
    }
}

DEV int ret_chunk_row0(int b, int cid) { return (cid < 2) ? ML + b * CTXL + 128 * cid : b * SEQ + 128 * (cid - 2); }
DEV int ret_chain(int d, int idx) { return d ? (idx < 2 ? 1 - idx : NCH128 + 1 - idx) : idx; }
DEV float ret_logg(const Args& A, int d, int h) { const float lg = A.in[I_DECAY][d * 4 + h]; return -log1pf(expf(-lg)); }
constexpr int RET_LD = 528, RET_VLD = 80;
DEV void ret_state_phase(const Frame& F) {
    const Args& A = *F.a; unsigned char* ws = A.ws; const bf16* E = (const bf16*)(ws + WS_E); bf16* SB = (bf16*)(ws + WS_SBUF);
    const int tid = F.tid, lane = F.lane, wave = F.wave, r32 = lane & 31, hh = lane >> 5;
    LAS unsigned char* KS = F.lds; LAS unsigned char* VS = F.lds + 128 * RET_LD;
    for (int it = F.bid; it < 256; it += F.G) {
        const int es = it & 7, d = (it >> 3) & 1, h = (it >> 4) & 3, b = it >> 6;
        const float lg = ret_logg(A, d, h), sdec = expf(lg * 128.f);
        const int vrow = tid >> 2, vc4 = tid & 3; const float vw = expf(lg * (float)(d ? vrow : 127 - vrow));
        u32x4 kreg[8], vreg;
        f32x16 acc = f32x16{};
#define RS_LOAD(cid_) do { const int m0_ = ret_chunk_row0(b, cid_); \
            _Pragma("unroll") for (int i = 0; i < 8; ++i) { const int id = tid + 512 * i, row = id >> 5, c16 = id & 31; kreg[i] = *(const u32x4*)(E + (size_t)(m0_ + row) * EVN + EC_K + 256 * h + 8 * c16); } \
            vreg = *(const u32x4*)(E + (size_t)(m0_ + vrow) * EVN + EC_V + 256 * h + 32 * es + 8 * vc4); } while (0)
        RS_LOAD(ret_chain(d, 0));
        for (int idx = 0; idx < NCH128; ++idx) {
            const int cid = ret_chain(d, idx);
#pragma unroll
            for (int i = 0; i < 8; ++i) { const int id = tid + 512 * i, row = id >> 5, c16 = id & 31; *(LAS u32x4*)(KS + row * RET_LD + c16 * 16) = kreg[i]; }
            { u32x4 w; w.x = pkbf(bflo(vreg.x) * vw, bfhi(vreg.x) * vw); w.y = pkbf(bflo(vreg.y) * vw, bfhi(vreg.y) * vw); w.z = pkbf(bflo(vreg.z) * vw, bfhi(vreg.z) * vw); w.w = pkbf(bflo(vreg.w) * vw, bfhi(vreg.w) * vw);
              *(LAS u32x4*)(VS + vrow * RET_VLD + vc4 * 16) = w; }
            __syncthreads();
            if (idx + 1 < NCH128) RS_LOAD(ret_chain(d, idx + 1));
            { bf16* sp = SB + ((size_t)(((b * 4 + h) * 2 + d) * NCH128 + cid) * 256 + 32 * es + r32) * 256 + 32 * wave + 4 * hh;
#pragma unroll
              for (int g = 0; g < 4; ++g) { u32x2 w; w.x = pkbf(acc[4 * g], acc[4 * g + 1]); w.y = pkbf(acc[4 * g + 2], acc[4 * g + 3]); *(u32x2*)(sp + 8 * g) = w; } }
#pragma unroll
            for (int r = 0; r < 16; ++r) acc[r] *= sdec;
#pragma unroll
            for (int ks = 0; ks < 8; ++ks) { const bf16x8 af = tr_frag(KS, RET_LD, 16 * ks, 32 * wave, lane); const bf16x8 bfr = tr_frag(VS, RET_VLD, 16 * ks, 0, lane);
                acc = __builtin_amdgcn_mfma_f32_32x32x16_bf16(af, bfr, acc, 0, 0, 0); }
            __syncthreads();
        }
#undef RS_LOAD
    }
}
DEV void ret_out_phase(const Frame& F, bool dry = false) {
    const Args& A = *F.a; unsigned char* ws = A.ws; bf16* E = (bf16*)(ws + WS_E); const bf16* SB = (const bf16*)(ws + WS_SBUF);
    const int wave = F.wave, ib = wave & 3, eh = wave >> 2;
    LAS unsigned char* RA = F.lds; LAS unsigned char* RB = F.lds + 128 * RET_LD; LAS float* GX = (LAS float*)(F.lds + 2 * 128 * RET_LD);
    constexpr int PLD = 272;
    for (int it = F.bid; it < 16 * NCH128; it += F.G) {
        int tid = F.tid; asm volatile("" : "+v"(tid)); int lane = tid & 63;
        const int r32 = lane & 31, hh = lane >> 5;
        const int cid = it % NCH128, bh = it / NCH128, h = bh & 3, b = bh >> 2, m0 = ret_chunk_row0(b, cid);
        const float lg0 = ret_logg(A, 0, h), lg1 = ret_logg(A, 1, h);
        bf16x8 qf[16];
        { const bf16* qp = E + (size_t)(m0 + 32 * ib + r32) * EVN + EC_Q + 256 * h + 8 * hh;
#pragma unroll
          for (int ks = 0; ks < 16; ++ks) qf[ks] = *(const bf16x8*)(qp + 16 * ks); }
        f32x16 o[4];
#pragma unroll
        for (int et = 0; et < 4; ++et) o[et] = f32x16{};
#pragma unroll 1
        for (int d = 0; d < 2; ++d) {
            const bf16* sp = SB + (size_t)((bh * 2 + d) * NCH128 + cid) * 65536; const float lgd = d ? lg1 : lg0;
            __syncthreads();
#pragma unroll
            for (int i = 0; i < 16; ++i) { const int id = tid + 512 * i, row = id >> 5, c16 = id & 31; *(LAS u32x4*)(RA + row * RET_LD + c16 * 16) = *(const u32x4*)(sp + (size_t)row * 256 + 8 * c16);
                if ((i & 3) == 3) asm volatile("" ::: "memory"); }
            __syncthreads();
#pragma unroll
            for (int et = 0; et < 4; ++et) { f32x16 T = f32x16{};
                const LAS unsigned char* bp = RA + (128 * eh + 32 * et + r32) * RET_LD + 16 * hh;
#pragma unroll
                for (int ks = 0; ks < 16; ++ks) { const bf16x8 bfr = *(const LAS bf16x8*)(bp + 32 * ks); T = __builtin_amdgcn_mfma_f32_32x32x16_bf16(qf[ks], bfr, T, 0, 0, 0); }
#pragma unroll
                for (int r = 0; r < 16; ++r) { const int i = 32 * ib + crow(r, hh); const float rs = fexp(lgd * (float)(d ? 128 - i : i + 1)); o[et][r] += T[r] * rs; } }
        }
        __syncthreads();
        int tid2 = tid; asm volatile("" : "+v"(tid2));
#pragma unroll
        for (int i = 0; i < 8; ++i) { const int id = tid2 + 512 * i, row = id >> 5, c16 = id & 31;
            *(LAS u32x4*)(RA + row * RET_LD + c16 * 16) = *(const u32x4*)(E + (size_t)(m0 + row) * EVN + EC_K + 256 * h + 8 * c16);
            *(LAS u32x4*)(RB + row * RET_LD + c16 * 16) = *(const u32x4*)(E + (size_t)(m0 + row) * EVN + EC_V + 256 * h + 8 * c16);
            if (i & 1) asm volatile("" ::: "memory"); }
        __syncthreads();
        u32x2 pw[2][4];
        { const int i = 32 * ib + r32;
#pragma unroll
          for (int jj = 0; jj < 2; ++jj) { const int jt = 2 * eh + jj;
            f32x16 X = f32x16{};
#pragma unroll
            for (int ks = 0; ks < 16; ++ks) { const bf16x8 af = *(const LAS bf16x8*)(RA + (32 * jt + r32) * RET_LD + (16 * ks + 8 * hh) * 2); X = __builtin_amdgcn_mfma_f32_32x32x16_bf16(af, qf[ks], X, 0, 0, 0); }
#pragma unroll
            for (int g = 0; g < 4; ++g) { float pv[4];
#pragma unroll
                for (int q = 0; q < 4; ++q) { const int j = 32 * jt + 8 * g + 4 * hh + q; const int dl = i - j; const float f = (dl > 0) ? fexp(lg0 * (float)dl) : (dl < 0) ? fexp(-lg1 * (float)dl) : 2.f; pv[q] = X[4 * g + q] * f; }
                pw[jj][g].x = pkbf(pv[0], pv[1]); pw[jj][g].y = pkbf(pv[2], pv[3]); } } }
        __syncthreads();
        { const int i = 32 * ib + r32;
#pragma unroll
          for (int jj = 0; jj < 2; ++jj)
#pragma unroll
            for (int g = 0; g < 4; ++g) *(LAS u32x2*)(RA + i * PLD + (32 * (2 * eh + jj) + 8 * g + 4 * hh) * 2) = pw[jj][g]; }
        __syncthreads();
#pragma unroll
        for (int ks = 0; ks < 8; ++ks) { const bf16x8 pa = *(const LAS bf16x8*)(RA + (32 * ib + r32) * PLD + (16 * ks + 8 * hh) * 2);
#pragma unroll
            for (int et = 0; et < 4; ++et) { const bf16x8 bfr = tr_frag(RB, RET_LD, 16 * ks, 128 * eh + 32 * et, lane); o[et] = __builtin_amdgcn_mfma_f32_32x32x16_bf16(pa, bfr, o[et], 0, 0, 0); } }
#pragma unroll
        for (int r = 0; r < 16; ++r) { float a = 0.f, q = 0.f;
#pragma unroll
            for (int et = 0; et < 4; ++et) { a += o[et][r]; q += o[et][r] * o[et][r]; }
#pragma unroll
            for (int off = 1; off < 32; off <<= 1) { a += __shfl_xor(a, off); q += __shfl_xor(q, off); }
            if (r32 == 0) { GX[(wave * 32 + crow(r, hh)) * 2] = a; GX[(wave * 32 + crow(r, hh)) * 2 + 1] = q; } }
        __syncthreads();
        { const float* gn = A.in[I_GN] + 256 * h + 128 * eh;
#pragma unroll
          for (int r = 0; r < 16; ++r) { const int rw = crow(r, hh); const float a = GX[(wave * 32 + rw) * 2] + GX[((wave ^ 4) * 32 + rw) * 2], q = GX[(wave * 32 + rw) * 2 + 1] + GX[((wave ^ 4) * 32 + rw) * 2 + 1];
            const float mean = a * (1.f / 256.f), var = q * (1.f / 256.f) - mean * mean, rstd = __builtin_amdgcn_rsqf(var + EPS);
            bf16* op = E + (size_t)(m0 + 32 * ib + rw) * EVN + EC_O + 256 * h + 128 * eh + r32;
#pragma unroll
            for (int et = 0; et < 4; ++et) { const float og = bf2f(op[32 * et]); bf16* wp = dry ? (bf16*)(ws + WS_H) + (size_t)(m0 + 32 * ib + rw) * DM + 1024 + 256 * h + 128 * eh + r32 : op;
                wp[32 * et] = f2bf((o[et][r] - mean) * rstd * gn[32 * et + r32] * fsilu(og)); } } }
    }
    __syncthreads();
}
DEV void odd_post_phase(const Frame& F) {
    const Args& A = *F.a; unsigned char* ws = A.ws; const bf16* E2 = (const bf16*)(ws + WS_E2);
    bf16* QB = (bf16*)(ws + WS_QB); bf16* KB = (bf16*)(ws + WS_KB); bf16* VB = (bf16*)(ws + WS_VB); bf16* MIX = (bf16*)(ws + WS_MIX2);
    const float* c2 = (const float*)(ws + WS_COS2); const float* s2 = (const float*)(ws + WS_SIN2);
    const int tid = F.tid, wave = F.wave;
    {
        const int gw = F.bid * 8 + F.wave, NGW = F.G * 8; const int lane0 = F.lane;
        const float qg1 = A.in[I_QN][lane0], qg2 = A.in[I_QN][64 + lane0], kg1 = A.in[I_KN][lane0], kg2 = A.in[I_KN][64 + lane0];
        for (int m = gw; m < MT; m += NGW) {
            int lane = F.lane; asm volatile("" : "+v"(lane));
            const bool lat = m < ML; const int b = lat ? m / SEQ : (m - ML) / CTXL, t = lat ? m % SEQ : 0, kpos = lat ? CTXL + t : (m - ML) % CTXL;
            const bf16* er = E2 + (size_t)m * ODN;
            float cs = 1.f, sn = 0.f; if (lat) { cs = c2[t * 64 + lane]; sn = s2[t * 64 + lane]; }
            if (lat) {
#pragma unroll 4
                for (int hq = 0; hq < 12; ++hq) { const float x1 = bf2f(er[512 + 128 * hq + lane]), x2 = bf2f(er[512 + 128 * hq + 64 + lane]);
                    const float rs = __builtin_amdgcn_rsqf(wave_sum(x1 * x1 + x2 * x2) * (1.f / 128.f) + EPS); const float y1 = x1 * rs * qg1, y2 = x2 * rs * qg2;
                    bf16* qo = QB + (size_t)m * 1536 + 128 * hq; qo[lane] = f2bf(y1 * cs - y2 * sn); qo[64 + lane] = f2bf(y1 * sn + y2 * cs); }
            }
            bf16* ko = KB + ((size_t)b * KVL + kpos) * 512; bf16* vo = VB + ((size_t)b * KVL + kpos) * 512;
#pragma unroll
            for (int hk = 0; hk < 4; ++hk) { const float x1 = bf2f(er[2048 + 128 * hk + lane]), x2 = bf2f(er[2048 + 128 * hk + 64 + lane]);
                const float rs = __builtin_amdgcn_rsqf(wave_sum(x1 * x1 + x2 * x2) * (1.f / 128.f) + EPS); const float y1 = x1 * rs * kg1, y2 = x2 * rs * kg2;
                ko[128 * hk + lane] = f2bf(y1 * cs - y2 * sn); ko[128 * hk + 64 + lane] = f2bf(y1 * sn + y2 * cs); }
            *(u32x4*)(vo + 8 * lane) = *(const u32x4*)(er + 2560 + 8 * lane);
        }
    }
    {
        const int lane = F.lane, r32 = lane & 31, hh = lane >> 5;
        LAS unsigned char* XS = F.lds; LAS unsigned char* DS = F.lds + 144 * 256; constexpr int DLD = 272;
        for (int it = F.bid; it < (ML / 128) * 4; it += F.G) {
            const int gi = it & 3, rt = it >> 2, b = (rt * 128) / SEQ, t0 = (rt * 128) % SEQ, half = 1 << gi;
            __syncthreads();
            for (int pc = tid; pc < 144 * 16; pc += 512) { const int rr = pc >> 4, c8 = pc & 15, pos = t0 - 8 + rr;
                u32x4 v = {0u, 0u, 0u, 0u}; if (pos >= 0 && pos < SEQ) v = *(const u32x4*)(E2 + (size_t)(b * SEQ + pos) * ODN + 128 * gi + 8 * c8);
                *(LAS u32x4*)(XS + rr * 256 + c8 * 16) = v; }
            __syncthreads();
            for (int pc = tid; pc < 128 * 16; pc += 512) { const int tt = pc >> 4, c8 = pc & 15, t = t0 + tt;
                const int lo = (t - half) < 0 ? 0 : t - half, hi = (t + half) > SEQ ? SEQ : t + half; const float inv = 1.f / (float)(hi - lo);
                float s[8] = {0.f, 0.f, 0.f, 0.f, 0.f, 0.f, 0.f, 0.f};
                for (int p = lo; p < hi; ++p) { const u32x4 v = *(const LAS u32x4*)(XS + (p - t0 + 8) * 256 + c8 * 16);
                    s[0] += bflo(v.x); s[1] += bfhi(v.x); s[2] += bflo(v.y); s[3] += bfhi(v.y); s[4] += bflo(v.z); s[5] += bfhi(v.z); s[6] += bflo(v.w); s[7] += bfhi(v.w); }
                const u32x4 xv = *(const LAS u32x4*)(XS + (tt + 8) * 256 + c8 * 16);
                u32x4 o; o.x = pkbf(s[0] * inv - bflo(xv.x), s[1] * inv - bfhi(xv.x)); o.y = pkbf(s[2] * inv - bflo(xv.y), s[3] * inv - bfhi(xv.y));
                o.z = pkbf(s[4] * inv - bflo(xv.z), s[5] * inv - bfhi(xv.z)); o.w = pkbf(s[6] * inv - bflo(xv.w), s[7] * inv - bfhi(xv.w));
                *(LAS u32x4*)(DS + tt * DLD + c8 * 16) = o; }
            __syncthreads();
            { const int rb = wave & 3, chh = wave >> 2; const bf16* WT = (const bf16*)(ws + WS_POOLW) + (size_t)gi * 16384;
              f32x16 acc[2] = {f32x16{}, f32x16{}};
#pragma unroll
              for (int ks = 0; ks < 8; ++ks) { const bf16x8 af = *(const LAS bf16x8*)(DS + (32 * rb + r32) * DLD + (16 * ks + 8 * hh) * 2);
#pragma unroll
                  for (int ct = 0; ct < 2; ++ct) { const bf16x8 bfr = *(const bf16x8*)(WT + (size_t)(64 * chh + 32 * ct + r32) * 128 + 16 * ks + 8 * hh);
                      acc[ct] = __builtin_amdgcn_mfma_f32_32x32x16_bf16(af, bfr, acc[ct], 0, 0, 0); } }
#pragma unroll
              for (int ct = 0; ct < 2; ++ct) { const int col = 128 * gi + 64 * chh + 32 * ct + r32; const float ps = A.in[I_POOLS][col];
#pragma unroll
                  for (int r = 0; r < 16; ++r) MIX[(size_t)(b * SEQ + t0 + 32 * rb + crow(r, hh)) * DM + col] = f2bf(acc[ct][r] * ps); } }
        }
        __syncthreads();
    }
}
DEV void attn_phase(const Frame& F) {
    unsigned char* ws = F.a->ws; const bf16* QB = (const bf16*)(ws + WS_QB); const bf16* KB = (const bf16*)(ws + WS_KB); const bf16* VB = (const bf16*)(ws + WS_VB); bf16* MIX = (bf16*)(ws + WS_MIX2);
    for (int u = F.bid; u < NB * 12 * (SEQ / 256); u += F.G) {
        const int qb = u & 31, g = (u >> 5) % 3, kvh = ((u >> 5) / 3) & 3, b = (u >> 5) / 12, hq = kvh * 3 + g;
        att::attn_dense_body<1536, 512, DM>(QB + (size_t)(b * SEQ + 256 * qb) * 1536 + 128 * hq, KB + (size_t)b * KVL * 512 + 128 * kvh, VB + (size_t)b * KVL * 512 + 128 * kvh,
                                           MIX + (size_t)(b * SEQ + 256 * qb) * DM + 512 + 128 * hq, KVL, (char*)F.lds);
    }
}

constexpr int NPH = 25;
__global__ void __launch_bounds__(512, 2) mk_fwd(Args args) {
    extern __shared__ __attribute__((aligned(16))) unsigned char lds_raw[];
    Frame F; F.lds = (LAS unsigned char*)lds_raw; F.tid = threadIdx.x; F.lane = F.tid & 63; F.wave = __builtin_amdgcn_readfirstlane(F.tid >> 6); F.G = gridDim.x; F.bid = blockIdx.x; F.a = &args;
    unsigned char* ws = args.ws;
    volatile LAS unsigned* MISC = (volatile LAS unsigned*)(F.lds + MISC_OFF);
    if (F.tid < 64) MISC[F.tid] = 0u;
    __syncthreads();
    XcdBarrier bar; bar.bar = (unsigned*)(ws + WS_CTL) + CW_BAR; bar.x = 0; bar.st = nullptr;
    const int lo = args.ph_lo, hi = args.ph_hi;
    if (hi - lo > 1) bar = xcd_barrier_post((unsigned*)(ws + WS_CTL) + CW_BAR, MISC + 8);
#ifndef MK_MASK
#define MK_MASK 0xFFFFFFFFu
#endif
#define IN(k) (((MK_MASK >> (k)) & 1u) && lo <= (k) && (k) < hi && (k) <= MK_STOP_AFTER)
#define SEAM(k) do { if (IN(k) && (k) + 1 < hi) xcd_barrier(bar); } while (0)
#ifndef MK_DOUBLE
#define MK_DOUBLE 0u
#endif
#ifndef MK_STAMP
#define MK_STAMP (-1)
#endif
#define PHASE(k) do { if ((k) == MK_STAMP) t_stamp0 = wall_clock64(); if (IN(k)) { PH_BODY_##k; if ((MK_DOUBLE >> (k)) & 1u) { xcd_barrier(bar); PH_BODY_##k; } } SEAM(k); if ((k) == MK_STAMP) t_stamp1 = wall_clock64(); } while (0)
    bf16* H = (bf16*)(ws + WS_H); bf16* ACT = (bf16*)(ws + WS_ACT); bf16* E = (bf16*)(ws + WS_E); bf16* E2 = (bf16*)(ws + WS_E2); bf16* MIX2 = (bf16*)(ws + WS_MIX2);
    float* XC = (float*)(ws + WS_XC);
#define GEMM_GU(lf, M_) do { pg8::Gemm g{H, (const bf16*)(ws + WS_WGU + (size_t)(lf) * 44 * MiB), (M_), 2 * DFF, DM, DM}; pg8::StaticOrder S; S.init((M_), 2 * DFF, F.G, F.bid); \
        pg8::EpiSwiGLU Ep{ACT, DFF}; pg8::gemm_phase<pg8::EpiSwiGLU, pg8::StaticOrder, PG8_ALIGN, PG8_SP2>(F.lds, g, S, Ep); } while (0)
#define GEMM_DN(lf, M_) do { pg8::Gemm g{ACT, (const bf16*)(ws + WS_WD + (size_t)(lf) * 22 * MiB), (M_), DM, DFF, DFF}; pg8::StaticOrder S; S.init((M_), DM, F.G, F.bid); \
        pg8::EpiPlain Ep{H, DM}; pg8::gemm_phase<pg8::EpiPlain, pg8::StaticOrder, PG8_ALIGN, PG8_SP2>(F.lds, g, S, Ep); } while (0)
#define RES(hr, hn, li_, sub_, li2_, sub2_, nrows_, w_, xol, xoc) do { ResCfg C{(hr), (hn), (li_), (sub_), (li2_), (sub2_), (nrows_), (w_), (xol), (xoc), args.out, XC}; res_phase(F, C); } while (0)

    unsigned long long t_stamp0 = 0, t_stamp1 = 0;
#define PH_BODY_0 p0_prologue(F)
    PHASE(0);
#define PH_BODY_1 RES(0, 1, 0, 0, 0, 0, MT, 0.f, args.in[I_X], args.in[I_CTX]);
    PHASE(1);
#define PH_BODY_2 GEMM_GU(0, MT)
    PHASE(2);
#define PH_BODY_3 GEMM_DN(0, MT)
    PHASE(3);
#define PH_BODY_4 RES(1, 1, 0, 0, 0, 1, MT, 0.5f, args.in[I_X], args.in[I_CTX])
    PHASE(4);
#define PH_BODY_5 { pg8::Gemm g{H, (const bf16*)(ws + WS_WEVIN), MT, EVN, DM, DM}; pg8::StaticOrder S; S.init(MT, EVN, F.G, F.bid); \
        pg8::EpiEvIn Ep{E, (const float*)(ws + WS_COS1), (const float*)(ws + WS_SIN1)}; pg8::gemm_phase<pg8::EpiEvIn, pg8::StaticOrder, PG8_ALIGN, PG8_SP2>(F.lds, g, S, Ep); }
    PHASE(5);
#define PH_BODY_6 lru_phase<false>(F)
    PHASE(6);
#define PH_BODY_7 { lru_carry_phase(F); ret_state_phase(F); }
    PHASE(7);
#ifndef MK_P8
#define MK_P8 3
#endif
#ifndef MK_DRY8
#define MK_DRY8 0
#endif
#define PH_BODY_8 { if (MK_DRY8 & 1) { lru_phase<true>(F, true); xcd_barrier(bar); } if (MK_DRY8 & 2) { ret_out_phase(F, true); xcd_barrier(bar); } if (MK_P8 & 1) lru_phase<true>(F); if (MK_P8 & 2) ret_out_phase(F); }
    PHASE(8);
#define PH_BODY_9 { pg8::Gemm g{E, (const bf16*)(ws + WS_WEVOUT), MT, DM, DM, EVN}; pg8::StaticOrder S; S.init(MT, DM, F.G, F.bid); \
        pg8::EpiPlain Ep{H, DM}; pg8::gemm_phase<pg8::EpiPlain, pg8::StaticOrder, PG8_ALIGN, PG8_SP2>(F.lds, g, S, Ep); }
    PHASE(9);
#define PH_BODY_10 RES(1, 1, 0, 1, 0, 2, MT, 1.0f, args.out, XC)
    PHASE(10);
#define PH_BODY_11 GEMM_GU(1, MT)
    PHASE(11);
#define PH_BODY_12 GEMM_DN(1, MT)
    PHASE(12);
#define PH_BODY_13 RES(1, 1, 0, 2, 1, 0, MT, 0.5f, args.out, XC)
    PHASE(13);
#define PH_BODY_14 GEMM_GU(2, MT)
    PHASE(14);
#define PH_BODY_15 GEMM_DN(2, MT)
    PHASE(15);
#define PH_BODY_16 RES(1, 1, 1, 0, 1, 1, MT, 0.5f, args.out, XC)
    PHASE(16);
#define PH_BODY_17 { pg8::Gemm g{H, (const bf16*)(ws + WS_WODIN), MT, ODN, DM, DM}; pg8::StaticOrder S; S.init(MT, ODN, F.G, F.bid); \
        pg8::EpiPlain Ep{E2, ODN}; pg8::gemm_phase<pg8::EpiPlain, pg8::StaticOrder, PG8_ALIGN, PG8_SP2>(F.lds, g, S, Ep); }
    PHASE(17);
#define PH_BODY_18 odd_post_phase(F)
    PHASE(18);
#define PH_BODY_19 attn_phase(F)
    PHASE(19);
#define PH_BODY_20 { pg8::Gemm g{MIX2, (const bf16*)(ws + WS_WODOUT), ML, DM, DM, DM}; pg8::StaticOrder S; S.init(ML, DM, F.G, F.bid); \
        pg8::EpiPlain Ep{H, DM}; pg8::gemm_phase<pg8::EpiPlain, pg8::StaticOrder, PG8_ALIGN, PG8_SP2>(F.lds, g, S, Ep); }
    PHASE(20);
#define PH_BODY_21 RES(1, 1, 1, 1, 1, 2, ML, 1.0f, args.out, XC)
    PHASE(21);
#define PH_BODY_22 GEMM_GU(3, ML)
    PHASE(22);
#define PH_BODY_23 GEMM_DN(3, ML)
    PHASE(23);
#define PH_BODY_24 RES(1, 0, 1, 2, 0, 0, ML, 0.5f, args.out, XC)
    PHASE(24);
    if (MK_STAMP >= 0 && F.bid == 0 && F.tid == 0) args.out[0] = 64.f * floorf((float)(t_stamp1 - t_stamp0) * 0.01f / 64.f + 0.5f);
#undef IN
#undef SEAM
}

extern "C" void kernel_launch(void* const* d_in, const int* in_sizes, int n_in, void* d_out, int out_size, void* d_ws, size_t ws_size, hipStream_t stream) {
    static int grid = 0;
    if (grid == 0) {
        if (n_in != 28 || out_size != ML * DM || ws_size < WS_END) { fprintf(stderr, "kernel_launch: unexpected shapes (n_in %d out %d ws %zu, need ws >= %zu)\n", n_in, out_size, ws_size, (size_t)WS_END); grid = -1; return; }
        int dev = 0, cus = 0, per_cu = 0;
        if (hipGetDevice(&dev) != hipSuccess || hipDeviceGetAttribute(&cus, hipDeviceAttributeMultiprocessorCount, dev) != hipSuccess) { grid = -1; return; }
        if (hipFuncSetAttribute((const void*)mk_fwd, hipFuncAttributeMaxDynamicSharedMemorySize, LDS_BYTES) != hipSuccess) { fprintf(stderr, "kernel_launch: hipFuncSetAttribute failed\n"); grid = -1; return; }
        if (hipOccupancyMaxActiveBlocksPerMultiprocessor(&per_cu, (const void*)mk_fwd, 512, LDS_BYTES) != hipSuccess || per_cu < 1) fprintf(stderr, "kernel_launch: occupancy query says %d\n", per_cu);
        (void)hipGetLastError();
        grid = cus;
    }
    if (grid < 0) return;
    (void)hipMemsetAsync((char*)d_ws + WS_CTL, 0, CTL_ZERO_BYTES, stream);
    Args a{};
    for (int i = 0; i < 28; ++i) a.in[i] = (const float*)d_in[i];
    a.out = (float*)d_out; a.ws = (unsigned char*)d_ws;
#if MK_N_LAUNCHES == 1
    a.ph_lo = 0; a.ph_hi = NPH;
    hipLaunchKernelGGL(mk_fwd, dim3(grid), dim3(512), LDS_BYTES, stream, a);
#else
    for (int p = 0; p < NPH && p <= MK_STOP_AFTER; ++p) { a.ph_lo = p; a.ph_hi = p + 1; hipLaunchKernelGGL(mk_fwd, dim3(grid), dim3(512), LDS_BYTES, stream, a); }
#endif
    const hipError_t le = hipPeekAtLastError();
    if (le != hipSuccess) fprintf(stderr, "kernel_launch: launch failed: %s\n", hipGetErrorName(le));
}
```

```cpp
#include <hip/hip_runtime.h>
#include <cstdio>
#include <cstdint>

#ifndef MK_N_LAUNCHES
#define MK_N_LAUNCHES 1
#endif
#ifndef MK_STOP_AFTER
#define MK_STOP_AFTER 1000
#endif

#define DEV __device__ __forceinline__
#define LAS __attribute__((address_space(3)))
typedef unsigned short bf16;
typedef float f32x4 __attribute__((ext_vector_type(4)));
typedef float f32x2 __attribute__((ext_vector_type(2)));
typedef float f32x16 __attribute__((ext_vector_type(16)));
typedef short bf16x8 __attribute__((ext_vector_type(8)));
typedef short s16x4 __attribute__((ext_vector_type(4)));
typedef unsigned u32x4 __attribute__((ext_vector_type(4)));
typedef unsigned u32x2 __attribute__((ext_vector_type(2)));

constexpr int NB = 4, SEQ = 8192, DM = 2048, CTXL = 256, DFF = 5632;
constexpr int ML = NB * SEQ, MC = NB * CTXL, MT = ML + MC;
constexpr float EPS = 1e-6f;
constexpr int EVN = 6144, ODN = 3072;
constexpr int EC_G = 0, EC_O = 1024, EC_Q = 2048, EC_K = 3072, EC_V = 4096, EC_R = 5120;
constexpr int NCH64 = (CTXL + SEQ) / 64;
constexpr int NCH128 = (CTXL + SEQ) / 128;
constexpr int KVL = CTXL + SEQ;

constexpr size_t MiB = 1u << 20;
constexpr size_t WS_CTL = 0, CTL_ZERO_BYTES = 1 * MiB;
constexpr size_t WS_MOD = 1 * MiB;
constexpr size_t WS_COS1 = 2 * MiB, WS_SIN1 = 6 * MiB;
constexpr size_t WS_COS2 = 10 * MiB, WS_SIN2 = 12 * MiB;
constexpr size_t WS_LRUW = 14 * MiB;
constexpr size_t WS_POOLW = 15 * MiB;
constexpr size_t WS_AGG = 16 * MiB;
constexpr size_t WS_CAR = 25 * MiB;
constexpr size_t WS_XC = 30 * MiB;
constexpr size_t WS_W = 40 * MiB;
constexpr size_t WS_WGU = WS_W;
constexpr size_t WS_WD = WS_W + 176 * MiB;
constexpr size_t WS_WEVIN = WS_W + 264 * MiB;
constexpr size_t WS_WEVOUT = WS_W + 288 * MiB;
constexpr size_t WS_WODIN = WS_W + 296 * MiB;
constexpr size_t WS_WODOUT = WS_W + 308 * MiB;
constexpr size_t WS_H = 356 * MiB;
constexpr size_t WS_BIG = 488 * MiB;
constexpr size_t WS_ACT = WS_BIG;
constexpr size_t WS_E = WS_BIG;
constexpr size_t WS_SBUF = WS_BIG + 396 * MiB;
constexpr size_t WS_E2 = WS_BIG;
constexpr size_t WS_QB = WS_BIG + 198 * MiB;
constexpr size_t WS_KB = WS_BIG + 294 * MiB;
constexpr size_t WS_VB = WS_BIG + 327 * MiB;
constexpr size_t WS_MIX2 = WS_BIG + 360 * MiB;
constexpr size_t WS_END = 1148 * MiB;
constexpr int CW_BAR = 4096;

constexpr int LDS_BYTES = 159744;
constexpr int MISC_OFF = LDS_BYTES - 256;

DEV float bflo(unsigned w) { return __uint_as_float(w << 16); }
DEV float bfhi(unsigned w) { return __uint_as_float(w & 0xffff0000u); }
DEV float bf2f(bf16 b) { return __uint_as_float((unsigned)b << 16); }
DEV unsigned pkbf(float lo, float hi) { unsigned r; asm volatile("v_cvt_pk_bf16_f32 %0, %1, %2" : "=v"(r) : "v"(lo), "v"(hi)); return r; }
DEV bf16 f2bf(float f) { return (bf16)(pkbf(f, 0.f) & 0xffffu); }
DEV float fexp(float x) { return __builtin_amdgcn_exp2f(x * 1.4426950408889634f); }
DEV float fsigmoid(float x) { return __builtin_amdgcn_rcpf(1.f + fexp(-x)); }
DEV float fsilu(float x) { return x * fsigmoid(x); }
DEV float fgelu_tanh(float x) { const float z = 0.7978845608028654f * (x + 0.044715f * x * x * x); return x * fsigmoid(2.f * z); }
DEV float wave_sum(float v) {
#pragma unroll
    for (int o = 1; o < 64; o <<= 1) v += __shfl_xor(v, o);
    return v;
}
DEV int crow(int r, int hi) { return (r & 3) + 8 * (r >> 2) + 4 * hi; }
typedef short v4i16_t __attribute__((ext_vector_type(4)));
DEV s16x4 ds_tr(const LAS unsigned char* p) { return __builtin_bit_cast(s16x4, __builtin_amdgcn_ds_read_tr16_b64_v4i16((LAS v4i16_t*)p)); }
DEV bf16x8 tr_frag(const LAS unsigned char* X, int ld, int k0, int n0, int lane) {
    const int h = lane >> 5, blk = (lane >> 4) & 1, q = (lane & 15) >> 2, p = lane & 3;
    const LAS unsigned char* a = X + (k0 + 8 * h + q) * ld + (n0 + 16 * blk + 4 * p) * 2;
    const s16x4 lo = ds_tr(a), hi = ds_tr(a + 4 * ld);
    return (bf16x8){lo[0], lo[1], lo[2], lo[3], hi[0], hi[1], hi[2], hi[3]};
}
DEV bf16x8 pack8(const float* v) { u32x4 w = {pkbf(v[0], v[1]), pkbf(v[2], v[3]), pkbf(v[4], v[5]), pkbf(v[6], v[7])}; return __builtin_bit_cast(bf16x8, w); }

namespace pg8 {
typedef unsigned short bf16_t;
constexpr int BM = 256, BK = 64, HALF = 128, HTB = HALF * BK * 2, STAGE_BYTES = 8 * HTB, NXCD = 8, WGM = 8;
__host__ __device__ __forceinline__ int lds_byte(int r, int c) { const int st = (r >> 4) * 2 + (c >> 5), rr = r & 15, cc = c & 31, ob = rr * 64 + cc * 2; return st * 1024 + (ob ^ (((ob >> 9) & 1) << 5)); }
__host__ __device__ __forceinline__ void stage_rc(int b, int& R, int& C) { const int st = b / 1024, sb = b % 1024, swz = sb ^ (((sb >> 9) & 1) << 5); R = (st >> 1) * 16 + swz / 64; C = (st & 1) * 32 + (swz % 64) / 2; }
__host__ __device__ __forceinline__ int perm32(int rho) { const int n = rho >> 4, i = rho & 15; return 8 * (i >> 2) + 4 * n + (i & 3); }
struct Unit { int pm, pn; };
struct Gemm { const bf16_t* A; const bf16_t* Bt; int M, N, K, lda; };
struct StaticOrder {
    int nM, nN, nwg, G, c;
    __host__ __device__ void init(int M, int N, int G_, int c_) { nM = M / BM; nN = N / BM; nwg = nM * nN; G = G_; c = c_; }
    __host__ __device__ bool next(int i, Unit& u) const {
        const long L = (long)i * G + c; if (L >= nwg) return false;
        int wgid = (int)L; { const int q = nwg / NXCD, r = nwg % NXCD, xcd = wgid % NXCD, off = wgid / NXCD; wgid = (xcd < r ? xcd * (q + 1) : r * (q + 1) + (xcd - r) * q) + off; }
        const int nig = WGM * nN, gid = wgid / nig, fm = gid * WGM, gsz = (nM - fm) < WGM ? (nM - fm) : WGM;
        u.pm = fm + ((wgid % nig) % gsz); u.pn = (wgid % nig) / gsz; return true;
    }
    __device__ __forceinline__ void a_ready(const Unit&) const {}
    __device__ __forceinline__ void done(const Unit&) const {}
};
struct EpiPlain {
    static constexpr bool PERM = true, AFTER_DRAIN = false;
    bf16_t* O; int ldc;
    __device__ __forceinline__ void operator()(const f32x4 (&acc)[2][2][4][2], const Unit& u, int wr, int wc, int fr, int fq) const {
        const int row0 = u.pm * BM + wr * 64 + fr, col0 = u.pn * BM + wc * 32 + 8 * fq;
#pragma unroll
        for (int ai = 0; ai < 2; ++ai)
#pragma unroll
            for (int m = 0; m < 4; ++m) { bf16_t* rowp = O + (size_t)(row0 + ai * HALF + m * 16) * ldc + col0;
#pragma unroll
                for (int bj = 0; bj < 2; ++bj) { const f32x4 v0 = acc[ai][bj][m][0], v1 = acc[ai][bj][m][1];
                    u32x4 w; w.x = pkbf(v0[0], v0[1]); w.y = pkbf(v0[2], v0[3]); w.z = pkbf(v1[0], v1[1]); w.w = pkbf(v1[2], v1[3]);
                    *(u32x4*)(rowp + bj * HALF) = w; } }
    }
};
struct EpiSwiGLU {
    static constexpr bool PERM = true, AFTER_DRAIN = false;
    bf16_t* O; int ldc;
    __device__ __forceinline__ void operator()(const f32x4 (&acc)[2][2][4][2], const Unit& u, int wr, int wc, int fr, int fq) const {
        const int row0 = u.pm * BM + wr * 64 + fr, col0 = u.pn * HALF + wc * 32 + 8 * fq;
#pragma unroll
        for (int ai = 0; ai < 2; ++ai)
#pragma unroll
            for (int m = 0; m < 4; ++m) { bf16_t* rowp = O + (size_t)(row0 + ai * HALF + m * 16) * ldc + col0;
                f32x4 a0, a1;
#pragma unroll
                for (int j = 0; j < 4; ++j) { a0[j] = fsilu(acc[ai][0][m][0][j]) * acc[ai][1][m][0][j]; a1[j] = fsilu(acc[ai][0][m][1][j]) * acc[ai][1][m][1][j]; }
                u32x4 w; w.x = pkbf(a0[0], a0[1]); w.y = pkbf(a0[2], a0[3]); w.z = pkbf(a1[0], a1[1]); w.w = pkbf(a1[2], a1[3]);
                *(u32x4*)rowp = w; }
    }
};
struct EpiEvIn {
    static constexpr bool PERM = true, AFTER_DRAIN = false;
    bf16_t* O; const float* cs; const float* sn;
    __device__ __forceinline__ void operator()(const f32x4 (&acc)[2][2][4][2], const Unit& u, int wr, int wc, int fr, int fq) const {
        const int ldc = EVN; const int row0 = u.pm * BM + wr * 64 + fr, col0 = u.pn * BM + wc * 32 + 8 * fq;
        const bool qk = (u.pn >= 8 && u.pn < 16), rot = qk && (u.pm < ML / BM); const float ksc = (u.pn >= 12 && u.pn < 16) ? 0.0625f : 1.f;
#pragma unroll
        for (int ai = 0; ai < 2; ++ai)
#pragma unroll
            for (int m = 0; m < 4; ++m) { const int row = row0 + ai * HALF + m * 16; bf16_t* rowp = O + (size_t)row * ldc + col0;
                f32x4 o1[2], o2[2];
#pragma unroll
                for (int n = 0; n < 2; ++n) { const f32x4 x1 = acc[ai][0][m][n], x2 = acc[ai][1][m][n];
                    if (rot) { const int t = row & (SEQ - 1); const int i0 = wc * 32 + 8 * fq + 4 * n;
                        const f32x4 c4 = *(const f32x4*)(cs + (size_t)t * 128 + i0), s4 = *(const f32x4*)(sn + (size_t)t * 128 + i0);
                        o1[n] = (x1 * c4 - x2 * s4) * ksc; o2[n] = (x1 * s4 + x2 * c4) * ksc; }
                    else { o1[n] = x1 * ksc; o2[n] = x2 * ksc; } }
                u32x4 w; w.x = pkbf(o1[0][0], o1[0][1]); w.y = pkbf(o1[0][2], o1[0][3]); w.z = pkbf(o1[1][0], o1[1][1]); w.w = pkbf(o1[1][2], o1[1][3]);
                *(u32x4*)rowp = w;
                w.x = pkbf(o2[0][0], o2[0][1]); w.y = pkbf(o2[0][2], o2[0][3]); w.z = pkbf(o2[1][0], o2[1][1]); w.w = pkbf(o2[1][2], o2[1][3]);
                *(u32x4*)(rowp + HALF) = w; }
    }
};

template <class Epi, class Sched, bool ALIGN_EPI = false, bool SP2 = false>
__device__ __forceinline__ void gemm_phase(LAS unsigned char* lds, const Gemm g, const Sched& S, const Epi& E) {
    const int tid = threadIdx.x, wid = __builtin_amdgcn_readfirstlane(tid >> 6), lane = tid & 63, wr = wid >> 2, wc = wid & 3, fr = lane & 15, fq = lane >> 4;
    const int K = g.K, nt = K / BK, lda = g.lda;
    unsigned voffA[2], voffB[2];
#pragma unroll
    for (int i = 0; i < 2; ++i) { int R, C; stage_rc(tid * 16 + i * 8192, R, C); const int Rb = Epi::PERM ? ((R & ~31) + perm32(R & 31)) : R;
        voffA[i] = (unsigned)(R * lda + C) * 2u; voffB[i] = (unsigned)(Rb * K + C) * 2u; }
    const size_t kstep = (size_t)(BK * 2);
    const size_t hstepA = (size_t)HALF * lda * 2, hstepB = (size_t)HALF * K * 2;
    const size_t tstepA = 2 * hstepA, tstepB = 2 * hstepB;
    const unsigned ldsw = (unsigned)wid * 1024u;
    const int aoff = lds_byte(wr * 64 + fr, fq * 8), boff = lds_byte(wc * 32 + fr, fq * 8);
#define PG8_SA(b, h) (((b) * 2 + (h)) * HTB)
#define PG8_SB(b, h) ((4 + (b) * 2 + (h)) * HTB)
#define PG8_STAGE(bufoff, gbase, voff) do { _Pragma("unroll") for (int _i = 0; _i < 2; ++_i) \
        __builtin_amdgcn_global_load_lds((const unsigned*)((const char*)(gbase) + (voff)[_i]), (LAS unsigned*)(lds + (bufoff) + ldsw + _i * 8192), 16, 0, 0); } while (0)
#define PG8_LDA(dst, b, h) do { _Pragma("unroll") for (int m = 0; m < 4; ++m) _Pragma("unroll") for (int k = 0; k < 2; ++k) dst[m][k] = *(const LAS bf16x8*)(lds + PG8_SA(b, h) + aoff + m * 2048 + k * 1024); } while (0)
#define PG8_LDB(dst, b, h) do { _Pragma("unroll") for (int n = 0; n < 2; ++n) _Pragma("unroll") for (int k = 0; k < 2; ++k) dst[n][k] = *(const LAS bf16x8*)(lds + PG8_SB(b, h) + boff + n * 2048 + k * 1024); } while (0)
#define PG8_MMA(ai, bj, At, Bt) do { __builtin_amdgcn_s_setprio(1); _Pragma("unroll") for (int m = 0; m < 4; ++m) _Pragma("unroll") for (int n = 0; n < 2; ++n) _Pragma("unroll") for (int k = 0; k < 2; ++k) \
        acc[ai][bj][m][n] = __builtin_amdgcn_mfma_f32_16x16x32_bf16(Bt[n][k], At[m][k], acc[ai][bj][m][n], 0, 0, 0); __builtin_amdgcn_s_setprio(0); } while (0)
#define PG8_WAIT_V(n) asm volatile("s_waitcnt vmcnt(" #n ")" ::: "memory")
#define PG8_WAIT_L(n) asm volatile("s_waitcnt lgkmcnt(" #n ")" ::: "memory")
#define PG8_BAR __builtin_amdgcn_s_barrier()
#define PG8_SCHED __builtin_amdgcn_sched_barrier(0)
    Unit cur, nxt; int ui = 0;
    if (!S.next(0, cur)) return;
    f32x4 acc[2][2][4][2];
#pragma unroll
    for (int a = 0; a < 2; ++a)
#pragma unroll
        for (int b = 0; b < 2; ++b)
#pragma unroll
            for (int m = 0; m < 4; ++m)
#pragma unroll
                for (int n = 0; n < 2; ++n) acc[a][b][m][n] = (f32x4){0.f, 0.f, 0.f, 0.f};
    bf16x8 At[4][2], B0[2][2], B1[2][2];
    const char* cA = (const char*)g.A + (size_t)cur.pm * tstepA; const char* cB = (const char*)g.Bt + (size_t)cur.pn * tstepB;
    S.a_ready(cur);
    if constexpr (SP2) {
        PG8_STAGE(PG8_SB(0, 0), cB, voffB); PG8_STAGE(PG8_SB(0, 1), cB + hstepB, voffB); PG8_STAGE(PG8_SA(0, 0), cA, voffA); PG8_STAGE(PG8_SA(0, 1), cA + hstepA, voffA);
        if (wr == 1) PG8_BAR;
        PG8_WAIT_V(2); PG8_BAR;
        PG8_STAGE(PG8_SB(1, 0), cB + kstep, voffB); PG8_STAGE(PG8_SA(1, 0), cA + kstep, voffA); PG8_STAGE(PG8_SB(1, 1), cB + hstepB + kstep, voffB);
        PG8_WAIT_V(6); PG8_BAR;
    } else {
        PG8_STAGE(PG8_SB(0, 0), cB, voffB); PG8_STAGE(PG8_SA(0, 0), cA, voffA); PG8_STAGE(PG8_SB(0, 1), cB + hstepB, voffB); PG8_STAGE(PG8_SA(0, 1), cA + hstepA, voffA);
        if (wr == 1) PG8_BAR;
        PG8_WAIT_V(4); PG8_BAR;
        PG8_STAGE(PG8_SB(1, 0), cB + kstep, voffB); PG8_STAGE(PG8_SA(1, 0), cA + kstep, voffA); PG8_STAGE(PG8_SB(1, 1), cB + hstepB + kstep, voffB);
        PG8_WAIT_V(6); PG8_BAR;
    }
    for (;;) {
        const bool has_next = S.next(ui + 1, nxt);
        const char* nA = has_next ? (const char*)g.A + (size_t)nxt.pm * tstepA : cA; const char* nB = has_next ? (const char*)g.Bt + (size_t)nxt.pn * tstepB : cB;
        for (int t = 0; t < nt; t += 2) {
            const bool last = (t == nt - 2);
            const char* a1 = cA + (size_t)(t + 1) * kstep;
            const char* a2 = last ? nA : cA + (size_t)(t + 2) * kstep; const char* b2 = last ? nB : cB + (size_t)(t + 2) * kstep;
            const char* a3 = a2 + kstep; const char* b3 = b2 + kstep;
            if (last && has_next) S.a_ready(nxt);
            if constexpr (SP2) {
            PG8_LDB(B0, 0, 0); PG8_LDB(B1, 0, 1); PG8_SCHED; PG8_LDA(At, 0, 0); PG8_STAGE(PG8_SA(1, 1), a1 + hstepA, voffA);
            PG8_WAIT_V(8); PG8_WAIT_L(0); PG8_BAR; PG8_MMA(0, 0, At, B0); PG8_MMA(0, 1, At, B1); PG8_BAR; PG8_SCHED;
            PG8_LDA(At, 0, 1); PG8_STAGE(PG8_SB(0, 0), b2, voffB); PG8_STAGE(PG8_SB(0, 1), b2 + hstepB, voffB); PG8_STAGE(PG8_SA(0, 0), a2, voffA);
            PG8_WAIT_V(8); PG8_WAIT_L(0); PG8_BAR; PG8_MMA(1, 0, At, B0); PG8_MMA(1, 1, At, B1); PG8_BAR; PG8_SCHED;
            PG8_LDB(B0, 1, 0); PG8_LDB(B1, 1, 1); PG8_SCHED; PG8_LDA(At, 1, 0); PG8_STAGE(PG8_SA(0, 1), a2 + hstepA, voffA);
            PG8_WAIT_V(8); PG8_WAIT_L(0); PG8_BAR; PG8_MMA(0, 0, At, B0); PG8_MMA(0, 1, At, B1); PG8_BAR; PG8_SCHED;
            PG8_LDA(At, 1, 1); PG8_STAGE(PG8_SB(1, 0), b3, voffB); PG8_STAGE(PG8_SB(1, 1), b3 + hstepB, voffB); PG8_STAGE(PG8_SA(1, 0), a3, voffA);
            PG8_WAIT_V(8); PG8_WAIT_L(0); PG8_BAR; PG8_MMA(1, 0, At, B0); PG8_MMA(1, 1, At, B1); PG8_BAR; PG8_SCHED;
            } else {
            PG8_LDB(B0, 0, 0); PG8_SCHED; PG8_LDA(At, 0, 0); PG8_STAGE(PG8_SA(1, 1), a1 + hstepA, voffA);
            PG8_WAIT_L(8); PG8_BAR; PG8_WAIT_L(0); PG8_MMA(0, 0, At, B0); PG8_BAR; PG8_SCHED;
            PG8_LDB(B1, 0, 1); PG8_STAGE(PG8_SB(0, 0), b2, voffB);
            PG8_BAR; PG8_WAIT_L(0); PG8_MMA(0, 1, At, B1); PG8_BAR;
            PG8_LDA(At, 0, 1); PG8_STAGE(PG8_SA(0, 0), a2, voffA);
            PG8_BAR; PG8_WAIT_L(0); PG8_MMA(1, 0, At, B0); PG8_BAR; PG8_SCHED;
            PG8_STAGE(PG8_SB(0, 1), b2 + hstepB, voffB);
            PG8_WAIT_V(6); PG8_BAR; PG8_MMA(1, 1, At, B1); PG8_BAR;
            PG8_LDB(B0, 1, 0); PG8_SCHED; PG8_LDA(At, 1, 0); PG8_STAGE(PG8_SA(0, 1), a2 + hstepA, voffA);
            PG8_WAIT_L(8); PG8_BAR; PG8_WAIT_L(0); PG8_MMA(0, 0, At, B0); PG8_BAR; PG8_SCHED;
            PG8_LDB(B1, 1, 1); PG8_STAGE(PG8_SB(1, 0), b3, voffB);
            PG8_BAR; PG8_WAIT_L(0); PG8_MMA(0, 1, At, B1); PG8_BAR;
            PG8_LDA(At, 1, 1); PG8_STAGE(PG8_SA(1, 0), a3, voffA);
            PG8_BAR; PG8_WAIT_L(0); PG8_MMA(1, 0, At, B0); PG8_BAR; PG8_SCHED;
            PG8_STAGE(PG8_SB(1, 1), b3 + hstepB, voffB);
            PG8_WAIT_V(6); PG8_BAR; PG8_MMA(1, 1, At, B1); PG8_BAR;
            }
        }
        if constexpr (ALIGN_EPI) { if (wr == 0) PG8_BAR; }
        if constexpr (!Epi::AFTER_DRAIN) { E(acc, cur, wr, wc, fr, fq); S.done(cur); }
        if (!has_next) break;
#pragma unroll
        for (int a = 0; a < 2; ++a)
#pragma unroll
            for (int b = 0; b < 2; ++b)
#pragma unroll
                for (int m = 0; m < 4; ++m)
#pragma unroll
                    for (int n = 0; n < 2; ++n) acc[a][b][m][n] = (f32x4){0.f, 0.f, 0.f, 0.f};
        cur = nxt; cA = nA; cB = nB; ++ui;
        if constexpr (ALIGN_EPI) { if (wr == 1) PG8_BAR; }
    }
    PG8_WAIT_V(0);
    if constexpr (!ALIGN_EPI) { if (wr == 0) PG8_BAR; }
    PG8_BAR;
#undef PG8_SA
#undef PG8_SB
#undef PG8_STAGE
#undef PG8_LDA
#undef PG8_LDB
#undef PG8_MMA
#undef PG8_WAIT_V
#undef PG8_WAIT_L
#undef PG8_BAR
#undef PG8_SCHED
}
}
#define PG8_SP2 true
#define PG8_ALIGN true

namespace att {
constexpr int D = 128, NW = 8, QBLK = 32, KVBLK = 64;
constexpr float SCALE = 0.088388347648318440f;
constexpr float THR = 8.f;
constexpr size_t SHM_V = KVBLK * D * 2, SHM_K = KVBLK * D * 2, SHM_ATTN = 2 * SHM_V + 2 * SHM_K + NW * 64 * 4;
#define KSWZ(row, colB) ((row) * 256 + ((colB) ^ (((row) & 7) << 4)))
#define SBAR() __builtin_amdgcn_sched_barrier(0)
DEV void partialSM(f32x16& p0, f32x16& p1, float& m_reg, float& mn, float& alpha) {
  constexpr float C = SCALE * 1.4426950408889634f;
  float pmax = p0[0]; for (int r = 1; r < 16; ++r) pmax = fmaxf(pmax, p0[r]); for (int r = 0; r < 16; ++r) pmax = fmaxf(pmax, p1[r]);
  { auto rr = __builtin_amdgcn_permlane32_swap(__float_as_uint(pmax), __float_as_uint(pmax), false, false);
    pmax = fmaxf(__uint_as_float(rr[0]), __uint_as_float(rr[1])); }
  if (__builtin_expect(__all(pmax - m_reg <= THR / SCALE), 1)) { mn = m_reg; alpha = 1.f; }
  else { mn = fmaxf(m_reg, pmax); alpha = __builtin_amdgcn_exp2f((m_reg - mn) * C); m_reg = mn; }
  float mnC = -mn * C;
  for (int r = 0; r < 16; ++r) p0[r] = fmaf(p0[r], C, mnC); for (int r = 0; r < 16; ++r) p1[r] = fmaf(p1[r], C, mnC);
  for (int r = 0; r < 16; ++r) p0[r] = __builtin_amdgcn_exp2f(p0[r]);
}
DEV void finishSM(f32x16& p0, f32x16& p1, float alpha, float& l_reg, bf16x8& pa0, bf16x8& pa1, bf16x8& pa2, bf16x8& pa3) {
  for (int r = 0; r < 16; ++r) p1[r] = __builtin_amdgcn_exp2f(p1[r]);
  float ps = 0; for (int r = 0; r < 16; ++r) ps += p0[r]; for (int r = 0; r < 16; ++r) ps += p1[r];
  { auto rr = __builtin_amdgcn_permlane32_swap(__float_as_uint(ps), __float_as_uint(ps), false, false);
    ps = __uint_as_float(rr[0]) + __uint_as_float(rr[1]); }
  l_reg = l_reg * alpha + ps;
#define PK4(P, BASE, OUT) do { unsigned a0 = pkbf(P[BASE + 0], P[BASE + 1]), a1 = pkbf(P[BASE + 2], P[BASE + 3]);   \
    unsigned b0 = pkbf(P[BASE + 4], P[BASE + 5]), b1 = pkbf(P[BASE + 6], P[BASE + 7]);                              \
    auto r0 = __builtin_amdgcn_permlane32_swap(a0, b0, false, false); auto r1 = __builtin_amdgcn_permlane32_swap(a1, b1, false, false); \
    u32x4 w = {r0[0], r1[0], r0[1], r1[1]}; OUT = __builtin_bit_cast(bf16x8, w); } while (0)
  PK4(p0, 0, pa0); PK4(p0, 8, pa1); PK4(p1, 0, pa2); PK4(p1, 8, pa3);
#undef PK4
}
DEV void qkt(f32x16& p0, f32x16& p1, const bf16* Ks, const bf16x8* qr, int r32, int hi) {
  p0 = f32x16{}; p1 = f32x16{};
  for (int d0 = 0; d0 < 8; ++d0) { int cb = (d0 * 16 + hi * 8) * 2;
    bf16x8 b0 = *reinterpret_cast<const bf16x8*>((const char*)Ks + KSWZ(r32, cb));
    bf16x8 b1 = *reinterpret_cast<const bf16x8*>((const char*)Ks + KSWZ(32 + r32, cb));
    p0 = __builtin_amdgcn_mfma_f32_32x32x16_bf16(b0, qr[d0], p0, 0, 0, 0);
    p1 = __builtin_amdgcn_mfma_f32_32x32x16_bf16(b1, qr[d0], p1, 0, 0, 0); }
}
DEV int v_st(int k, int c) { const int kk = (k & ~0xC) | ((k & 4) << 1) | ((k & 8) >> 1); return ((kk >> 3) * 4 + (c >> 5)) * 512 + ((kk & 7) * 32 + (c & 31)) * 2; }
DEV int v_rd_base(int lane) { return ((lane & 3) << 3) | (((lane >> 2) & 3) << 6) | (((lane >> 4) & 1) << 5) | (((lane >> 5) & 1) << 8); }
constexpr int v_rd_off(int d0, int ks, int half) { return d0 * 512 + ks * 4096 + half * 2048; }
template <int OFF> DEV s16x4 tr_read(int vb) {
  s16x4 r; asm volatile("ds_read_b64_tr_b16 %0, %1 offset:%2" : "=&v"(r) : "v"(vb), "i"(OFF) : "memory"); return r;
}
template <int D0> DEV void pv_one(f32x16& od, int vb, bf16x8 pa0, bf16x8 pa1, bf16x8 pa2, bf16x8 pa3) {
  const s16x4 l0 = tr_read<v_rd_off(D0, 0, 0)>(vb), h0 = tr_read<v_rd_off(D0, 0, 1)>(vb), l1 = tr_read<v_rd_off(D0, 1, 0)>(vb), h1 = tr_read<v_rd_off(D0, 1, 1)>(vb);
  const s16x4 l2 = tr_read<v_rd_off(D0, 2, 0)>(vb), h2 = tr_read<v_rd_off(D0, 2, 1)>(vb), l3 = tr_read<v_rd_off(D0, 3, 0)>(vb), h3 = tr_read<v_rd_off(D0, 3, 1)>(vb);
  asm volatile("s_waitcnt lgkmcnt(0)" ::: "memory"); SBAR();
#define PK(L, H) (bf16x8){L[0], L[1], L[2], L[3], H[0], H[1], H[2], H[3]}
  od = __builtin_amdgcn_mfma_f32_32x32x16_bf16(pa0, PK(l0, h0), od, 0, 0, 0);
  od = __builtin_amdgcn_mfma_f32_32x32x16_bf16(pa1, PK(l1, h1), od, 0, 0, 0);
  od = __builtin_amdgcn_mfma_f32_32x32x16_bf16(pa2, PK(l2, h2), od, 0, 0, 0);
  od = __builtin_amdgcn_mfma_f32_32x32x16_bf16(pa3, PK(l3, h3), od, 0, 0, 0);
#undef PK
}
DEV void pv_d0(f32x16* o, int vb, bf16x8 pa0, bf16x8 pa1, bf16x8 pa2, bf16x8 pa3) {
  pv_one<0>(o[0], vb, pa0, pa1, pa2, pa3); pv_one<1>(o[1], vb, pa0, pa1, pa2, pa3); pv_one<2>(o[2], vb, pa0, pa1, pa2, pa3); pv_one<3>(o[3], vb, pa0, pa1, pa2, pa3);
}
template <int LDQ, int LDK, int LDO>
DEV void attn_dense_body(const bf16* __restrict__ Qb, const bf16* __restrict__ Kh, const bf16* __restrict__ Vh, bf16* __restrict__ Ob, int seq, char* lds) {
  const int tid = threadIdx.x, wid = tid >> 6, lane = tid & 63, r32 = lane & 31, hi = lane >> 5;
  bf16* V_lds = (bf16*)lds; bf16* K_lds = (bf16*)(lds + 2 * SHM_V);
  float* ws = (float*)(lds + 2 * SHM_V + 2 * SHM_K) + wid * 64; float* li_l = ws; float* al_l = ws + 32;
  float m_reg = -1e30f, l_reg = 0; f32x16 o[4] = {}; bf16x8 qr[8];
  const bf16* Qw = Qb + (long)(wid * QBLK + r32) * LDQ + hi * 8;
#pragma unroll
  for (int d0 = 0; d0 < 8; ++d0) qr[d0] = *reinterpret_cast<const bf16x8*>(Qw + d0 * 16);
  const int sr = tid >> 4, sc = (tid & 15) * 8, vst0 = v_st(sr, sc), vst1 = v_st(32 + sr, sc);
  const int vb0 = (int)(uintptr_t)V_lds + v_rd_base(lane);
  struct { bf16x8 vs0, vs1, ks0, ks1; } sr_[2];
#define SLOAD(i, k0) do { sr_[i].vs0 = *reinterpret_cast<const bf16x8*>(&Vh[(long)((k0) + sr) * LDK + sc]); sr_[i].vs1 = *reinterpret_cast<const bf16x8*>(&Vh[(long)((k0) + 32 + sr) * LDK + sc]); \
    sr_[i].ks0 = *reinterpret_cast<const bf16x8*>(&Kh[(long)((k0) + sr) * LDK + sc]); sr_[i].ks1 = *reinterpret_cast<const bf16x8*>(&Kh[(long)((k0) + 32 + sr) * LDK + sc]); } while (0)
#define SWRITE(b, i) do { *(bf16x8*)((char*)V_lds + (b) * SHM_V + vst0) = sr_[i].vs0;          \
    *(bf16x8*)((char*)V_lds + (b) * SHM_V + vst1) = sr_[i].vs1; int kc = sc * 2;               \
    *(bf16x8*)((char*)K_lds + (b) * SHM_K + KSWZ(sr, kc)) = sr_[i].ks0;                       \
    *(bf16x8*)((char*)K_lds + (b) * SHM_K + KSWZ(32 + sr, kc)) = sr_[i].ks1; } while (0)
#define SWAIT() asm volatile("s_waitcnt vmcnt(4)" ::: "memory")
#define RESC(a) do { if (__any((a) < 1.f)) { if (hi == 0) al_l[r32] = (a); asm volatile("s_waitcnt lgkmcnt(0)" ::: "memory"); \
    for (int d = 0; d < 4; ++d) for (int r = 0; r < 16; ++r) o[d][r] *= al_l[crow(r, hi)]; } } while (0)
  f32x16 pA0, pA1, pB0, pB1; float mnA, mnB, alA, alB; bf16x8 pa0, pa1, pa2, pa3; const int NT = seq / KVBLK;
  constexpr int SE = 0, SO = 1;
  SLOAD(SE, 0); asm volatile("s_waitcnt vmcnt(0)" ::: "memory"); SWRITE(0, SE); __syncthreads();
  qkt(pA0, pA1, K_lds, qr, r32, hi); partialSM(pA0, pA1, m_reg, mnA, alA);
  SLOAD(SO, KVBLK); if (2 < NT) SLOAD(SE, 2 * KVBLK);
  SWAIT(); SWRITE(1, SO); __syncthreads();
  for (int j = 1; j + 1 < NT; j += 2) {
    SBAR(); qkt(pB0, pB1, (bf16*)((char*)K_lds + SHM_K), qr, r32, hi);
    finishSM(pA0, pA1, alA, l_reg, pa0, pa1, pa2, pa3); SBAR();
    SLOAD(SO, (j + 2) * KVBLK); SBAR();
    pv_d0(o, vb0, pa0, pa1, pa2, pa3); partialSM(pB0, pB1, m_reg, mnB, alB);
    __syncthreads(); SWAIT(); SWRITE(0, SE);
    RESC(alB); __syncthreads();
    SBAR(); qkt(pA0, pA1, K_lds, qr, r32, hi);
    finishSM(pB0, pB1, alB, l_reg, pa0, pa1, pa2, pa3); SBAR();
    if (j + 3 < NT) SLOAD(SE, (j + 3) * KVBLK); SBAR();
    pv_d0(o, vb0 + (int)SHM_V, pa0, pa1, pa2, pa3); partialSM(pA0, pA1, m_reg, mnA, alA);
    __syncthreads(); SWAIT(); SWRITE(1, SO);
    RESC(alA); __syncthreads();
  }
  SBAR(); qkt(pB0, pB1, (bf16*)((char*)K_lds + SHM_K), qr, r32, hi);
  finishSM(pA0, pA1, alA, l_reg, pa0, pa1, pa2, pa3); SBAR();
  pv_d0(o, vb0, pa0, pa1, pa2, pa3); partialSM(pB0, pB1, m_reg, mnB, alB);
  __syncthreads(); RESC(alB);
  finishSM(pB0, pB1, alB, l_reg, pa0, pa1, pa2, pa3); SBAR();
  pv_d0(o, vb0 + (int)SHM_V, pa0, pa1, pa2, pa3);
  if (hi == 0) li_l[r32] = l_reg; asm volatile("s_waitcnt lgkmcnt(0)" ::: "memory");
  float rli[16];
#pragma unroll
  for (int r = 0; r < 16; ++r) rli[r] = __builtin_amdgcn_rcpf(li_l[crow(r, hi)]);
  bf16* Ow = Ob + (long)(wid * QBLK) * LDO;
#pragma unroll
  for (int r = 0; r < 16; ++r) { int orow = crow(r, hi);
    for (int d0 = 0; d0 < 4; ++d0) Ow[(long)orow * LDO + d0 * 32 + r32] = f2bf(o[d0][r] * rli[r]); }
  __syncthreads();
#undef SLOAD
#undef SWRITE
#undef SWAIT
#undef RESC
}
#undef KSWZ
}

#define XB_TMO      128
#define XB_XCNT(j)  (256  + 64 * (j))
#define XB_XSUB(j)  (1280 + 64 * (j))
#define XB_XGEN(j)  (2304 + 64 * (j))
#define XB_TOP      3328
#define XB_TOPGEN   3392
#define XCD_BAR_WORDS 3456
#define XB_SPIN_CAP (1u << 18)
DEV unsigned xb_ld(unsigned* p)              { return __hip_atomic_load(p, __ATOMIC_RELAXED, __HIP_MEMORY_SCOPE_AGENT); }
DEV unsigned xb_add(unsigned* p, unsigned v) { return __hip_atomic_fetch_add(p, v, __ATOMIC_RELAXED, __HIP_MEMORY_SCOPE_AGENT); }
DEV unsigned xb_xcc_id() { return (unsigned)__builtin_amdgcn_s_getreg((3 << 11) | 20) & 0xFu; }
#define XB_SPIN(cond, bar) do { unsigned _sp = 0; while (cond) { __builtin_amdgcn_s_sleep(1); \
    if ((++_sp & 255u) == 0u) { if (xb_ld(&(bar)[XB_TMO])) break; if (_sp > XB_SPIN_CAP) { atomicAdd(&(bar)[XB_TMO], 1u); break; } } } } while (0)
struct XcdBarrier { unsigned* bar; unsigned x; volatile LAS unsigned* st; };
DEV XcdBarrier xcd_barrier_post(unsigned* bar, volatile LAS unsigned* st) {
    XcdBarrier b; b.bar = bar; b.x = xb_xcc_id(); b.st = st;
    if (threadIdx.x == 0) (void)xb_add(&bar[XB_XCNT(b.x)], 1u);
    return b;
}
DEV void xcd_barrier_complete(unsigned* bar, unsigned x, unsigned& nloc, unsigned& nx) {
    const unsigned G = gridDim.x * gridDim.y * gridDim.z;
    unsigned sum, cnt, mine, sp = 0u;
    for (;;) {
        sum = 0u; cnt = 0u; mine = 0u;
#pragma unroll
        for (unsigned j = 0; j < 16; ++j) { const unsigned c = xb_ld(&bar[XB_XCNT(j)]); sum += c; cnt += (c > 0u) ? 1u : 0u; mine = (j == x) ? c : mine; }
        if (sum == G) break;
        __builtin_amdgcn_s_sleep(1);
        if ((++sp & 255u) == 0u) { if (xb_ld(&bar[XB_TMO])) break; if (sp > XB_SPIN_CAP) { atomicAdd(&bar[XB_TMO], 1u); break; } }
    }
    nloc = mine > 0u ? mine : 1u; nx = cnt > 0u ? cnt : 1u;
}
DEV void xcd_barrier(const XcdBarrier& b) {
    asm volatile("s_waitcnt vmcnt(0)" ::: "memory");
    __syncthreads();
    if (threadIdx.x == 0) {
        unsigned* bar = b.bar;
        __builtin_amdgcn_s_waitcnt(0);
        unsigned nloc = b.st[0], nx = b.st[1];
        if (nloc == 0u) { xcd_barrier_complete(bar, b.x, nloc, nx); b.st[0] = nloc; b.st[1] = nx; }
        const unsigned old = xb_add(&bar[XB_XSUB(b.x)], 1u);
        const unsigned gen = old / nloc;
        if (old + 1u == (gen + 1u) * nloc) {
            __builtin_amdgcn_fence(__ATOMIC_RELEASE, "agent");
            asm volatile("s_waitcnt vmcnt(0)" ::: "memory");
            const unsigned og = xb_add(&bar[XB_TOP], 1u);
            const unsigned tg = og / nx;
            if (og + 1u == (tg + 1u) * nx) xb_add(&bar[XB_TOPGEN], 1u);
            else XB_SPIN(xb_ld(&bar[XB_TOPGEN]) == tg, bar);
            __builtin_amdgcn_fence(__ATOMIC_ACQUIRE, "agent");
            xb_add(&bar[XB_XGEN(b.x)], 1u);
            asm volatile("s_waitcnt vmcnt(0)" ::: "memory");
        } else {
            XB_SPIN(xb_ld(&bar[XB_XGEN(b.x)]) == gen, bar);
            __builtin_amdgcn_fence(__ATOMIC_ACQUIRE, "agent");
            asm volatile("s_waitcnt vmcnt(0)" ::: "memory");
        }
    }
    __syncthreads();
}

struct Args { const float* in[28]; float* out; unsigned char* ws; int ph_lo, ph_hi; };
enum { I_X = 0, I_C, I_CTX, I_CCTX, I_MODW, I_MODB, I_NPRE, I_NPOST, I_FG, I_FU, I_FD, I_EVIN, I_EVOUT, I_CONVW, I_CONVB, I_WA, I_BA, I_WX, I_BX, I_LAM, I_DECAY, I_GN,
       I_ODIN, I_ODOUT, I_POOLW, I_POOLS, I_QN, I_KN };
struct Frame {
    LAS unsigned char* lds; int tid, lane, wave, G, bid;
    const Args* a;
};
#define LDS_WAIT() asm volatile("s_waitcnt lgkmcnt(0)" ::: "memory")

DEV void transpose_item(const float* W, int K, int N, bf16* WT, int drow0, LAS float* scr, int kb, int nb, int lane) {
    const int k0 = 64 * kb, n0 = 32 * nb;
#pragma unroll 8
    for (int i = 0; i < 32; ++i) { const int kk = 2 * i + (lane >> 5); scr[kk * 33 + (lane & 31)] = W[(size_t)(k0 + kk) * N + n0 + (lane & 31)]; }
    LDS_WAIT(); asm volatile("" ::: "memory");
    const int c = lane & 7;
#pragma unroll
    for (int j = 0; j < 4; ++j) { const int n = (lane >> 3) + 8 * j; const LAS float* s = scr + (8 * c) * 33 + n;
        u32x4 o; o.x = pkbf(s[0 * 33], s[1 * 33]); o.y = pkbf(s[2 * 33], s[3 * 33]); o.z = pkbf(s[4 * 33], s[5 * 33]); o.w = pkbf(s[6 * 33], s[7 * 33]);
        *(u32x4*)(WT + (size_t)(drow0 + n) * K + k0 + 8 * c) = o; }
    LDS_WAIT(); asm volatile("" ::: "memory");
}
DEV void p0_prologue(const Frame& F) {
    const Args& A = *F.a; unsigned char* ws = A.ws;
    {
        LAS float* ssc = (LAS float*)F.lds;
        LAS float* red = (LAS float*)(F.lds + 40960);
        for (int i = F.tid; i < 5 * DM; i += 512) { const int r = i / DM, k = i % DM; const float v = (r < 4) ? A.in[I_C][r * DM + k] : A.in[I_CCTX][k]; ssc[i] = fsilu(v); }
        __syncthreads();
        float* MOD = (float*)(ws + WS_MOD);
        for (int it = F.bid; it < 288; it += F.G) {
            const int li = it / 144, col0 = (it % 144) * 128;
            const float* Wp = A.in[I_MODW] + (size_t)li * DM * 18432 + (size_t)(F.wave * 256) * 18432 + col0 + 2 * F.lane;
            f32x2 acc[5];
#pragma unroll
            for (int r = 0; r < 5; ++r) acc[r] = (f32x2){0.f, 0.f};
#pragma unroll 8
            for (int kk = 0; kk < 256; ++kk) { const f32x2 wv = *(const f32x2*)(Wp + (size_t)kk * 18432);
#pragma unroll
                for (int r = 0; r < 5; ++r) { const float s = ssc[r * DM + F.wave * 256 + kk]; acc[r] += wv * s; } }
#pragma unroll
            for (int r = 0; r < 5; ++r) { red[(F.wave * 5 + r) * 128 + 2 * F.lane] = acc[r].x; red[(F.wave * 5 + r) * 128 + 2 * F.lane + 1] = acc[r].y; }
            __syncthreads();
            for (int o = F.tid; o < 640; o += 512) { const int r = o >> 7, c = o & 127; float s = A.in[I_MODB][li * 18432 + col0 + c];
#pragma unroll
                for (int w = 0; w < 8; ++w) s += red[(w * 5 + r) * 128 + c];
                MOD[(size_t)(li * 5 + r) * 18432 + col0 + c] = s; }
            __syncthreads();
        }
    }
    {
        LAS float* scr = (LAS float*)(F.lds + F.wave * 16384);
        const int gw = F.bid * 8 + F.wave, NGW = F.G * 8;
        constexpr int I_FFN = 5632, N_FFN = 12 * I_FFN, I_EI = 32 * 192, I_EO = 32 * 64, I_OI = 32 * 96, I_OO = 32 * 64, I_SM = 8 * 36;
        constexpr int NITEMS = N_FFN + I_EI + I_EO + I_OI + I_OO + I_SM;
        for (int it = gw; it < NITEMS; it += NGW) {
            int r = it;
            if (r < N_FFN) { const int idx = r / I_FFN, item = r % I_FFN, lf = idx / 3, kind = idx % 3;
                if (kind < 2) { const float* W = A.in[kind == 0 ? I_FG : I_FU] + (size_t)lf * DM * DFF; const int nb = item % 176, kb = item / 176, n0 = 32 * nb;
                    transpose_item(W, DM, DFF, (bf16*)(ws + WS_WGU + (size_t)lf * 44 * MiB), 256 * (n0 / 128) + 128 * kind + (n0 % 128), scr, kb, nb, F.lane); }
                else { const float* W = A.in[I_FD] + (size_t)lf * DFF * DM; const int nb = item % 64, kb = item / 64;
                    transpose_item(W, DFF, DM, (bf16*)(ws + WS_WD + (size_t)lf * 22 * MiB), 32 * nb, scr, kb, nb, F.lane); }
                continue; }
            r -= N_FFN;
            if (r < I_EI) { const int nb = r % 192, kb = r / 192, n0 = 32 * nb, blk = n0 / 1024;
                const int dblk = (blk == 1) ? 5 : (blk == 5) ? 1 : blk;
                transpose_item(A.in[I_EVIN], DM, EVN, (bf16*)(ws + WS_WEVIN), dblk * 1024 + (n0 % 1024), scr, kb, nb, F.lane); continue; }
            r -= I_EI;
            if (r < I_EO) { const int nb = r % 64, kb = r / 64; transpose_item(A.in[I_EVOUT], DM, DM, (bf16*)(ws + WS_WEVOUT), 32 * nb, scr, kb, nb, F.lane); continue; }
            r -= I_EO;
            if (r < I_OI) { const int nb = r % 96, kb = r / 96; transpose_item(A.in[I_ODIN], DM, ODN, (bf16*)(ws + WS_WODIN), 32 * nb, scr, kb, nb, F.lane); continue; }
            r -= I_OI;
            if (r < I_OO) { const int nb = r % 64, kb = r / 64; transpose_item(A.in[I_ODOUT], DM, DM, (bf16*)(ws + WS_WODOUT), 32 * nb, scr, kb, nb, F.lane); continue; }
            r -= I_OO;
            { const int mat = r / 8, item = r % 8, nb = item % 4, kb = item / 4;
                const float* W; bf16* dst;
                if (mat < 16) { W = A.in[I_WA] + (size_t)mat * 16384; dst = (bf16*)(ws + WS_LRUW) + (size_t)mat * 16384; }
                else if (mat < 32) { W = A.in[I_WX] + (size_t)(mat - 16) * 16384; dst = (bf16*)(ws + WS_LRUW) + (size_t)mat * 16384; }
                else { W = A.in[I_POOLW] + (size_t)(mat - 32) * 16384; dst = (bf16*)(ws + WS_POOLW) + (size_t)(mat - 32) * 16384; }
                transpose_item(W, 128, 128, dst, 32 * nb, scr, kb, nb, F.lane); }
        }
    }
    {
        const int gt = F.bid * 512 + F.tid, NT = F.G * 512;
        float* c1 = (float*)(ws + WS_COS1); float* s1 = (float*)(ws + WS_SIN1); float* c2 = (float*)(ws + WS_COS2); float* s2 = (float*)(ws + WS_SIN2);
        for (int i = gt; i < SEQ * 128 + SEQ * 64; i += NT) {
            float pos, f; float* cd; float* sd;
            if (i < SEQ * 128) { const int t = i >> 7, k = i & 127; pos = (float)t; f = exp2f(-(float)k * (13.287712379549449f / 128.f)); cd = c1 + i; sd = s1 + i; }
            else { const int j = i - SEQ * 128, t = j >> 6, k = j & 63; pos = (k < 32) ? (float)(t >> 6) : (float)(t & 63); f = exp2f(-(float)(k & 31) * (13.287712379549449f / 32.f)); cd = c2 + j; sd = s2 + j; }
            const float ang = pos * f;
            double rev = (double)ang * 0.15915494309189535; rev -= __builtin_rint(rev);
            const float fr = (float)rev;
            *cd = __builtin_amdgcn_cosf(fr); *sd = __builtin_amdgcn_sinf(fr);
        }
    }
}

struct ResCfg { int has_res, has_next, li, sub, li2, sub2, nrows; float wres; const float* xold_l; const float* xold_c; float* xnew_l; float* xnew_c; };
DEV void res_rows(const Frame& F, const ResCfg& C, int m0, int cnt, int prow) {
    const Args& A = *F.a; const float* MOD = (const float*)(A.ws + WS_MOD); bf16* H = (bf16*)(A.ws + WS_H);
    f32x4 Ca[8], Cb[8], Cs[8];
    int e0 = 4 * F.lane; asm volatile("" : "+v"(e0));
    if (C.has_res) {
        const float* gate = MOD + (size_t)(C.li * 5 + prow) * 18432 + C.sub * 6144 + 4096; const float* gp = A.in[I_NPOST] + (C.li * 3 + C.sub) * DM;
#pragma unroll
        for (int j = 0; j < 8; ++j) Ca[j] = *(const f32x4*)(gate + 256 * j + e0) * *(const f32x4*)(gp + 256 * j + e0) * C.wres;
    }
    if (C.has_next) {
        const float* sh = MOD + (size_t)(C.li2 * 5 + prow) * 18432 + C.sub2 * 6144; const float* sc = sh + 2048; const float* gp = A.in[I_NPRE] + (C.li2 * 3 + C.sub2) * DM;
#pragma unroll
        for (int j = 0; j < 8; ++j) { Cb[j] = *(const f32x4*)(gp + 256 * j + e0) * (*(const f32x4*)(sc + 256 * j + e0) + 1.f); Cs[j] = *(const f32x4*)(sh + 256 * j + e0); }
    }
    for (int m = m0; m < m0 + cnt; ++m) {
        const float* xo = (m < ML) ? C.xold_l + (size_t)m * DM : C.xold_c + (size_t)(m - ML) * DM;
        f32x4 x[8];
#pragma unroll
        for (int j = 0; j < 8; ++j) x[j] = *(const f32x4*)(xo + 256 * j + e0);
        if (C.has_res) {
            u32x2 yv[8]; const bf16* yr = H + (size_t)m * DM;
#pragma unroll
            for (int j = 0; j < 8; ++j) yv[j] = *(const u32x2*)(yr + 256 * j + e0);
            float ss = 0.f;
#pragma unroll
            for (int j = 0; j < 8; ++j) { const float a = bflo(yv[j].x), b = bfhi(yv[j].x), c = bflo(yv[j].y), d = bfhi(yv[j].y); ss += (a * a + b * b) + (c * c + d * d); }
            const float rs = __builtin_amdgcn_rsqf(wave_sum(ss) * (1.f / DM) + EPS);
            float* xn = (m < ML) ? C.xnew_l + (size_t)m * DM : C.xnew_c + (size_t)(m - ML) * DM;
#pragma unroll
            for (int j = 0; j < 8; ++j) { const f32x4 yy = (f32x4){bflo(yv[j].x), bfhi(yv[j].x), bflo(yv[j].y), bfhi(yv[j].y)}; x[j] = x[j] + Ca[j] * (yy * rs); *(f32x4*)(xn + 256 * j + e0) = x[j]; }
        }
        if (C.has_next) {
            float ss = 0.f;
#pragma unroll
            for (int j = 0; j < 8; ++j) ss += (x[j].x * x[j].x + x[j].y * x[j].y) + (x[j].z * x[j].z + x[j].w * x[j].w);
            const float rs = __builtin_amdgcn_rsqf(wave_sum(ss) * (1.f / DM) + EPS);
            bf16* hr = H + (size_t)m * DM;
#pragma unroll
            for (int j = 0; j < 8; ++j) { const f32x4 h = x[j] * rs * Cb[j] + Cs[j]; u32x2 w; w.x = pkbf(h.x, h.y); w.y = pkbf(h.z, h.w); *(u32x2*)(hr + 256 * j + e0) = w; }
        }
    }
}
DEV void res_phase(const Frame& F, const ResCfg& C) {
    const int gw = F.bid * 8 + F.wave, NGW = F.G * 8;
    for (int blk = gw; blk < ML / 16; blk += NGW) res_rows(F, C, blk * 16, 16, (blk * 16) / SEQ);
    if (C.nrows > ML) {
        if (NGW >= 2 * MC) { if ((gw & 1) == 0 && (gw >> 1) < MC) res_rows(F, C, ML + (gw >> 1), 1, 4); }
        else { const int per = (MC + NGW - 1) / NGW, r0 = gw * per, cnt = (MC - r0) < per ? (MC - r0) : per; if (cnt > 0) res_rows(F, C, ML + r0, cnt, 4); }
    }
}

constexpr int LRU_UB = 0, LRU_UB_LD = 272, LRU_ARR = 17408, LRU_ARR_SZ = 32768;
DEV int lru_chunk_row0(int b, int ck) { return (ck < 4) ? ML + b * CTXL + 64 * ck : b * SEQ + 64 * (ck - 4); }
DEV float one_minus_exp(float t) {
    const float ser = -t * (1.f + t * 0.5f * (1.f + t * (1.f / 3.f) * (1.f + t * 0.25f * (1.f + t * 0.2f * (1.f + t * (1.f / 6.f))))));
    return (t > -0.25f) ? ser : 1.f - fexp(t);
}
template <bool FINAL> DEV void lru_phase(const Frame& F, bool dry = false) {
    const Args& A = *F.a; unsigned char* ws = A.ws; bf16* E = (bf16*)(ws + WS_E);
    const int tid = F.tid, wave = F.wave, lane = F.lane, r32 = lane & 31, hh = lane >> 5;
    LAS unsigned char* UB = F.lds + LRU_UB; LAS float* ARR = (LAS float*)(F.lds + LRU_ARR); LAS unsigned char* RS = F.lds + LRU_ARR;
    const int slot = F.bid & 31, n = slot & 7, b = slot >> 3, ck0 = F.bid >> 5, ckst = (F.G + 31) >> 5;
    if (F.bid >= 32 * ckst) return;
    u32x4 rp[3];
#define LRU_LOAD(ck_) do { const int L_ = ((ck_) < 4) ? CTXL : SEQ, p0_ = ((ck_) < 4) ? 64 * (ck_) : 64 * ((ck_) - 4), rb_ = ((ck_) < 4) ? ML + b * CTXL : b * SEQ; \
        _Pragma("unroll") for (int i_ = 0; i_ < 3; ++i_) { const int pc = tid + 512 * i_, rr = pc >> 4, c8 = pc & 15, pos = p0_ - 2 + rr; \
            rp[i_] = (u32x4){0u, 0u, 0u, 0u}; if (pc < 67 * 16 && pos >= 0 && pos < L_) rp[i_] = *(const u32x4*)(E + (size_t)(rb_ + pos) * EVN + EC_R + 128 * n + 8 * c8); } } while (0)
    if (ck0 < NCH64) LRU_LOAD(ck0);
    const int c8t = tid & 15, cht = 128 * n + 8 * c8t;
    float cw[4][8], cb[8];
#pragma unroll
    for (int i = 0; i < 8; ++i) cb[i] = A.in[I_CONVB][cht + i];
#pragma unroll
    for (int k = 0; k < 4; ++k)
#pragma unroll
        for (int i = 0; i < 8; ++i) cw[k][i] = A.in[I_CONVW][k * 1024 + cht + i];
    const int gd = wave >> 2, cq = wave & 3, gcol = 32 * cq + r32, gchn = 128 * n + gcol;
    bf16x8 fa[8], fx[8];
    { const bf16* WA = (const bf16*)(ws + WS_LRUW) + (size_t)(gd * 8 + n) * 16384 + (size_t)gcol * 128 + 8 * hh; const bf16* WX = WA + (size_t)16 * 16384;
#pragma unroll
      for (int ks = 0; ks < 8; ++ks) { fa[ks] = *(const bf16x8*)(WA + 16 * ks); fx[ks] = *(const bf16x8*)(WX + 16 * ks); } }
    const float gba = A.in[I_BA][gd * 1024 + gchn], gbx = A.in[I_BX][gd * 1024 + gchn], sp8 = -8.f * log1pf(expf(-A.in[I_LAM][gd * 1024 + gchn]));
    for (int ck = ck0; ck < NCH64; ck += ckst) {
        const int p0 = (ck < 4) ? 64 * ck : 64 * (ck - 4), rowbase = (ck < 4) ? ML + b * CTXL : b * SEQ;
        const int sd = (tid >> 7) & 1, sc = tid & 127; const size_t gi = ((size_t)(ck * NB + b) * 2 + sd) * 1024 + 128 * n + sc;
        float hcar = 0.f; if (FINAL && tid < 256) hcar = ((const float*)(ws + WS_CAR))[gi];
        u32x4 gv[2];
        if (FINAL) {
#pragma unroll
            for (int i = 0; i < 2; ++i) { const int pc = tid + 512 * i, tt = pc >> 4; gv[i] = *(const u32x4*)(E + (size_t)(rowbase + p0 + tt) * EVN + EC_G + 128 * n + 8 * c8t); } }
#pragma unroll
        for (int i = 0; i < 3; ++i) { const int pc = tid + 512 * i, rr = pc >> 4, c8 = pc & 15; if (pc < 67 * 16) *(LAS u32x4*)(RS + rr * 256 + c8 * 16) = rp[i]; }
        __syncthreads();
#pragma unroll
        for (int i2 = 0; i2 < 2; ++i2) { const int pc = tid + 512 * i2, tt = pc >> 4;
            float u[8];
#pragma unroll
            for (int i = 0; i < 8; ++i) u[i] = cb[i];
#pragma unroll
            for (int k = 0; k < 4; ++k) { const u32x4 rv = *(const LAS u32x4*)(RS + (tt + k) * 256 + c8t * 16);
                u[0] += cw[k][0] * bflo(rv.x); u[1] += cw[k][1] * bfhi(rv.x); u[2] += cw[k][2] * bflo(rv.y); u[3] += cw[k][3] * bfhi(rv.y);
                u[4] += cw[k][4] * bflo(rv.z); u[5] += cw[k][5] * bfhi(rv.z); u[6] += cw[k][6] * bflo(rv.w); u[7] += cw[k][7] * bfhi(rv.w); }
            u32x4 o = {pkbf(u[0], u[1]), pkbf(u[2], u[3]), pkbf(u[4], u[5]), pkbf(u[6], u[7])};
            *(LAS u32x4*)(UB + tt * LRU_UB_LD + c8t * 16) = o; }
        __syncthreads();
        if (ck + ckst < NCH64) LRU_LOAD(ck + ckst);
        {
            f32x16 aa[2] = {f32x16{}, f32x16{}}, ax[2] = {f32x16{}, f32x16{}};
#pragma unroll
            for (int ks = 0; ks < 8; ++ks) {
#pragma unroll
                for (int rt = 0; rt < 2; ++rt) { const bf16x8 af = *(const LAS bf16x8*)(UB + (32 * rt + r32) * LRU_UB_LD + (16 * ks + 8 * hh) * 2);
                    aa[rt] = __builtin_amdgcn_mfma_f32_32x32x16_bf16(af, fa[ks], aa[rt], 0, 0, 0); ax[rt] = __builtin_amdgcn_mfma_f32_32x32x16_bf16(af, fx[ks], ax[rt], 0, 0, 0); }
            }
            LAS float* AO = ARR + (size_t)(gd * 2) * (LRU_ARR_SZ / 4); LAS float* BO = AO + LRU_ARR_SZ / 4;
#pragma unroll
            for (int rt = 0; rt < 2; ++rt)
#pragma unroll
                for (int r = 0; r < 16; ++r) { const int row = 32 * rt + crow(r, hh);
                    const float la = sp8 * fsigmoid(aa[rt][r] + gba), av = fexp(la), mlt = __builtin_amdgcn_sqrtf(one_minus_exp(2.f * la));
                    const float uv = bf2f(*(const LAS bf16*)(UB + row * LRU_UB_LD + gcol * 2));
                    AO[row * 128 + gcol] = av; BO[row * 128 + gcol] = mlt * fsigmoid(ax[rt][r] + gbx) * uv; }
        }
        __syncthreads();
        if (tid < 256) { LAS float* AO = ARR + (size_t)(sd * 2) * (LRU_ARR_SZ / 4); const LAS float* BO = AO + LRU_ARR_SZ / 4;
            if (!FINAL) { float h = 0.f, P = 1.f;
#pragma unroll 8
                for (int s = 0; s < 64; ++s) { const int tt = sd ? 63 - s : s; const float a = AO[tt * 128 + sc]; h = a * h + BO[tt * 128 + sc]; P *= a; }
                ((f32x2*)(ws + WS_AGG))[gi] = (f32x2){P, h}; }
            else { float h = hcar;
#pragma unroll 8
                for (int s = 0; s < 64; ++s) { const int tt = sd ? 63 - s : s; h = AO[tt * 128 + sc] * h + BO[tt * 128 + sc]; AO[tt * 128 + sc] = h; } }
        }
        __syncthreads();
        if (FINAL) {
            const LAS float* H0 = ARR; const LAS float* H1 = ARR + 2 * (LRU_ARR_SZ / 4);
#pragma unroll
            for (int i2 = 0; i2 < 2; ++i2) { const int pc = tid + 512 * i2, tt = pc >> 4;
                const f32x4 h0a = *(const LAS f32x4*)(H0 + tt * 128 + 8 * c8t), h0b = *(const LAS f32x4*)(H0 + tt * 128 + 8 * c8t + 4), h1a = *(const LAS f32x4*)(H1 + tt * 128 + 8 * c8t), h1b = *(const LAS f32x4*)(H1 + tt * 128 + 8 * c8t + 4);
                const f32x4 sa = h0a + h1a, sb = h0b + h1b; const u32x4 g4 = gv[i2];
                u32x4 w = {pkbf(fgelu_tanh(bflo(g4.x)) * sa.x, fgelu_tanh(bfhi(g4.x)) * sa.y), pkbf(fgelu_tanh(bflo(g4.y)) * sa.z, fgelu_tanh(bfhi(g4.y)) * sa.w),
                           pkbf(fgelu_tanh(bflo(g4.z)) * sb.x, fgelu_tanh(bfhi(g4.z)) * sb.y), pkbf(fgelu_tanh(bflo(g4.w)) * sb.z, fgelu_tanh(bfhi(g4.w)) * sb.w)};
                bf16* wp = dry ? (bf16*)(ws + WS_H) + (size_t)(rowbase + p0 + tt) * DM + 128 * n + 8 * c8t : E + (size_t)(rowbase + p0 + tt) * EVN + EC_G + 128 * n + 8 * c8t; *(u32x4*)wp = w; }
            __syncthreads();
        }
    }
#undef LRU_LOAD
}
DEV void lru_carry_phase(const Frame& F) {
    unsigned char* ws = F.a->ws; const f32x2* AGG = (const f32x2*)(ws + WS_AGG); float* CAR = (float*)(ws + WS_CAR);
    const int gw = F.bid * 8 + F.wave, NGW = F.G * 8;
    for (int it = gw; it < NB * 2 * 16; it += NGW) { const int cg = it & 15, d = (it >> 4) & 1, b = it >> 5;
        float h = 0.f;
#pragma unroll 12
        for (int idx = 0; idx < NCH64; ++idx) { const int ck = d ? (idx < 4 ? 3 - idx : NCH64 + 3 - idx) : idx;
            const size_t gi = ((size_t)(ck * NB + b) * 2 + d) * 1024 + 64 * cg + F.lane; const f32x2 v = AGG[gi]; CAR[gi] = h; h = v.x * h + v.y; }
    }
}

DEV int ret_chunk_row0(int b, int cid) { return (cid < 2) ? ML + b * CTXL + 128 * cid : b * SEQ + 128 * (cid - 2); }
DEV int ret_chain(int d, int idx) { return d ? (idx < 2 ? 1 - idx : NCH128 + 1 - idx) : idx; }
DEV float ret_logg(const Args& A, int d, int h) { const float lg = A.in[I_DECAY][d * 4 + h]; return -log1pf(expf(-lg)); }
constexpr int RET_LD = 528, RET_VLD = 80;
DEV void ret_state_phase(const Frame& F) {
    const Args& A = *F.a; unsigned char* ws = A.ws; const bf16* E = (const bf16*)(ws + WS_E); bf16* SB = (bf16*)(ws + WS_SBUF);
    const int tid = F.tid, lane = F.lane, wave = F.wave, r32 = lane & 31, hh = lane >> 5;
    LAS unsigned char* KS = F.lds; LAS unsigned char* VS = F.lds + 128 * RET_LD;
    for (int it = F.bid; it < 256; it += F.G) {
        const int es = it & 7, d = (it >> 3) & 1, h = (it >> 4) & 3, b = it >> 6;
        const float lg = ret_logg(A, d, h), sdec = expf(lg * 128.f);
        const int vrow = tid >> 2, vc4 = tid & 3; const float vw = expf(lg * (float)(d ? vrow : 127 - vrow));
        u32x4 kreg[8], vreg;
        f32x16 acc = f32x16{};
#define RS_LOAD(cid_) do { const int m0_ = ret_chunk_row0(b, cid_); \
            _Pragma("unroll") for (int i = 0; i < 8; ++i) { const int id = tid + 512 * i, row = id >> 5, c16 = id & 31; kreg[i] = *(const u32x4*)(E + (size_t)(m0_ + row) * EVN + EC_K + 256 * h + 8 * c16); } \
            vreg = *(const u32x4*)(E + (size_t)(m0_ + vrow) * EVN + EC_V + 256 * h + 32 * es + 8 * vc4); } while (0)
        RS_LOAD(ret_chain(d, 0));
        for (int idx = 0; idx < NCH128; ++idx) {
            const int cid = ret_chain(d, idx);
#pragma unroll
            for (int i = 0; i < 8; ++i) { const int id = tid + 512 * i, row = id >> 5, c16 = id & 31; *(LAS u32x4*)(KS + row * RET_LD + c16 * 16) = kreg[i]; }
            { u32x4 w; w.x = pkbf(bflo(vreg.x) * vw, bfhi(vreg.x) * vw); w.y = pkbf(bflo(vreg.y) * vw, bfhi(vreg.y) * vw); w.z = pkbf(bflo(vreg.z) * vw, bfhi(vreg.z) * vw); w.w = pkbf(bflo(vreg.w) * vw, bfhi(vreg.w) * vw);
              *(LAS u32x4*)(VS + vrow * RET_VLD + vc4 * 16) = w; }
            __syncthreads();
            if (idx + 1 < NCH128) RS_LOAD(ret_chain(d, idx + 1));
            { bf16* sp = SB + ((size_t)(((b * 4 + h) * 2 + d) * NCH128 + cid) * 256 + 32 * es + r32) * 256 + 32 * wave + 4 * hh;
#pragma unroll
              for (int g = 0; g < 4; ++g) { u32x2 w; w.x = pkbf(acc[4 * g], acc[4 * g + 1]); w.y = pkbf(acc[4 * g + 2], acc[4 * g + 3]); *(u32x2*)(sp + 8 * g) = w; } }
#pragma unroll
            for (int r = 0; r < 16; ++r) acc[r] *= sdec;
#pragma unroll
            for (int ks = 0; ks < 8; ++ks) { const bf16x8 af = tr_frag(KS, RET_LD, 16 * ks, 32 * wave, lane); const bf16x8 bfr = tr_frag(VS, RET_VLD, 16 * ks, 0, lane);
                acc = __builtin_amdgcn_mfma_f32_32x32x16_bf16(af, bfr, acc, 0, 0, 0); }
            __syncthreads();
        }
#undef RS_LOAD
    }
}
DEV void ret_out_phase(const Frame& F, bool dry = false) {
    const Args& A = *F.a; unsigned char* ws = A.ws; bf16* E = (bf16*)(ws + WS_E); const bf16* SB = (const bf16*)(ws + WS_SBUF);
    const int wave = F.wave, ib = wave & 3, eh = wave >> 2;
    LAS unsigned char* RA = F.lds; LAS unsigned char* RB = F.lds + 128 * RET_LD; LAS float* GX = (LAS float*)(F.lds + 2 * 128 * RET_LD);
    constexpr int PLD = 272;
    for (int it = F.bid; it < 16 * NCH128; it += F.G) {
        int tid = F.tid; asm volatile("" : "+v"(tid)); int lane = tid & 63;
        const int r32 = lane & 31, hh = lane >> 5;
        const int cid = it % NCH128, bh = it / NCH128, h = bh & 3, b = bh >> 2, m0 = ret_chunk_row0(b, cid);
        const float lg0 = ret_logg(A, 0, h), lg1 = ret_logg(A, 1, h);
        bf16x8 qf[16];
        { const bf16* qp = E + (size_t)(m0 + 32 * ib + r32) * EVN + EC_Q + 256 * h + 8 * hh;
#pragma unroll
          for (int ks = 0; ks < 16; ++ks) qf[ks] = *(const bf16x8*)(qp + 16 * ks); }
        f32x16 o[4];
#pragma unroll
        for (int et = 0; et < 4; ++et) o[et] = f32x16{};
#pragma unroll 1
        for (int d = 0; d < 2; ++d) {
            const bf16* sp = SB + (size_t)((bh * 2 + d) * NCH128 + cid) * 65536; const float lgd = d ? lg1 : lg0;
            __syncthreads();
#pragma unroll
            for (int i = 0; i < 16; ++i) { const int id = tid + 512 * i, row = id >> 5, c16 = id & 31; *(LAS u32x4*)(RA + row * RET_LD + c16 * 16) = *(const u32x4*)(sp + (size_t)row * 256 + 8 * c16);
                if ((i & 3) == 3) asm volatile("" ::: "memory"); }
            __syncthreads();
#pragma unroll
            for (int et = 0; et < 4; ++et) { f32x16 T = f32x16{};
                const LAS unsigned char* bp = RA + (128 * eh + 32 * et + r32) * RET_LD + 16 * hh;
#pragma unroll
                for (int ks = 0; ks < 16; ++ks) { const bf16x8 bfr = *(const LAS bf16x8*)(bp + 32 * ks); T = __builtin_amdgcn_mfma_f32_32x32x16_bf16(qf[ks], bfr, T, 0, 0, 0); }
#pragma unroll
                for (int r = 0; r < 16; ++r) { const int i = 32 * ib + crow(r, hh); const float rs = fexp(lgd * (float)(d ? 128 - i : i + 1)); o[et][r] += T[r] * rs; } }
        }
        __syncthreads();
        int tid2 = tid; asm volatile("" : "+v"(tid2));
#pragma unroll
        for (int i = 0; i < 8; ++i) { const int id = tid2 + 512 * i, row = id >> 5, c16 = id & 31;
            *(LAS u32x4*)(RA + row * RET_LD + c16 * 16) = *(const u32x4*)(E + (size_t)(m0 + row) * EVN + EC_K + 256 * h + 8 * c16);
            *(LAS u32x4*)(RB + row * RET_LD + c16 * 16) = *(const u32x4*)(E + (size_t)(m0 + row) * EVN + EC_V + 256 * h + 8 * c16);
            if (i & 1) asm volatile("" ::: "memory"); }
        __syncthreads();
        u32x2 pw[2][4];
        { const int i = 32 * ib + r32;
#pragma unroll
          for (int jj = 0; jj < 2; ++jj) { const int jt = 2 * eh + jj;
            f32x16 X = f32x16{};
#pragma unroll
            for (int ks = 0; ks < 16; ++ks) { const bf16x8 af = *(const LAS bf16x8*)(RA + (32 * jt + r32) * RET_LD + (16 * ks + 8 * hh) * 2); X = __builtin_amdgcn_mfma_f32_32x32x16_bf16(af, qf[ks], X, 0, 0, 0); }
#pragma unroll
            for (int g = 0; g < 4; ++g) { float pv[4];
#pragma unroll
                for (int q = 0; q < 4; ++q) { const int j = 32 * jt + 8 * g + 4 * hh + q; const int dl = i - j; const float f = (dl > 0) ? fexp(lg0 * (float)dl) : (dl < 0) ? fexp(-lg1 * (float)dl) : 2.f; pv[q] = X[4 * g + q] * f; }
                pw[jj][g].x = pkbf(pv[0], pv[1]); pw[jj][g].y = pkbf(pv[2], pv[3]); } } }
        __syncthreads();
        { const int i = 32 * ib + r32;
#pragma unroll
          for (int jj = 0; jj < 2; ++jj)
#pragma unroll
            for (int g = 0; g < 4; ++g) *(LAS u32x2*)(RA + i * PLD + (32 * (2 * eh + jj) + 8 * g + 4 * hh) * 2) = pw[jj][g]; }
        __syncthreads();
#pragma unroll
        for (int ks = 0; ks < 8; ++ks) { const bf16x8 pa = *(const LAS bf16x8*)(RA + (32 * ib + r32) * PLD + (16 * ks + 8 * hh) * 2);
#pragma unroll
            for (int et = 0; et < 4; ++et) { const bf16x8 bfr = tr_frag(RB, RET_LD, 16 * ks, 128 * eh + 32 * et, lane); o[et] = __builtin_amdgcn_mfma_f32_32x32x16_bf16(pa, bfr, o[et], 0, 0, 0); } }
#pragma unroll
        for (int r = 0; r < 16; ++r) { float a = 0.f, q = 0.f;
#pragma unroll
            for (int et = 0; et < 4; ++et) { a += o[et][r]; q += o[et][r] * o[et][r]; }
#pragma unroll
            for (int off = 1; off < 32; off <<= 1) { a += __shfl_xor(a, off); q += __shfl_xor(q, off); }
            if (r32 == 0) { GX[(wave * 32 + crow(r, hh)) * 2] = a; GX[(wave * 32 + crow(r, hh)) * 2 + 1] = q; } }
        __syncthreads();
        { const float* gn = A.in[I_GN] + 256 * h + 128 * eh;
#pragma unroll
          for (int r = 0; r < 16; ++r) { const int rw = crow(r, hh); const float a = GX[(wave * 32 + rw) * 2] + GX[((wave ^ 4) * 32 + rw) * 2], q = GX[(wave * 32 + rw) * 2 + 1] + GX[((wave ^ 4) * 32 + rw) * 2 + 1];
            const float mean = a * (1.f / 256.f), var = q * (1.f / 256.f) - mean * mean, rstd = __builtin_amdgcn_rsqf(var + EPS);
            bf16* op = E + (size_t)(m0 + 32 * ib + rw) * EVN + EC_O + 256 * h + 128 * eh + r32;
#pragma unroll
            for (int et = 0; et < 4; ++et) { const float og = bf2f(op[32 * et]); bf16* wp = dry ? (bf16*)(ws + WS_H) + (size_t)(m0 + 32 * ib + rw) * DM + 1024 + 256 * h + 128 * eh + r32 : op;
                wp[32 * et] = f2bf((o[et][r] - mean) * rstd * gn[32 * et + r32] * fsilu(og)); } } }
    }
    __syncthreads();
}
DEV void odd_post_phase(const Frame& F) {
    const Args& A = *F.a; unsigned char* ws = A.ws; const bf16* E2 = (const bf16*)(ws + WS_E2);
    bf16* QB = (bf16*)(ws + WS_QB); bf16* KB = (bf16*)(ws + WS_KB); bf16* VB = (bf16*)(ws + WS_VB); bf16* MIX = (bf16*)(ws + WS_MIX2);
    const float* c2 = (const float*)(ws + WS_COS2); const float* s2 = (const float*)(ws + WS_SIN2);
    const int tid = F.tid, wave = F.wave;
    {
        const int gw = F.bid * 8 + F.wave, NGW = F.G * 8; const int lane0 = F.lane;
        const float qg1 = A.in[I_QN][lane0], qg2 = A.in[I_QN][64 + lane0], kg1 = A.in[I_KN][lane0], kg2 = A.in[I_KN][64 + lane0];
        for (int m = gw; m < MT; m += NGW) {
            int lane = F.lane; asm volatile("" : "+v"(lane));
            const bool lat = m < ML; const int b = lat ? m / SEQ : (m - ML) / CTXL, t = lat ? m % SEQ : 0, kpos = lat ? CTXL + t : (m - ML) % CTXL;
            const bf16* er = E2 + (size_t)m * ODN;
            float cs = 1.f, sn = 0.f; if (lat) { cs = c2[t * 64 + lane]; sn = s2[t * 64 + lane]; }
            if (lat) {
#pragma unroll 4
                for (int hq = 0; hq < 12; ++hq) { const float x1 = bf2f(er[512 + 128 * hq + lane]), x2 = bf2f(er[512 + 128 * hq + 64 + lane]);
                    const float rs = __builtin_amdgcn_rsqf(wave_sum(x1 * x1 + x2 * x2) * (1.f / 128.f) + EPS); const float y1 = x1 * rs * qg1, y2 = x2 * rs * qg2;
                    bf16* qo = QB + (size_t)m * 1536 + 128 * hq; qo[lane] = f2bf(y1 * cs - y2 * sn); qo[64 + lane] = f2bf(y1 * sn + y2 * cs); }
            }
            bf16* ko = KB + ((size_t)b * KVL + kpos) * 512; bf16* vo = VB + ((size_t)b * KVL + kpos) * 512;
#pragma unroll
            for (int hk = 0; hk < 4; ++hk) { const float x1 = bf2f(er[2048 + 128 * hk + lane]), x2 = bf2f(er[2048 + 128 * hk + 64 + lane]);
                const float rs = __builtin_amdgcn_rsqf(wave_sum(x1 * x1 + x2 * x2) * (1.f / 128.f) + EPS); const float y1 = x1 * rs * kg1, y2 = x2 * rs * kg2;
                ko[128 * hk + lane] = f2bf(y1 * cs - y2 * sn); ko[128 * hk + 64 + lane] = f2bf(y1 * sn + y2 * cs); }
            *(u32x4*)(vo + 8 * lane) = *(const u32x4*)(er + 2560 + 8 * lane);
        }
    }
    {
        const int lane = F.lane, r32 = lane & 31, hh = lane >> 5;
        LAS unsigned char* XS = F.lds; LAS unsigned char* DS = F.lds + 144 * 256; constexpr int DLD = 272;
        for (int it = F.bid; it < (ML / 128) * 4; it += F.G) {
            const int gi = it & 3, rt = it >> 2, b = (rt * 128) / SEQ, t0 = (rt * 128) % SEQ, half = 1 << gi;
            __syncthreads();
            for (int pc = tid; pc < 144 * 16; pc += 512) { const int rr = pc >> 4, c8 = pc & 15, pos = t0 - 8 + rr;
                u32x4 v = {0u, 0u, 0u, 0u}; if (pos >= 0 && pos < SEQ) v = *(const u32x4*)(E2 + (size_t)(b * SEQ + pos) * ODN + 128 * gi + 8 * c8);
                *(LAS u32x4*)(XS + rr * 256 + c8 * 16) = v; }
            __syncthreads();
            for (int pc = tid; pc < 128 * 16; pc += 512) { const int tt = pc >> 4, c8 = pc & 15, t = t0 + tt;
                const int lo = (t - half) < 0 ? 0 : t - half, hi = (t + half) > SEQ ? SEQ : t + half; const float inv = 1.f / (float)(hi - lo);
                float s[8] = {0.f, 0.f, 0.f, 0.f, 0.f, 0.f, 0.f, 0.f};
                for (int p = lo; p < hi; ++p) { const u32x4 v = *(const LAS u32x4*)(XS + (p - t0 + 8) * 256 + c8 * 16);
                    s[0] += bflo(v.x); s[1] += bfhi(v.x); s[2] += bflo(v.y); s[3] += bfhi(v.y); s[4] += bflo(v.z); s[5] += bfhi(v.z); s[6] += bflo(v.w); s[7] += bfhi(v.w); }
                const u32x4 xv = *(const LAS u32x4*)(XS + (tt + 8) * 256 + c8 * 16);
                u32x4 o; o.x = pkbf(s[0] * inv - bflo(xv.x), s[1] * inv - bfhi(xv.x)); o.y = pkbf(s[2] * inv - bflo(xv.y), s[3] * inv - bfhi(xv.y));
                o.z = pkbf(s[4] * inv - bflo(xv.z), s[5] * inv - bfhi(xv.z)); o.w = pkbf(s[6] * inv - bflo(xv.w), s[7] * inv - bfhi(xv.w));
                *(LAS u32x4*)(DS + tt * DLD + c8 * 16) = o; }
            __syncthreads();
            { const int rb = wave & 3, chh = wave >> 2; const bf16* WT = (const bf16*)(ws + WS_POOLW) + (size_t)gi * 16384;
              f32x16 acc[2] = {f32x16{}, f32x16{}};
#pragma unroll
              for (int ks = 0; ks < 8; ++ks) { const bf16x8 af = *(const LAS bf16x8*)(DS + (32 * rb + r32) * DLD + (16 * ks + 8 * hh) * 2);
#pragma unroll
                  for (int ct = 0; ct < 2; ++ct) { const bf16x8 bfr = *(const bf16x8*)(WT + (size_t)(64 * chh + 32 * ct + r32) * 128 + 16 * ks + 8 * hh);
                      acc[ct] = __builtin_amdgcn_mfma_f32_32x32x16_bf16(af, bfr, acc[ct], 0, 0, 0); } }
#pragma unroll
              for (int ct = 0; ct < 2; ++ct) { const int col = 128 * gi + 64 * chh + 32 * ct + r32; const float ps = A.in[I_POOLS][col];
#pragma unroll
                  for (int r = 0; r < 16; ++r) MIX[(size_t)(b * SEQ + t0 + 32 * rb + crow(r, hh)) * DM + col] = f2bf(acc[ct][r] * ps); } }
        }
        __syncthreads();
    }
}
DEV void attn_phase(const Frame& F) {
    unsigned char* ws = F.a->ws; const bf16* QB = (const bf16*)(ws + WS_QB); const bf16* KB = (const bf16*)(ws + WS_KB); const bf16* VB = (const bf16*)(ws + WS_VB); bf16* MIX = (bf16*)(ws + WS_MIX2);
    for (int u = F.bid; u < NB * 12 * (SEQ / 256); u += F.G) {
        const int qb = u & 31, g = (u >> 5) % 3, kvh = ((u >> 5) / 3) & 3, b = (u >> 5) / 12, hq = kvh * 3 + g;
        att::attn_dense_body<1536, 512, DM>(QB + (size_t)(b * SEQ + 256 * qb) * 1536 + 128 * hq, KB + (size_t)b * KVL * 512 + 128 * kvh, VB + (size_t)b * KVL * 512 + 128 * kvh,
                                           MIX + (size_t)(b * SEQ + 256 * qb) * DM + 512 + 128 * hq, KVL, (char*)F.lds);
    }
}

constexpr int NPH = 25;
__global__ void __launch_bounds__(512, 2) mk_fwd(Args args) {
    extern __shared__ __attribute__((aligned(16))) unsigned char lds_raw[];
    Frame F; F.lds = (LAS unsigned char*)lds_raw; F.tid = threadIdx.x; F.lane = F.tid & 63; F.wave = __builtin_amdgcn_readfirstlane(F.tid >> 6); F.G = gridDim.x; F.bid = blockIdx.x; F.a = &args;
    unsigned char* ws = args.ws;
    volatile LAS unsigned* MISC = (volatile LAS unsigned*)(F.lds + MISC_OFF);
    if (F.tid < 64) MISC[F.tid] = 0u;
    __syncthreads();
    XcdBarrier bar; bar.bar = (unsigned*)(ws + WS_CTL) + CW_BAR; bar.x = 0; bar.st = nullptr;
    const int lo = args.ph_lo, hi = args.ph_hi;
    if (hi - lo > 1) bar = xcd_barrier_post((unsigned*)(ws + WS_CTL) + CW_BAR, MISC + 8);
#ifndef MK_MASK
#define MK_MASK 0xFFFFFFFFu
#endif
#define IN(k) (((MK_MASK >> (k)) & 1u) && lo <= (k) && (k) < hi && (k) <= MK_STOP_AFTER)
#define SEAM(k) do { if (IN(k) && (k) + 1 < hi) xcd_barrier(bar); } while (0)
#ifndef MK_DOUBLE
#define MK_DOUBLE 0u
#endif
#ifndef MK_STAMP
#define MK_STAMP (-1)
#endif
#define PHASE(k) do { if ((k) == MK_STAMP) t_stamp0 = wall_clock64(); if (IN(k)) { PH_BODY_##k; if ((MK_DOUBLE >> (k)) & 1u) { xcd_barrier(bar); PH_BODY_##k; } } SEAM(k); if ((k) == MK_STAMP) t_stamp1 = wall_clock64(); } while (0)
    bf16* H = (bf16*)(ws + WS_H); bf16* ACT = (bf16*)(ws + WS_ACT); bf16* E = (bf16*)(ws + WS_E); bf16* E2 = (bf16*)(ws + WS_E2); bf16* MIX2 = (bf16*)(ws + WS_MIX2);
    float* XC = (float*)(ws + WS_XC);
#define GEMM_GU(lf, M_) do { pg8::Gemm g{H, (const bf16*)(ws + WS_WGU + (size_t)(lf) * 44 * MiB), (M_), 2 * DFF, DM, DM}; pg8::StaticOrder S; S.init((M_), 2 * DFF, F.G, F.bid); \
        pg8::EpiSwiGLU Ep{ACT, DFF}; pg8::gemm_phase<pg8::EpiSwiGLU, pg8::StaticOrder, PG8_ALIGN, PG8_SP2>(F.lds, g, S, Ep); } while (0)
#define GEMM_DN(lf, M_) do { pg8::Gemm g{ACT, (const bf16*)(ws + WS_WD + (size_t)(lf) * 22 * MiB), (M_), DM, DFF, DFF}; pg8::StaticOrder S; S.init((M_), DM, F.G, F.bid); \
        pg8::EpiPlain Ep{H, DM}; pg8::gemm_phase<pg8::EpiPlain, pg8::StaticOrder, PG8_ALIGN, PG8_SP2>(F.lds, g, S, Ep); } while (0)
#define RES(hr, hn, li_, sub_, li2_, sub2_, nrows_, w_, xol, xoc) do { ResCfg C{(hr), (hn), (li_), (sub_), (li2_), (sub2_), (nrows_), (w_), (xol), (xoc), args.out, XC}; res_phase(F, C); } while (0)

    unsigned long long t_stamp0 = 0, t_stamp1 = 0;
#define PH_BODY_0 p0_prologue(F)
    PHASE(0);
#define PH_BODY_1 RES(0, 1, 0, 0, 0, 0, MT, 0.f, args.in[I_X], args.in[I_CTX]);
    PHASE(1);
#define PH_BODY_2 GEMM_GU(0, MT)
    PHASE(2);
#define PH_BODY_3 GEMM_DN(0, MT)
    PHASE(3);
#define PH_BODY_4 RES(1, 1, 0, 0, 0, 1, MT, 0.5f, args.in[I_X], args.in[I_CTX])
    PHASE(4);
#define PH_BODY_5 { pg8::Gemm g{H, (const bf16*)(ws + WS_WEVIN), MT, EVN, DM, DM}; pg8::StaticOrder S; S.init(MT, EVN, F.G, F.bid); \
        pg8::EpiEvIn Ep{E, (const float*)(ws + WS_COS1), (const float*)(ws + WS_SIN1)}; pg8::gemm_phase<pg8::EpiEvIn, pg8::StaticOrder, PG8_ALIGN, PG8_SP2>(F.lds, g, S, Ep); }
    PHASE(5);
#define PH_BODY_6 lru_phase<false>(F)
    PHASE(6);
#define PH_BODY_7 { lru_carry_phase(F); ret_state_phase(F); }
    PHASE(7);
#ifndef MK_P8
#define MK_P8 3
#endif
#ifndef MK_DRY8
#define MK_DRY8 0
#endif
#define PH_BODY_8 { if (MK_DRY8 & 1) { lru_phase<true>(F, true); xcd_barrier(bar); } if (MK_DRY8 & 2) { ret_out_phase(F, true); xcd_barrier(bar); } if (MK_P8 & 1) lru_phase<true>(F); if (MK_P8 & 2) ret_out_phase(F); }
    PHASE(8);
#define PH_BODY_9 { pg8::Gemm g{E, (const bf16*)(ws + WS_WEVOUT), MT, DM, DM, EVN}; pg8::StaticOrder S; S.init(MT, DM, F.G, F.bid); \
        pg8::EpiPlain Ep{H, DM}; pg8::gemm_phase<pg8::EpiPlain, pg8::StaticOrder, PG8_ALIGN, PG8_SP2>(F.lds, g, S, Ep); }
    PHASE(9);
#define PH_BODY_10 RES(1, 1, 0, 1, 0, 2, MT, 1.0f, args.out, XC)
    PHASE(10);
#define PH_BODY_11 GEMM_GU(1, MT)
    PHASE(11);
#define PH_BODY_12 GEMM_DN(1, MT)
    PHASE(12);
#define PH_BODY_13 RES(1, 1, 0, 2, 1, 0, MT, 0.5f, args.out, XC)
    PHASE(13);
#define PH_BODY_14 GEMM_GU(2, MT)
    PHASE(14);
#define PH_BODY_15 GEMM_DN(2, MT)
    PHASE(15);
#define PH_BODY_16 RES(1, 1, 1, 0, 1, 1, MT, 0.5f, args.out, XC)
    PHASE(16);
#define PH_BODY_17 { pg8::Gemm g{H, (const bf16*)(ws + WS_WODIN), MT, ODN, DM, DM}; pg8::StaticOrder S; S.init(MT, ODN, F.G, F.bid); \
        pg8::EpiPlain Ep{E2, ODN}; pg8::gemm_phase<pg8::EpiPlain, pg8::StaticOrder, PG8_ALIGN, PG8_SP2>(F.lds, g, S, Ep); }
    PHASE(17);
#define PH_BODY_18 odd_post_phase(F)
    PHASE(18);
#define PH_BODY_19 attn_phase(F)
    PHASE(19);
#define PH_BODY_20 { pg8::Gemm g{MIX2, (const bf16*)(ws + WS_WODOUT), ML, DM, DM, DM}; pg8::StaticOrder S; S.init(ML, DM, F.G, F.bid); \
        pg8::EpiPlain Ep{H, DM}; pg8::gemm_phase<pg8::EpiPlain, pg8::StaticOrder, PG8_ALIGN, PG8_SP2>(F.lds, g, S, Ep); }
    PHASE(20);
#define PH_BODY_21 RES(1, 1, 1, 1, 1, 2, ML, 1.0f, args.out, XC)
    PHASE(21);
#define PH_BODY_22 GEMM_GU(3, ML)
    PHASE(22);
#define PH_BODY_23 GEMM_DN(3, ML)
    PHASE(23);
#define PH_BODY_24 RES(1, 0, 1, 2, 0, 0, ML, 0.5f, args.out, XC)
    PHASE(24);
    if (MK_STAMP >= 0 && F.bid == 0 && F.tid == 0) args.out[0] = 64.f * floorf((float)(t_stamp1 - t_stamp0) * 0.01f / 64.f + 0.5f);
#undef IN
#undef SEAM
}

extern "C" void kernel_launch(void* const* d_in, const int* in_sizes, int n_in, void* d_out, int out_size, void* d_ws, size_t ws_size, hipStream_t stream) {
    static int grid = 0;
    if (grid == 0) {
        if (n_in != 28 || out_size != ML * DM || ws_size < WS_END) { fprintf(stderr, "kernel_launch: unexpected shapes (n_in %d out %d ws %zu, need ws >= %zu)\n", n_in, out_size, ws_size, (size_t)WS_END); grid = -1; return; }
        int dev = 0, cus = 0, per_cu = 0;
        if (hipGetDevice(&dev) != hipSuccess || hipDeviceGetAttribute(&cus, hipDeviceAttributeMultiprocessorCount, dev) != hipSuccess) { grid = -1; return; }
        if (hipFuncSetAttribute((const void*)mk_fwd, hipFuncAttributeMaxDynamicSharedMemorySize, LDS_BYTES) != hipSuccess) { fprintf(stderr, "kernel_launch: hipFuncSetAttribute failed\n"); grid = -1; return; }
        if (hipOccupancyMaxActiveBlocksPerMultiprocessor(&per_cu, (const void*)mk_fwd, 512, LDS_BYTES) != hipSuccess || per_cu < 1) fprintf(stderr, "kernel_launch: occupancy query says %d\n", per_cu);
        (void)hipGetLastError();
        grid = cus;
    }
    if (grid < 0) return;
    (void)hipMemsetAsync((char*)d_ws + WS_CTL, 0, CTL_ZERO_BYTES, stream);
    Args a{};
    for (int i = 0; i < 28; ++i) a.in[i] = (const float*)d_in[i];
    a.out = (float*)d_out; a.ws = (unsigned char*)d_ws;
#if MK_N_LAUNCHES == 1
    a.ph_lo = 0; a.ph_hi = NPH;
    hipLaunchKernelGGL(mk_fwd, dim3(grid), dim3(512), LDS_BYTES, stream, a);
#else
    for (int p = 0; p < NPH && p <= MK_STOP_AFTER; ++p) { a.ph_lo = p; a.ph_hi = p + 1; hipLaunchKernelGGL(mk_fwd, dim3(grid), dim3(512), LDS_BYTES, stream, a); }
#endif
    const hipError_t le = hipPeekAtLastError();
    if (le != hipSuccess) fprintf(stderr, "kernel_launch: launch failed: %s\n", hipGetErrorName(le));
}
```

```cpp
#include <hip/hip_runtime.h>
#include <cstdio>
#include <cstdint>

#ifndef MK_N_LAUNCHES
#define MK_N_LAUNCHES 1
#endif
#ifndef MK_STOP_AFTER
#define MK_STOP_AFTER 1000
#endif

#define DEV __device__ __forceinline__
#define LAS __attribute__((address_space(3)))
typedef unsigned short bf16;
typedef float f32x4 __attribute__((ext_vector_type(4)));
typedef float f32x2 __attribute__((ext_vector_type(2)));
typedef float f32x16 __attribute__((ext_vector_type(16)));
typedef short bf16x8 __attribute__((ext_vector_type(8)));
typedef short s16x4 __attribute__((ext_vector_type(4)));
typedef unsigned u32x4 __attribute__((ext_vector_type(4)));
typedef unsigned u32x2 __attribute__((ext_vector_type(2)));

constexpr int NB = 4, SEQ = 8192, DM = 2048, CTXL = 256, DFF = 5632;
constexpr int ML = NB * SEQ, MC = NB * CTXL, MT = ML + MC;
constexpr float EPS = 1e-6f;
constexpr int EVN = 6144, ODN = 3072;
constexpr int EC_G = 0, EC_O = 1024, EC_Q = 2048, EC_K = 3072, EC_V = 4096, EC_R = 5120;
constexpr int NCH64 = (CTXL + SEQ) / 64;
constexpr int NCH128 = (CTXL + SEQ) / 128;
constexpr int KVL = CTXL + SEQ;

constexpr size_t MiB = 1u << 20;
constexpr size_t WS_CTL = 0, CTL_ZERO_BYTES = 1 * MiB;
constexpr size_t WS_MOD = 1 * MiB;
constexpr size_t WS_COS1 = 2 * MiB, WS_SIN1 = 6 * MiB;
constexpr size_t WS_COS2 = 10 * MiB, WS_SIN2 = 12 * MiB;
constexpr size_t WS_LRUW = 14 * MiB;
constexpr size_t WS_POOLW = 15 * MiB;
constexpr size_t WS_AGG = 16 * MiB;
constexpr size_t WS_CAR = 25 * MiB;
constexpr size_t WS_XC = 30 * MiB;
constexpr size_t WS_W = 40 * MiB;
constexpr size_t WS_WGU = WS_W;
constexpr size_t WS_WD = WS_W + 176 * MiB;
constexpr size_t WS_WEVIN = WS_W + 264 * MiB;
constexpr size_t WS_WEVOUT = WS_W + 288 * MiB;
constexpr size_t WS_WODIN = WS_W + 296 * MiB;
constexpr size_t WS_WODOUT = WS_W + 308 * MiB;
constexpr size_t WS_H = 356 * MiB;
constexpr size_t WS_BIG = 488 * MiB;
constexpr size_t WS_ACT = WS_BIG;
constexpr size_t WS_E = WS_BIG;
constexpr size_t WS_SBUF = WS_BIG + 396 * MiB;
constexpr size_t WS_PART = WS_BIG + 400 * MiB;
constexpr size_t WS_E2 = WS_BIG;
constexpr size_t WS_QB = WS_BIG + 198 * MiB;
constexpr size_t WS_KB = WS_BIG + 294 * MiB;
constexpr size_t WS_VB = WS_BIG + 327 * MiB;
constexpr size_t WS_MIX2 = WS_BIG + 360 * MiB;
constexpr size_t WS_END = 1148 * MiB;
constexpr int CW_BAR = 4096;

constexpr int LDS_BYTES = 159744;
constexpr int MISC_OFF = LDS_BYTES - 256;

DEV float bflo(unsigned w) { return __uint_as_float(w << 16); }
DEV float bfhi(unsigned w) { return __uint_as_float(w & 0xffff0000u); }
DEV float bf2f(bf16 b) { return __uint_as_float((unsigned)b << 16); }
DEV unsigned pkbf(float lo, float hi) { unsigned r; asm volatile("v_cvt_pk_bf16_f32 %0, %1, %2" : "=v"(r) : "v"(lo), "v"(hi)); return r; }
DEV bf16 f2bf(float f) { return (bf16)(pkbf(f, 0.f) & 0xffffu); }
DEV float fexp(float x) { return __builtin_amdgcn_exp2f(x * 1.4426950408889634f); }
DEV float fsigmoid(float x) { return __builtin_amdgcn_rcpf(1.f + fexp(-x)); }
DEV float fsilu(float x) { return x * fsigmoid(x); }
DEV float fgelu_tanh(float x) { const float z = 0.7978845608028654f * (x + 0.044715f * x * x * x); return x * fsigmoid(2.f * z); }
DEV float wave_sum(float v) {
#pragma unroll
    for (int o = 1; o < 64; o <<= 1) v += __shfl_xor(v, o);
    return v;
}
DEV int crow(int r, int hi) { return (r & 3) + 8 * (r >> 2) + 4 * hi; }
typedef short v4i16_t __attribute__((ext_vector_type(4)));
DEV s16x4 ds_tr(const LAS unsigned char* p) { return __builtin_bit_cast(s16x4, __builtin_amdgcn_ds_read_tr16_b64_v4i16((LAS v4i16_t*)p)); }
DEV bf16x8 tr_frag(const LAS unsigned char* X, int ld, int k0, int n0, int lane) {
    const int h = lane >> 5, blk = (lane >> 4) & 1, q = (lane & 15) >> 2, p = lane & 3;
    const LAS unsigned char* a = X + (k0 + 8 * h + q) * ld + (n0 + 16 * blk + 4 * p) * 2;
    const s16x4 lo = ds_tr(a), hi = ds_tr(a + 4 * ld);
    return (bf16x8){lo[0], lo[1], lo[2], lo[3], hi[0], hi[1], hi[2], hi[3]};
}
DEV bf16x8 pack8(const float* v) { u32x4 w = {pkbf(v[0], v[1]), pkbf(v[2], v[3]), pkbf(v[4], v[5]), pkbf(v[6], v[7])}; return __builtin_bit_cast(bf16x8, w); }

namespace pg8 {
typedef unsigned short bf16_t;
constexpr int BM = 256, BK = 64, HALF = 128, HTB = HALF * BK * 2, STAGE_BYTES = 8 * HTB, NXCD = 8, WGM = 8;
__host__ __device__ __forceinline__ int lds_byte(int r, int c) { const int st = (r >> 4) * 2 + (c >> 5), rr = r & 15, cc = c & 31, ob = rr * 64 + cc * 2; return st * 1024 + (ob ^ (((ob >> 9) & 1) << 5)); }
__host__ __device__ __forceinline__ void stage_rc(int b, int& R, int& C) { const int st = b / 1024, sb = b % 1024, swz = sb ^ (((sb >> 9) & 1) << 5); R = (st >> 1) * 16 + swz / 64; C = (st & 1) * 32 + (swz % 64) / 2; }
__host__ __device__ __forceinline__ int perm32(int rho) { const int n = rho >> 4, i = rho & 15; return 8 * (i >> 2) + 4 * n + (i & 3); }
struct Unit { int pm, pn, ks, nks; };
struct Gemm { const bf16_t* A; const bf16_t* Bt; int M, N, K, lda; };
struct StaticOrder {
    int nM, nN, nwg, G, c;
    __host__ __device__ void init(int M, int N, int G_, int c_) { nM = M / BM; nN = N / BM; nwg = nM * nN; G = G_; c = c_; }
    __host__ __device__ __forceinline__ bool next(int i, Unit& u) const {
        const long L = (long)i * G + c; if (L >= nwg) return false;
        int wgid = (int)L; { const int q = nwg / NXCD, r = nwg % NXCD, xcd = wgid % NXCD, off = wgid / NXCD; wgid = (xcd < r ? xcd * (q + 1) : r * (q + 1) + (xcd - r) * q) + off; }
        const int nig = WGM * nN, gid = wgid / nig, fm = gid * WGM, gsz = (nM - fm) < WGM ? (nM - fm) : WGM;
        u.pm = fm + ((wgid % nig) % gsz); u.pn = (wgid % nig) / gsz; u.ks = 0; u.nks = 1; return true;
    }
    __device__ __forceinline__ void a_ready(const Unit&) const {}
    __device__ __forceinline__ void done(const Unit&) const {}
};
struct TailSplitOrder {
    StaticOrder full; int nMf, nMt, nN, nfull, split;
    __host__ __device__ void init(int Mfull, int Mtail, int N, int G_, int c_, int split_) { full.init(Mfull, N, G_, c_); nMf = Mfull / BM; nMt = Mtail / BM; nN = N / BM; nfull = nMf * nN; split = split_; }
    __host__ __device__ __forceinline__ bool next(int i, Unit& u) const {
        const long L = (long)i * full.G + full.c; int pm = 0, pn = 0, ks = 0, nks = 1; bool ok;
        if (L < nfull) { Unit f; ok = full.next(i, f); pm = f.pm; pn = f.pn; }
        else { const int Lp = (int)(L - nfull); ok = Lp < nMt * nN * split; const int t = Lp / split, d = nMt > 0 ? nMt : 1; ks = Lp % split; nks = split; pm = nMf + t % d; pn = t / d; }
        u.pm = pm; u.pn = pn; u.ks = ks; u.nks = nks; return ok;
    }
    __device__ __forceinline__ void a_ready(const Unit&) const {}
    __device__ __forceinline__ void done(const Unit&) const {}
};
struct EpiPlain {
    static constexpr bool PERM = true, AFTER_DRAIN = false;
    bf16_t* O; int ldc;
    __device__ __forceinline__ void operator()(const f32x4 (&acc)[2][2][4][2], const Unit& u, int wr, int wc, int fr, int fq) const {
        const int row0 = u.pm * BM + wr * 64 + fr, col0 = u.pn * BM + wc * 32 + 8 * fq;
#pragma unroll
        for (int ai = 0; ai < 2; ++ai)
#pragma unroll
            for (int m = 0; m < 4; ++m) { bf16_t* rowp = O + (size_t)(row0 + ai * HALF + m * 16) * ldc + col0;
#pragma unroll
                for (int bj = 0; bj < 2; ++bj) { const f32x4 v0 = acc[ai][bj][m][0], v1 = acc[ai][bj][m][1];
                    u32x4 w; w.x = pkbf(v0[0], v0[1]); w.y = pkbf(v0[2], v0[3]); w.z = pkbf(v1[0], v1[1]); w.w = pkbf(v1[2], v1[3]);
                    *(u32x4*)(rowp + bj * HALF) = w; } }
    }
};
struct EpiPlainSplit {
    static constexpr bool PERM = true, AFTER_DRAIN = false;
    bf16_t* O; int ldc; float* P; int prow0, prow_cnt;
    __device__ __forceinline__ void operator()(const f32x4 (&acc)[2][2][4][2], const Unit& u, int wr, int wc, int fr, int fq) const {
        const int row0 = u.pm * BM + wr * 64 + fr, col0 = u.pn * BM + wc * 32 + 8 * fq;
        if (u.nks == 1) {
#pragma unroll
            for (int ai = 0; ai < 2; ++ai)
#pragma unroll
                for (int m = 0; m < 4; ++m) { bf16_t* rowp = O + (size_t)(row0 + ai * HALF + m * 16) * ldc + col0;
#pragma unroll
                    for (int bj = 0; bj < 2; ++bj) { const f32x4 v0 = acc[ai][bj][m][0], v1 = acc[ai][bj][m][1];
                        u32x4 w; w.x = pkbf(v0[0], v0[1]); w.y = pkbf(v0[2], v0[3]); w.z = pkbf(v1[0], v1[1]); w.w = pkbf(v1[2], v1[3]);
                        *(u32x4*)(rowp + bj * HALF) = w; } }
        } else {
#pragma unroll
            for (int ai = 0; ai < 2; ++ai)
#pragma unroll
                for (int m = 0; m < 4; ++m) { float* rowp = P + ((size_t)u.ks * prow_cnt + (row0 + ai * HALF + m * 16 - prow0)) * ldc + col0;
#pragma unroll
                    for (int bj = 0; bj < 2; ++bj) { *(f32x4*)(rowp + bj * HALF) = acc[ai][bj][m][0]; *(f32x4*)(rowp + bj * HALF + 4) = acc[ai][bj][m][1]; } }
        }
    }
};
struct EpiSwiGLU {
    static constexpr bool PERM = true, AFTER_DRAIN = false;
    bf16_t* O; int ldc;
    __device__ __forceinline__ void operator()(const f32x4 (&acc)[2][2][4][2], const Unit& u, int wr, int wc, int fr, int fq) const {
        const int row0 = u.pm * BM + wr * 64 + fr, col0 = u.pn * HALF + wc * 32 + 8 * fq;
#pragma unroll
        for (int ai = 0; ai < 2; ++ai)
#pragma unroll
            for (int m = 0; m < 4; ++m) { bf16_t* rowp = O + (size_t)(row0 + ai * HALF + m * 16) * ldc + col0;
                f32x4 a0, a1;
#pragma unroll
                for (int j = 0; j < 4; ++j) { a0[j] = fsilu(acc[ai][0][m][0][j]) * acc[ai][1][m][0][j]; a1[j] = fsilu(acc[ai][0][m][1][j]) * acc[ai][1][m][1][j]; }
                u32x4 w; w.x = pkbf(a0[0], a0[1]); w.y = pkbf(a0[2], a0[3]); w.z = pkbf(a1[0], a1[1]); w.w = pkbf(a1[2], a1[3]);
                *(u32x4*)rowp = w; }
    }
};
struct EpiEvIn {
    static constexpr bool PERM = true, AFTER_DRAIN = false;
    bf16_t* O; const float* cs; const float* sn;
    __device__ __forceinline__ void operator()(const f32x4 (&acc)[2][2][4][2], const Unit& u, int wr, int wc, int fr, int fq) const {
        const int ldc = EVN; const int row0 = u.pm * BM + wr * 64 + fr, col0 = u.pn * BM + wc * 32 + 8 * fq;
        const bool qk = (u.pn >= 8 && u.pn < 16), rot = qk && (u.pm < ML / BM); const float ksc = (u.pn >= 12 && u.pn < 16) ? 0.0625f : 1.f;
#pragma unroll
        for (int ai = 0; ai < 2; ++ai)
#pragma unroll
            for (int m = 0; m < 4; ++m) { const int row = row0 + ai * HALF + m * 16; bf16_t* rowp = O + (size_t)row * ldc + col0;
                f32x4 o1[2], o2[2];
#pragma unroll
                for (int n = 0; n < 2; ++n) { const f32x4 x1 = acc[ai][0][m][n], x2 = acc[ai][1][m][n];
                    if (rot) { const int t = row & (SEQ - 1); const int i0 = wc * 32 + 8 * fq + 4 * n;
                        const f32x4 c4 = *(const f32x4*)(cs + (size_t)t * 128 + i0), s4 = *(const f32x4*)(sn + (size_t)t * 128 + i0);
                        o1[n] = (x1 * c4 - x2 * s4) * ksc; o2[n] = (x1 * s4 + x2 * c4) * ksc; }
                    else { o1[n] = x1 * ksc; o2[n] = x2 * ksc; } }
                u32x4 w; w.x = pkbf(o1[0][0], o1[0][1]); w.y = pkbf(o1[0][2], o1[0][3]); w.z = pkbf(o1[1][0], o1[1][1]); w.w = pkbf(o1[1][2], o1[1][3]);
                *(u32x4*)rowp = w;
                w.x = pkbf(o2[0][0], o2[0][1]); w.y = pkbf(o2[0][2], o2[0][3]); w.z = pkbf(o2[1][0], o2[1][1]); w.w = pkbf(o2[1][2], o2[1][3]);
                *(u32x4*)(rowp + HALF) = w; }
    }
};

template <class Epi, class Sched, bool ALIGN_EPI = false, bool SP2 = false>
__device__ __forceinline__ void gemm_phase(LAS unsigned char* lds, const Gemm g, const Sched& S, const Epi& E) {
    const int tid = threadIdx.x, wid = __builtin_amdgcn_readfirstlane(tid >> 6), lane = tid & 63, wr = wid >> 2, wc = wid & 3, fr = lane & 15, fq = lane >> 4;
    const int K = g.K, nt_full = K / BK, lda = g.lda;
    unsigned voffA[2], voffB[2];
#pragma unroll
    for (int i = 0; i < 2; ++i) { int R, C; stage_rc(tid * 16 + i * 8192, R, C); const int Rb = Epi::PERM ? ((R & ~31) + perm32(R & 31)) : R;
        voffA[i] = (unsigned)(R * lda + C) * 2u; voffB[i] = (unsigned)(Rb * K + C) * 2u; }
    const size_t kstep = (size_t)(BK * 2);
    const size_t hstepA = (size_t)HALF * lda * 2, hstepB = (size_t)HALF * K * 2;
    const size_t tstepA = 2 * hstepA, tstepB = 2 * hstepB;
    const unsigned ldsw = (unsigned)wid * 1024u;
    const int aoff = lds_byte(wr * 64 + fr, fq * 8), boff = lds_byte(wc * 32 + fr, fq * 8);
#define PG8_SA(b, h) (((b) * 2 + (h)) * HTB)
#define PG8_SB(b, h) ((4 + (b) * 2 + (h)) * HTB)
#define PG8_STAGE(bufoff, gbase, voff) do { _Pragma("unroll") for (int _i = 0; _i < 2; ++_i) \
        __builtin_amdgcn_global_load_lds((const unsigned*)((const char*)(gbase) + (voff)[_i]), (LAS unsigned*)(lds + (bufoff) + ldsw + _i * 8192), 16, 0, 0); } while (0)
#define PG8_LDA(dst, b, h) do { _Pragma("unroll") for (int m = 0; m < 4; ++m) _Pragma("unroll") for (int k = 0; k < 2; ++k) dst[m][k] = *(const LAS bf16x8*)(lds + PG8_SA(b, h) + aoff + m * 2048 + k * 1024); } while (0)
#define PG8_LDB(dst, b, h) do { _Pragma("unroll") for (int n = 0; n < 2; ++n) _Pragma("unroll") for (int k = 0; k < 2; ++k) dst[n][k] = *(const LAS bf16x8*)(lds + PG8_SB(b, h) + boff + n * 2048 + k * 1024); } while (0)
#define PG8_MMA(ai, bj, At, Bt) do { __builtin_amdgcn_s_setprio(1); _Pragma("unroll") for (int m = 0; m < 4; ++m) _Pragma("unroll") for (int n = 0; n < 2; ++n) _Pragma("unroll") for (int k = 0; k < 2; ++k) \
        acc[ai][bj][m][n] = __builtin_amdgcn_mfma_f32_16x16x32_bf16(Bt[n][k], At[m][k], acc[ai][bj][m][n], 0, 0, 0); __builtin_amdgcn_s_setprio(0); } while (0)
#define PG8_WAIT_V(n) asm volatile("s_waitcnt vmcnt(" #n ")" ::: "memory")
#define PG8_WAIT_L(n) asm volatile("s_waitcnt lgkmcnt(" #n ")" ::: "memory")
#define PG8_BAR __builtin_amdgcn_s_barrier()
#define PG8_SCHED __builtin_amdgcn_sched_barrier(0)
    Unit cur, nxt; int ui = 0;
    if (!S.next(0, cur)) return;
    f32x4 acc[2][2][4][2];
#pragma unroll
    for (int a = 0; a < 2; ++a)
#pragma unroll
        for (int b = 0; b < 2; ++b)
#pragma unroll
            for (int m = 0; m < 4; ++m)
#pragma unroll
                for (int n = 0; n < 2; ++n) acc[a][b][m][n] = (f32x4){0.f, 0.f, 0.f, 0.f};
    bf16x8 At[4][2], B0[2][2], B1[2][2];
    int nt = nt_full / cur.nks;
    const char* cA = (const char*)g.A + (size_t)cur.pm * tstepA + (size_t)cur.ks * (K / cur.nks) * 2; const char* cB = (const char*)g.Bt + (size_t)cur.pn * tstepB + (size_t)cur.ks * (K / cur.nks) * 2;
    S.a_ready(cur);
    if constexpr (SP2) {
        PG8_STAGE(PG8_SB(0, 0), cB, voffB); PG8_STAGE(PG8_SB(0, 1), cB + hstepB, voffB); PG8_STAGE(PG8_SA(0, 0), cA, voffA); PG8_STAGE(PG8_SA(0, 1), cA + hstepA, voffA);
        if (wr == 1) PG8_BAR;
        PG8_WAIT_V(2); PG8_BAR;
        PG8_STAGE(PG8_SB(1, 0), cB + kstep, voffB); PG8_STAGE(PG8_SA(1, 0), cA + kstep, voffA); PG8_STAGE(PG8_SB(1, 1), cB + hstepB + kstep, voffB);
        PG8_WAIT_V(6); PG8_BAR;
    } else {
        PG8_STAGE(PG8_SB(0, 0), cB, voffB); PG8_STAGE(PG8_SA(0, 0), cA, voffA); PG8_STAGE(PG8_SB(0, 1), cB + hstepB, voffB); PG8_STAGE(PG8_SA(0, 1), cA + hstepA, voffA);
        if (wr == 1) PG8_BAR;
        PG8_WAIT_V(4); PG8_BAR;
        PG8_STAGE(PG8_SB(1, 0), cB + kstep, voffB); PG8_STAGE(PG8_SA(1, 0), cA + kstep, voffA); PG8_STAGE(PG8_SB(1, 1), cB + hstepB + kstep, voffB);
        PG8_WAIT_V(6); PG8_BAR;
    }
    for (;;) {
        const bool has_next = S.next(ui + 1, nxt);
        const char* nA = has_next ? (const char*)g.A + (size_t)nxt.pm * tstepA + (size_t)nxt.ks * (K / nxt.nks) * 2 : cA; const char* nB = has_next ? (const char*)g.Bt + (size_t)nxt.pn * tstepB + (size_t)nxt.ks * (K / nxt.nks) * 2 : cB;
        for (int t = 0; t < nt; t += 2) {
            const bool last = (t == nt - 2);
            const char* a1 = cA + (size_t)(t + 1) * kstep;
            const char* a2 = last ? nA : cA + (size_t)(t + 2) * kstep; const char* b2 = last ? nB : cB + (size_t)(t + 2) * kstep;
            const char* a3 = a2 + kstep; const char* b3 = b2 + kstep;
            if (last && has_next) S.a_ready(nxt);
            if constexpr (SP2) {
            PG8_LDB(B0, 0, 0); PG8_LDB(B1, 0, 1); PG8_SCHED; PG8_LDA(At, 0, 0); PG8_STAGE(PG8_SA(1, 1), a1 + hstepA, voffA);
            PG8_WAIT_V(8); PG8_WAIT_L(0); PG8_BAR; PG8_MMA(0, 0, At, B0); PG8_MMA(0, 1, At, B1); PG8_BAR; PG8_SCHED;
            PG8_LDA(At, 0, 1); PG8_STAGE(PG8_SB(0, 0), b2, voffB); PG8_STAGE(PG8_SB(0, 1), b2 + hstepB, voffB); PG8_STAGE(PG8_SA(0, 0), a2, voffA);
            PG8_WAIT_V(8); PG8_WAIT_L(0); PG8_BAR; PG8_MMA(1, 0, At, B0); PG8_MMA(1, 1, At, B1); PG8_BAR; PG8_SCHED;
            PG8_LDB(B0, 1, 0); PG8_LDB(B1, 1, 1); PG8_SCHED; PG8_LDA(At, 1, 0); PG8_STAGE(PG8_SA(0, 1), a2 + hstepA, voffA);
            PG8_WAIT_V(8); PG8_WAIT_L(0); PG8_BAR; PG8_MMA(0, 0, At, B0); PG8_MMA(0, 1, At, B1); PG8_BAR; PG8_SCHED;
            PG8_LDA(At, 1, 1); PG8_STAGE(PG8_SB(1, 0), b3, voffB); PG8_STAGE(PG8_SB(1, 1), b3 + hstepB, voffB); PG8_STAGE(PG8_SA(1, 0), a3, voffA);
            PG8_WAIT_V(8); PG8_WAIT_L(0); PG8_BAR; PG8_MMA(1, 0, At, B0); PG8_MMA(1, 1, At, B1); PG8_BAR; PG8_SCHED;
            } else {
            PG8_LDB(B0, 0, 0); PG8_SCHED; PG8_LDA(At, 0, 0); PG8_STAGE(PG8_SA(1, 1), a1 + hstepA, voffA);
            PG8_WAIT_L(8); PG8_BAR; PG8_WAIT_L(0); PG8_MMA(0, 0, At, B0); PG8_BAR; PG8_SCHED;
            PG8_LDB(B1, 0, 1); PG8_STAGE(PG8_SB(0, 0), b2, voffB);
            PG8_BAR; PG8_WAIT_L(0); PG8_MMA(0, 1, At, B1); PG8_BAR;
            PG8_LDA(At, 0, 1); PG8_STAGE(PG8_SA(0, 0), a2, voffA);
            PG8_BAR; PG8_WAIT_L(0); PG8_MMA(1, 0, At, B0); PG8_BAR; PG8_SCHED;
            PG8_STAGE(PG8_SB(0, 1), b2 + hstepB, voffB);
            PG8_WAIT_V(6); PG8_BAR; PG8_MMA(1, 1, At, B1); PG8_BAR;
            PG8_LDB(B0, 1, 0); PG8_SCHED; PG8_LDA(At, 1, 0); PG8_STAGE(PG8_SA(0, 1), a2 + hstepA, voffA);
            PG8_WAIT_L(8); PG8_BAR; PG8_WAIT_L(0); PG8_MMA(0, 0, At, B0); PG8_BAR; PG8_SCHED;
            PG8_LDB(B1, 1, 1); PG8_STAGE(PG8_SB(1, 0), b3, voffB);
            PG8_BAR; PG8_WAIT_L(0); PG8_MMA(0, 1, At, B1); PG8_BAR;
            PG8_LDA(At, 1, 1); PG8_STAGE(PG8_SA(1, 0), a3, voffA);
            PG8_BAR; PG8_WAIT_L(0); PG8_MMA(1, 0, At, B0); PG8_BAR; PG8_SCHED;
            PG8_STAGE(PG8_SB(1, 1), b3 + hstepB, voffB);
            PG8_WAIT_V(6); PG8_BAR; PG8_MMA(1, 1, At, B1); PG8_BAR;
            }
        }
        if constexpr (ALIGN_EPI) { if (wr == 0) PG8_BAR; }
        if constexpr (!Epi::AFTER_DRAIN) { E(acc, cur, wr, wc, fr, fq); S.done(cur); }
        if (!has_next) break;
#pragma unroll
        for (int a = 0; a < 2; ++a)
#pragma unroll
            for (int b = 0; b < 2; ++b)
#pragma unroll
                for (int m = 0; m < 4; ++m)
#pragma unroll
                    for (int n = 0; n < 2; ++n) acc[a][b][m][n] = (f32x4){0.f, 0.f, 0.f, 0.f};
        cur = nxt; cA = nA; cB = nB; ++ui; nt = nt_full / cur.nks;
        if constexpr (ALIGN_EPI) { if (wr == 1) PG8_BAR; }
    }
    PG8_WAIT_V(0);
    if constexpr (!ALIGN_EPI) { if (wr == 0) PG8_BAR; }
    PG8_BAR;
#undef PG8_SA
#undef PG8_SB
#undef PG8_STAGE
#undef PG8_LDA
#undef PG8_LDB
#undef PG8_MMA
#undef PG8_WAIT_V
#undef PG8_WAIT_L
#undef PG8_BAR
#undef PG8_SCHED
}
}
#define PG8_SP2 true
#define PG8_ALIGN true

namespace att {
constexpr int D = 128, NW = 8, QBLK = 32, KVBLK = 64;
constexpr float SCALE = 0.088388347648318440f;
constexpr float THR = 8.f;
constexpr size_t SHM_V = KVBLK * D * 2, SHM_K = KVBLK * D * 2, SHM_ATTN = 2 * SHM_V + 2 * SHM_K + NW * 64 * 4;
#define KSWZ(row, colB) ((row) * 256 + ((colB) ^ (((row) & 7) << 4)))
#define SBAR() __builtin_amdgcn_sched_barrier(0)
DEV void partialSM(f32x16& p0, f32x16& p1, float& m_reg, float& mn, float& alpha) {
  constexpr float C = SCALE * 1.4426950408889634f;
  float pmax = p0[0]; for (int r = 1; r < 16; ++r) pmax = fmaxf(pmax, p0[r]); for (int r = 0; r < 16; ++r) pmax = fmaxf(pmax, p1[r]);
  { auto rr = __builtin_amdgcn_permlane32_swap(__float_as_uint(pmax), __float_as_uint(pmax), false, false);
    pmax = fmaxf(__uint_as_float(rr[0]), __uint_as_float(rr[1])); }
  if (__builtin_expect(__all(pmax - m_reg <= THR / SCALE), 1)) { mn = m_reg; alpha = 1.f; }
  else { mn = fmaxf(m_reg, pmax); alpha = __builtin_amdgcn_exp2f((m_reg - mn) * C); m_reg = mn; }
  float mnC = -mn * C;
  for (int r = 0; r < 16; ++r) p0[r] = fmaf(p0[r], C, mnC); for (int r = 0; r < 16; ++r) p1[r] = fmaf(p1[r], C, mnC);
  for (int r = 0; r < 16; ++r) p0[r] = __builtin_amdgcn_exp2f(p0[r]);
}
DEV void finishSM(f32x16& p0, f32x16& p1, float alpha, float& l_reg, bf16x8& pa0, bf16x8& pa1, bf16x8& pa2, bf16x8& pa3) {
  for (int r = 0; r < 16; ++r) p1[r] = __builtin_amdgcn_exp2f(p1[r]);
  float ps = 0; for (int r = 0; r < 16; ++r) ps += p0[r]; for (int r = 0; r < 16; ++r) ps += p1[r];
  { auto rr = __builtin_amdgcn_permlane32_swap(__float_as_uint(ps), __float_as_uint(ps), false, false);
    ps = __uint_as_float(rr[0]) + __uint_as_float(rr[1]); }
  l_reg = l_reg * alpha + ps;
#define PK4(P, BASE, OUT) do { unsigned a0 = pkbf(P[BASE + 0], P[BASE + 1]), a1 = pkbf(P[BASE + 2], P[BASE + 3]);   \
    unsigned b0 = pkbf(P[BASE + 4], P[BASE + 5]), b1 = pkbf(P[BASE + 6], P[BASE + 7]);                              \
    auto r0 = __builtin_amdgcn_permlane32_swap(a0, b0, false, false); auto r1 = __builtin_amdgcn_permlane32_swap(a1, b1, false, false); \
    u32x4 w = {r0[0], r1[0], r0[1], r1[1]}; OUT = __builtin_bit_cast(bf16x8, w); } while (0)
  PK4(p0, 0, pa0); PK4(p0, 8, pa1); PK4(p1, 0, pa2); PK4(p1, 8, pa3);
#undef PK4
}
DEV void qkt(f32x16& p0, f32x16& p1, const bf16* Ks, const bf16x8* qr, int r32, int hi) {
  p0 = f32x16{}; p1 = f32x16{};
  for (int d0 = 0; d0 < 8; ++d0) { int cb = (d0 * 16 + hi * 8) * 2;
    bf16x8 b0 = *reinterpret_cast<const bf16x8*>((const char*)Ks + KSWZ(r32, cb));
    bf16x8 b1 = *reinterpret_cast<const bf16x8*>((const char*)Ks + KSWZ(32 + r32, cb));
    p0 = __builtin_amdgcn_mfma_f32_32x32x16_bf16(b0, qr[d0], p0, 0, 0, 0);
    p1 = __builtin_amdgcn_mfma_f32_32x32x16_bf16(b1, qr[d0], p1, 0, 0, 0); }
}
DEV int v_st(int k, int c) { const int kk = (k & ~0xC) | ((k & 4) << 1) | ((k & 8) >> 1); return ((kk >> 3) * 4 + (c >> 5)) * 512 + ((kk & 7) * 32 + (c & 31)) * 2; }
DEV int v_rd_base(int lane) { return ((lane & 3) << 3) | (((lane >> 2) & 3) << 6) | (((lane >> 4) & 1) << 5) | (((lane >> 5) & 1) << 8); }
constexpr int v_rd_off(int d0, int ks, int half) { return d0 * 512 + ks * 4096 + half * 2048; }
template <int OFF> DEV s16x4 tr_read(int vb) {
  s16x4 r; asm volatile("ds_read_b64_tr_b16 %0, %1 offset:%2" : "=&v"(r) : "v"(vb), "i"(OFF) : "memory"); return r;
}
template <int D0> DEV void pv_one(f32x16& od, int vb, bf16x8 pa0, bf16x8 pa1, bf16x8 pa2, bf16x8 pa3) {
  const s16x4 l0 = tr_read<v_rd_off(D0, 0, 0)>(vb), h0 = tr_read<v_rd_off(D0, 0, 1)>(vb), l1 = tr_read<v_rd_off(D0, 1, 0)>(vb), h1 = tr_read<v_rd_off(D0, 1, 1)>(vb);
  const s16x4 l2 = tr_read<v_rd_off(D0, 2, 0)>(vb), h2 = tr_read<v_rd_off(D0, 2, 1)>(vb), l3 = tr_read<v_rd_off(D0, 3, 0)>(vb), h3 = tr_read<v_rd_off(D0, 3, 1)>(vb);
  asm volatile("s_waitcnt lgkmcnt(0)" ::: "memory"); SBAR();
#define PK(L, H) (bf16x8){L[0], L[1], L[2], L[3], H[0], H[1], H[2], H[3]}
  od = __builtin_amdgcn_mfma_f32_32x32x16_bf16(pa0, PK(l0, h0), od, 0, 0, 0);
  od = __builtin_amdgcn_mfma_f32_32x32x16_bf16(pa1, PK(l1, h1), od, 0, 0, 0);
  od = __builtin_amdgcn_mfma_f32_32x32x16_bf16(pa2, PK(l2, h2), od, 0, 0, 0);
  od = __builtin_amdgcn_mfma_f32_32x32x16_bf16(pa3, PK(l3, h3), od, 0, 0, 0);
#undef PK
}
DEV void pv_d0(f32x16* o, int vb, bf16x8 pa0, bf16x8 pa1, bf16x8 pa2, bf16x8 pa3) {
  pv_one<0>(o[0], vb, pa0, pa1, pa2, pa3); pv_one<1>(o[1], vb, pa0, pa1, pa2, pa3); pv_one<2>(o[2], vb, pa0, pa1, pa2, pa3); pv_one<3>(o[3], vb, pa0, pa1, pa2, pa3);
}
template <int LDQ, int LDK, int LDO>
DEV void attn_dense_body(const bf16* __restrict__ Qb, const bf16* __restrict__ Kh, const bf16* __restrict__ Vh, bf16* __restrict__ Ob, int seq, char* lds) {
  const int tid = threadIdx.x, wid = tid >> 6, lane = tid & 63, r32 = lane & 31, hi = lane >> 5;
  bf16* V_lds = (bf16*)lds; bf16* K_lds = (bf16*)(lds + 2 * SHM_V);
  float* ws = (float*)(lds + 2 * SHM_V + 2 * SHM_K) + wid * 64; float* li_l = ws; float* al_l = ws + 32;
  float m_reg = -1e30f, l_reg = 0; f32x16 o[4] = {}; bf16x8 qr[8];
  const bf16* Qw = Qb + (long)(wid * QBLK + r32) * LDQ + hi * 8;
#pragma unroll
  for (int d0 = 0; d0 < 8; ++d0) qr[d0] = *reinterpret_cast<const bf16x8*>(Qw + d0 * 16);
  const int sr = tid >> 4, sc = (tid & 15) * 8, vst0 = v_st(sr, sc), vst1 = v_st(32 + sr, sc);
  const int vb0 = (int)(uintptr_t)V_lds + v_rd_base(lane);
  struct { bf16x8 vs0, vs1, ks0, ks1; } sr_[2];
#define SLOAD(i, k0) do { sr_[i].vs0 = *reinterpret_cast<const bf16x8*>(&Vh[(long)((k0) + sr) * LDK + sc]); sr_[i].vs1 = *reinterpret_cast<const bf16x8*>(&Vh[(long)((k0) + 32 + sr) * LDK + sc]); \
    sr_[i].ks0 = *reinterpret_cast<const bf16x8*>(&Kh[(long)((k0) + sr) * LDK + sc]); sr_[i].ks1 = *reinterpret_cast<const bf16x8*>(&Kh[(long)((k0) + 32 + sr) * LDK + sc]); } while (0)
#define SWRITE(b, i) do { *(bf16x8*)((char*)V_lds + (b) * SHM_V + vst0) = sr_[i].vs0;          \
    *(bf16x8*)((char*)V_lds + (b) * SHM_V + vst1) = sr_[i].vs1; int kc = sc * 2;               \
    *(bf16x8*)((char*)K_lds + (b) * SHM_K + KSWZ(sr, kc)) = sr_[i].ks0;                       \
    *(bf16x8*)((char*)K_lds + (b) * SHM_K + KSWZ(32 + sr, kc)) = sr_[i].ks1; } while (0)
#define SWAIT() asm volatile("s_waitcnt vmcnt(4)" ::: "memory")
#define RESC(a) do { if (__any((a) < 1.f)) { if (hi == 0) al_l[r32] = (a); asm volatile("s_waitcnt lgkmcnt(0)" ::: "memory"); \
    for (int d = 0; d < 4; ++d) for (int r = 0; r < 16; ++r) o[d][r] *= al_l[crow(r, hi)]; } } while (0)
  f32x16 pA0, pA1, pB0, pB1; float mnA, mnB, alA, alB; bf16x8 pa0, pa1, pa2, pa3; const int NT = seq / KVBLK;
  constexpr int SE = 0, SO = 1;
  SLOAD(SE, 0); asm volatile("s_waitcnt vmcnt(0)" ::: "memory"); SWRITE(0, SE); __syncthreads();
  qkt(pA0, pA1, K_lds, qr, r32, hi); partialSM(pA0, pA1, m_reg, mnA, alA);
  SLOAD(SO, KVBLK); if (2 < NT) SLOAD(SE, 2 * KVBLK);
  SWAIT(); SWRITE(1, SO); __syncthreads();
  for (int j = 1; j + 1 < NT; j += 2) {
    SBAR(); qkt(pB0, pB1, (bf16*)((char*)K_lds + SHM_K), qr, r32, hi);
    finishSM(pA0, pA1, alA, l_reg, pa0, pa1, pa2, pa3); SBAR();
    SLOAD(SO, (j + 2) * KVBLK); SBAR();
    pv_d0(o, vb0, pa0, pa1, pa2, pa3); partialSM(pB0, pB1, m_reg, mnB, alB);
    __syncthreads(); SWAIT(); SWRITE(0, SE);
    RESC(alB); __syncthreads();
    SBAR(); qkt(pA0, pA1, K_lds, qr, r32, hi);
    finishSM(pB0, pB1, alB, l_reg, pa0, pa1, pa2, pa3); SBAR();
    if (j + 3 < NT) SLOAD(SE, (j + 3) * KVBLK); SBAR();
    pv_d0(o, vb0 + (int)SHM_V, pa0, pa1, pa2, pa3); partialSM(pA0, pA1, m_reg, mnA, alA);
    __syncthreads(); SWAIT(); SWRITE(1, SO);
    RESC(alA); __syncthreads();
  }
  SBAR(); qkt(pB0, pB1, (bf16*)((char*)K_lds + SHM_K), qr, r32, hi);
  finishSM(pA0, pA1, alA, l_reg, pa0, pa1, pa2, pa3); SBAR();
  pv_d0(o, vb0, pa0, pa1, pa2, pa3); partialSM(pB0, pB1, m_reg, mnB, alB);
  __syncthreads(); RESC(alB);
  finishSM(pB0, pB1, alB, l_reg, pa0, pa1, pa2, pa3); SBAR();
  pv_d0(o, vb0 + (int)SHM_V, pa0, pa1, pa2, pa3);
  if (hi == 0) li_l[r32] = l_reg; asm volatile("s_waitcnt lgkmcnt(0)" ::: "memory");
  float rli[16];
#pragma unroll
  for (int r = 0; r < 16; ++r) rli[r] = __builtin_amdgcn_rcpf(li_l[crow(r, hi)]);
  bf16* Ow = Ob + (long)(wid * QBLK) * LDO;
#pragma unroll
  for (int r = 0; r < 16; ++r) { int orow = crow(r, hi);
    for (int d0 = 0; d0 < 4; ++d0) Ow[(long)orow * LDO + d0 * 32 + r32] = f2bf(o[d0][r] * rli[r]); }
  __syncthreads();
#undef SLOAD
#undef SWRITE
#undef SWAIT
#undef RESC
}
#undef KSWZ
}

#define XB_TMO      128
#define XB_XCNT(j)  (256  + 64 * (j))
#define XB_XSUB(j)  (1280 + 64 * (j))
#define XB_XGEN(j)  (2304 + 64 * (j))
#define XB_TOP      3328
#define XB_TOPGEN   3392
#define XCD_BAR_WORDS 3456
#define XB_SPIN_CAP (1u << 18)
DEV unsigned xb_ld(unsigned* p)              { return __hip_atomic_load(p, __ATOMIC_RELAXED, __HIP_MEMORY_SCOPE_AGENT); }
DEV unsigned xb_add(unsigned* p, unsigned v) { return __hip_atomic_fetch_add(p, v, __ATOMIC_RELAXED, __HIP_MEMORY_SCOPE_AGENT); }
DEV unsigned xb_xcc_id() { return (unsigned)__builtin_amdgcn_s_getreg((3 << 11) | 20) & 0xFu; }
#define XB_SPIN(cond, bar) do { unsigned _sp = 0; while (cond) { __builtin_amdgcn_s_sleep(1); \
    if ((++_sp & 255u) == 0u) { if (xb_ld(&(bar)[XB_TMO])) break; if (_sp > XB_SPIN_CAP) { atomicAdd(&(bar)[XB_TMO], 1u); break; } } } } while (0)
struct XcdBarrier { unsigned* bar; unsigned x; volatile LAS unsigned* st; };
DEV XcdBarrier xcd_barrier_post(unsigned* bar, volatile LAS unsigned* st) {
    XcdBarrier b; b.bar = bar; b.x = xb_xcc_id(); b.st = st;
    if (threadIdx.x == 0) (void)xb_add(&bar[XB_XCNT(b.x)], 1u);
    return b;
}
DEV void xcd_barrier_complete(unsigned* bar, unsigned x, unsigned& nloc, unsigned& nx) {
    const unsigned G = gridDim.x * gridDim.y * gridDim.z;
    unsigned sum, cnt, mine, sp = 0u;
    for (;;) {
        sum = 0u; cnt = 0u; mine = 0u;
#pragma unroll
        for (unsigned j = 0; j < 16; ++j) { const unsigned c = xb_ld(&bar[XB_XCNT(j)]); sum += c; cnt += (c > 0u) ? 1u : 0u; mine = (j == x) ? c : mine; }
        if (sum == G) break;
        __builtin_amdgcn_s_sleep(1);
        if ((++sp & 255u) == 0u) { if (xb_ld(&bar[XB_TMO])) break; if (sp > XB_SPIN_CAP) { atomicAdd(&bar[XB_TMO], 1u); break; } }
    }
    nloc = mine > 0u ? mine : 1u; nx = cnt > 0u ? cnt : 1u;
}
DEV void xcd_barrier(const XcdBarrier& b) {
    asm volatile("s_waitcnt vmcnt(0)" ::: "memory");
    __syncthreads();
    if (threadIdx.x == 0) {
        unsigned* bar = b.bar;
        __builtin_amdgcn_s_waitcnt(0);
        unsigned nloc = b.st[0], nx = b.st[1];
        if (nloc == 0u) { xcd_barrier_complete(bar, b.x, nloc, nx); b.st[0] = nloc; b.st[1] = nx; }
        const unsigned old = xb_add(&bar[XB_XSUB(b.x)], 1u);
        const unsigned gen = old / nloc;
        if (old + 1u == (gen + 1u) * nloc) {
            __builtin_amdgcn_fence(__ATOMIC_RELEASE, "agent");
            asm volatile("s_waitcnt vmcnt(0)" ::: "memory");
            const unsigned og = xb_add(&bar[XB_TOP], 1u);
            const unsigned tg = og / nx;
            if (og + 1u == (tg + 1u) * nx) xb_add(&bar[XB_TOPGEN], 1u);
            else XB_SPIN(xb_ld(&bar[XB_TOPGEN]) == tg, bar);
            __builtin_amdgcn_fence(__ATOMIC_ACQUIRE, "agent");
            xb_add(&bar[XB_XGEN(b.x)], 1u);
            asm volatile("s_waitcnt vmcnt(0)" ::: "memory");
        } else {
            XB_SPIN(xb_ld(&bar[XB_XGEN(b.x)]) == gen, bar);
            __builtin_amdgcn_fence(__ATOMIC_ACQUIRE, "agent");
            asm volatile("s_waitcnt vmcnt(0)" ::: "memory");
        }
    }
    __syncthreads();
}

struct Args { const float* in[28]; float* out; unsigned char* ws; int ph_lo, ph_hi; };
enum { I_X = 0, I_C, I_CTX, I_CCTX, I_MODW, I_MODB, I_NPRE, I_NPOST, I_FG, I_FU, I_FD, I_EVIN, I_EVOUT, I_CONVW, I_CONVB, I_WA, I_BA, I_WX, I_BX, I_LAM, I_DECAY, I_GN,
       I_ODIN, I_ODOUT, I_POOLW, I_POOLS, I_QN, I_KN };
struct Frame {
    LAS unsigned char* lds; int tid, lane, wave, G, bid;
    const Args* a;
};
#define LDS_WAIT() asm volatile("s_waitcnt lgkmcnt(0)" ::: "memory")

DEV void transpose_item(const float* W, int K, int N, bf16* WT, int drow0, LAS float* scr, int kb, int nb, int lane) {
    const int k0 = 64 * kb, n0 = 32 * nb;
#pragma unroll 8
    for (int i = 0; i < 32; ++i) { const int kk = 2 * i + (lane >> 5); scr[kk * 33 + (lane & 31)] = W[(size_t)(k0 + kk) * N + n0 + (lane & 31)]; }
    LDS_WAIT(); asm volatile("" ::: "memory");
    const int c = lane & 7;
#pragma unroll
    for (int j = 0; j < 4; ++j) { const int n = (lane >> 3) + 8 * j; const LAS float* s = scr + (8 * c) * 33 + n;
        u32x4 o; o.x = pkbf(s[0 * 33], s[1 * 33]); o.y = pkbf(s[2 * 33], s[3 * 33]); o.z = pkbf(s[4 * 33], s[5 * 33]); o.w = pkbf(s[6 * 33], s[7 * 33]);
        *(u32x4*)(WT + (size_t)(drow0 + n) * K + k0 + 8 * c) = o; }
    LDS_WAIT(); asm volatile("" ::: "memory");
}
DEV void p0_prologue(const Frame& F) {
    const Args& A = *F.a; unsigned char* ws = A.ws;
    {
        LAS float* ssc = (LAS float*)F.lds;
        LAS float* red = (LAS float*)(F.lds + 40960);
        for (int i = F.tid; i < 5 * DM; i += 512) { const int r = i / DM, k = i % DM; const float v = (r < 4) ? A.in[I_C][r * DM + k] : A.in[I_CCTX][k]; ssc[i] = fsilu(v); }
        __syncthreads();
        float* MOD = (float*)(ws + WS_MOD);
        for (int it = F.bid; it < 288; it += F.G) {
            const int li = it / 144, col0 = (it % 144) * 128;
            const float* Wp = A.in[I_MODW] + (size_t)li * DM * 18432 + (size_t)(F.wave * 256) * 18432 + col0 + 2 * F.lane;
            f32x2 acc[5];
#pragma unroll
            for (int r = 0; r < 5; ++r) acc[r] = (f32x2){0.f, 0.f};
#pragma unroll 8
            for (int kk = 0; kk < 256; ++kk) { const f32x2 wv = *(const f32x2*)(Wp + (size_t)kk * 18432);
#pragma unroll
                for (int r = 0; r < 5; ++r) { const float s = ssc[r * DM + F.wave * 256 + kk]; acc[r] += wv * s; } }
#pragma unroll
            for (int r = 0; r < 5; ++r) { red[(F.wave * 5 + r) * 128 + 2 * F.lane] = acc[r].x; red[(F.wave * 5 + r) * 128 + 2 * F.lane + 1] = acc[r].y; }
            __syncthreads();
            for (int o = F.tid; o < 640; o += 512) { const int r = o >> 7, c = o & 127; float s = A.in[I_MODB][li * 18432 + col0 + c];
#pragma unroll
                for (int w = 0; w < 8; ++w) s += red[(w * 5 + r) * 128 + c];
                MOD[(size_t)(li * 5 + r) * 18432 + col0 + c] = s; }
            __syncthreads();
        }
    }
    {
        LAS float* scr = (LAS float*)(F.lds + F.wave * 16384);
        const int gw = F.bid * 8 + F.wave, NGW = F.G * 8;
        constexpr int I_FFN = 5632, N_FFN = 12 * I_FFN, I_EI = 32 * 192, I_EO = 32 * 64, I_OI = 32 * 96, I_OO = 32 * 64, I_SM = 8 * 36;
        constexpr int NITEMS = N_FFN + I_EI + I_EO + I_OI + I_OO + I_SM;
        for (int it = gw; it < NITEMS; it += NGW) {
            int r = it;
            if (r < N_FFN) { const int idx = r / I_FFN, item = r % I_FFN, lf = idx / 3, kind = idx % 3;
                if (kind < 2) { const float* W = A.in[kind == 0 ? I_FG : I_FU] + (size_t)lf * DM * DFF; const int nb = item % 176, kb = item / 176, n0 = 32 * nb;
                    transpose_item(W, DM, DFF, (bf16*)(ws + WS_WGU + (size_t)lf * 44 * MiB), 256 * (n0 / 128) + 128 * kind + (n0 % 128), scr, kb, nb, F.lane); }
                else { const float* W = A.in[I_FD] + (size_t)lf * DFF * DM; const int nb = item % 64, kb = item / 64;
                    transpose_item(W, DFF, DM, (bf16*)(ws + WS_WD + (size_t)lf * 22 * MiB), 32 * nb, scr, kb, nb, F.lane); }
                continue; }
            r -= N_FFN;
            if (r < I_EI) { const int nb = r % 192, kb = r / 192, n0 = 32 * nb, blk = n0 / 1024;
                const int dblk = (blk == 1) ? 5 : (blk == 5) ? 1 : blk;
                transpose_item(A.in[I_EVIN], DM, EVN, (bf16*)(ws + WS_WEVIN), dblk * 1024 + (n0 % 1024), scr, kb, nb, F.lane); continue; }
            r -= I_EI;
            if (r < I_EO) { const int nb = r % 64, kb = r / 64; transpose_item(A.in[I_EVOUT], DM, DM, (bf16*)(ws + WS_WEVOUT), 32 * nb, scr, kb, nb, F.lane); continue; }
            r -= I_EO;
            if (r < I_OI) { const int nb = r % 96, kb = r / 96; transpose_item(A.in[I_ODIN], DM, ODN, (bf16*)(ws + WS_WODIN), 32 * nb, scr, kb, nb, F.lane); continue; }
            r -= I_OI;
            if (r < I_OO) { const int nb = r % 64, kb = r / 64; transpose_item(A.in[I_ODOUT], DM, DM, (bf16*)(ws + WS_WODOUT), 32 * nb, scr, kb, nb, F.lane); continue; }
            r -= I_OO;
            { const int mat = r / 8, item = r % 8, nb = item % 4, kb = item / 4;
                const float* W; bf16* dst;
                if (mat < 16) { W = A.in[I_WA] + (size_t)mat * 16384; dst = (bf16*)(ws + WS_LRUW) + (size_t)mat * 16384; }
                else if (mat < 32) { W = A.in[I_WX] + (size_t)(mat - 16) * 16384; dst = (bf16*)(ws + WS_LRUW) + (size_t)mat * 16384; }
                else { W = A.in[I_POOLW] + (size_t)(mat - 32) * 16384; dst = (bf16*)(ws + WS_POOLW) + (size_t)(mat - 32) * 16384; }
                transpose_item(W, 128, 128, dst, 32 * nb, scr, kb, nb, F.lane); }
        }
    }
    {
        const int gt = F.bid * 512 + F.tid, NT = F.G * 512;
        float* c1 = (float*)(ws + WS_COS1); float* s1 = (float*)(ws + WS_SIN1); float* c2 = (float*)(ws + WS_COS2); float* s2 = (float*)(ws + WS_SIN2);
        for (int i = gt; i < SEQ * 128 + SEQ * 64; i += NT) {
            float pos, f; float* cd; float* sd;
            if (i < SEQ * 128) { const int t = i >> 7, k = i & 127; pos = (float)t; f = exp2f(-(float)k * (13.287712379549449f / 128.f)); cd = c1 + i; sd = s1 + i; }
            else { const int j = i - SEQ * 128, t = j >> 6, k = j & 63; pos = (k < 32) ? (float)(t >> 6) : (float)(t & 63); f = exp2f(-(float)(k & 31) * (13.287712379549449f / 32.f)); cd = c2 + j; sd = s2 + j; }
            const float ang = pos * f;
            double rev = (double)ang * 0.15915494309189535; rev -= __builtin_rint(rev);
            const float fr = (float)rev;
            *cd = __builtin_amdgcn_cosf(fr); *sd = __builtin_amdgcn_sinf(fr);
        }
    }
}

struct ResCfg { int has_res, has_next, li, sub, li2, sub2, nrows; float wres; const float* xold_l; const float* xold_c; float* xnew_l; float* xnew_c; const float* part; };
DEV void res_rows(const Frame& F, const ResCfg& C, int m0, int cnt, int prow) {
    const Args& A = *F.a; const float* MOD = (const float*)(A.ws + WS_MOD); bf16* H = (bf16*)(A.ws + WS_H);
    f32x4 Ca[8], Cb[8], Cs[8];
    int e0 = 4 * F.lane; asm volatile("" : "+v"(e0));
    if (C.has_res) {
        const float* gate = MOD + (size_t)(C.li * 5 + prow) * 18432 + C.sub * 6144 + 4096; const float* gp = A.in[I_NPOST] + (C.li * 3 + C.sub) * DM;
#pragma unroll
        for (int j = 0; j < 8; ++j) Ca[j] = *(const f32x4*)(gate + 256 * j + e0) * *(const f32x4*)(gp + 256 * j + e0) * C.wres;
    }
    if (C.has_next) {
        const float* sh = MOD + (size_t)(C.li2 * 5 + prow) * 18432 + C.sub2 * 6144; const float* sc = sh + 2048; const float* gp = A.in[I_NPRE] + (C.li2 * 3 + C.sub2) * DM;
#pragma unroll
        for (int j = 0; j < 8; ++j) { Cb[j] = *(const f32x4*)(gp + 256 * j + e0) * (*(const f32x4*)(sc + 256 * j + e0) + 1.f); Cs[j] = *(const f32x4*)(sh + 256 * j + e0); }
    }
    for (int m = m0; m < m0 + cnt; ++m) {
        const float* xo = (m < ML) ? C.xold_l + (size_t)m * DM : C.xold_c + (size_t)(m - ML) * DM;
        f32x4 x[8];
#pragma unroll
        for (int j = 0; j < 8; ++j) x[j] = *(const f32x4*)(xo + 256 * j + e0);
        if (C.has_res) {
            f32x4 yy[8];
            if (C.part && m >= ML) { const float* pr = C.part + (size_t)(m - ML) * DM;
#pragma unroll
                for (int j = 0; j < 8; ++j) yy[j] = (*(const f32x4*)(pr + 256 * j + e0) + *(const f32x4*)(pr + (size_t)MC * DM + 256 * j + e0)) + (*(const f32x4*)(pr + (size_t)2 * MC * DM + 256 * j + e0) + *(const f32x4*)(pr + (size_t)3 * MC * DM + 256 * j + e0)); }
            else { const bf16* yr = H + (size_t)m * DM;
#pragma unroll
                for (int j = 0; j < 8; ++j) { const u32x2 yv = *(const u32x2*)(yr + 256 * j + e0); yy[j] = (f32x4){bflo(yv.x), bfhi(yv.x), bflo(yv.y), bfhi(yv.y)}; } }
            float ss = 0.f;
#pragma unroll
            for (int j = 0; j < 8; ++j) ss += (yy[j].x * yy[j].x + yy[j].y * yy[j].y) + (yy[j].z * yy[j].z + yy[j].w * yy[j].w);
            const float rs = __builtin_amdgcn_rsqf(wave_sum(ss) * (1.f / DM) + EPS);
            float* xn = (m < ML) ? C.xnew_l + (size_t)m * DM : C.xnew_c + (size_t)(m - ML) * DM;
#pragma unroll
            for (int j = 0; j < 8; ++j) { x[j] = x[j] + Ca[j] * (yy[j] * rs); *(f32x4*)(xn + 256 * j + e0) = x[j]; }
        }
        if (C.has_next) {
            float ss = 0.f;
#pragma unroll
            for (int j = 0; j < 8; ++j) ss += (x[j].x * x[j].x + x[j].y * x[j].y) + (x[j].z * x[j].z + x[j].w * x[j].w);
            const float rs = __builtin_amdgcn_rsqf(wave_sum(ss) * (1.f / DM) + EPS);
            bf16* hr = H + (size_t)m * DM;
#pragma unroll
            for (int j = 0; j < 8; ++j) { const f32x4 h = x[j] * rs * Cb[j] + Cs[j]; u32x2 w; w.x = pkbf(h.x, h.y); w.y = pkbf(h.z, h.w); *(u32x2*)(hr + 256 * j + e0) = w; }
        }
    }
}
DEV void res_phase(const Frame& F, const ResCfg& C) {
    const int gw = F.bid * 8 + F.wave, NGW = F.G * 8;
    for (int blk = gw; blk < ML / 16; blk += NGW) res_rows(F, C, blk * 16, 16, (blk * 16) / SEQ);
    if (C.nrows > ML) {
        if (NGW >= 2 * MC) { if ((gw & 1) == 0 && (gw >> 1) < MC) res_rows(F, C, ML + (gw >> 1), 1, 4); }
        else { const int per = (MC + NGW - 1) / NGW, r0 = gw * per, cnt = (MC - r0) < per ? (MC - r0) : per; if (cnt > 0) res_rows(F, C, ML + r0, cnt, 4); }
    }
}

constexpr int LRU_UB = 0, LRU_UB_LD = 272, LRU_ARR = 17408, LRU_ARR_SZ = 32768;
DEV int lru_chunk_row0(int b, int ck) { return (ck < 4) ? ML + b * CTXL + 64 * ck : b * SEQ + 64 * (ck - 4); }
DEV float one_minus_exp(float t) {
    const float ser = -t * (1.f + t * 0.5f * (1.f + t * (1.f / 3.f) * (1.f + t * 0.25f * (1.f + t * 0.2f * (1.f + t * (1.f / 6.f))))));
    return (t > -0.25f) ? ser : 1.f - fexp(t);
}
template <bool FINAL> DEV void lru_phase(const Frame& F, bool dry = false) {
    const Args& A = *F.a; unsigned char* ws = A.ws; bf16* E = (bf16*)(ws + WS_E);
    const int tid = F.tid, wave = F.wave, lane = F.lane, r32 = lane & 31, hh = lane >> 5;
    LAS unsigned char* UB = F.lds + LRU_UB; LAS float* ARR = (LAS float*)(F.lds + LRU_ARR); LAS unsigned char* RS = F.lds + LRU_ARR;
    const int slot = F.bid & 31, n = slot & 7, b = slot >> 3, ck0 = F.bid >> 5, ckst = (F.G + 31) >> 5;
    if (F.bid >= 32 * ckst) return;
    u32x4 rp[3];
#define LRU_LOAD(ck_) do { const int L_ = ((ck_) < 4) ? CTXL : SEQ, p0_ = ((ck_) < 4) ? 64 * (ck_) : 64 * ((ck_) - 4), rb_ = ((ck_) < 4) ? ML + b * CTXL : b * SEQ; \
        _Pragma("unroll") for (int i_ = 0; i_ < 3; ++i_) { const int pc = tid + 512 * i_, rr = pc >> 4, c8 = pc & 15, pos = p0_ - 2 + rr; \
            rp[i_] = (u32x4){0u, 0u, 0u, 0u}; if (pc < 67 * 16 && pos >= 0 && pos < L_) rp[i_] = *(const u32x4*)(E + (size_t)(rb_ + pos) * EVN + EC_R + 128 * n + 8 * c8); } } while (0)
    if (ck0 < NCH64) LRU_LOAD(ck0);
    const int c8t = tid & 15, cht = 128 * n + 8 * c8t;
    float cw[4][8], cb[8];
#pragma unroll
    for (int i = 0; i < 8; ++i) cb[i] = A.in[I_CONVB][cht + i];
#pragma unroll
    for (int k = 0; k < 4; ++k)
#pragma unroll
        for (int i = 0; i < 8; ++i) cw[k][i] = A.in[I_CONVW][k * 1024 + cht + i];
    const int gd = wave >> 2, cq = wave & 3, gcol = 32 * cq + r32, gchn = 128 * n + gcol;
    bf16x8 fa[8], fx[8];
    { const bf16* WA = (const bf16*)(ws + WS_LRUW) + (size_t)(gd * 8 + n) * 16384 + (size_t)gcol * 128 + 8 * hh; const bf16* WX = WA + (size_t)16 * 16384;
#pragma unroll
      for (int ks = 0; ks < 8; ++ks) { fa[ks] = *(const bf16x8*)(WA + 16 * ks); fx[ks] = *(const bf16x8*)(WX + 16 * ks); } }
    const float gba = A.in[I_BA][gd * 1024 + gchn], gbx = A.in[I_BX][gd * 1024 + gchn], sp8 = -8.f * log1pf(expf(-A.in[I_LAM][gd * 1024 + gchn]));
    for (int ck = ck0; ck < NCH64; ck += ckst) {
        const int p0 = (ck < 4) ? 64 * ck : 64 * (ck - 4), rowbase = (ck < 4) ? ML + b * CTXL : b * SEQ;
        const int sd = (tid >> 7) & 1, sc = tid & 127; const size_t gi = ((size_t)(ck * NB + b) * 2 + sd) * 1024 + 128 * n + sc;
        float hcar = 0.f; if (FINAL && tid < 256) hcar = ((const float*)(ws + WS_CAR))[gi];
        u32x4 gv[2];
        if (FINAL) {
#pragma unroll
            for (int i = 0; i < 2; ++i) { const int pc = tid + 512 * i, tt = pc >> 4; gv[i] = *(const u32x4*)(E + (size_t)(rowbase + p0 + tt) * EVN + EC_G + 128 * n + 8 * c8t); } }
#pragma unroll
        for (int i = 0; i < 3; ++i) { const int pc = tid + 512 * i, rr = pc >> 4, c8 = pc & 15; if (pc < 67 * 16) *(LAS u32x4*)(RS + rr * 256 + c8 * 16) = rp[i]; }
        __syncthreads();
#pragma unroll
        for (int i2 = 0; i2 < 2; ++i2) { const int pc = tid + 512 * i2, tt = pc >> 4;
            float u[8];
#pragma unroll
            for (int i = 0; i < 8; ++i) u[i] = cb[i];
#pragma unroll
            for (int k = 0; k < 4; ++k) { const u32x4 rv = *(const LAS u32x4*)(RS + (tt + k) * 256 + c8t * 16);
                u[0] += cw[k][0] * bflo(rv.x); u[1] += cw[k][1] * bfhi(rv.x); u[2] += cw[k][2] * bflo(rv.y); u[3] += cw[k][3] * bfhi(rv.y);
                u[4] += cw[k][4] * bflo(rv.z); u[5] += cw[k][5] * bfhi(rv.z); u[6] += cw[k][6] * bflo(rv.w); u[7] += cw[k][7] * bfhi(rv.w); }
            u32x4 o = {pkbf(u[0], u[1]), pkbf(u[2], u[3]), pkbf(u[4], u[5]), pkbf(u[6], u[7])};
            *(LAS u32x4*)(UB + tt * LRU_UB_LD + c8t * 16) = o; }
        __syncthreads();
        if (ck + ckst < NCH64) LRU_LOAD(ck + ckst);
        {
            f32x16 aa[2] = {f32x16{}, f32x16{}}, ax[2] = {f32x16{}, f32x16{}};
#pragma unroll
            for (int ks = 0; ks < 8; ++ks) {
#pragma unroll
                for (int rt = 0; rt < 2; ++rt) { const bf16x8 af = *(const LAS bf16x8*)(UB + (32 * rt + r32) * LRU_UB_LD + (16 * ks + 8 * hh) * 2);
                    aa[rt] = __builtin_amdgcn_mfma_f32_32x32x16_bf16(af, fa[ks], aa[rt], 0, 0, 0); ax[rt] = __builtin_amdgcn_mfma_f32_32x32x16_bf16(af, fx[ks], ax[rt], 0, 0, 0); }
            }
            LAS float* AO = ARR + (size_t)(gd * 2) * (LRU_ARR_SZ / 4); LAS float* BO = AO + LRU_ARR_SZ / 4;
#pragma unroll
            for (int rt = 0; rt < 2; ++rt)
#pragma unroll
                for (int r = 0; r < 16; ++r) { const int row = 32 * rt + crow(r, hh);
                    const float la = sp8 * fsigmoid(aa[rt][r] + gba), av = fexp(la), mlt = __builtin_amdgcn_sqrtf(one_minus_exp(2.f * la));
                    const float uv = bf2f(*(const LAS bf16*)(UB + row * LRU_UB_LD + gcol * 2));
                    AO[row * 128 + gcol] = av; BO[row * 128 + gcol] = mlt * fsigmoid(ax[rt][r] + gbx) * uv; }
        }
        __syncthreads();
        if (tid < 256) { LAS float* AO = ARR + (size_t)(sd * 2) * (LRU_ARR_SZ / 4); const LAS float* BO = AO + LRU_ARR_SZ / 4;
            if (!FINAL) { float h = 0.f, P = 1.f;
#pragma unroll 8
                for (int s = 0; s < 64; ++s) { const int tt = sd ? 63 - s : s; const float a = AO[tt * 128 + sc]; h = a * h + BO[tt * 128 + sc]; P *= a; }
                ((f32x2*)(ws + WS_AGG))[gi] = (f32x2){P, h}; }
            else { float h = hcar;
#pragma unroll 8
                for (int s = 0; s < 64; ++s) { const int tt = sd ? 63 - s : s; h = AO[tt * 128 + sc] * h + BO[tt * 128 + sc]; AO[tt * 128 + sc] = h; } }
        }
        __syncthreads();
        if (FINAL) {
            const LAS float* H0 = ARR; const LAS float* H1 = ARR + 2 * (LRU_ARR_SZ / 4);
#pragma unroll
            for (int i2 = 0; i2 < 2; ++i2) { const int pc = tid + 512 * i2, tt = pc >> 4;
                const f32x4 h0a = *(const LAS f32x4*)(H0 + tt * 128 + 8 * c8t), h0b = *(const LAS f32x4*)(H0 + tt * 128 + 8 * c8t + 4), h1a = *(const LAS f32x4*)(H1 + tt * 128 + 8 * c8t), h1b = *(const LAS f32x4*)(H1 + tt * 128 + 8 * c8t + 4);
                const f32x4 sa = h0a + h1a, sb = h0b + h1b; const u32x4 g4 = gv[i2];
                u32x4 w = {pkbf(fgelu_tanh(bflo(g4.x)) * sa.x, fgelu_tanh(bfhi(g4.x)) * sa.y), pkbf(fgelu_tanh(bflo(g4.y)) * sa.z, fgelu_tanh(bfhi(g4.y)) * sa.w),
                           pkbf(fgelu_tanh(bflo(g4.z)) * sb.x, fgelu_tanh(bfhi(g4.z)) * sb.y), pkbf(fgelu_tanh(bflo(g4.w)) * sb.z, fgelu_tanh(bfhi(g4.w)) * sb.w)};
                bf16* wp = dry ? (bf16*)(ws + WS_H) + (size_t)(rowbase + p0 + tt) * DM + 128 * n + 8 * c8t : E + (size_t)(rowbase + p0 + tt) * EVN + EC_G + 128 * n + 8 * c8t; *(u32x4*)wp = w; }
            __syncthreads();
        }
    }
#undef LRU_LOAD
}
DEV void lru_carry_phase(const Frame& F) {
    unsigned char* ws = F.a->ws; const f32x2* AGG = (const f32x2*)(ws + WS_AGG); float* CAR = (float*)(ws + WS_CAR);
    const int gw = F.bid * 8 + F.wave, NGW = F.G * 8;
    for (int it = gw; it < NB * 2 * 16; it += NGW) { const int cg = it & 15, d = (it >> 4) & 1, b = it >> 5;
        float h = 0.f;
#pragma unroll 12
        for (int idx = 0; idx < NCH64; ++idx) { const int ck = d ? (idx < 4 ? 3 - idx : NCH64 + 3 - idx) : idx;
            const size_t gi = ((size_t)(ck * NB + b) * 2 + d) * 1024 + 64 * cg + F.lane; const f32x2 v = AGG[gi]; CAR[gi] = h; h = v.x * h + v.y; }
    }
}

DEV int ret_chunk_row0(int b, int cid) { return (cid < 2) ? ML + b * CTXL + 128 * cid : b * SEQ + 128 * (cid - 2); }
DEV int ret_chain(int d, int idx) { return d ? (idx < 2 ? 1 - idx : NCH128 + 1 - idx) : idx; }
DEV float ret_logg(const Args& A, int d, int h) { const float lg = A.in[I_DECAY][d * 4 + h]; return -log1pf(expf(-lg)); }
constexpr int RET_LD = 528, RET_VLD = 80;
DEV void ret_state_phase(const Frame& F) {
    const Args& A = *F.a; unsigned char* ws = A.ws; const bf16* E = (const bf16*)(ws + WS_E); bf16* SB = (bf16*)(ws + WS_SBUF);
    const int tid = F.tid, lane = F.lane, wave = F.wave, r32 = lane & 31, hh = lane >> 5;
    LAS unsigned char* KS = F.lds; LAS unsigned char* VS = F.lds + 128 * RET_LD;
    for (int it = F.bid; it < 256; it += F.G) {
        const int es = it & 7, d = (it >> 3) & 1, h = (it >> 4) & 3, b = it >> 6;
        const float lg = ret_logg(A, d, h), sdec = expf(lg * 128.f);
        const int vrow = tid >> 2, vc4 = tid & 3; const float vw = expf(lg * (float)(d ? vrow : 127 - vrow));
        u32x4 kreg[8], vreg;
        f32x16 acc = f32x16{};
#define RS_LOAD(cid_) do { const int m0_ = ret_chunk_row0(b, cid_); \
            _Pragma("unroll") for (int i = 0; i < 8; ++i) { const int id = tid + 512 * i, row = id >> 5, c16 = id & 31; kreg[i] = *(const u32x4*)(E + (size_t)(m0_ + row) * EVN + EC_K + 256 * h + 8 * c16); } \
            vreg = *(const u32x4*)(E + (size_t)(m0_ + vrow) * EVN + EC_V + 256 * h + 32 * es + 8 * vc4); } while (0)
        RS_LOAD(ret_chain(d, 0));
        for (int idx = 0; idx < NCH128; ++idx) {
            const int cid = ret_chain(d, idx);
#pragma unroll
            for (int i = 0; i < 8; ++i) { const int id = tid + 512 * i, row = id >> 5, c16 = id & 31; *(LAS u32x4*)(KS + row * RET_LD + c16 * 16) = kreg[i]; }
            { u32x4 w; w.x = pkbf(bflo(vreg.x) * vw, bfhi(vreg.x) * vw); w.y = pkbf(bflo(vreg.y) * vw, bfhi(vreg.y) * vw); w.z = pkbf(bflo(vreg.z) * vw, bfhi(vreg.z) * vw); w.w = pkbf(bflo(vreg.w) * vw, bfhi(vreg.w) * vw);
              *(LAS u32x4*)(VS + vrow * RET_VLD + vc4 * 16) = w; }
            __syncthreads();
            if (idx + 1 < NCH128) RS_LOAD(ret_chain(d, idx + 1));
            { bf16* sp = SB + ((size_t)(((b * 4 + h) * 2 + d) * NCH128 + cid) * 256 + 32 * es + r32) * 256 + 32 * wave + 4 * hh;
#pragma unroll
              for (int g = 0; g < 4; ++g) { u32x2 w; w.x = pkbf(acc[4 * g], acc[4 * g + 1]); w.y = pkbf(acc[4 * g + 2], acc[4 * g + 3]); *(u32x2*)(sp + 8 * g) = w; } }
#pragma unroll
            for (int r = 0; r < 16; ++r) acc[r] *= sdec;
#pragma unroll
            for (int ks = 0; ks < 8; ++ks) { const bf16x8 af = tr_frag(KS, RET_LD, 16 * ks, 32 * wave, lane); const bf16x8 bfr = tr_frag(VS, RET_VLD, 16 * ks, 0, lane);
                acc = __builtin_amdgcn_mfma_f32_32x32x16_bf16(af, bfr, acc, 0, 0, 0); }
            __syncthreads();
        }
#undef RS_LOAD
    }
}
DEV void ret_out_phase(const Frame& F, bool dry = false) {
    const Args& A = *F.a; unsigned char* ws = A.ws; bf16* E = (bf16*)(ws + WS_E); const bf16* SB = (const bf16*)(ws + WS_SBUF);
    const int wave = F.wave, ib = wave & 3, eh = wave >> 2;
    LAS unsigned char* RA = F.lds; LAS unsigned char* RB = F.lds + 128 * RET_LD; LAS float* GX = (LAS float*)(F.lds + 2 * 128 * RET_LD);
    constexpr int PLD = 272;
    for (int it = F.bid; it < 16 * NCH128; it += F.G) {
        int tid = F.tid; asm volatile("" : "+v"(tid)); int lane = tid & 63;
        const int r32 = lane & 31, hh = lane >> 5;
        const int cid = it % NCH128, bh = it / NCH128, h = bh & 3, b = bh >> 2, m0 = ret_chunk_row0(b, cid);
        const float lg0 = ret_logg(A, 0, h), lg1 = ret_logg(A, 1, h);
        bf16x8 qf[16];
        { const bf16* qp = E + (size_t)(m0 + 32 * ib + r32) * EVN + EC_Q + 256 * h + 8 * hh;
#pragma unroll
          for (int ks = 0; ks < 16; ++ks) qf[ks] = *(const bf16x8*)(qp + 16 * ks); }
        f32x16 o[4];
#pragma unroll
        for (int et = 0; et < 4; ++et) o[et] = f32x16{};
#pragma unroll 1
        for (int d = 0; d < 2; ++d) {
            const bf16* sp = SB + (size_t)((bh * 2 + d) * NCH128 + cid) * 65536; const float lgd = d ? lg1 : lg0;
            __syncthreads();
#pragma unroll
            for (int i = 0; i < 16; ++i) { const int id = tid + 512 * i, row = id >> 5, c16 = id & 31; *(LAS u32x4*)(RA + row * RET_LD + c16 * 16) = *(const u32x4*)(sp + (size_t)row * 256 + 8 * c16);
                if ((i & 3) == 3) asm volatile("" ::: "memory"); }
            __syncthreads();
#pragma unroll
            for (int et = 0; et < 4; ++et) { f32x16 T = f32x16{};
                const LAS unsigned char* bp = RA + (128 * eh + 32 * et + r32) * RET_LD + 16 * hh;
#pragma unroll
                for (int ks = 0; ks < 16; ++ks) { const bf16x8 bfr = *(const LAS bf16x8*)(bp + 32 * ks); T = __builtin_amdgcn_mfma_f32_32x32x16_bf16(qf[ks], bfr, T, 0, 0, 0); }
#pragma unroll
                for (int r = 0; r < 16; ++r) { const int i = 32 * ib + crow(r, hh); const float rs = fexp(lgd * (float)(d ? 128 - i : i + 1)); o[et][r] += T[r] * rs; } }
        }
        __syncthreads();
        int tid2 = tid; asm volatile("" : "+v"(tid2));
#pragma unroll
        for (int i = 0; i < 8; ++i) { const int id = tid2 + 512 * i, row = id >> 5, c16 = id & 31;
            *(LAS u32x4*)(RA + row * RET_LD + c16 * 16) = *(const u32x4*)(E + (size_t)(m0 + row) * EVN + EC_K + 256 * h + 8 * c16);
            *(LAS u32x4*)(RB + row * RET_LD + c16 * 16) = *(const u32x4*)(E + (size_t)(m0 + row) * EVN + EC_V + 256 * h + 8 * c16);
            if (i & 1) asm volatile("" ::: "memory"); }
        __syncthreads();
        u32x2 pw[2][4];
        { const int i = 32 * ib + r32;
#pragma unroll
          for (int jj = 0; jj < 2; ++jj) { const int jt = 2 * eh + jj;
            f32x16 X = f32x16{};
#pragma unroll
            for (int ks = 0; ks < 16; ++ks) { const bf16x8 af = *(const LAS bf16x8*)(RA + (32 * jt + r32) * RET_LD + (16 * ks + 8 * hh) * 2); X = __builtin_amdgcn_mfma_f32_32x32x16_bf16(af, qf[ks], X, 0, 0, 0); }
#pragma unroll
            for (int g = 0; g < 4; ++g) { float pv[4];
#pragma unroll
                for (int q = 0; q < 4; ++q) { const int j = 32 * jt + 8 * g + 4 * hh + q; const int dl = i - j; const float f = (dl > 0) ? fexp(lg0 * (float)dl) : (dl < 0) ? fexp(-lg1 * (float)dl) : 2.f; pv[q] = X[4 * g + q] * f; }
                pw[jj][g].x = pkbf(pv[0], pv[1]); pw[jj][g].y = pkbf(pv[2], pv[3]); } } }
        __syncthreads();
        { const int i = 32 * ib + r32;
#pragma unroll
          for (int jj = 0; jj < 2; ++jj)
#pragma unroll
            for (int g = 0; g < 4; ++g) *(LAS u32x2*)(RA + i * PLD + (32 * (2 * eh + jj) + 8 * g + 4 * hh) * 2) = pw[jj][g]; }
        __syncthreads();
#pragma unroll
        for (int ks = 0; ks < 8; ++ks) { const bf16x8 pa = *(const LAS bf16x8*)(RA + (32 * ib + r32) * PLD + (16 * ks + 8 * hh) * 2);
#pragma unroll
            for (int et = 0; et < 4; ++et) { const bf16x8 bfr = tr_frag(RB, RET_LD, 16 * ks, 128 * eh + 32 * et, lane); o[et] = __builtin_amdgcn_mfma_f32_32x32x16_bf16(pa, bfr, o[et], 0, 0, 0); } }
#pragma unroll
        for (int r = 0; r < 16; ++r) { float a = 0.f, q = 0.f;
#pragma unroll
            for (int et = 0; et < 4; ++et) { a += o[et][r]; q += o[et][r] * o[et][r]; }
#pragma unroll
            for (int off = 1; off < 32; off <<= 1) { a += __shfl_xor(a, off); q += __shfl_xor(q, off); }
            if (r32 == 0) { GX[(wave * 32 + crow(r, hh)) * 2] = a; GX[(wave * 32 + crow(r, hh)) * 2 + 1] = q; } }
        __syncthreads();
        { const float* gn = A.in[I_GN] + 256 * h + 128 * eh;
#pragma unroll
          for (int r = 0; r < 16; ++r) { const int rw = crow(r, hh); const float a = GX[(wave * 32 + rw) * 2] + GX[((wave ^ 4) * 32 + rw) * 2], q = GX[(wave * 32 + rw) * 2 + 1] + GX[((wave ^ 4) * 32 + rw) * 2 + 1];
            const float mean = a * (1.f / 256.f), var = q * (1.f / 256.f) - mean * mean, rstd = __builtin_amdgcn_rsqf(var + EPS);
            bf16* op = E + (size_t)(m0 + 32 * ib + rw) * EVN + EC_O + 256 * h + 128 * eh + r32;
#pragma unroll
            for (int et = 0; et < 4; ++et) { const float og = bf2f(op[32 * et]); bf16* wp = dry ? (bf16*)(ws + WS_H) + (size_t)(m0 + 32 * ib + rw) * DM + 1024 + 256 * h + 128 * eh + r32 : op;
                wp[32 * et] = f2bf((o[et][r] - mean) * rstd * gn[32 * et + r32] * fsilu(og)); } } }
    }
    __syncthreads();
}
DEV void odd_post_phase(const Frame& F) {
    const Args& A = *F.a; unsigned char* ws = A.ws; const bf16* E2 = (const bf16*)(ws + WS_E2);
    bf16* QB = (bf16*)(ws + WS_QB); bf16* KB = (bf16*)(ws + WS_KB); bf16* VB = (bf16*)(ws + WS_VB); bf16* MIX = (bf16*)(ws + WS_MIX2);
    const float* c2 = (const float*)(ws + WS_COS2); const float* s2 = (const float*)(ws + WS_SIN2);
    const int tid = F.tid, wave = F.wave;
    {
        const int gw = F.bid * 8 + F.wave, NGW = F.G * 8; const int lane0 = F.lane;
        const float qg1 = A.in[I_QN][lane0], qg2 = A.in[I_QN][64 + lane0], kg1 = A.in[I_KN][lane0], kg2 = A.in[I_KN][64 + lane0];
        for (int m = gw; m < MT; m += NGW) {
            int lane = F.lane; asm volatile("" : "+v"(lane));
            const bool lat = m < ML; const int b = lat ? m / SEQ : (m - ML) / CTXL, t = lat ? m % SEQ : 0, kpos = lat ? CTXL + t : (m - ML) % CTXL;
            const bf16* er = E2 + (size_t)m * ODN;
            float cs = 1.f, sn = 0.f; if (lat) { cs = c2[t * 64 + lane]; sn = s2[t * 64 + lane]; }
            if (lat) {
#pragma unroll 4
                for (int hq = 0; hq < 12; ++hq) { const float x1 = bf2f(er[512 + 128 * hq + lane]), x2 = bf2f(er[512 + 128 * hq + 64 + lane]);
                    const float rs = __builtin_amdgcn_rsqf(wave_sum(x1 * x1 + x2 * x2) * (1.f / 128.f) + EPS); const float y1 = x1 * rs * qg1, y2 = x2 * rs * qg2;
                    bf16* qo = QB + (size_t)m * 1536 + 128 * hq; qo[lane] = f2bf(y1 * cs - y2 * sn); qo[64 + lane] = f2bf(y1 * sn + y2 * cs); }
            }
            bf16* ko = KB + ((size_t)b * KVL + kpos) * 512; bf16* vo = VB + ((size_t)b * KVL + kpos) * 512;
#pragma unroll
            for (int hk = 0; hk < 4; ++hk) { const float x1 = bf2f(er[2048 + 128 * hk + lane]), x2 = bf2f(er[2048 + 128 * hk + 64 + lane]);
                const float rs = __builtin_amdgcn_rsqf(wave_sum(x1 * x1 + x2 * x2) * (1.f / 128.f) + EPS); const float y1 = x1 * rs * kg1, y2 = x2 * rs * kg2;
                ko[128 * hk + lane] = f2bf(y1 * cs - y2 * sn); ko[128 * hk + 64 + lane] = f2bf(y1 * sn + y2 * cs); }
            *(u32x4*)(vo + 8 * lane) = *(const u32x4*)(er + 2560 + 8 * lane);
        }
    }
    {
        const int lane = F.lane, r32 = lane & 31, hh = lane >> 5;
        LAS unsigned char* XS = F.lds; LAS unsigned char* DS = F.lds + 144 * 256; constexpr int DLD = 272;
        for (int it = F.bid; it < (ML / 128) * 4; it += F.G) {
            const int gi = it & 3, rt = it >> 2, b = (rt * 128) / SEQ, t0 = (rt * 128) % SEQ, half = 1 << gi;
            __syncthreads();
            for (int pc = tid; pc < 144 * 16; pc += 512) { const int rr = pc >> 4, c8 = pc & 15, pos = t0 - 8 + rr;
                u32x4 v = {0u, 0u, 0u, 0u}; if (pos >= 0 && pos < SEQ) v = *(const u32x4*)(E2 + (size_t)(b * SEQ + pos) * ODN + 128 * gi + 8 * c8);
                *(LAS u32x4*)(XS + rr * 256 + c8 * 16) = v; }
            __syncthreads();
            for (int pc = tid; pc < 128 * 16; pc += 512) { const int tt = pc >> 4, c8 = pc & 15, t = t0 + tt;
                const int lo = (t - half) < 0 ? 0 : t - half, hi = (t + half) > SEQ ? SEQ : t + half; const float inv = 1.f / (float)(hi - lo);
                float s[8] = {0.f, 0.f, 0.f, 0.f, 0.f, 0.f, 0.f, 0.f};
                for (int p = lo; p < hi; ++p) { const u32x4 v = *(const LAS u32x4*)(XS + (p - t0 + 8) * 256 + c8 * 16);
                    s[0] += bflo(v.x); s[1] += bfhi(v.x); s[2] += bflo(v.y); s[3] += bfhi(v.y); s[4] += bflo(v.z); s[5] += bfhi(v.z); s[6] += bflo(v.w); s[7] += bfhi(v.w); }
                const u32x4 xv = *(const LAS u32x4*)(XS + (tt + 8) * 256 + c8 * 16);
                u32x4 o; o.x = pkbf(s[0] * inv - bflo(xv.x), s[1] * inv - bfhi(xv.x)); o.y = pkbf(s[2] * inv - bflo(xv.y), s[3] * inv - bfhi(xv.y));
                o.z = pkbf(s[4] * inv - bflo(xv.z), s[5] * inv - bfhi(xv.z)); o.w = pkbf(s[6] * inv - bflo(xv.w), s[7] * inv - bfhi(xv.w));
                *(LAS u32x4*)(DS + tt * DLD + c8 * 16) = o; }
            __syncthreads();
            { const int rb = wave & 3, chh = wave >> 2; const bf16* WT = (const bf16*)(ws + WS_POOLW) + (size_t)gi * 16384;
              f32x16 acc[2] = {f32x16{}, f32x16{}};
#pragma unroll
              for (int ks = 0; ks < 8; ++ks) { const bf16x8 af = *(const LAS bf16x8*)(DS + (32 * rb + r32) * DLD + (16 * ks + 8 * hh) * 2);
#pragma unroll
                  for (int ct = 0; ct < 2; ++ct) { const bf16x8 bfr = *(const bf16x8*)(WT + (size_t)(64 * chh + 32 * ct + r32) * 128 + 16 * ks + 8 * hh);
                      acc[ct] = __builtin_amdgcn_mfma_f32_32x32x16_bf16(af, bfr, acc[ct], 0, 0, 0); } }
#pragma unroll
              for (int ct = 0; ct < 2; ++ct) { const int col = 128 * gi + 64 * chh + 32 * ct + r32; const float ps = A.in[I_POOLS][col];
#pragma unroll
                  for (int r = 0; r < 16; ++r) MIX[(size_t)(b * SEQ + t0 + 32 * rb + crow(r, hh)) * DM + col] = f2bf(acc[ct][r] * ps); } }
        }
        __syncthreads();
    }
}
DEV void attn_phase(const Frame& F) {
    unsigned char* ws = F.a->ws; const bf16* QB = (const bf16*)(ws + WS_QB); const bf16* KB = (const bf16*)(ws + WS_KB); const bf16* VB = (const bf16*)(ws + WS_VB); bf16* MIX = (bf16*)(ws + WS_MIX2);
    for (int u = F.bid; u < NB * 12 * (SEQ / 256); u += F.G) {
        const int qb = u & 31, g = (u >> 5) % 3, kvh = ((u >> 5) / 3) & 3, b = (u >> 5) / 12, hq = kvh * 3 + g;
        att::attn_dense_body<1536, 512, DM>(QB + (size_t)(b * SEQ + 256 * qb) * 1536 + 128 * hq, KB + (size_t)b * KVL * 512 + 128 * kvh, VB + (size_t)b * KVL * 512 + 128 * kvh,
                                           MIX + (size_t)(b * SEQ + 256 * qb) * DM + 512 + 128 * hq, KVL, (char*)F.lds);
    }
}

constexpr int NPH = 25;
__global__ void __launch_bounds__(512, 2) mk_fwd(Args args) {
    extern __shared__ __attribute__((aligned(16))) unsigned char lds_raw[];
    Frame F; F.lds = (LAS unsigned char*)lds_raw; F.tid = threadIdx.x; F.lane = F.tid & 63; F.wave = __builtin_amdgcn_readfirstlane(F.tid >> 6); F.G = gridDim.x; F.bid = blockIdx.x; F.a = &args;
    unsigned char* ws = args.ws;
    volatile LAS unsigned* MISC = (volatile LAS unsigned*)(F.lds + MISC_OFF);
    if (F.tid < 64) MISC[F.tid] = 0u;
    __syncthreads();
    XcdBarrier bar; bar.bar = (unsigned*)(ws + WS_CTL) + CW_BAR; bar.x = 0; bar.st = nullptr;
    const int lo = args.ph_lo, hi = args.ph_hi;
    if (hi - lo > 1) bar = xcd_barrier_post((unsigned*)(ws + WS_CTL) + CW_BAR, MISC + 8);
#ifndef MK_MASK
#define MK_MASK 0xFFFFFFFFu
#endif
#define IN(k) (((MK_MASK >> (k)) & 1u) && lo <= (k) && (k) < hi && (k) <= MK_STOP_AFTER)
#define SEAM(k) do { if (IN(k) && (k) + 1 < hi) xcd_barrier(bar); } while (0)
#ifndef MK_DOUBLE
#define MK_DOUBLE 0u
#endif
#ifndef MK_STAMP
#define MK_STAMP (-1)
#endif
#define PHASE(k) do { if ((k) == MK_STAMP) t_stamp0 = wall_clock64(); if (IN(k)) { PH_BODY_##k; if ((MK_DOUBLE >> (k)) & 1u) { xcd_barrier(bar); PH_BODY_##k; } } SEAM(k); if ((k) == MK_STAMP) t_stamp1 = wall_clock64(); } while (0)
    bf16* H = (bf16*)(ws + WS_H); bf16* ACT = (bf16*)(ws + WS_ACT); bf16* E = (bf16*)(ws + WS_E); bf16* E2 = (bf16*)(ws + WS_E2); bf16* MIX2 = (bf16*)(ws + WS_MIX2);
    float* XC = (float*)(ws + WS_XC); float* PART = (float*)(ws + WS_PART);
#define GEMM_GU(lf, M_) do { pg8::Gemm g{H, (const bf16*)(ws + WS_WGU + (size_t)(lf) * 44 * MiB), (M_), 2 * DFF, DM, DM}; pg8::StaticOrder S; S.init((M_), 2 * DFF, F.G, F.bid); \
        pg8::EpiSwiGLU Ep{ACT, DFF}; pg8::gemm_phase<pg8::EpiSwiGLU, pg8::StaticOrder, PG8_ALIGN, PG8_SP2>(F.lds, g, S, Ep); } while (0)
#define GEMM_DN(lf, M_) do { pg8::Gemm g{ACT, (const bf16*)(ws + WS_WD + (size_t)(lf) * 22 * MiB), (M_), DM, DFF, DFF}; pg8::TailSplitOrder S; S.init(ML, (M_) - ML, DM, F.G, F.bid, 4); \
        pg8::EpiPlainSplit Ep{H, DM, PART, ML, MC}; pg8::gemm_phase<pg8::EpiPlainSplit, pg8::TailSplitOrder, PG8_ALIGN, PG8_SP2>(F.lds, g, S, Ep); } while (0)
#define RES(hr, hn, li_, sub_, li2_, sub2_, nrows_, w_, xol, xoc, part_) do { ResCfg C{(hr), (hn), (li_), (sub_), (li2_), (sub2_), (nrows_), (w_), (xol), (xoc), args.out, XC, (part_)}; res_phase(F, C); } while (0)

    unsigned long long t_stamp0 = 0, t_stamp1 = 0;
#define PH_BODY_0 p0_prologue(F)
    PHASE(0);
#define PH_BODY_1 RES(0, 1, 0, 0, 0, 0, MT, 0.f, args.in[I_X], args.in[I_CTX], nullptr);
    PHASE(1);
#define PH_BODY_2 GEMM_GU(0, MT)
    PHASE(2);
#define PH_BODY_3 GEMM_DN(0, MT)
    PHASE(3);
#define PH_BODY_4 RES(1, 1, 0, 0, 0, 1, MT, 0.5f, args.in[I_X], args.in[I_CTX], PART)
    PHASE(4);
#define PH_BODY_5 { pg8::Gemm g{H, (const bf16*)(ws + WS_WEVIN), MT, EVN, DM, DM}; pg8::StaticOrder S; S.init(MT, EVN, F.G, F.bid); \
        pg8::EpiEvIn Ep{E, (const float*)(ws + WS_COS1), (const float*)(ws + WS_SIN1)}; pg8::gemm_phase<pg8::EpiEvIn, pg8::StaticOrder, PG8_ALIGN, PG8_SP2>(F.lds, g, S, Ep); }
    PHASE(5);
#define PH_BODY_6 lru_phase<false>(F)
    PHASE(6);
#define PH_BODY_7 { lru_carry_phase(F); ret_state_phase(F); }
    PHASE(7);
#ifndef MK_P8
#define MK_P8 3
#endif
#ifndef MK_DRY8
#define MK_DRY8 0
#endif
#define PH_BODY_8 { if (MK_DRY8 & 1) { lru_phase<true>(F, true); xcd_barrier(bar); } if (MK_DRY8 & 2) { ret_out_phase(F, true); xcd_barrier(bar); } if (MK_P8 & 1) lru_phase<true>(F); if (MK_P8 & 2) ret_out_phase(F); }
    PHASE(8);
#define PH_BODY_9 { pg8::Gemm g{E, (const bf16*)(ws + WS_WEVOUT), MT, DM, DM, EVN}; pg8::TailSplitOrder S; S.init(ML, MC, DM, F.G, F.bid, 4); \
        pg8::EpiPlainSplit Ep{H, DM, PART, ML, MC}; pg8::gemm_phase<pg8::EpiPlainSplit, pg8::TailSplitOrder, PG8_ALIGN, PG8_SP2>(F.lds, g, S, Ep); }
    PHASE(9);
#define PH_BODY_10 RES(1, 1, 0, 1, 0, 2, MT, 1.0f, args.out, XC, PART)
    PHASE(10);
#define PH_BODY_11 GEMM_GU(1, MT)
    PHASE(11);
#define PH_BODY_12 GEMM_DN(1, MT)
    PHASE(12);
#define PH_BODY_13 RES(1, 1, 0, 2, 1, 0, MT, 0.5f, args.out, XC, PART)
    PHASE(13);
#define PH_BODY_14 GEMM_GU(2, MT)
    PHASE(14);
#define PH_BODY_15 GEMM_DN(2, MT)
    PHASE(15);
#define PH_BODY_16 RES(1, 1, 1, 0, 1, 1, MT, 0.5f, args.out, XC, PART)
    PHASE(16);
#define PH_BODY_17 { pg8::Gemm g{H, (const bf16*)(ws + WS_WODIN), MT, ODN, DM, DM}; pg8::StaticOrder S; S.init(MT, ODN, F.G, F.bid); \
        pg8::EpiPlain Ep{E2, ODN}; pg8::gemm_phase<pg8::EpiPlain, pg8::StaticOrder, PG8_ALIGN, PG8_SP2>(F.lds, g, S, Ep); }
    PHASE(17);
#define PH_BODY_18 odd_post_phase(F)
    PHASE(18);
#define PH_BODY_19 attn_phase(F)
    PHASE(19);
#define PH_BODY_20 { pg8::Gemm g{MIX2, (const bf16*)(ws + WS_WODOUT), ML, DM, DM, DM}; pg8::StaticOrder S; S.init(ML, DM, F.G, F.bid); \
        pg8::EpiPlain Ep{H, DM}; pg8::gemm_phase<pg8::EpiPlain, pg8::StaticOrder, PG8_ALIGN, PG8_SP2>(F.lds, g, S, Ep); }
    PHASE(20);
#define PH_BODY_21 RES(1, 1, 1, 1, 1, 2, ML, 1.0f, args.out, XC, nullptr)
    PHASE(21);
#define PH_BODY_22 GEMM_GU(3, ML)
    PHASE(22);
#define PH_BODY_23 GEMM_DN(3, ML)
    PHASE(23);
#define PH_BODY_24 RES(1, 0, 1, 2, 0, 0, ML, 0.5f, args.out, XC, nullptr)
    PHASE(24);
    if (MK_STAMP >= 0 && F.bid == 0 && F.tid == 0) args.out[0] = 64.f * floorf((float)(t_stamp1 - t_stamp0) * 0.01f / 64.f + 0.5f);
#undef IN
#undef SEAM
}

extern "C" void kernel_launch(void* const* d_in, const int* in_sizes, int n_in, void* d_out, int out_size, void* d_ws, size_t ws_size, hipStream_t stream) {
    static int grid = 0;
    if (grid == 0) {
        if (n_in != 28 || out_size != ML * DM || ws_size < WS_END) { fprintf(stderr, "kernel_launch: unexpected shapes (n_in %d out %d ws %zu, need ws >= %zu)\n", n_in, out_size, ws_size, (size_t)WS_END); grid = -1; return; }
        int dev = 0, cus = 0, per_cu = 0;
        if (hipGetDevice(&dev) != hipSuccess || hipDeviceGetAttribute(&cus, hipDeviceAttributeMultiprocessorCount, dev) != hipSuccess) { grid = -1; return; }
        if (hipFuncSetAttribute((const void*)mk_fwd, hipFuncAttributeMaxDynamicSharedMemorySize, LDS_BYTES) != hipSuccess) { fprintf(stderr, "kernel_launch: hipFuncSetAttribute failed\n"); grid = -1; return; }
        if (hipOccupancyMaxActiveBlocksPerMultiprocessor(&per_cu, (const void*)mk_fwd, 512, LDS_BYTES) != hipSuccess || per_cu < 1) fprintf(stderr, "kernel_launch: occupancy query says %d\n", per_cu);
        (void)hipGetLastError();
        grid = cus;
    }
    if (grid < 0) return;
    (void)hipMemsetAsync((char*)d_ws + WS_CTL, 0, CTL_ZERO_BYTES, stream);
    Args a{};
    for (int i = 0; i < 28; ++i) a.in[i] = (const float*)d_in[i];
    a.out = (float*)d_out; a.ws = (unsigned char*)d_ws;
#if MK_N_LAUNCHES == 1
    a.ph_lo = 0; a.ph_hi = NPH;
    hipLaunchKernelGGL(mk_fwd, dim3(grid), dim3(512), LDS_BYTES, stream, a);
#else
    for (int p = 0; p < NPH && p <= MK_STOP_AFTER; ++p) { a.ph_lo = p; a.ph_hi = p + 1; hipLaunchKernelGGL(mk_fwd, dim3(grid), dim3(512), LDS_BYTES, stream, a); }
#endif
    const hipError_t le = hipPeekAtLastError();
    if (le != hipSuccess) fprintf(stderr, "kernel_launch: launch failed: %s\n", hipGetErrorName(le));
}
```

```cpp
#include <hip/hip_runtime.h>
#include <cstdio>
#include <cstdint>

#ifndef MK_N_LAUNCHES
#define MK_N_LAUNCHES 1
#endif
#ifndef MK_STOP_AFTER
#define MK_STOP_AFTER 1000
#endif

#define DEV __device__ __forceinline__
#define LAS __attribute__((address_space(3)))
typedef unsigned short bf16;
typedef float f32x4 __attribute__((ext_vector_type(4)));
typedef float f32x2 __attribute__((ext_vector_type(2)));
typedef float f32x16 __attribute__((ext_vector_type(16)));
typedef short bf16x8 __attribute__((ext_vector_type(8)));
typedef short s16x4 __attribute__((ext_vector_type(4)));
typedef unsigned u32x4 __attribute__((ext_vector_type(4)));
typedef unsigned u32x2 __attribute__((ext_vector_type(2)));

constexpr int NB = 4, SEQ = 8192, DM = 2048, CTXL = 256, DFF = 5632;
constexpr int ML = NB * SEQ, MC = NB * CTXL, MT = ML + MC;
constexpr float EPS = 1e-6f;
constexpr int EVN = 6144, ODN = 3072;
constexpr int EC_G = 0, EC_O = 1024, EC_Q = 2048, EC_K = 3072, EC_V = 4096, EC_R = 5120;
constexpr int NCH64 = (CTXL + SEQ) / 64;
constexpr int NCH128 = (CTXL + SEQ) / 128;
constexpr int KVL = CTXL + SEQ;

constexpr size_t MiB = 1u << 20;
constexpr size_t WS_CTL = 0, CTL_ZERO_BYTES = 1 * MiB;
constexpr size_t WS_MOD = 1 * MiB;
constexpr size_t WS_COS1 = 2 * MiB, WS_SIN1 = 6 * MiB;
constexpr size_t WS_COS2 = 10 * MiB, WS_SIN2 = 12 * MiB;
constexpr size_t WS_LRUW = 14 * MiB;
constexpr size_t WS_POOLW = 15 * MiB;
constexpr size_t WS_AGG = 16 * MiB;
constexpr size_t WS_CAR = 25 * MiB;
constexpr size_t WS_XC = 30 * MiB;
constexpr size_t WS_W = 40 * MiB;
constexpr size_t WS_WGU = WS_W;
constexpr size_t WS_WD = WS_W + 176 * MiB;
constexpr size_t WS_WEVIN = WS_W + 264 * MiB;
constexpr size_t WS_WEVOUT = WS_W + 288 * MiB;
constexpr size_t WS_WODIN = WS_W + 296 * MiB;
constexpr size_t WS_WODOUT = WS_W + 308 * MiB;
constexpr size_t WS_H = 356 * MiB;
constexpr size_t WS_BIG = 488 * MiB;
constexpr size_t WS_ACT = WS_BIG;
constexpr size_t WS_E = WS_BIG;
constexpr size_t WS_SBUF = WS_BIG + 396 * MiB;
constexpr size_t WS_PART = WS_BIG + 400 * MiB;
constexpr size_t WS_E2 = WS_BIG;
constexpr size_t WS_QB = WS_BIG + 198 * MiB;
constexpr size_t WS_KB = WS_BIG + 294 * MiB;
constexpr size_t WS_VB = WS_BIG + 327 * MiB;
constexpr size_t WS_MIX2 = WS_BIG + 360 * MiB;
constexpr size_t WS_END = 1148 * MiB;
constexpr int CW_BAR = 4096;

constexpr int LDS_BYTES = 159744;
constexpr int MISC_OFF = LDS_BYTES - 256;

DEV float bflo(unsigned w) { return __uint_as_float(w << 16); }
DEV float bfhi(unsigned w) { return __uint_as_float(w & 0xffff0000u); }
DEV float bf2f(bf16 b) { return __uint_as_float((unsigned)b << 16); }
DEV unsigned pkbf(float lo, float hi) { unsigned r; asm volatile("v_cvt_pk_bf16_f32 %0, %1, %2" : "=v"(r) : "v"(lo), "v"(hi)); return r; }
DEV bf16 f2bf(float f) { return (bf16)(pkbf(f, 0.f) & 0xffffu); }
DEV float fexp(float x) { return __builtin_amdgcn_exp2f(x * 1.4426950408889634f); }
DEV float fsigmoid(float x) { return __builtin_amdgcn_rcpf(1.f + fexp(-x)); }
DEV float fsilu(float x) { return x * fsigmoid(x); }
DEV float fgelu_tanh(float x) { const float z = 0.7978845608028654f * (x + 0.044715f * x * x * x); return x * fsigmoid(2.f * z); }
DEV float wave_sum(float v) {
#pragma unroll
    for (int o = 1; o < 64; o <<= 1) v += __shfl_xor(v, o);
    return v;
}
DEV int crow(int r, int hi) { return (r & 3) + 8 * (r >> 2) + 4 * hi; }
typedef short v4i16_t __attribute__((ext_vector_type(4)));
DEV s16x4 ds_tr(const LAS unsigned char* p) { return __builtin_bit_cast(s16x4, __builtin_amdgcn_ds_read_tr16_b64_v4i16((LAS v4i16_t*)p)); }
DEV bf16x8 tr_frag(const LAS unsigned char* X, int ld, int k0, int n0, int lane) {
    const int h = lane >> 5, blk = (lane >> 4) & 1, q = (lane & 15) >> 2, p = lane & 3;
    const LAS unsigned char* a = X + (k0 + 8 * h + q) * ld + (n0 + 16 * blk + 4 * p) * 2;
    const s16x4 lo = ds_tr(a), hi = ds_tr(a + 4 * ld);
    return (bf16x8){lo[0], lo[1], lo[2], lo[3], hi[0], hi[1], hi[2], hi[3]};
}
DEV bf16x8 pack8(const float* v) { u32x4 w = {pkbf(v[0], v[1]), pkbf(v[2], v[3]), pkbf(v[4], v[5]), pkbf(v[6], v[7])}; return __builtin_bit_cast(bf16x8, w); }

namespace pg8 {
typedef unsigned short bf16_t;
constexpr int BM = 256, BK = 64, HALF = 128, HTB = HALF * BK * 2, STAGE_BYTES = 8 * HTB, NXCD = 8, WGM = 8;
__host__ __device__ __forceinline__ int lds_byte(int r, int c) { const int st = (r >> 4) * 2 + (c >> 5), rr = r & 15, cc = c & 31, ob = rr * 64 + cc * 2; return st * 1024 + (ob ^ (((ob >> 9) & 1) << 5)); }
__host__ __device__ __forceinline__ void stage_rc(int b, int& R, int& C) { const int st = b / 1024, sb = b % 1024, swz = sb ^ (((sb >> 9) & 1) << 5); R = (st >> 1) * 16 + swz / 64; C = (st & 1) * 32 + (swz % 64) / 2; }
__host__ __device__ __forceinline__ int perm32(int rho) { const int n = rho >> 4, i = rho & 15; return 8 * (i >> 2) + 4 * n + (i & 3); }
struct Unit { int pm, pn, ks, nks; };
struct Gemm { const bf16_t* A; const bf16_t* Bt; int M, N, K, lda; };
struct StaticOrder {
    int nM, nN, nwg, G, c;
    __host__ __device__ void init(int M, int N, int G_, int c_) { nM = M / BM; nN = N / BM; nwg = nM * nN; G = G_; c = c_; }
    __host__ __device__ __forceinline__ bool next(int i, Unit& u) const {
        const long L = (long)i * G + c; if (L >= nwg) return false;
        int wgid = (int)L; { const int q = nwg / NXCD, r = nwg % NXCD, xcd = wgid % NXCD, off = wgid / NXCD; wgid = (xcd < r ? xcd * (q + 1) : r * (q + 1) + (xcd - r) * q) + off; }
        const int nig = WGM * nN, gid = wgid / nig, fm = gid * WGM, gsz = (nM - fm) < WGM ? (nM - fm) : WGM;
        u.pm = fm + ((wgid % nig) % gsz); u.pn = (wgid % nig) / gsz; u.ks = 0; u.nks = 1; return true;
    }
    __device__ __forceinline__ void a_ready(const Unit&) const {}
    __device__ __forceinline__ void done(const Unit&) const {}
};
struct TailSplitOrder {
    StaticOrder full; int nMf, nMt, nN, nfull, split;
    __host__ __device__ void init(int Mfull, int Mtail, int N, int G_, int c_, int split_) { full.init(Mfull, N, G_, c_); nMf = Mfull / BM; nMt = Mtail / BM; nN = N / BM; nfull = nMf * nN; split = split_; }
    __host__ __device__ __forceinline__ bool next(int i, Unit& u) const {
        const long L = (long)i * full.G + full.c; int pm = 0, pn = 0, ks = 0, nks = 1; bool ok;
        if (L < nfull) { Unit f; ok = full.next(i, f); pm = f.pm; pn = f.pn; }
        else { const int Lp = (int)(L - nfull); ok = Lp < nMt * nN * split; const int t = Lp / split, d = nMt > 0 ? nMt : 1; ks = Lp % split; nks = split; pm = nMf + t % d; pn = t / d; }
        u.pm = pm; u.pn = pn; u.ks = ks; u.nks = nks; return ok;
    }
    __device__ __forceinline__ void a_ready(const Unit&) const {}
    __device__ __forceinline__ void done(const Unit&) const {}
};
struct EpiPlain {
    static constexpr bool PERM = true, AFTER_DRAIN = false;
    bf16_t* O; int ldc;
    __device__ __forceinline__ void operator()(const f32x4 (&acc)[2][2][4][2], const Unit& u, int wr, int wc, int fr, int fq) const {
        const int row0 = u.pm * BM + wr * 64 + fr, col0 = u.pn * BM + wc * 32 + 8 * fq;
#pragma unroll
        for (int ai = 0; ai < 2; ++ai)
#pragma unroll
            for (int m = 0; m < 4; ++m) { bf16_t* rowp = O + (size_t)(row0 + ai * HALF + m * 16) * ldc + col0;
#pragma unroll
                for (int bj = 0; bj < 2; ++bj) { const f32x4 v0 = acc[ai][bj][m][0], v1 = acc[ai][bj][m][1];
                    u32x4 w; w.x = pkbf(v0[0], v0[1]); w.y = pkbf(v0[2], v0[3]); w.z = pkbf(v1[0], v1[1]); w.w = pkbf(v1[2], v1[3]);
                    *(u32x4*)(rowp + bj * HALF) = w; } }
    }
};
struct EpiPlainSplit {
    static constexpr bool PERM = true, AFTER_DRAIN = false;
    bf16_t* O; int ldc; float* P; int prow0, prow_cnt;
    __device__ __forceinline__ void operator()(const f32x4 (&acc)[2][2][4][2], const Unit& u, int wr, int wc, int fr, int fq) const {
        const int row0 = u.pm * BM + wr * 64 + fr, col0 = u.pn * BM + wc * 32 + 8 * fq;
        if (u.nks == 1) {
#pragma unroll
            for (int ai = 0; ai < 2; ++ai)
#pragma unroll
                for (int m = 0; m < 4; ++m) { bf16_t* rowp = O + (size_t)(row0 + ai * HALF + m * 16) * ldc + col0;
#pragma unroll
                    for (int bj = 0; bj < 2; ++bj) { const f32x4 v0 = acc[ai][bj][m][0], v1 = acc[ai][bj][m][1];
                        u32x4 w; w.x = pkbf(v0[0], v0[1]); w.y = pkbf(v0[2], v0[3]); w.z = pkbf(v1[0], v1[1]); w.w = pkbf(v1[2], v1[3]);
                        *(u32x4*)(rowp + bj * HALF) = w; } }
        } else {
#pragma unroll
            for (int ai = 0; ai < 2; ++ai)
#pragma unroll
                for (int m = 0; m < 4; ++m) { float* rowp = P + ((size_t)u.ks * prow_cnt + (row0 + ai * HALF + m * 16 - prow0)) * ldc + col0;
#pragma unroll
                    for (int bj = 0; bj < 2; ++bj) { *(f32x4*)(rowp + bj * HALF) = acc[ai][bj][m][0]; *(f32x4*)(rowp + bj * HALF + 4) = acc[ai][bj][m][1]; } }
        }
    }
};
struct EpiSwiGLU {
    static constexpr bool PERM = true, AFTER_DRAIN = false;
    bf16_t* O; int ldc;
    __device__ __forceinline__ void operator()(const f32x4 (&acc)[2][2][4][2], const Unit& u, int wr, int wc, int fr, int fq) const {
        const int row0 = u.pm * BM + wr * 64 + fr, col0 = u.pn * HALF + wc * 32 + 8 * fq;
#pragma unroll
        for (int ai = 0; ai < 2; ++ai)
#pragma unroll
            for (int m = 0; m < 4; ++m) { bf16_t* rowp = O + (size_t)(row0 + ai * HALF + m * 16) * ldc + col0;
                f32x4 a0, a1;
#pragma unroll
                for (int j = 0; j < 4; ++j) { a0[j] = fsilu(acc[ai][0][m][0][j]) * acc[ai][1][m][0][j]; a1[j] = fsilu(acc[ai][0][m][1][j]) * acc[ai][1][m][1][j]; }
                u32x4 w; w.x = pkbf(a0[0], a0[1]); w.y = pkbf(a0[2], a0[3]); w.z = pkbf(a1[0], a1[1]); w.w = pkbf(a1[2], a1[3]);
                *(u32x4*)rowp = w; }
    }
};
struct EpiEvIn {
    static constexpr bool PERM = true, AFTER_DRAIN = false;
    bf16_t* O; const float* cs; const float* sn;
    __device__ __forceinline__ void operator()(const f32x4 (&acc)[2][2][4][2], const Unit& u, int wr, int wc, int fr, int fq) const {
        const int ldc = EVN; const int row0 = u.pm * BM + wr * 64 + fr, col0 = u.pn * BM + wc * 32 + 8 * fq;
        const bool qk = (u.pn >= 8 && u.pn < 16), rot = qk && (u.pm < ML / BM); const float ksc = (u.pn >= 12 && u.pn < 16) ? 0.0625f : 1.f;
#pragma unroll
        for (int ai = 0; ai < 2; ++ai)
#pragma unroll
            for (int m = 0; m < 4; ++m) { const int row = row0 + ai * HALF + m * 16; bf16_t* rowp = O + (size_t)row * ldc + col0;
                f32x4 o1[2], o2[2];
#pragma unroll
                for (int n = 0; n < 2; ++n) { const f32x4 x1 = acc[ai][0][m][n], x2 = acc[ai][1][m][n];
                    if (rot) { const int t = row & (SEQ - 1); const int i0 = wc * 32 + 8 * fq + 4 * n;
                        const f32x4 c4 = *(const f32x4*)(cs + (size_t)t * 128 + i0), s4 = *(const f32x4*)(sn + (size_t)t * 128 + i0);
                        o1[n] = (x1 * c4 - x2 * s4) * ksc; o2[n] = (x1 * s4 + x2 * c4) * ksc; }
                    else { o1[n] = x1 * ksc; o2[n] = x2 * ksc; } }
                u32x4 w; w.x = pkbf(o1[0][0], o1[0][1]); w.y = pkbf(o1[0][2], o1[0][3]); w.z = pkbf(o1[1][0], o1[1][1]); w.w = pkbf(o1[1][2], o1[1][3]);
                *(u32x4*)rowp = w;
                w.x = pkbf(o2[0][0], o2[0][1]); w.y = pkbf(o2[0][2], o2[0][3]); w.z = pkbf(o2[1][0], o2[1][1]); w.w = pkbf(o2[1][2], o2[1][3]);
                *(u32x4*)(rowp + HALF) = w; }
    }
};

template <class Epi, class Sched, bool ALIGN_EPI = false, bool SP2 = false>
__device__ __forceinline__ unsigned gemm_phase(LAS unsigned char* lds, const Gemm g, const Sched& S, const Epi& E) {
    const int tid = threadIdx.x, wid = __builtin_amdgcn_readfirstlane(tid >> 6), lane = tid & 63, wr = wid >> 2, wc = wid & 3, fr = lane & 15, fq = lane >> 4;
    const int K = g.K, nt_full = K / BK, lda = g.lda;
    unsigned voffA[2], voffB[2];
#pragma unroll
    for (int i = 0; i < 2; ++i) { int R, C; stage_rc(tid * 16 + i * 8192, R, C); const int Rb = Epi::PERM ? ((R & ~31) + perm32(R & 31)) : R;
        voffA[i] = (unsigned)(R * lda + C) * 2u; voffB[i] = (unsigned)(Rb * K + C) * 2u; }
    const size_t kstep = (size_t)(BK * 2);
    const size_t hstepA = (size_t)HALF * lda * 2, hstepB = (size_t)HALF * K * 2;
    const size_t tstepA = 2 * hstepA, tstepB = 2 * hstepB;
    const unsigned ldsw = (unsigned)wid * 1024u;
    const int aoff = lds_byte(wr * 64 + fr, fq * 8), boff = lds_byte(wc * 32 + fr, fq * 8);
#define PG8_SA(b, h) (((b) * 2 + (h)) * HTB)
#define PG8_SB(b, h) ((4 + (b) * 2 + (h)) * HTB)
#define PG8_STAGE(bufoff, gbase, voff) do { _Pragma("unroll") for (int _i = 0; _i < 2; ++_i) \
        __builtin_amdgcn_global_load_lds((const unsigned*)((const char*)(gbase) + (voff)[_i]), (LAS unsigned*)(lds + (bufoff) + ldsw + _i * 8192), 16, 0, 0); } while (0)
#define PG8_LDA(dst, b, h) do { _Pragma("unroll") for (int m = 0; m < 4; ++m) _Pragma("unroll") for (int k = 0; k < 2; ++k) dst[m][k] = *(const LAS bf16x8*)(lds + PG8_SA(b, h) + aoff + m * 2048 + k * 1024); } while (0)
#define PG8_LDB(dst, b, h) do { _Pragma("unroll") for (int n = 0; n < 2; ++n) _Pragma("unroll") for (int k = 0; k < 2; ++k) dst[n][k] = *(const LAS bf16x8*)(lds + PG8_SB(b, h) + boff + n * 2048 + k * 1024); } while (0)
#define PG8_MMA(ai, bj, At, Bt) do { __builtin_amdgcn_s_setprio(1); _Pragma("unroll") for (int m = 0; m < 4; ++m) _Pragma("unroll") for (int n = 0; n < 2; ++n) _Pragma("unroll") for (int k = 0; k < 2; ++k) \
        acc[ai][bj][m][n] = __builtin_amdgcn_mfma_f32_16x16x32_bf16(Bt[n][k], At[m][k], acc[ai][bj][m][n], 0, 0, 0); __builtin_amdgcn_s_setprio(0); } while (0)
#define PG8_WAIT_V(n) asm volatile("s_waitcnt vmcnt(" #n ")" ::: "memory")
#define PG8_WAIT_L(n) asm volatile("s_waitcnt lgkmcnt(" #n ")" ::: "memory")
#define PG8_BAR __builtin_amdgcn_s_barrier()
#define PG8_SCHED __builtin_amdgcn_sched_barrier(0)
    Unit cur, nxt; int ui = 0;
    if (!S.next(0, cur)) return 0u;
    f32x4 acc[2][2][4][2];
#pragma unroll
    for (int a = 0; a < 2; ++a)
#pragma unroll
        for (int b = 0; b < 2; ++b)
#pragma unroll
            for (int m = 0; m < 4; ++m)
#pragma unroll
                for (int n = 0; n < 2; ++n) acc[a][b][m][n] = (f32x4){0.f, 0.f, 0.f, 0.f};
    bf16x8 At[4][2], B0[2][2], B1[2][2];
    int nt = nt_full / cur.nks;
    const char* cA = (const char*)g.A + (size_t)cur.pm * tstepA + (size_t)cur.ks * (K / cur.nks) * 2; const char* cB = (const char*)g.Bt + (size_t)cur.pn * tstepB + (size_t)cur.ks * (K / cur.nks) * 2;
    S.a_ready(cur);
    if constexpr (SP2) {
        PG8_STAGE(PG8_SB(0, 0), cB, voffB); PG8_STAGE(PG8_SB(0, 1), cB + hstepB, voffB); PG8_STAGE(PG8_SA(0, 0), cA, voffA); PG8_STAGE(PG8_SA(0, 1), cA + hstepA, voffA);
        if (wr == 1) PG8_BAR;
        PG8_WAIT_V(2); PG8_BAR;
        PG8_STAGE(PG8_SB(1, 0), cB + kstep, voffB); PG8_STAGE(PG8_SA(1, 0), cA + kstep, voffA); PG8_STAGE(PG8_SB(1, 1), cB + hstepB + kstep, voffB);
        PG8_WAIT_V(6); PG8_BAR;
    } else {
        PG8_STAGE(PG8_SB(0, 0), cB, voffB); PG8_STAGE(PG8_SA(0, 0), cA, voffA); PG8_STAGE(PG8_SB(0, 1), cB + hstepB, voffB); PG8_STAGE(PG8_SA(0, 1), cA + hstepA, voffA);
        if (wr == 1) PG8_BAR;
        PG8_WAIT_V(4); PG8_BAR;
        PG8_STAGE(PG8_SB(1, 0), cB + kstep, voffB); PG8_STAGE(PG8_SA(1, 0), cA + kstep, voffA); PG8_STAGE(PG8_SB(1, 1), cB + hstepB + kstep, voffB);
        PG8_WAIT_V(6); PG8_BAR;
    }
#ifdef MK_GSTAMP
    unsigned gs_t2 = (unsigned)wall_clock64(), gs_acc = 0;
#endif
    for (;;) {
        const bool has_next = S.next(ui + 1, nxt);
        const char* nA = has_next ? (const char*)g.A + (size_t)nxt.pm * tstepA + (size_t)nxt.ks * (K / nxt.nks) * 2 : cA; const char* nB = has_next ? (const char*)g.Bt + (size_t)nxt.pn * tstepB + (size_t)nxt.ks * (K / nxt.nks) * 2 : cB;
        for (int t = 0; t < nt; t += 2) {
            const bool last = (t == nt - 2);
            const char* a1 = cA + (size_t)(t + 1) * kstep;
            const char* a2 = last ? nA : cA + (size_t)(t + 2) * kstep; const char* b2 = last ? nB : cB + (size_t)(t + 2) * kstep;
            const char* a3 = a2 + kstep; const char* b3 = b2 + kstep;
            if (last && has_next) S.a_ready(nxt);
            if constexpr (SP2) {
            PG8_LDB(B0, 0, 0); PG8_LDB(B1, 0, 1); PG8_SCHED; PG8_LDA(At, 0, 0); PG8_STAGE(PG8_SA(1, 1), a1 + hstepA, voffA);
            PG8_WAIT_V(8); PG8_WAIT_L(0); PG8_BAR; PG8_MMA(0, 0, At, B0); PG8_MMA(0, 1, At, B1); PG8_BAR; PG8_SCHED;
            PG8_LDA(At, 0, 1); PG8_STAGE(PG8_SB(0, 0), b2, voffB); PG8_STAGE(PG8_SB(0, 1), b2 + hstepB, voffB); PG8_STAGE(PG8_SA(0, 0), a2, voffA);
            PG8_WAIT_V(8); PG8_WAIT_L(0); PG8_BAR; PG8_MMA(1, 0, At, B0); PG8_MMA(1, 1, At, B1); PG8_BAR; PG8_SCHED;
            PG8_LDB(B0, 1, 0); PG8_LDB(B1, 1, 1); PG8_SCHED; PG8_LDA(At, 1, 0); PG8_STAGE(PG8_SA(0, 1), a2 + hstepA, voffA);
            PG8_WAIT_V(8); PG8_WAIT_L(0); PG8_BAR; PG8_MMA(0, 0, At, B0); PG8_MMA(0, 1, At, B1); PG8_BAR; PG8_SCHED;
            PG8_LDA(At, 1, 1); PG8_STAGE(PG8_SB(1, 0), b3, voffB); PG8_STAGE(PG8_SB(1, 1), b3 + hstepB, voffB); PG8_STAGE(PG8_SA(1, 0), a3, voffA);
            PG8_WAIT_V(8); PG8_WAIT_L(0); PG8_BAR; PG8_MMA(1, 0, At, B0); PG8_MMA(1, 1, At, B1); PG8_BAR; PG8_SCHED;
            } else {
            PG8_LDB(B0, 0, 0); PG8_SCHED; PG8_LDA(At, 0, 0); PG8_STAGE(PG8_SA(1, 1), a1 + hstepA, voffA);
            PG8_WAIT_L(8); PG8_BAR; PG8_WAIT_L(0); PG8_MMA(0, 0, At, B0); PG8_BAR; PG8_SCHED;
            PG8_LDB(B1, 0, 1); PG8_STAGE(PG8_SB(0, 0), b2, voffB);
            PG8_BAR; PG8_WAIT_L(0); PG8_MMA(0, 1, At, B1); PG8_BAR;
            PG8_LDA(At, 0, 1); PG8_STAGE(PG8_SA(0, 0), a2, voffA);
            PG8_BAR; PG8_WAIT_L(0); PG8_MMA(1, 0, At, B0); PG8_BAR; PG8_SCHED;
            PG8_STAGE(PG8_SB(0, 1), b2 + hstepB, voffB);
            PG8_WAIT_V(6); PG8_BAR; PG8_MMA(1, 1, At, B1); PG8_BAR;
            PG8_LDB(B0, 1, 0); PG8_SCHED; PG8_LDA(At, 1, 0); PG8_STAGE(PG8_SA(0, 1), a2 + hstepA, voffA);
            PG8_WAIT_L(8); PG8_BAR; PG8_WAIT_L(0); PG8_MMA(0, 0, At, B0); PG8_BAR; PG8_SCHED;
            PG8_LDB(B1, 1, 1); PG8_STAGE(PG8_SB(1, 0), b3, voffB);
            PG8_BAR; PG8_WAIT_L(0); PG8_MMA(0, 1, At, B1); PG8_BAR;
            PG8_LDA(At, 1, 1); PG8_STAGE(PG8_SA(1, 0), a3, voffA);
            PG8_BAR; PG8_WAIT_L(0); PG8_MMA(1, 0, At, B0); PG8_BAR; PG8_SCHED;
            PG8_STAGE(PG8_SB(1, 1), b3 + hstepB, voffB);
            PG8_WAIT_V(6); PG8_BAR; PG8_MMA(1, 1, At, B1); PG8_BAR;
            }
        }
#ifdef MK_GSTAMP
        const unsigned gs_t0 = (unsigned)wall_clock64(); if (MK_GSTAMP == 2) gs_acc += gs_t0 - gs_t2;
#endif
        if constexpr (ALIGN_EPI) { if (wr == 0) PG8_BAR; }
        if constexpr (!Epi::AFTER_DRAIN) { E(acc, cur, wr, wc, fr, fq); S.done(cur); }
#ifdef MK_GSTAMP
        const unsigned gs_t1 = (unsigned)wall_clock64(); if (MK_GSTAMP == 0) gs_acc += gs_t1 - gs_t0;
#endif
        if (!has_next) break;
#pragma unroll
        for (int a = 0; a < 2; ++a)
#pragma unroll
            for (int b = 0; b < 2; ++b)
#pragma unroll
                for (int m = 0; m < 4; ++m)
#pragma unroll
                    for (int n = 0; n < 2; ++n) acc[a][b][m][n] = (f32x4){0.f, 0.f, 0.f, 0.f};
        cur = nxt; cA = nA; cB = nB; ++ui; nt = nt_full / cur.nks;
        if constexpr (ALIGN_EPI) { if (wr == 1) PG8_BAR; }
#ifdef MK_GSTAMP
        gs_t2 = (unsigned)wall_clock64(); if (MK_GSTAMP == 1) gs_acc += gs_t2 - gs_t1;
#endif
    }
    PG8_WAIT_V(0);
    if constexpr (!ALIGN_EPI) { if (wr == 0) PG8_BAR; }
    PG8_BAR;
#ifdef MK_GSTAMP
    return gs_acc;
#else
    return 0u;
#endif
#undef PG8_SA
#undef PG8_SB
#undef PG8_STAGE
#undef PG8_LDA
#undef PG8_LDB
#undef PG8_MMA
#undef PG8_WAIT_V
#undef PG8_WAIT_L
#undef PG8_BAR
#undef PG8_SCHED
}
}
#define PG8_SP2 true
#define PG8_ALIGN true

namespace att {
constexpr int D = 128, NW = 8, QBLK = 32, KVBLK = 64;
constexpr float SCALE = 0.088388347648318440f;
constexpr float THR = 8.f;
constexpr size_t SHM_V = KVBLK * D * 2, SHM_K = KVBLK * D * 2, SHM_ATTN = 2 * SHM_V + 2 * SHM_K + NW * 64 * 4;
#define KSWZ(row, colB) ((row) * 256 + ((colB) ^ (((row) & 7) << 4)))
#define SBAR() __builtin_amdgcn_sched_barrier(0)
DEV void partialSM(f32x16& p0, f32x16& p1, float& m_reg, float& mn, float& alpha) {
  constexpr float C = SCALE * 1.4426950408889634f;
  float pmax = p0[0]; for (int r = 1; r < 16; ++r) pmax = fmaxf(pmax, p0[r]); for (int r = 0; r < 16; ++r) pmax = fmaxf(pmax, p1[r]);
  { auto rr = __builtin_amdgcn_permlane32_swap(__float_as_uint(pmax), __float_as_uint(pmax), false, false);
    pmax = fmaxf(__uint_as_float(rr[0]), __uint_as_float(rr[1])); }
  if (__builtin_expect(__all(pmax - m_reg <= THR / SCALE), 1)) { mn = m_reg; alpha = 1.f; }
  else { mn = fmaxf(m_reg, pmax); alpha = __builtin_amdgcn_exp2f((m_reg - mn) * C); m_reg = mn; }
  float mnC = -mn * C;
  for (int r = 0; r < 16; ++r) p0[r] = fmaf(p0[r], C, mnC); for (int r = 0; r < 16; ++r) p1[r] = fmaf(p1[r], C, mnC);
  for (int r = 0; r < 16; ++r) p0[r] = __builtin_amdgcn_exp2f(p0[r]);
}
DEV void finishSM(f32x16& p0, f32x16& p1, float alpha, float& l_reg, bf16x8& pa0, bf16x8& pa1, bf16x8& pa2, bf16x8& pa3) {
  for (int r = 0; r < 16; ++r) p1[r] = __builtin_amdgcn_exp2f(p1[r]);
  float ps = 0; for (int r = 0; r < 16; ++r) ps += p0[r]; for (int r = 0; r < 16; ++r) ps += p1[r];
  { auto rr = __builtin_amdgcn_permlane32_swap(__float_as_uint(ps), __float_as_uint(ps), false, false);
    ps = __uint_as_float(rr[0]) + __uint_as_float(rr[1]); }
  l_reg = l_reg * alpha + ps;
#define PK4(P, BASE, OUT) do { unsigned a0 = pkbf(P[BASE + 0], P[BASE + 1]), a1 = pkbf(P[BASE + 2], P[BASE + 3]);   \
    unsigned b0 = pkbf(P[BASE + 4], P[BASE + 5]), b1 = pkbf(P[BASE + 6], P[BASE + 7]);                              \
    auto r0 = __builtin_amdgcn_permlane32_swap(a0, b0, false, false); auto r1 = __builtin_amdgcn_permlane32_swap(a1, b1, false, false); \
    u32x4 w = {r0[0], r1[0], r0[1], r1[1]}; OUT = __builtin_bit_cast(bf16x8, w); } while (0)
  PK4(p0, 0, pa0); PK4(p0, 8, pa1); PK4(p1, 0, pa2); PK4(p1, 8, pa3);
#undef PK4
}
DEV void qkt(f32x16& p0, f32x16& p1, const bf16* Ks, const bf16x8* qr, int r32, int hi) {
  p0 = f32x16{}; p1 = f32x16{};
  for (int d0 = 0; d0 < 8; ++d0) { int cb = (d0 * 16 + hi * 8) * 2;
    bf16x8 b0 = *reinterpret_cast<const bf16x8*>((const char*)Ks + KSWZ(r32, cb));
    bf16x8 b1 = *reinterpret_cast<const bf16x8*>((const char*)Ks + KSWZ(32 + r32, cb));
    p0 = __builtin_amdgcn_mfma_f32_32x32x16_bf16(b0, qr[d0], p0, 0, 0, 0);
    p1 = __builtin_amdgcn_mfma_f32_32x32x16_bf16(b1, qr[d0], p1, 0, 0, 0); }
}
DEV int v_st(int k, int c) { const int kk = (k & ~0xC) | ((k & 4) << 1) | ((k & 8) >> 1); return ((kk >> 3) * 4 + (c >> 5)) * 512 + ((kk & 7) * 32 + (c & 31)) * 2; }
DEV int v_rd_base(int lane) { return ((lane & 3) << 3) | (((lane >> 2) & 3) << 6) | (((lane >> 4) & 1) << 5) | (((lane >> 5) & 1) << 8); }
constexpr int v_rd_off(int d0, int ks, int half) { return d0 * 512 + ks * 4096 + half * 2048; }
template <int OFF> DEV s16x4 tr_read(int vb) {
  s16x4 r; asm volatile("ds_read_b64_tr_b16 %0, %1 offset:%2" : "=&v"(r) : "v"(vb), "i"(OFF) : "memory"); return r;
}
template <int D0> DEV void pv_one(f32x16& od, int vb, bf16x8 pa0, bf16x8 pa1, bf16x8 pa2, bf16x8 pa3) {
  const s16x4 l0 = tr_read<v_rd_off(D0, 0, 0)>(vb), h0 = tr_read<v_rd_off(D0, 0, 1)>(vb), l1 = tr_read<v_rd_off(D0, 1, 0)>(vb), h1 = tr_read<v_rd_off(D0, 1, 1)>(vb);
  const s16x4 l2 = tr_read<v_rd_off(D0, 2, 0)>(vb), h2 = tr_read<v_rd_off(D0, 2, 1)>(vb), l3 = tr_read<v_rd_off(D0, 3, 0)>(vb), h3 = tr_read<v_rd_off(D0, 3, 1)>(vb);
  asm volatile("s_waitcnt lgkmcnt(0)" ::: "memory"); SBAR();
#define PK(L, H) (bf16x8){L[0], L[1], L[2], L[3], H[0], H[1], H[2], H[3]}
  od = __builtin_amdgcn_mfma_f32_32x32x16_bf16(pa0, PK(l0, h0), od, 0, 0, 0);
  od = __builtin_amdgcn_mfma_f32_32x32x16_bf16(pa1, PK(l1, h1), od, 0, 0, 0);
  od = __builtin_amdgcn_mfma_f32_32x32x16_bf16(pa2, PK(l2, h2), od, 0, 0, 0);
  od = __builtin_amdgcn_mfma_f32_32x32x16_bf16(pa3, PK(l3, h3), od, 0, 0, 0);
#undef PK
}
DEV void pv_d0(f32x16* o, int vb, bf16x8 pa0, bf16x8 pa1, bf16x8 pa2, bf16x8 pa3) {
  pv_one<0>(o[0], vb, pa0, pa1, pa2, pa3); pv_one<1>(o[1], vb, pa0, pa1, pa2, pa3); pv_one<2>(o[2], vb, pa0, pa1, pa2, pa3); pv_one<3>(o[3], vb, pa0, pa1, pa2, pa3);
}
template <int LDQ, int LDK, int LDO>
DEV void attn_dense_body(const bf16* __restrict__ Qb, const bf16* __restrict__ Kh, const bf16* __restrict__ Vh, bf16* __restrict__ Ob, int seq, char* lds) {
  const int tid = threadIdx.x, wid = tid >> 6, lane = tid & 63, r32 = lane & 31, hi = lane >> 5;
  bf16* V_lds = (bf16*)lds; bf16* K_lds = (bf16*)(lds + 2 * SHM_V);
  float* ws = (float*)(lds + 2 * SHM_V + 2 * SHM_K) + wid * 64; float* li_l = ws; float* al_l = ws + 32;
  float m_reg = -1e30f, l_reg = 0; f32x16 o[4] = {}; bf16x8 qr[8];
  const bf16* Qw = Qb + (long)(wid * QBLK + r32) * LDQ + hi * 8;
#pragma unroll
  for (int d0 = 0; d0 < 8; ++d0) qr[d0] = *reinterpret_cast<const bf16x8*>(Qw + d0 * 16);
  const int sr = tid >> 4, sc = (tid & 15) * 8, vst0 = v_st(sr, sc), vst1 = v_st(32 + sr, sc);
  const int vb0 = (int)(uintptr_t)V_lds + v_rd_base(lane);
  struct { bf16x8 vs0, vs1, ks0, ks1; } sr_[2];
#define SLOAD(i, k0) do { sr_[i].vs0 = *reinterpret_cast<const bf16x8*>(&Vh[(long)((k0) + sr) * LDK + sc]); sr_[i].vs1 = *reinterpret_cast<const bf16x8*>(&Vh[(long)((k0) + 32 + sr) * LDK + sc]); \
    sr_[i].ks0 = *reinterpret_cast<const bf16x8*>(&Kh[(long)((k0) + sr) * LDK + sc]); sr_[i].ks1 = *reinterpret_cast<const bf16x8*>(&Kh[(long)((k0) + 32 + sr) * LDK + sc]); } while (0)
#define SWRITE(b, i) do { *(bf16x8*)((char*)V_lds + (b) * SHM_V + vst0) = sr_[i].vs0;          \
    *(bf16x8*)((char*)V_lds + (b) * SHM_V + vst1) = sr_[i].vs1; int kc = sc * 2;               \
    *(bf16x8*)((char*)K_lds + (b) * SHM_K + KSWZ(sr, kc)) = sr_[i].ks0;                       \
    *(bf16x8*)((char*)K_lds + (b) * SHM_K + KSWZ(32 + sr, kc)) = sr_[i].ks1; } while (0)
#define SWAIT() asm volatile("s_waitcnt vmcnt(4)" ::: "memory")
#define RESC(a) do { if (__any((a) < 1.f)) { if (hi == 0) al_l[r32] = (a); asm volatile("s_waitcnt lgkmcnt(0)" ::: "memory"); \
    for (int d = 0; d < 4; ++d) for (int r = 0; r < 16; ++r) o[d][r] *= al_l[crow(r, hi)]; } } while (0)
  f32x16 pA0, pA1, pB0, pB1; float mnA, mnB, alA, alB; bf16x8 pa0, pa1, pa2, pa3; const int NT = seq / KVBLK;
  constexpr int SE = 0, SO = 1;
  SLOAD(SE, 0); asm volatile("s_waitcnt vmcnt(0)" ::: "memory"); SWRITE(0, SE); __syncthreads();
  qkt(pA0, pA1, K_lds, qr, r32, hi); partialSM(pA0, pA1, m_reg, mnA, alA);
  SLOAD(SO, KVBLK); if (2 < NT) SLOAD(SE, 2 * KVBLK);
  SWAIT(); SWRITE(1, SO); __syncthreads();
  for (int j = 1; j + 1 < NT; j += 2) {
    SBAR(); qkt(pB0, pB1, (bf16*)((char*)K_lds + SHM_K), qr, r32, hi);
    finishSM(pA0, pA1, alA, l_reg, pa0, pa1, pa2, pa3); SBAR();
    SLOAD(SO, (j + 2) * KVBLK); SBAR();
    pv_d0(o, vb0, pa0, pa1, pa2, pa3); partialSM(pB0, pB1, m_reg, mnB, alB);
    __syncthreads(); SWAIT(); SWRITE(0, SE);
    RESC(alB); __syncthreads();
    SBAR(); qkt(pA0, pA1, K_lds, qr, r32, hi);
    finishSM(pB0, pB1, alB, l_reg, pa0, pa1, pa2, pa3); SBAR();
    if (j + 3 < NT) SLOAD(SE, (j + 3) * KVBLK); SBAR();
    pv_d0(o, vb0 + (int)SHM_V, pa0, pa1, pa2, pa3); partialSM(pA0, pA1, m_reg, mnA, alA);
    __syncthreads(); SWAIT(); SWRITE(1, SO);
    RESC(alA); __syncthreads();
  }
  SBAR(); qkt(pB0, pB1, (bf16*)((char*)K_lds + SHM_K), qr, r32, hi);
  finishSM(pA0, pA1, alA, l_reg, pa0, pa1, pa2, pa3); SBAR();
  pv_d0(o, vb0, pa0, pa1, pa2, pa3); partialSM(pB0, pB1, m_reg, mnB, alB);
  __syncthreads(); RESC(alB);
  finishSM(pB0, pB1, alB, l_reg, pa0, pa1, pa2, pa3); SBAR();
  pv_d0(o, vb0 + (int)SHM_V, pa0, pa1, pa2, pa3);
  if (hi == 0) li_l[r32] = l_reg; asm volatile("s_waitcnt lgkmcnt(0)" ::: "memory");
  float rli[16];
#pragma unroll
  for (int r = 0; r < 16; ++r) rli[r] = __builtin_amdgcn_rcpf(li_l[crow(r, hi)]);
  bf16* Ow = Ob + (long)(wid * QBLK) * LDO;
#pragma unroll
  for (int r = 0; r < 16; ++r) { int orow = crow(r, hi);
    for (int d0 = 0; d0 < 4; ++d0) Ow[(long)orow * LDO + d0 * 32 + r32] = f2bf(o[d0][r] * rli[r]); }
  __syncthreads();
#undef SLOAD
#undef SWRITE
#undef SWAIT
#undef RESC
}
#undef KSWZ
}

#define XB_TMO      128
#define XB_XCNT(j)  (256  + 64 * (j))
#define XB_XSUB(j)  (1280 + 64 * (j))
#define XB_XGEN(j)  (2304 + 64 * (j))
#define XB_TOP      3328
#define XB_TOPGEN   3392
#define XCD_BAR_WORDS 3456
#define XB_SPIN_CAP (1u << 18)
DEV unsigned xb_ld(unsigned* p)              { return __hip_atomic_load(p, __ATOMIC_RELAXED, __HIP_MEMORY_SCOPE_AGENT); }
DEV unsigned xb_add(unsigned* p, unsigned v) { return __hip_atomic_fetch_add(p, v, __ATOMIC_RELAXED, __HIP_MEMORY_SCOPE_AGENT); }
DEV unsigned xb_xcc_id() { return (unsigned)__builtin_amdgcn_s_getreg((3 << 11) | 20) & 0xFu; }
#define XB_SPIN(cond, bar) do { unsigned _sp = 0; while (cond) { __builtin_amdgcn_s_sleep(1); \
    if ((++_sp & 255u) == 0u) { if (xb_ld(&(bar)[XB_TMO])) break; if (_sp > XB_SPIN_CAP) { atomicAdd(&(bar)[XB_TMO], 1u); break; } } } } while (0)
struct XcdBarrier { unsigned* bar; unsigned x; volatile LAS unsigned* st; };
DEV XcdBarrier xcd_barrier_post(unsigned* bar, volatile LAS unsigned* st) {
    XcdBarrier b; b.bar = bar; b.x = xb_xcc_id(); b.st = st;
    if (threadIdx.x == 0) (void)xb_add(&bar[XB_XCNT(b.x)], 1u);
    return b;
}
DEV void xcd_barrier_complete(unsigned* bar, unsigned x, unsigned& nloc, unsigned& nx) {
    const unsigned G = gridDim.x * gridDim.y * gridDim.z;
    unsigned sum, cnt, mine, sp = 0u;
    for (;;) {
        sum = 0u; cnt = 0u; mine = 0u;
#pragma unroll
        for (unsigned j = 0; j < 16; ++j) { const unsigned c = xb_ld(&bar[XB_XCNT(j)]); sum += c; cnt += (c > 0u) ? 1u : 0u; mine = (j == x) ? c : mine; }
        if (sum == G) break;
        __builtin_amdgcn_s_sleep(1);
        if ((++sp & 255u) == 0u) { if (xb_ld(&bar[XB_TMO])) break; if (sp > XB_SPIN_CAP) { atomicAdd(&bar[XB_TMO], 1u); break; } }
    }
    nloc = mine > 0u ? mine : 1u; nx = cnt > 0u ? cnt : 1u;
}
DEV void xcd_barrier(const XcdBarrier& b) {
    asm volatile("s_waitcnt vmcnt(0)" ::: "memory");
    __syncthreads();
    if (threadIdx.x == 0) {
        unsigned* bar = b.bar;
        __builtin_amdgcn_s_waitcnt(0);
        unsigned nloc = b.st[0], nx = b.st[1];
        if (nloc == 0u) { xcd_barrier_complete(bar, b.x, nloc, nx); b.st[0] = nloc; b.st[1] = nx; }
        const unsigned old = xb_add(&bar[XB_XSUB(b.x)], 1u);
        const unsigned gen = old / nloc;
        if (old + 1u == (gen + 1u) * nloc) {
            __builtin_amdgcn_fence(__ATOMIC_RELEASE, "agent");
            asm volatile("s_waitcnt vmcnt(0)" ::: "memory");
            const unsigned og = xb_add(&bar[XB_TOP], 1u);
            const unsigned tg = og / nx;
            if (og + 1u == (tg + 1u) * nx) xb_add(&bar[XB_TOPGEN], 1u);
            else XB_SPIN(xb_ld(&bar[XB_TOPGEN]) == tg, bar);
            __builtin_amdgcn_fence(__ATOMIC_ACQUIRE, "agent");
            xb_add(&bar[XB_XGEN(b.x)], 1u);
            asm volatile("s_waitcnt vmcnt(0)" ::: "memory");
        } else {
            XB_SPIN(xb_ld(&bar[XB_XGEN(b.x)]) == gen, bar);
            __builtin_amdgcn_fence(__ATOMIC_ACQUIRE, "agent");
            asm volatile("s_waitcnt vmcnt(0)" ::: "memory");
        }
    }
    __syncthreads();
}

struct Args { const float* in[28]; float* out; unsigned char* ws; int ph_lo, ph_hi; };
enum { I_X = 0, I_C, I_CTX, I_CCTX, I_MODW, I_MODB, I_NPRE, I_NPOST, I_FG, I_FU, I_FD, I_EVIN, I_EVOUT, I_CONVW, I_CONVB, I_WA, I_BA, I_WX, I_BX, I_LAM, I_DECAY, I_GN,
       I_ODIN, I_ODOUT, I_POOLW, I_POOLS, I_QN, I_KN };
struct Frame {
    LAS unsigned char* lds; int tid, lane, wave, G, bid;
    const Args* a;
};
#define LDS_WAIT() asm volatile("s_waitcnt lgkmcnt(0)" ::: "memory")

DEV void transpose_item(const float* W, int K, int N, bf16* WT, int drow0, LAS float* scr, int kb, int nb, int lane) {
    const int k0 = 64 * kb, n0 = 32 * nb;
#pragma unroll 8
    for (int i = 0; i < 32; ++i) { const int kk = 2 * i + (lane >> 5); scr[kk * 33 + (lane & 31)] = W[(size_t)(k0 + kk) * N + n0 + (lane & 31)]; }
    LDS_WAIT(); asm volatile("" ::: "memory");
    const int c = lane & 7;
#pragma unroll
    for (int j = 0; j < 4; ++j) { const int n = (lane >> 3) + 8 * j; const LAS float* s = scr + (8 * c) * 33 + n;
        u32x4 o; o.x = pkbf(s[0 * 33], s[1 * 33]); o.y = pkbf(s[2 * 33], s[3 * 33]); o.z = pkbf(s[4 * 33], s[5 * 33]); o.w = pkbf(s[6 * 33], s[7 * 33]);
        *(u32x4*)(WT + (size_t)(drow0 + n) * K + k0 + 8 * c) = o; }
    LDS_WAIT(); asm volatile("" ::: "memory");
}
DEV void p0_prologue(const Frame& F) {
    const Args& A = *F.a; unsigned char* ws = A.ws;
    {
        LAS float* ssc = (LAS float*)F.lds;
        LAS float* red = (LAS float*)(F.lds + 40960);
        for (int i = F.tid; i < 5 * DM; i += 512) { const int r = i / DM, k = i % DM; const float v = (r < 4) ? A.in[I_C][r * DM + k] : A.in[I_CCTX][k]; ssc[i] = fsilu(v); }
        __syncthreads();
        float* MOD = (float*)(ws + WS_MOD);
        for (int it = F.bid; it < 288; it += F.G) {
            const int li = it / 144, col0 = (it % 144) * 128;
            const float* Wp = A.in[I_MODW] + (size_t)li * DM * 18432 + (size_t)(F.wave * 256) * 18432 + col0 + 2 * F.lane;
            f32x2 acc[5];
#pragma unroll
            for (int r = 0; r < 5; ++r) acc[r] = (f32x2){0.f, 0.f};
#pragma unroll 8
            for (int kk = 0; kk < 256; ++kk) { const f32x2 wv = *(const f32x2*)(Wp + (size_t)kk * 18432);
#pragma unroll
                for (int r = 0; r < 5; ++r) { const float s = ssc[r * DM + F.wave * 256 + kk]; acc[r] += wv * s; } }
#pragma unroll
            for (int r = 0; r < 5; ++r) { red[(F.wave * 5 + r) * 128 + 2 * F.lane] = acc[r].x; red[(F.wave * 5 + r) * 128 + 2 * F.lane + 1] = acc[r].y; }
            __syncthreads();
            for (int o = F.tid; o < 640; o += 512) { const int r = o >> 7, c = o & 127; float s = A.in[I_MODB][li * 18432 + col0 + c];
#pragma unroll
                for (int w = 0; w < 8; ++w) s += red[(w * 5 + r) * 128 + c];
                MOD[(size_t)(li * 5 + r) * 18432 + col0 + c] = s; }
            __syncthreads();
        }
    }
    {
        LAS float* scr = (LAS float*)(F.lds + F.wave * 16384);
        const int gw = F.bid * 8 + F.wave, NGW = F.G * 8;
        constexpr int I_FFN = 5632, N_FFN = 12 * I_FFN, I_EI = 32 * 192, I_EO = 32 * 64, I_OI = 32 * 96, I_OO = 32 * 64, I_SM = 8 * 36;
        constexpr int NITEMS = N_FFN + I_EI + I_EO + I_OI + I_OO + I_SM;
        for (int it = gw; it < NITEMS; it += NGW) {
            int r = it;
            if (r < N_FFN) { const int idx = r / I_FFN, item = r % I_FFN, lf = idx / 3, kind = idx % 3;
                if (kind < 2) { const float* W = A.in[kind == 0 ? I_FG : I_FU] + (size_t)lf * DM * DFF; const int nb = item % 176, kb = item / 176, n0 = 32 * nb;
                    transpose_item(W, DM, DFF, (bf16*)(ws + WS_WGU + (size_t)lf * 44 * MiB), 256 * (n0 / 128) + 128 * kind + (n0 % 128), scr, kb, nb, F.lane); }
                else { const float* W = A.in[I_FD] + (size_t)lf * DFF * DM; const int nb = item % 64, kb = item / 64;
                    transpose_item(W, DFF, DM, (bf16*)(ws + WS_WD + (size_t)lf * 22 * MiB), 32 * nb, scr, kb, nb, F.lane); }
                continue; }
            r -= N_FFN;
            if (r < I_EI) { const int nb = r % 192, kb = r / 192, n0 = 32 * nb, blk = n0 / 1024;
                const int dblk = (blk == 1) ? 5 : (blk == 5) ? 1 : blk;
                transpose_item(A.in[I_EVIN], DM, EVN, (bf16*)(ws + WS_WEVIN), dblk * 1024 + (n0 % 1024), scr, kb, nb, F.lane); continue; }
            r -= I_EI;
            if (r < I_EO) { const int nb = r % 64, kb = r / 64; transpose_item(A.in[I_EVOUT], DM, DM, (bf16*)(ws + WS_WEVOUT), 32 * nb, scr, kb, nb, F.lane); continue; }
            r -= I_EO;
            if (r < I_OI) { const int nb = r % 96, kb = r / 96; transpose_item(A.in[I_ODIN], DM, ODN, (bf16*)(ws + WS_WODIN), 32 * nb, scr, kb, nb, F.lane); continue; }
            r -= I_OI;
            if (r < I_OO) { const int nb = r % 64, kb = r / 64; transpose_item(A.in[I_ODOUT], DM, DM, (bf16*)(ws + WS_WODOUT), 32 * nb, scr, kb, nb, F.lane); continue; }
            r -= I_OO;
            { const int mat = r / 8, item = r % 8, nb = item % 4, kb = item / 4;
                const float* W; bf16* dst;
                if (mat < 16) { W = A.in[I_WA] + (size_t)mat * 16384; dst = (bf16*)(ws + WS_LRUW) + (size_t)mat * 16384; }
                else if (mat < 32) { W = A.in[I_WX] + (size_t)(mat - 16) * 16384; dst = (bf16*)(ws + WS_LRUW) + (size_t)mat * 16384; }
                else { W = A.in[I_POOLW] + (size_t)(mat - 32) * 16384; dst = (bf16*)(ws + WS_POOLW) + (size_t)(mat - 32) * 16384; }
                transpose_item(W, 128, 128, dst, 32 * nb, scr, kb, nb, F.lane); }
        }
    }
    {
        const int gt = F.bid * 512 + F.tid, NT = F.G * 512;
        float* c1 = (float*)(ws + WS_COS1); float* s1 = (float*)(ws + WS_SIN1); float* c2 = (float*)(ws + WS_COS2); float* s2 = (float*)(ws + WS_SIN2);
        for (int i = gt; i < SEQ * 128 + SEQ * 64; i += NT) {
            float pos, f; float* cd; float* sd;
            if (i < SEQ * 128) { const int t = i >> 7, k = i & 127; pos = (float)t; f = exp2f(-(float)k * (13.287712379549449f / 128.f)); cd = c1 + i; sd = s1 + i; }
            else { const int j = i - SEQ * 128, t = j >> 6, k = j & 63; pos = (k < 32) ? (float)(t >> 6) : (float)(t & 63); f = exp2f(-(float)(k & 31) * (13.287712379549449f / 32.f)); cd = c2 + j; sd = s2 + j; }
            const float ang = pos * f;
            double rev = (double)ang * 0.15915494309189535; rev -= __builtin_rint(rev);
            const float fr = (float)rev;
            *cd = __builtin_amdgcn_cosf(fr); *sd = __builtin_amdgcn_sinf(fr);
        }
    }
}

struct ResCfg { int has_res, has_next, li, sub, li2, sub2, nrows; float wres; const float* xold_l; const float* xold_c; float* xnew_l; float* xnew_c; const float* part; };
DEV void res_rows(const Frame& F, const ResCfg& C, int m0, int cnt, int prow) {
    const Args& A = *F.a; const float* MOD = (const float*)(A.ws + WS_MOD); bf16* H = (bf16*)(A.ws + WS_H);
    f32x4 Ca[8], Cb[8], Cs[8];
    int e0 = 4 * F.lane; asm volatile("" : "+v"(e0));
    if (C.has_res) {
        const float* gate = MOD + (size_t)(C.li * 5 + prow) * 18432 + C.sub * 6144 + 4096; const float* gp = A.in[I_NPOST] + (C.li * 3 + C.sub) * DM;
#pragma unroll
        for (int j = 0; j < 8; ++j) Ca[j] = *(const f32x4*)(gate + 256 * j + e0) * *(const f32x4*)(gp + 256 * j + e0) * C.wres;
    }
    if (C.has_next) {
        const float* sh = MOD + (size_t)(C.li2 * 5 + prow) * 18432 + C.sub2 * 6144; const float* sc = sh + 2048; const float* gp = A.in[I_NPRE] + (C.li2 * 3 + C.sub2) * DM;
#pragma unroll
        for (int j = 0; j < 8; ++j) { Cb[j] = *(const f32x4*)(gp + 256 * j + e0) * (*(const f32x4*)(sc + 256 * j + e0) + 1.f); Cs[j] = *(const f32x4*)(sh + 256 * j + e0); }
    }
    for (int m = m0; m < m0 + cnt; ++m) {
        const float* xo = (m < ML) ? C.xold_l + (size_t)m * DM : C.xold_c + (size_t)(m - ML) * DM;
        f32x4 x[8];
#pragma unroll
        for (int j = 0; j < 8; ++j) x[j] = *(const f32x4*)(xo + 256 * j + e0);
        if (C.has_res) {
            f32x4 yy[8];
            if (C.part && m >= ML) { const float* pr = C.part + (size_t)(m - ML) * DM;
#pragma unroll
                for (int j = 0; j < 8; ++j) yy[j] = (*(const f32x4*)(pr + 256 * j + e0) + *(const f32x4*)(pr + (size_t)MC * DM + 256 * j + e0)) + (*(const f32x4*)(pr + (size_t)2 * MC * DM + 256 * j + e0) + *(const f32x4*)(pr + (size_t)3 * MC * DM + 256 * j + e0)); }
            else { const bf16* yr = H + (size_t)m * DM;
#pragma unroll
                for (int j = 0; j < 8; ++j) { const u32x2 yv = *(const u32x2*)(yr + 256 * j + e0); yy[j] = (f32x4){bflo(yv.x), bfhi(yv.x), bflo(yv.y), bfhi(yv.y)}; } }
            float ss = 0.f;
#pragma unroll
            for (int j = 0; j < 8; ++j) ss += (yy[j].x * yy[j].x + yy[j].y * yy[j].y) + (yy[j].z * yy[j].z + yy[j].w * yy[j].w);
            const float rs = __builtin_amdgcn_rsqf(wave_sum(ss) * (1.f / DM) + EPS);
            float* xn = (m < ML) ? C.xnew_l + (size_t)m * DM : C.xnew_c + (size_t)(m - ML) * DM;
#pragma unroll
            for (int j = 0; j < 8; ++j) { x[j] = x[j] + Ca[j] * (yy[j] * rs); *(f32x4*)(xn + 256 * j + e0) = x[j]; }
        }
        if (C.has_next) {
            float ss = 0.f;
#pragma unroll
            for (int j = 0; j < 8; ++j) ss += (x[j].x * x[j].x + x[j].y * x[j].y) + (x[j].z * x[j].z + x[j].w * x[j].w);
            const float rs = __builtin_amdgcn_rsqf(wave_sum(ss) * (1.f / DM) + EPS);
            bf16* hr = H + (size_t)m * DM;
#pragma unroll
            for (int j = 0; j < 8; ++j) { const f32x4 h = x[j] * rs * Cb[j] + Cs[j]; u32x2 w; w.x = pkbf(h.x, h.y); w.y = pkbf(h.z, h.w); *(u32x2*)(hr + 256 * j + e0) = w; }
        }
    }
}
DEV void res_phase(const Frame& F, const ResCfg& C) {
    const int gw = F.bid * 8 + F.wave, NGW = F.G * 8;
    for (int blk = gw; blk < ML / 16; blk += NGW) res_rows(F, C, blk * 16, 16, (blk * 16) / SEQ);
    if (C.nrows > ML) {
        if (NGW >= 2 * MC) { if ((gw & 1) == 0 && (gw >> 1) < MC) res_rows(F, C, ML + (gw >> 1), 1, 4); }
        else { const int per = (MC + NGW - 1) / NGW, r0 = gw * per, cnt = (MC - r0) < per ? (MC - r0) : per; if (cnt > 0) res_rows(F, C, ML + r0, cnt, 4); }
    }
}

constexpr int LRU_UB = 0, LRU_UB_LD = 272, LRU_ARR = 17408, LRU_ARR_SZ = 32768;
DEV int lru_chunk_row0(int b, int ck) { return (ck < 4) ? ML + b * CTXL + 64 * ck : b * SEQ + 64 * (ck - 4); }
DEV float one_minus_exp(float t) {
    const float ser = -t * (1.f + t * 0.5f * (1.f + t * (1.f / 3.f) * (1.f + t * 0.25f * (1.f + t * 0.2f * (1.f + t * (1.f / 6.f))))));
    return (t > -0.25f) ? ser : 1.f - fexp(t);
}
template <bool FINAL> DEV void lru_phase(const Frame& F, bool dry = false) {
    const Args& A = *F.a; unsigned char* ws = A.ws; bf16* E = (bf16*)(ws + WS_E);
    const int tid = F.tid, wave = F.wave, lane = F.lane, r32 = lane & 31, hh = lane >> 5;
    LAS unsigned char* UB = F.lds + LRU_UB; LAS float* ARR = (LAS float*)(F.lds + LRU_ARR); LAS unsigned char* RS = F.lds + LRU_ARR;
    const int slot = F.bid & 31, n = slot & 7, b = slot >> 3, ck0 = F.bid >> 5, ckst = (F.G + 31) >> 5;
    if (F.bid >= 32 * ckst) return;
    u32x4 rp[3];
#define LRU_LOAD(ck_) do { const int L_ = ((ck_) < 4) ? CTXL : SEQ, p0_ = ((ck_) < 4) ? 64 * (ck_) : 64 * ((ck_) - 4), rb_ = ((ck_) < 4) ? ML + b * CTXL : b * SEQ; \
        _Pragma("unroll") for (int i_ = 0; i_ < 3; ++i_) { const int pc = tid + 512 * i_, rr = pc >> 4, c8 = pc & 15, pos = p0_ - 2 + rr; \
            rp[i_] = (u32x4){0u, 0u, 0u, 0u}; if (pc < 67 * 16 && pos >= 0 && pos < L_) rp[i_] = *(const u32x4*)(E + (size_t)(rb_ + pos) * EVN + EC_R + 128 * n + 8 * c8); } } while (0)
    if (ck0 < NCH64) LRU_LOAD(ck0);
    const int c8t = tid & 15, cht = 128 * n + 8 * c8t;
    float cw[4][8], cb[8];
#pragma unroll
    for (int i = 0; i < 8; ++i) cb[i] = A.in[I_CONVB][cht + i];
#pragma unroll
    for (int k = 0; k < 4; ++k)
#pragma unroll
        for (int i = 0; i < 8; ++i) cw[k][i] = A.in[I_CONVW][k * 1024 + cht + i];
    const int gd = wave >> 2, cq = wave & 3, gcol = 32 * cq + r32, gchn = 128 * n + gcol;
    bf16x8 fa[8], fx[8];
    { const bf16* WA = (const bf16*)(ws + WS_LRUW) + (size_t)(gd * 8 + n) * 16384 + (size_t)gcol * 128 + 8 * hh; const bf16* WX = WA + (size_t)16 * 16384;
#pragma unroll
      for (int ks = 0; ks < 8; ++ks) { fa[ks] = *(const bf16x8*)(WA + 16 * ks); fx[ks] = *(const bf16x8*)(WX + 16 * ks); } }
    const float gba = A.in[I_BA][gd * 1024 + gchn], gbx = A.in[I_BX][gd * 1024 + gchn], sp8 = -8.f * log1pf(expf(-A.in[I_LAM][gd * 1024 + gchn]));
    for (int ck = ck0; ck < NCH64; ck += ckst) {
        const int p0 = (ck < 4) ? 64 * ck : 64 * (ck - 4), rowbase = (ck < 4) ? ML + b * CTXL : b * SEQ;
        const int sd = (tid >> 7) & 1, sc = tid & 127; const size_t gi = ((size_t)(ck * NB + b) * 2 + sd) * 1024 + 128 * n + sc;
        float hcar = 0.f; if (FINAL && tid < 256) hcar = ((const float*)(ws + WS_CAR))[gi];
        u32x4 gv[2];
        if (FINAL) {
#pragma unroll
            for (int i = 0; i < 2; ++i) { const int pc = tid + 512 * i, tt = pc >> 4; gv[i] = *(const u32x4*)(E + (size_t)(rowbase + p0 + tt) * EVN + EC_G + 128 * n + 8 * c8t); } }
#pragma unroll
        for (int i = 0; i < 3; ++i) { const int pc = tid + 512 * i, rr = pc >> 4, c8 = pc & 15; if (pc < 67 * 16) *(LAS u32x4*)(RS + rr * 256 + c8 * 16) = rp[i]; }
        __syncthreads();
#pragma unroll
        for (int i2 = 0; i2 < 2; ++i2) { const int pc = tid + 512 * i2, tt = pc >> 4;
            float u[8];
#pragma unroll
            for (int i = 0; i < 8; ++i) u[i] = cb[i];
#pragma unroll
            for (int k = 0; k < 4; ++k) { const u32x4 rv = *(const LAS u32x4*)(RS + (tt + k) * 256 + c8t * 16);
                u[0] += cw[k][0] * bflo(rv.x); u[1] += cw[k][1] * bfhi(rv.x); u[2] += cw[k][2] * bflo(rv.y); u[3] += cw[k][3] * bfhi(rv.y);
                u[4] += cw[k][4] * bflo(rv.z); u[5] += cw[k][5] * bfhi(rv.z); u[6] += cw[k][6] * bflo(rv.w); u[7] += cw[k][7] * bfhi(rv.w); }
            u32x4 o = {pkbf(u[0], u[1]), pkbf(u[2], u[3]), pkbf(u[4], u[5]), pkbf(u[6], u[7])};
            *(LAS u32x4*)(UB + tt * LRU_UB_LD + c8t * 16) = o; }
        __syncthreads();
        if (ck + ckst < NCH64) LRU_LOAD(ck + ckst);
        {
            f32x16 aa[2] = {f32x16{}, f32x16{}}, ax[2] = {f32x16{}, f32x16{}};
#pragma unroll
            for (int ks = 0; ks < 8; ++ks) {
#pragma unroll
                for (int rt = 0; rt < 2; ++rt) { const bf16x8 af = *(const LAS bf16x8*)(UB + (32 * rt + r32) * LRU_UB_LD + (16 * ks + 8 * hh) * 2);
                    aa[rt] = __builtin_amdgcn_mfma_f32_32x32x16_bf16(af, fa[ks], aa[rt], 0, 0, 0); ax[rt] = __builtin_amdgcn_mfma_f32_32x32x16_bf16(af, fx[ks], ax[rt], 0, 0, 0); }
            }
            LAS float* AO = ARR + (size_t)(gd * 2) * (LRU_ARR_SZ / 4); LAS float* BO = AO + LRU_ARR_SZ / 4;
#pragma unroll
            for (int rt = 0; rt < 2; ++rt)
#pragma unroll
                for (int r = 0; r < 16; ++r) { const int row = 32 * rt + crow(r, hh);
                    const float la = sp8 * fsigmoid(aa[rt][r] + gba), av = fexp(la), mlt = __builtin_amdgcn_sqrtf(one_minus_exp(2.f * la));
                    const float uv = bf2f(*(const LAS bf16*)(UB + row * LRU_UB_LD + gcol * 2));
                    AO[row * 128 + gcol] = av; BO[row * 128 + gcol] = mlt * fsigmoid(ax[rt][r] + gbx) * uv; }
        }
        __syncthreads();
        if (tid < 256) { LAS float* AO = ARR + (size_t)(sd * 2) * (LRU_ARR_SZ / 4); const LAS float* BO = AO + LRU_ARR_SZ / 4;
            if (!FINAL) { float h = 0.f, P = 1.f;
#pragma unroll 8
                for (int s = 0; s < 64; ++s) { const int tt = sd ? 63 - s : s; const float a = AO[tt * 128 + sc]; h = a * h + BO[tt * 128 + sc]; P *= a; }
                ((f32x2*)(ws + WS_AGG))[gi] = (f32x2){P, h}; }
            else { float h = hcar;
#pragma unroll 8
                for (int s = 0; s < 64; ++s) { const int tt = sd ? 63 - s : s; h = AO[tt * 128 + sc] * h + BO[tt * 128 + sc]; AO[tt * 128 + sc] = h; } }
        }
        __syncthreads();
        if (FINAL) {
            const LAS float* H0 = ARR; const LAS float* H1 = ARR + 2 * (LRU_ARR_SZ / 4);
#pragma unroll
            for (int i2 = 0; i2 < 2; ++i2) { const int pc = tid + 512 * i2, tt = pc >> 4;
                const f32x4 h0a = *(const LAS f32x4*)(H0 + tt * 128 + 8 * c8t), h0b = *(const LAS f32x4*)(H0 + tt * 128 + 8 * c8t + 4), h1a = *(const LAS f32x4*)(H1 + tt * 128 + 8 * c8t), h1b = *(const LAS f32x4*)(H1 + tt * 128 + 8 * c8t + 4);
                const f32x4 sa = h0a + h1a, sb = h0b + h1b; const u32x4 g4 = gv[i2];
                u32x4 w = {pkbf(fgelu_tanh(bflo(g4.x)) * sa.x, fgelu_tanh(bfhi(g4.x)) * sa.y), pkbf(fgelu_tanh(bflo(g4.y)) * sa.z, fgelu_tanh(bfhi(g4.y)) * sa.w),
                           pkbf(fgelu_tanh(bflo(g4.z)) * sb.x, fgelu_tanh(bfhi(g4.z)) * sb.y), pkbf(fgelu_tanh(bflo(g4.w)) * sb.z, fgelu_tanh(bfhi(g4.w)) * sb.w)};
                bf16* wp = dry ? (bf16*)(ws + WS_H) + (size_t)(rowbase + p0 + tt) * DM + 128 * n + 8 * c8t : E + (size_t)(rowbase + p0 + tt) * EVN + EC_G + 128 * n + 8 * c8t; *(u32x4*)wp = w; }
            __syncthreads();
        }
    }
#undef LRU_LOAD
}
DEV void lru_carry_phase(const Frame& F) {
    unsigned char* ws = F.a->ws; const f32x2* AGG = (const f32x2*)(ws + WS_AGG); float* CAR = (float*)(ws + WS_CAR);
    const int gw = F.bid * 8 + F.wave, NGW = F.G * 8;
    for (int it = gw; it < NB * 2 * 16; it += NGW) { const int cg = it & 15, d = (it >> 4) & 1, b = it >> 5;
        float h = 0.f;
#pragma unroll 12
        for (int idx = 0; idx < NCH64; ++idx) { const int ck = d ? (idx < 4 ? 3 - idx : NCH64 + 3 - idx) : idx;
            const size_t gi = ((size_t)(ck * NB + b) * 2 + d) * 1024 + 64 * cg + F.lane; const f32x2 v = AGG[gi]; CAR[gi] = h; h = v.x * h + v.y; }
    }
}

DEV int ret_chunk_row0(int b, int cid) { return (cid < 2) ? ML + b * CTXL + 128 * cid : b * SEQ + 128 * (cid - 2); }
DEV int ret_chain(int d, int idx) { return d ? (idx < 2 ? 1 - idx : NCH128 + 1 - idx) : idx; }
DEV float ret_logg(const Args& A, int d, int h) { const float lg = A.in[I_DECAY][d * 4 + h]; return -log1pf(expf(-lg)); }
constexpr int RET_LD = 528, RET_VLD = 80;
DEV void ret_state_phase(const Frame& F) {
    const Args& A = *F.a; unsigned char* ws = A.ws; const bf16* E = (const bf16*)(ws + WS_E); bf16* SB = (bf16*)(ws + WS_SBUF);
    const int tid = F.tid, lane = F.lane, wave = F.wave, r32 = lane & 31, hh = lane >> 5;
    LAS unsigned char* KS = F.lds; LAS unsigned char* VS = F.lds + 128 * RET_LD;
    for (int it = F.bid; it < 256; it += F.G) {
        const int es = it & 7, d = (it >> 3) & 1, h = (it >> 4) & 3, b = it >> 6;
        const float lg = ret_logg(A, d, h), sdec = expf(lg * 128.f);
        const int vrow = tid >> 2, vc4 = tid & 3; const float vw = expf(lg * (float)(d ? vrow : 127 - vrow));
        u32x4 kreg[8], vreg;
        f32x16 acc = f32x16{};
#define RS_LOAD(cid_) do { const int m0_ = ret_chunk_row0(b, cid_); \
            _Pragma("unroll") for (int i = 0; i < 8; ++i) { const int id = tid + 512 * i, row = id >> 5, c16 = id & 31; kreg[i] = *(const u32x4*)(E + (size_t)(m0_ + row) * EVN + EC_K + 256 * h + 8 * c16); } \
            vreg = *(const u32x4*)(E + (size_t)(m0_ + vrow) * EVN + EC_V + 256 * h + 32 * es + 8 * vc4); } while (0)
        RS_LOAD(ret_chain(d, 0));
        for (int idx = 0; idx < NCH128; ++idx) {
            const int cid = ret_chain(d, idx);
#pragma unroll
            for (int i = 0; i < 8; ++i) { const int id = tid + 512 * i, row = id >> 5, c16 = id & 31; *(LAS u32x4*)(KS + row * RET_LD + c16 * 16) = kreg[i]; }
            { u32x4 w; w.x = pkbf(bflo(vreg.x) * vw, bfhi(vreg.x) * vw); w.y = pkbf(bflo(vreg.y) * vw, bfhi(vreg.y) * vw); w.z = pkbf(bflo(vreg.z) * vw, bfhi(vreg.z) * vw); w.w = pkbf(bflo(vreg.w) * vw, bfhi(vreg.w) * vw);
              *(LAS u32x4*)(VS + vrow * RET_VLD + vc4 * 16) = w; }
            __syncthreads();
            if (idx + 1 < NCH128) RS_LOAD(ret_chain(d, idx + 1));
            { bf16* sp = SB + ((size_t)(((b * 4 + h) * 2 + d) * NCH128 + cid) * 256 + 32 * es + r32) * 256 + 32 * wave + 4 * hh;
#pragma unroll
              for (int g = 0; g < 4; ++g) { u32x2 w; w.x = pkbf(acc[4 * g], acc[4 * g + 1]); w.y = pkbf(acc[4 * g + 2], acc[4 * g + 3]); *(u32x2*)(sp + 8 * g) = w; } }
#pragma unroll
            for (int r = 0; r < 16; ++r) acc[r] *= sdec;
#pragma unroll
            for (int ks = 0; ks < 8; ++ks) { const bf16x8 af = tr_frag(KS, RET_LD, 16 * ks, 32 * wave, lane); const bf16x8 bfr = tr_frag(VS, RET_VLD, 16 * ks, 0, lane);
                acc = __builtin_amdgcn_mfma_f32_32x32x16_bf16(af, bfr, acc, 0, 0, 0); }
            __syncthreads();
        }
#undef RS_LOAD
    }
}
DEV void ret_out_phase(const Frame& F, bool dry = false) {
    const Args& A = *F.a; unsigned char* ws = A.ws; bf16* E = (bf16*)(ws + WS_E); const bf16* SB = (const bf16*)(ws + WS_SBUF);
    const int wave = F.wave, ib = wave & 3, eh = wave >> 2;
    LAS unsigned char* RA = F.lds; LAS unsigned char* RB = F.lds + 128 * RET_LD; LAS float* GX = (LAS float*)(F.lds + 2 * 128 * RET_LD);
    constexpr int PLD = 272;
    for (int it = F.bid; it < 16 * NCH128; it += F.G) {
        int tid = F.tid; asm volatile("" : "+v"(tid)); int lane = tid & 63;
        const int r32 = lane & 31, hh = lane >> 5;
        const int cid = it % NCH128, bh = it / NCH128, h = bh & 3, b = bh >> 2, m0 = ret_chunk_row0(b, cid);
        const float lg0 = ret_logg(A, 0, h), lg1 = ret_logg(A, 1, h);
        bf16x8 qf[16];
        { const bf16* qp = E + (size_t)(m0 + 32 * ib + r32) * EVN + EC_Q + 256 * h + 8 * hh;
#pragma unroll
          for (int ks = 0; ks < 16; ++ks) qf[ks] = *(const bf16x8*)(qp + 16 * ks); }
        f32x16 o[4];
#pragma unroll
        for (int et = 0; et < 4; ++et) o[et] = f32x16{};
#pragma unroll 1
        for (int d = 0; d < 2; ++d) {
            const bf16* sp = SB + (size_t)((bh * 2 + d) * NCH128 + cid) * 65536; const float lgd = d ? lg1 : lg0;
            __syncthreads();
#pragma unroll
            for (int hb = 0; hb < 2; ++hb) { u32x4 tmp[8];
#pragma unroll
                for (int i = 0; i < 8; ++i) { const int id = tid + 512 * (8 * hb + i), row = id >> 5, c16 = id & 31; tmp[i] = *(const u32x4*)(sp + (size_t)row * 256 + 8 * c16); }
                asm volatile("" ::: "memory");
#pragma unroll
                for (int i = 0; i < 8; ++i) { const int id = tid + 512 * (8 * hb + i), row = id >> 5, c16 = id & 31; *(LAS u32x4*)(RA + row * RET_LD + c16 * 16) = tmp[i]; }
                asm volatile("" ::: "memory"); }
            __syncthreads();
#pragma unroll
            for (int et = 0; et < 4; ++et) { f32x16 T = f32x16{};
                const LAS unsigned char* bp = RA + (128 * eh + 32 * et + r32) * RET_LD + 16 * hh;
#pragma unroll
                for (int ks = 0; ks < 16; ++ks) { const bf16x8 bfr = *(const LAS bf16x8*)(bp + 32 * ks); T = __builtin_amdgcn_mfma_f32_32x32x16_bf16(qf[ks], bfr, T, 0, 0, 0); }
#pragma unroll
                for (int r = 0; r < 16; ++r) { const int i = 32 * ib + crow(r, hh); const float rs = fexp(lgd * (float)(d ? 128 - i : i + 1)); o[et][r] += T[r] * rs; } }
        }
        __syncthreads();
        int tid2 = tid; asm volatile("" : "+v"(tid2));
#pragma unroll
        for (int kv = 0; kv < 2; ++kv) { u32x4 tmp[8];
#pragma unroll
            for (int i = 0; i < 8; ++i) { const int id = tid2 + 512 * i, row = id >> 5, c16 = id & 31; tmp[i] = *(const u32x4*)(E + (size_t)(m0 + row) * EVN + (kv ? EC_V : EC_K) + 256 * h + 8 * c16); }
            asm volatile("" ::: "memory");
#pragma unroll
            for (int i = 0; i < 8; ++i) { const int id = tid2 + 512 * i, row = id >> 5, c16 = id & 31; *(LAS u32x4*)((kv ? RB : RA) + row * RET_LD + c16 * 16) = tmp[i]; }
            asm volatile("" ::: "memory"); }
        __syncthreads();
        u32x2 pw[2][4];
        { const int i = 32 * ib + r32;
#pragma unroll
          for (int jj = 0; jj < 2; ++jj) { const int jt = 2 * eh + jj;
            f32x16 X = f32x16{};
#pragma unroll
            for (int ks = 0; ks < 16; ++ks) { const bf16x8 af = *(const LAS bf16x8*)(RA + (32 * jt + r32) * RET_LD + (16 * ks + 8 * hh) * 2); X = __builtin_amdgcn_mfma_f32_32x32x16_bf16(af, qf[ks], X, 0, 0, 0); }
#pragma unroll
            for (int g = 0; g < 4; ++g) { float pv[4];
#pragma unroll
                for (int q = 0; q < 4; ++q) { const int j = 32 * jt + 8 * g + 4 * hh + q; const int dl = i - j; const float f = (dl > 0) ? fexp(lg0 * (float)dl) : (dl < 0) ? fexp(-lg1 * (float)dl) : 2.f; pv[q] = X[4 * g + q] * f; }
                pw[jj][g].x = pkbf(pv[0], pv[1]); pw[jj][g].y = pkbf(pv[2], pv[3]); } } }
        __syncthreads();
        { const int i = 32 * ib + r32;
#pragma unroll
          for (int jj = 0; jj < 2; ++jj)
#pragma unroll
            for (int g = 0; g < 4; ++g) *(LAS u32x2*)(RA + i * PLD + (32 * (2 * eh + jj) + 8 * g + 4 * hh) * 2) = pw[jj][g]; }
        __syncthreads();
#pragma unroll
        for (int ks = 0; ks < 8; ++ks) { const bf16x8 pa = *(const LAS bf16x8*)(RA + (32 * ib + r32) * PLD + (16 * ks + 8 * hh) * 2);
#pragma unroll
            for (int et = 0; et < 4; ++et) { const bf16x8 bfr = tr_frag(RB, RET_LD, 16 * ks, 128 * eh + 32 * et, lane); o[et] = __builtin_amdgcn_mfma_f32_32x32x16_bf16(pa, bfr, o[et], 0, 0, 0); } }
#pragma unroll
        for (int r = 0; r < 16; ++r) { float a = 0.f, q = 0.f;
#pragma unroll
            for (int et = 0; et < 4; ++et) { a += o[et][r]; q += o[et][r] * o[et][r]; }
#pragma unroll
            for (int off = 1; off < 32; off <<= 1) { a += __shfl_xor(a, off); q += __shfl_xor(q, off); }
            if (r32 == 0) { GX[(wave * 32 + crow(r, hh)) * 2] = a; GX[(wave * 32 + crow(r, hh)) * 2 + 1] = q; } }
        __syncthreads();
        { const float* gn = A.in[I_GN] + 256 * h + 128 * eh;
#pragma unroll
          for (int r = 0; r < 16; ++r) { const int rw = crow(r, hh); const float a = GX[(wave * 32 + rw) * 2] + GX[((wave ^ 4) * 32 + rw) * 2], q = GX[(wave * 32 + rw) * 2 + 1] + GX[((wave ^ 4) * 32 + rw) * 2 + 1];
            const float mean = a * (1.f / 256.f), var = q * (1.f / 256.f) - mean * mean, rstd = __builtin_amdgcn_rsqf(var + EPS);
            bf16* op = E + (size_t)(m0 + 32 * ib + rw) * EVN + EC_O + 256 * h + 128 * eh + r32;
#pragma unroll
            for (int et = 0; et < 4; ++et) { const float og = bf2f(op[32 * et]); bf16* wp = dry ? (bf16*)(ws + WS_H) + (size_t)(m0 + 32 * ib + rw) * DM + 1024 + 256 * h + 128 * eh + r32 : op;
                wp[32 * et] = f2bf((o[et][r] - mean) * rstd * gn[32 * et + r32] * fsilu(og)); } } }
    }
    __syncthreads();
}
DEV void odd_post_phase(const Frame& F) {
    const Args& A = *F.a; unsigned char* ws = A.ws; const bf16* E2 = (const bf16*)(ws + WS_E2);
    bf16* QB = (bf16*)(ws + WS_QB); bf16* KB = (bf16*)(ws + WS_KB); bf16* VB = (bf16*)(ws + WS_VB); bf16* MIX = (bf16*)(ws + WS_MIX2);
    const float* c2 = (const float*)(ws + WS_COS2); const float* s2 = (const float*)(ws + WS_SIN2);
    const int tid = F.tid, wave = F.wave;
    {
        const int gw = F.bid * 8 + F.wave, NGW = F.G * 8; const int lane0 = F.lane;
        const float qg1 = A.in[I_QN][lane0], qg2 = A.in[I_QN][64 + lane0], kg1 = A.in[I_KN][lane0], kg2 = A.in[I_KN][64 + lane0];
        for (int m = gw; m < MT; m += NGW) {
            int lane = F.lane; asm volatile("" : "+v"(lane));
            const bool lat = m < ML; const int b = lat ? m / SEQ : (m - ML) / CTXL, t = lat ? m % SEQ : 0, kpos = lat ? CTXL + t : (m - ML) % CTXL;
            const bf16* er = E2 + (size_t)m * ODN;
            float cs = 1.f, sn = 0.f; if (lat) { cs = c2[t * 64 + lane]; sn = s2[t * 64 + lane]; }
            if (lat) {
#pragma unroll 4
                for (int hq = 0; hq < 12; ++hq) { const float x1 = bf2f(er[512 + 128 * hq + lane]), x2 = bf2f(er[512 + 128 * hq + 64 + lane]);
                    const float rs = __builtin_amdgcn_rsqf(wave_sum(x1 * x1 + x2 * x2) * (1.f / 128.f) + EPS); const float y1 = x1 * rs * qg1, y2 = x2 * rs * qg2;
                    bf16* qo = QB + (size_t)m * 1536 + 128 * hq; qo[lane] = f2bf(y1 * cs - y2 * sn); qo[64 + lane] = f2bf(y1 * sn + y2 * cs); }
            }
            bf16* ko = KB + ((size_t)b * KVL + kpos) * 512; bf16* vo = VB + ((size_t)b * KVL + kpos) * 512;
#pragma unroll
            for (int hk = 0; hk < 4; ++hk) { const float x1 = bf2f(er[2048 + 128 * hk + lane]), x2 = bf2f(er[2048 + 128 * hk + 64 + lane]);
                const float rs = __builtin_amdgcn_rsqf(wave_sum(x1 * x1 + x2 * x2) * (1.f / 128.f) + EPS); const float y1 = x1 * rs * kg1, y2 = x2 * rs * kg2;
                ko[128 * hk + lane] = f2bf(y1 * cs - y2 * sn); ko[128 * hk + 64 + lane] = f2bf(y1 * sn + y2 * cs); }
            *(u32x4*)(vo + 8 * lane) = *(const u32x4*)(er + 2560 + 8 * lane);
        }
    }
    {
        const int lane = F.lane, r32 = lane & 31, hh = lane >> 5;
        LAS unsigned char* XS = F.lds; LAS unsigned char* DS = F.lds + 144 * 256; constexpr int DLD = 272;
        for (int it = F.bid; it < (ML / 128) * 4; it += F.G) {
            const int gi = it & 3, rt = it >> 2, b = (rt * 128) / SEQ, t0 = (rt * 128) % SEQ, half = 1 << gi;
            __syncthreads();
            for (int pc = tid; pc < 144 * 16; pc += 512) { const int rr = pc >> 4, c8 = pc & 15, pos = t0 - 8 + rr;
                u32x4 v = {0u, 0u, 0u, 0u}; if (pos >= 0 && pos < SEQ) v = *(const u32x4*)(E2 + (size_t)(b * SEQ + pos) * ODN + 128 * gi + 8 * c8);
                *(LAS u32x4*)(XS + rr * 256 + c8 * 16) = v; }
            __syncthreads();
            for (int pc = tid; pc < 128 * 16; pc += 512) { const int tt = pc >> 4, c8 = pc & 15, t = t0 + tt;
                const int lo = (t - half) < 0 ? 0 : t - half, hi = (t + half) > SEQ ? SEQ : t + half; const float inv = 1.f / (float)(hi - lo);
                float s[8] = {0.f, 0.f, 0.f, 0.f, 0.f, 0.f, 0.f, 0.f};
                for (int p = lo; p < hi; ++p) { const u32x4 v = *(const LAS u32x4*)(XS + (p - t0 + 8) * 256 + c8 * 16);
                    s[0] += bflo(v.x); s[1] += bfhi(v.x); s[2] += bflo(v.y); s[3] += bfhi(v.y); s[4] += bflo(v.z); s[5] += bfhi(v.z); s[6] += bflo(v.w); s[7] += bfhi(v.w); }
                const u32x4 xv = *(const LAS u32x4*)(XS + (tt + 8) * 256 + c8 * 16);
                u32x4 o; o.x = pkbf(s[0] * inv - bflo(xv.x), s[1] * inv - bfhi(xv.x)); o.y = pkbf(s[2] * inv - bflo(xv.y), s[3] * inv - bfhi(xv.y));
                o.z = pkbf(s[4] * inv - bflo(xv.z), s[5] * inv - bfhi(xv.z)); o.w = pkbf(s[6] * inv - bflo(xv.w), s[7] * inv - bfhi(xv.w));
                *(LAS u32x4*)(DS + tt * DLD + c8 * 16) = o; }
            __syncthreads();
            { const int rb = wave & 3, chh = wave >> 2; const bf16* WT = (const bf16*)(ws + WS_POOLW) + (size_t)gi * 16384;
              f32x16 acc[2] = {f32x16{}, f32x16{}};
#pragma unroll
              for (int ks = 0; ks < 8; ++ks) { const bf16x8 af = *(const LAS bf16x8*)(DS + (32 * rb + r32) * DLD + (16 * ks + 8 * hh) * 2);
#pragma unroll
                  for (int ct = 0; ct < 2; ++ct) { const bf16x8 bfr = *(const bf16x8*)(WT + (size_t)(64 * chh + 32 * ct + r32) * 128 + 16 * ks + 8 * hh);
                      acc[ct] = __builtin_amdgcn_mfma_f32_32x32x16_bf16(af, bfr, acc[ct], 0, 0, 0); } }
#pragma unroll
              for (int ct = 0; ct < 2; ++ct) { const int col = 128 * gi + 64 * chh + 32 * ct + r32; const float ps = A.in[I_POOLS][col];
#pragma unroll
                  for (int r = 0; r < 16; ++r) MIX[(size_t)(b * SEQ + t0 + 32 * rb + crow(r, hh)) * DM + col] = f2bf(acc[ct][r] * ps); } }
        }
        __syncthreads();
    }
}
DEV void attn_phase(const Frame& F) {
    unsigned char* ws = F.a->ws; const bf16* QB = (const bf16*)(ws + WS_QB); const bf16* KB = (const bf16*)(ws + WS_KB); const bf16* VB = (const bf16*)(ws + WS_VB); bf16* MIX = (bf16*)(ws + WS_MIX2);
    for (int u = F.bid; u < NB * 12 * (SEQ / 256); u += F.G) {
        const int qb = u & 31, g = (u >> 5) % 3, kvh = ((u >> 5) / 3) & 3, b = (u >> 5) / 12, hq = kvh * 3 + g;
        att::attn_dense_body<1536, 512, DM>(QB + (size_t)(b * SEQ + 256 * qb) * 1536 + 128 * hq, KB + (size_t)b * KVL * 512 + 128 * kvh, VB + (size_t)b * KVL * 512 + 128 * kvh,
                                           MIX + (size_t)(b * SEQ + 256 * qb) * DM + 512 + 128 * hq, KVL, (char*)F.lds);
    }
}

constexpr int NPH = 25;
__global__ void __launch_bounds__(512, 2) mk_fwd(Args args) {
    extern __shared__ __attribute__((aligned(16))) unsigned char lds_raw[];
    Frame F; F.lds = (LAS unsigned char*)lds_raw; F.tid = threadIdx.x; F.lane = F.tid & 63; F.wave = __builtin_amdgcn_readfirstlane(F.tid >> 6); F.G = gridDim.x; F.bid = blockIdx.x; F.a = &args;
    unsigned char* ws = args.ws;
    volatile LAS unsigned* MISC = (volatile LAS unsigned*)(F.lds + MISC_OFF);
    if (F.tid < 64) MISC[F.tid] = 0u;
    __syncthreads();
    XcdBarrier bar; bar.bar = (unsigned*)(ws + WS_CTL) + CW_BAR; bar.x = 0; bar.st = nullptr;
    const int lo = args.ph_lo, hi = args.ph_hi;
    if (hi - lo > 1) bar = xcd_barrier_post((unsigned*)(ws + WS_CTL) + CW_BAR, MISC + 8);
#ifndef MK_MASK
#define MK_MASK 0xFFFFFFFFu
#endif
#define IN(k) (((MK_MASK >> (k)) & 1u) && lo <= (k) && (k) < hi && (k) <= MK_STOP_AFTER)
#define SEAM(k) do { if (IN(k) && (k) + 1 < hi) xcd_barrier(bar); } while (0)
#ifndef MK_DOUBLE
#define MK_DOUBLE 0u
#endif
#ifndef MK_STAMP
#define MK_STAMP (-1)
#endif
#define PHASE(k) do { if ((k) == MK_STAMP) t_stamp0 = wall_clock64(); if (IN(k)) { PH_BODY_##k; if ((MK_DOUBLE >> (k)) & 1u) { xcd_barrier(bar); PH_BODY_##k; } } SEAM(k); if ((k) == MK_STAMP) t_stamp1 = wall_clock64(); } while (0)
    bf16* H = (bf16*)(ws + WS_H); bf16* ACT = (bf16*)(ws + WS_ACT); bf16* E = (bf16*)(ws + WS_E); bf16* E2 = (bf16*)(ws + WS_E2); bf16* MIX2 = (bf16*)(ws + WS_MIX2);
    float* XC = (float*)(ws + WS_XC); float* PART = (float*)(ws + WS_PART);
#define GEMM_GU(lf, M_) do { pg8::Gemm g{H, (const bf16*)(ws + WS_WGU + (size_t)(lf) * 44 * MiB), (M_), 2 * DFF, DM, DM}; pg8::StaticOrder S; S.init((M_), 2 * DFF, F.G, F.bid); \
        pg8::EpiSwiGLU Ep{ACT, DFF}; pg8::gemm_phase<pg8::EpiSwiGLU, pg8::StaticOrder, PG8_ALIGN, PG8_SP2>(F.lds, g, S, Ep); } while (0)
#define GEMM_DN(lf, M_) do { pg8::Gemm g{ACT, (const bf16*)(ws + WS_WD + (size_t)(lf) * 22 * MiB), (M_), DM, DFF, DFF}; pg8::TailSplitOrder S; S.init(ML, (M_) - ML, DM, F.G, F.bid, 4); \
        pg8::EpiPlainSplit Ep{H, DM, PART, ML, MC}; pg8::gemm_phase<pg8::EpiPlainSplit, pg8::TailSplitOrder, PG8_ALIGN, PG8_SP2>(F.lds, g, S, Ep); } while (0)
#define RES(hr, hn, li_, sub_, li2_, sub2_, nrows_, w_, xol, xoc, part_) do { ResCfg C{(hr), (hn), (li_), (sub_), (li2_), (sub2_), (nrows_), (w_), (xol), (xoc), args.out, XC, (part_)}; res_phase(F, C); } while (0)

    unsigned long long t_stamp0 = 0, t_stamp1 = 0;
#define PH_BODY_0 p0_prologue(F)
    PHASE(0);
#define PH_BODY_1 RES(0, 1, 0, 0, 0, 0, MT, 0.f, args.in[I_X], args.in[I_CTX], nullptr);
    PHASE(1);
#ifdef MK_GSTAMP
#define PH_BODY_2 { pg8::Gemm g{H, (const bf16*)(ws + WS_WGU), MT, 2 * DFF, DM, DM}; pg8::StaticOrder S; S.init(MT, 2 * DFF, F.G, F.bid); \
        pg8::EpiSwiGLU Ep{ACT, DFF}; const unsigned gstv = pg8::gemm_phase<pg8::EpiSwiGLU, pg8::StaticOrder, PG8_ALIGN, PG8_SP2>(F.lds, g, S, Ep); if (F.bid == 0 && F.tid == 0) ((unsigned*)(ws + WS_CTL))[64] = gstv; }
#else
#define PH_BODY_2 GEMM_GU(0, MT)
#endif
    PHASE(2);
#define PH_BODY_3 GEMM_DN(0, MT)
    PHASE(3);
#define PH_BODY_4 RES(1, 1, 0, 0, 0, 1, MT, 0.5f, args.in[I_X], args.in[I_CTX], PART)
    PHASE(4);
#define PH_BODY_5 { pg8::Gemm g{H, (const bf16*)(ws + WS_WEVIN), MT, EVN, DM, DM}; pg8::StaticOrder S; S.init(MT, EVN, F.G, F.bid); \
        pg8::EpiEvIn Ep{E, (const float*)(ws + WS_COS1), (const float*)(ws + WS_SIN1)}; pg8::gemm_phase<pg8::EpiEvIn, pg8::StaticOrder, PG8_ALIGN, PG8_SP2>(F.lds, g, S, Ep); }
    PHASE(5);
#define PH_BODY_6 lru_phase<false>(F)
    PHASE(6);
#define PH_BODY_7 { lru_carry_phase(F); ret_state_phase(F); }
    PHASE(7);
#ifndef MK_P8
#define MK_P8 3
#endif
#ifndef MK_DRY8
#define MK_DRY8 0
#endif
#define PH_BODY_8 { if (MK_DRY8 & 1) { lru_phase<true>(F, true); xcd_barrier(bar); } if (MK_DRY8 & 2) { ret_out_phase(F, true); xcd_barrier(bar); } if (MK_P8 & 1) lru_phase<true>(F); if (MK_P8 & 2) ret_out_phase(F); }
    PHASE(8);
#define PH_BODY_9 { pg8::Gemm g{E, (const bf16*)(ws + WS_WEVOUT), MT, DM, DM, EVN}; pg8::TailSplitOrder S; S.init(ML, MC, DM, F.G, F.bid, 4); \
        pg8::EpiPlainSplit Ep{H, DM, PART, ML, MC}; pg8::gemm_phase<pg8::EpiPlainSplit, pg8::TailSplitOrder, PG8_ALIGN, PG8_SP2>(F.lds, g, S, Ep); }
    PHASE(9);
#define PH_BODY_10 RES(1, 1, 0, 1, 0, 2, MT, 1.0f, args.out, XC, PART)
    PHASE(10);
#define PH_BODY_11 GEMM_GU(1, MT)
    PHASE(11);
#define PH_BODY_12 GEMM_DN(1, MT)
    PHASE(12);
#define PH_BODY_13 RES(1, 1, 0, 2, 1, 0, MT, 0.5f, args.out, XC, PART)
    PHASE(13);
#define PH_BODY_14 GEMM_GU(2, MT)
    PHASE(14);
#define PH_BODY_15 GEMM_DN(2, MT)
    PHASE(15);
#define PH_BODY_16 RES(1, 1, 1, 0, 1, 1, MT, 0.5f, args.out, XC, PART)
    PHASE(16);
#define PH_BODY_17 { pg8::Gemm g{H, (const bf16*)(ws + WS_WODIN), MT, ODN, DM, DM}; pg8::StaticOrder S; S.init(MT, ODN, F.G, F.bid); \
        pg8::EpiPlain Ep{E2, ODN}; pg8::gemm_phase<pg8::EpiPlain, pg8::StaticOrder, PG8_ALIGN, PG8_SP2>(F.lds, g, S, Ep); }
    PHASE(17);
#define PH_BODY_18 odd_post_phase(F)
    PHASE(18);
#define PH_BODY_19 attn_phase(F)
    PHASE(19);
#define PH_BODY_20 { pg8::Gemm g{MIX2, (const bf16*)(ws + WS_WODOUT), ML, DM, DM, DM}; pg8::StaticOrder S; S.init(ML, DM, F.G, F.bid); \
        pg8::EpiPlain Ep{H, DM}; pg8::gemm_phase<pg8::EpiPlain, pg8::StaticOrder, PG8_ALIGN, PG8_SP2>(F.lds, g, S, Ep); }
    PHASE(20);
#define PH_BODY_21 RES(1, 1, 1, 1, 1, 2, ML, 1.0f, args.out, XC, nullptr)
    PHASE(21);
#define PH_BODY_22 GEMM_GU(3, ML)
    PHASE(22);
#define PH_BODY_23 GEMM_DN(3, ML)
    PHASE(23);
#define PH_BODY_24 RES(1, 0, 1, 2, 0, 0, ML, 0.5f, args.out, XC, nullptr)
    PHASE(24);
#ifdef MK_GSTAMP
    if (F.bid == 0 && F.tid == 0) args.out[0] = 64.f * floorf((float)((const unsigned*)(ws + WS_CTL))[64] * 0.01f / 64.f + 0.5f);
#endif
    if (MK_STAMP >= 0 && F.bid == 0 && F.tid == 0) args.out[0] = 64.f * floorf((float)(t_stamp1 - t_stamp0) * 0.01f / 64.f + 0.5f);
#undef IN
#undef SEAM
}

extern "C" void kernel_launch(void* const* d_in, const int* in_sizes, int n_in, void* d_out, int out_size, void* d_ws, size_t ws_size, hipStream_t stream) {
    static int grid = 0;
    if (grid == 0) {
        if (n_in != 28 || out_size != ML * DM || ws_size < WS_END) { fprintf(stderr, "kernel_launch: unexpected shapes (n_in %d out %d ws %zu, need ws >= %zu)\n", n_in, out_size, ws_size, (size_t)WS_END); grid = -1; return; }
        int dev = 0, cus = 0, per_cu = 0;
        if (hipGetDevice(&dev) != hipSuccess || hipDeviceGetAttribute(&cus, hipDeviceAttributeMultiprocessorCount, dev) != hipSuccess) { grid = -1; return; }
        if (hipFuncSetAttribute((const void*)mk_fwd, hipFuncAttributeMaxDynamicSharedMemorySize, LDS_BYTES) != hipSuccess) { fprintf(stderr, "kernel_launch: hipFuncSetAttribute failed\n"); grid = -1; return; }
        if (hipOccupancyMaxActiveBlocksPerMultiprocessor(&per_cu, (const void*)mk_fwd, 512, LDS_BYTES) != hipSuccess || per_cu < 1) fprintf(stderr, "kernel_launch: occupancy query says %d\n", per_cu);
        (void)hipGetLastError();
        grid = cus;
    }
    if (grid < 0) return;
    (void)hipMemsetAsync((char*)d_ws + WS_CTL, 0, CTL_ZERO_BYTES, stream);
    Args a{};
    for (int i = 0; i < 28; ++i) a.in[i] = (const float*)d_in[i];
    a.out = (float*)d_out; a.ws = (unsigned char*)d_ws;
#if MK_N_LAUNCHES == 1
    a.ph_lo = 0; a.ph_hi = NPH;
    hipLaunchKernelGGL(mk_fwd, dim3(grid), dim3(512), LDS_BYTES, stream, a);
#else
    for (int p = 0; p < NPH && p <= MK_STOP_AFTER; ++p) { a.ph_lo = p; a.ph_hi = p + 1; hipLaunchKernelGGL(mk_fwd, dim3(grid), dim3(512), LDS_BYTES, stream, a); }
#endif
    const hipError_t le = hipPeekAtLastError();
    if (le != hipSuccess) fprintf(stderr, "kernel_launch: launch failed: %s\n", hipGetErrorName(le));
}
```

```cpp
#include <hip/hip_runtime.h>
#include <cstdio>
#include <cstdint>

#ifndef MK_N_LAUNCHES
#define MK_N_LAUNCHES 1
#endif
#ifndef MK_STOP_AFTER
#define MK_STOP_AFTER 1000
#endif

#define DEV __device__ __forceinline__
#define LAS __attribute__((address_space(3)))
typedef unsigned short bf16;
typedef float f32x4 __attribute__((ext_vector_type(4)));
typedef float f32x2 __attribute__((ext_vector_type(2)));
typedef float f32x16 __attribute__((ext_vector_type(16)));
typedef short bf16x8 __attribute__((ext_vector_type(8)));
typedef short s16x4 __attribute__((ext_vector_type(4)));
typedef unsigned u32x4 __attribute__((ext_vector_type(4)));
typedef unsigned u32x2 __attribute__((ext_vector_type(2)));

constexpr int NB = 4, SEQ = 8192, DM = 2048, CTXL = 256, DFF = 5632;
constexpr int ML = NB * SEQ, MC = NB * CTXL, MT = ML + MC;
constexpr float EPS = 1e-6f;
constexpr int EVN = 6144, ODN = 3072;
constexpr int EC_G = 0, EC_O = 1024, EC_Q = 2048, EC_K = 3072, EC_V = 4096, EC_R = 5120;
constexpr int NCH64 = (CTXL + SEQ) / 64;
constexpr int NCH128 = (CTXL + SEQ) / 128;
constexpr int KVL = CTXL + SEQ;

constexpr size_t MiB = 1u << 20;
constexpr size_t WS_CTL = 0, CTL_ZERO_BYTES = 1 * MiB;
constexpr size_t WS_MOD = 1 * MiB;
constexpr size_t WS_COS1 = 2 * MiB, WS_SIN1 = 6 * MiB;
constexpr size_t WS_COS2 = 10 * MiB, WS_SIN2 = 12 * MiB;
constexpr size_t WS_LRUW = 14 * MiB;
constexpr size_t WS_POOLW = 15 * MiB;
constexpr size_t WS_AGG = 16 * MiB;
constexpr size_t WS_CAR = 25 * MiB;
constexpr size_t WS_XC = 30 * MiB;
constexpr size_t WS_W = 40 * MiB;
constexpr size_t WS_WGU = WS_W;
constexpr size_t WS_WD = WS_W + 176 * MiB;
constexpr size_t WS_WEVIN = WS_W + 264 * MiB;
constexpr size_t WS_WEVOUT = WS_W + 288 * MiB;
constexpr size_t WS_WODIN = WS_W + 296 * MiB;
constexpr size_t WS_WODOUT = WS_W + 308 * MiB;
constexpr size_t WS_H = 356 * MiB;
constexpr size_t WS_BIG = 488 * MiB;
constexpr size_t WS_ACT = WS_BIG;
constexpr size_t WS_E = WS_BIG;
constexpr size_t WS_SBUF = WS_BIG + 396 * MiB;
constexpr size_t WS_PART = WS_BIG + 400 * MiB;
constexpr size_t WS_E2 = WS_BIG;
constexpr size_t WS_QB = WS_BIG + 198 * MiB;
constexpr size_t WS_KB = WS_BIG + 294 * MiB;
constexpr size_t WS_VB = WS_BIG + 327 * MiB;
constexpr size_t WS_MIX2 = WS_BIG + 360 * MiB;
constexpr size_t WS_END = 1148 * MiB;
constexpr int CW_BAR = 4096;

constexpr int LDS_BYTES = 159744;
constexpr int MISC_OFF = LDS_BYTES - 256;

DEV float bflo(unsigned w) { return __uint_as_float(w << 16); }
DEV float bfhi(unsigned w) { return __uint_as_float(w & 0xffff0000u); }
DEV float bf2f(bf16 b) { return __uint_as_float((unsigned)b << 16); }
DEV unsigned pkbf(float lo, float hi) { unsigned r; asm volatile("v_cvt_pk_bf16_f32 %0, %1, %2" : "=v"(r) : "v"(lo), "v"(hi)); return r; }
DEV bf16 f2bf(float f) { return (bf16)(pkbf(f, 0.f) & 0xffffu); }
DEV float fexp(float x) { return __builtin_amdgcn_exp2f(x * 1.4426950408889634f); }
DEV float fsigmoid(float x) { return __builtin_amdgcn_rcpf(1.f + fexp(-x)); }
DEV float fsilu(float x) { return x * fsigmoid(x); }
DEV float fgelu_tanh(float x) { const float z = 0.7978845608028654f * (x + 0.044715f * x * x * x); return x * fsigmoid(2.f * z); }
DEV float wave_sum(float v) {
#pragma unroll
    for (int o = 1; o < 64; o <<= 1) v += __shfl_xor(v, o);
    return v;
}
DEV int crow(int r, int hi) { return (r & 3) + 8 * (r >> 2) + 4 * hi; }
typedef short v4i16_t __attribute__((ext_vector_type(4)));
DEV s16x4 ds_tr(const LAS unsigned char* p) { return __builtin_bit_cast(s16x4, __builtin_amdgcn_ds_read_tr16_b64_v4i16((LAS v4i16_t*)p)); }
DEV bf16x8 tr_frag(const LAS unsigned char* X, int ld, int k0, int n0, int lane) {
    const int h = lane >> 5, blk = (lane >> 4) & 1, q = (lane & 15) >> 2, p = lane & 3;
    const LAS unsigned char* a = X + (k0 + 8 * h + q) * ld + (n0 + 16 * blk + 4 * p) * 2;
    const s16x4 lo = ds_tr(a), hi = ds_tr(a + 4 * ld);
    return (bf16x8){lo[0], lo[1], lo[2], lo[3], hi[0], hi[1], hi[2], hi[3]};
}
DEV bf16x8 pack8(const float* v) { u32x4 w = {pkbf(v[0], v[1]), pkbf(v[2], v[3]), pkbf(v[4], v[5]), pkbf(v[6], v[7])}; return __builtin_bit_cast(bf16x8, w); }

namespace pg8 {
typedef unsigned short bf16_t;
constexpr int BM = 256, BK = 64, HALF = 128, HTB = HALF * BK * 2, STAGE_BYTES = 8 * HTB, NXCD = 8, WGM = 8;
__host__ __device__ __forceinline__ int lds_byte(int r, int c) { const int st = (r >> 4) * 2 + (c >> 5), rr = r & 15, cc = c & 31, ob = rr * 64 + cc * 2; return st * 1024 + (ob ^ (((ob >> 9) & 1) << 5)); }
__host__ __device__ __forceinline__ void stage_rc(int b, int& R, int& C) { const int st = b / 1024, sb = b % 1024, swz = sb ^ (((sb >> 9) & 1) << 5); R = (st >> 1) * 16 + swz / 64; C = (st & 1) * 32 + (swz % 64) / 2; }
__host__ __device__ __forceinline__ int perm32(int rho) { const int n = rho >> 4, i = rho & 15; return 8 * (i >> 2) + 4 * n + (i & 3); }
struct Unit { int pm, pn, ks, nks; };
struct Gemm { const bf16_t* A; const bf16_t* Bt; int M, N, K, lda; };
struct StaticOrder {
    int nM, nN, nwg, G, c;
    __host__ __device__ void init(int M, int N, int G_, int c_) { nM = M / BM; nN = N / BM; nwg = nM * nN; G = G_; c = c_; }
    __host__ __device__ __forceinline__ bool next(int i, Unit& u) const {
        const long L = (long)i * G + c; if (L >= nwg) return false;
        int wgid = (int)L; { const int q = nwg / NXCD, r = nwg % NXCD, xcd = wgid % NXCD, off = wgid / NXCD; wgid = (xcd < r ? xcd * (q + 1) : r * (q + 1) + (xcd - r) * q) + off; }
        const int nig = WGM * nN, gid = wgid / nig, fm = gid * WGM, gsz = (nM - fm) < WGM ? (nM - fm) : WGM;
        u.pm = fm + ((wgid % nig) % gsz); u.pn = (wgid % nig) / gsz; u.ks = 0; u.nks = 1; return true;
    }
    __device__ __forceinline__ void a_ready(const Unit&) const {}
    __device__ __forceinline__ void done(const Unit&) const {}
};
struct TailSplitOrder {
    StaticOrder full; int nMf, nMt, nN, nfull, split;
    __host__ __device__ void init(int Mfull, int Mtail, int N, int G_, int c_, int split_) { full.init(Mfull, N, G_, c_); nMf = Mfull / BM; nMt = Mtail / BM; nN = N / BM; nfull = nMf * nN; split = split_; }
    __host__ __device__ __forceinline__ bool next(int i, Unit& u) const {
        const long L = (long)i * full.G + full.c; int pm = 0, pn = 0, ks = 0, nks = 1; bool ok;
        if (L < nfull) { Unit f; ok = full.next(i, f); pm = f.pm; pn = f.pn; }
        else { const int Lp = (int)(L - nfull); ok = Lp < nMt * nN * split; const int t = Lp / split, d = nMt > 0 ? nMt : 1; ks = Lp % split; nks = split; pm = nMf + t % d; pn = t / d; }
        u.pm = pm; u.pn = pn; u.ks = ks; u.nks = nks; return ok;
    }
    __device__ __forceinline__ void a_ready(const Unit&) const {}
    __device__ __forceinline__ void done(const Unit&) const {}
};
struct EpiPlain {
    static constexpr bool PERM = true, AFTER_DRAIN = false;
    bf16_t* O; int ldc;
    __device__ __forceinline__ void operator()(const f32x4 (&acc)[2][2][4][2], const Unit& u, int wr, int wc, int fr, int fq) const {
        const int row0 = u.pm * BM + wr * 64 + fr, col0 = u.pn * BM + wc * 32 + 8 * fq;
#pragma unroll
        for (int ai = 0; ai < 2; ++ai)
#pragma unroll
            for (int m = 0; m < 4; ++m) { bf16_t* rowp = O + (size_t)(row0 + ai * HALF + m * 16) * ldc + col0;
#pragma unroll
                for (int bj = 0; bj < 2; ++bj) { const f32x4 v0 = acc[ai][bj][m][0], v1 = acc[ai][bj][m][1];
                    u32x4 w; w.x = pkbf(v0[0], v0[1]); w.y = pkbf(v0[2], v0[3]); w.z = pkbf(v1[0], v1[1]); w.w = pkbf(v1[2], v1[3]);
                    *(u32x4*)(rowp + bj * HALF) = w; } }
    }
};
struct EpiPlainSplit {
    static constexpr bool PERM = true, AFTER_DRAIN = false;
    bf16_t* O; int ldc; float* P; int prow0, prow_cnt;
    __device__ __forceinline__ void operator()(const f32x4 (&acc)[2][2][4][2], const Unit& u, int wr, int wc, int fr, int fq) const {
        const int row0 = u.pm * BM + wr * 64 + fr, col0 = u.pn * BM + wc * 32 + 8 * fq;
        if (u.nks == 1) {
#pragma unroll
            for (int ai = 0; ai < 2; ++ai)
#pragma unroll
                for (int m = 0; m < 4; ++m) { bf16_t* rowp = O + (size_t)(row0 + ai * HALF + m * 16) * ldc + col0;
#pragma unroll
                    for (int bj = 0; bj < 2; ++bj) { const f32x4 v0 = acc[ai][bj][m][0], v1 = acc[ai][bj][m][1];
                        u32x4 w; w.x = pkbf(v0[0], v0[1]); w.y = pkbf(v0[2], v0[3]); w.z = pkbf(v1[0], v1[1]); w.w = pkbf(v1[2], v1[3]);
                        *(u32x4*)(rowp + bj * HALF) = w; } }
        } else {
#pragma unroll
            for (int ai = 0; ai < 2; ++ai)
#pragma unroll
                for (int m = 0; m < 4; ++m) { float* rowp = P + ((size_t)u.ks * prow_cnt + (row0 + ai * HALF + m * 16 - prow0)) * ldc + col0;
#pragma unroll
                    for (int bj = 0; bj < 2; ++bj) { *(f32x4*)(rowp + bj * HALF) = acc[ai][bj][m][0]; *(f32x4*)(rowp + bj * HALF + 4) = acc[ai][bj][m][1]; } }
        }
    }
};
struct EpiSwiGLU {
    static constexpr bool PERM = true, AFTER_DRAIN = false;
    bf16_t* O; int ldc;
    __device__ __forceinline__ void operator()(const f32x4 (&acc)[2][2][4][2], const Unit& u, int wr, int wc, int fr, int fq) const {
        const int row0 = u.pm * BM + wr * 64 + fr, col0 = u.pn * HALF + wc * 32 + 8 * fq;
#pragma unroll
        for (int ai = 0; ai < 2; ++ai)
#pragma unroll
            for (int m = 0; m < 4; ++m) { bf16_t* rowp = O + (size_t)(row0 + ai * HALF + m * 16) * ldc + col0;
                f32x4 a0, a1;
#pragma unroll
                for (int j = 0; j < 4; ++j) { a0[j] = fsilu(acc[ai][0][m][0][j]) * acc[ai][1][m][0][j]; a1[j] = fsilu(acc[ai][0][m][1][j]) * acc[ai][1][m][1][j]; }
                u32x4 w; w.x = pkbf(a0[0], a0[1]); w.y = pkbf(a0[2], a0[3]); w.z = pkbf(a1[0], a1[1]); w.w = pkbf(a1[2], a1[3]);
                *(u32x4*)rowp = w; }
    }
};
struct EpiEvIn {
    static constexpr bool PERM = true, AFTER_DRAIN = false;
    bf16_t* O; const float* cs; const float* sn;
    __device__ __forceinline__ void operator()(const f32x4 (&acc)[2][2][4][2], const Unit& u, int wr, int wc, int fr, int fq) const {
        const int ldc = EVN; const int row0 = u.pm * BM + wr * 64 + fr, col0 = u.pn * BM + wc * 32 + 8 * fq;
        const bool qk = (u.pn >= 8 && u.pn < 16), rot = qk && (u.pm < ML / BM); const float ksc = (u.pn >= 12 && u.pn < 16) ? 0.0625f : 1.f;
#pragma unroll
        for (int ai = 0; ai < 2; ++ai)
#pragma unroll
            for (int m = 0; m < 4; ++m) { const int row = row0 + ai * HALF + m * 16; bf16_t* rowp = O + (size_t)row * ldc + col0;
                f32x4 o1[2], o2[2];
#pragma unroll
                for (int n = 0; n < 2; ++n) { const f32x4 x1 = acc[ai][0][m][n], x2 = acc[ai][1][m][n];
                    if (rot) { const int t = row & (SEQ - 1); const int i0 = wc * 32 + 8 * fq + 4 * n;
                        const f32x4 c4 = *(const f32x4*)(cs + (size_t)t * 128 + i0), s4 = *(const f32x4*)(sn + (size_t)t * 128 + i0);
                        o1[n] = (x1 * c4 - x2 * s4) * ksc; o2[n] = (x1 * s4 + x2 * c4) * ksc; }
                    else { o1[n] = x1 * ksc; o2[n] = x2 * ksc; } }
                u32x4 w; w.x = pkbf(o1[0][0], o1[0][1]); w.y = pkbf(o1[0][2], o1[0][3]); w.z = pkbf(o1[1][0], o1[1][1]); w.w = pkbf(o1[1][2], o1[1][3]);
                *(u32x4*)rowp = w;
                w.x = pkbf(o2[0][0], o2[0][1]); w.y = pkbf(o2[0][2], o2[0][3]); w.z = pkbf(o2[1][0], o2[1][1]); w.w = pkbf(o2[1][2], o2[1][3]);
                *(u32x4*)(rowp + HALF) = w; }
    }
};

template <class Epi, class Sched, bool ALIGN_EPI = false, bool SP2 = false>
__device__ __forceinline__ unsigned gemm_phase(LAS unsigned char* lds, const Gemm g, const Sched& S, const Epi& E) {
    const int tid = threadIdx.x, wid = __builtin_amdgcn_readfirstlane(tid >> 6), lane = tid & 63, wr = wid >> 2, wc = wid & 3, fr = lane & 15, fq = lane >> 4;
    const int K = g.K, nt_full = K / BK, lda = g.lda;
    unsigned voffA[2], voffB[2];
#pragma unroll
    for (int i = 0; i < 2; ++i) { int R, C; stage_rc(tid * 16 + i * 8192, R, C); const int Rb = Epi::PERM ? ((R & ~31) + perm32(R & 31)) : R;
        voffA[i] = (unsigned)(R * lda + C) * 2u; voffB[i] = (unsigned)(Rb * K + C) * 2u; }
    const size_t kstep = (size_t)(BK * 2);
    const size_t hstepA = (size_t)HALF * lda * 2, hstepB = (size_t)HALF * K * 2;
    const size_t tstepA = 2 * hstepA, tstepB = 2 * hstepB;
    const unsigned ldsw = (unsigned)wid * 1024u;
    const int aoff = lds_byte(wr * 64 + fr, fq * 8), boff = lds_byte(wc * 32 + fr, fq * 8);
#define PG8_SA(b, h) (((b) * 2 + (h)) * HTB)
#define PG8_SB(b, h) ((4 + (b) * 2 + (h)) * HTB)
#define PG8_STAGE(bufoff, gbase, voff) do { _Pragma("unroll") for (int _i = 0; _i < 2; ++_i) \
        __builtin_amdgcn_global_load_lds((const unsigned*)((const char*)(gbase) + (voff)[_i]), (LAS unsigned*)(lds + (bufoff) + ldsw + _i * 8192), 16, 0, 0); } while (0)
#define PG8_LDA(dst, b, h) do { _Pragma("unroll") for (int m = 0; m < 4; ++m) _Pragma("unroll") for (int k = 0; k < 2; ++k) dst[m][k] = *(const LAS bf16x8*)(lds + PG8_SA(b, h) + aoff + m * 2048 + k * 1024); } while (0)
#define PG8_LDB(dst, b, h) do { _Pragma("unroll") for (int n = 0; n < 2; ++n) _Pragma("unroll") for (int k = 0; k < 2; ++k) dst[n][k] = *(const LAS bf16x8*)(lds + PG8_SB(b, h) + boff + n * 2048 + k * 1024); } while (0)
#define PG8_MMA(ai, bj, At, Bt) do { __builtin_amdgcn_s_setprio(1); _Pragma("unroll") for (int m = 0; m < 4; ++m) _Pragma("unroll") for (int n = 0; n < 2; ++n) _Pragma("unroll") for (int k = 0; k < 2; ++k) \
        acc[ai][bj][m][n] = __builtin_amdgcn_mfma_f32_16x16x32_bf16(Bt[n][k], At[m][k], acc[ai][bj][m][n], 0, 0, 0); __builtin_amdgcn_s_setprio(0); } while (0)
#define PG8_WAIT_V(n) asm volatile("s_waitcnt vmcnt(" #n ")" ::: "memory")
#define PG8_WAIT_L(n) asm volatile("s_waitcnt lgkmcnt(" #n ")" ::: "memory")
#define PG8_BAR __builtin_amdgcn_s_barrier()
#define PG8_SCHED __builtin_amdgcn_sched_barrier(0)
    Unit cur, nxt; int ui = 0;
    if (!S.next(0, cur)) return 0u;
    f32x4 acc[2][2][4][2];
#pragma unroll
    for (int a = 0; a < 2; ++a)
#pragma unroll
        for (int b = 0; b < 2; ++b)
#pragma unroll
            for (int m = 0; m < 4; ++m)
#pragma unroll
                for (int n = 0; n < 2; ++n) acc[a][b][m][n] = (f32x4){0.f, 0.f, 0.f, 0.f};
    bf16x8 At[4][2], B0[2][2], B1[2][2];
    int nt = nt_full / cur.nks;
    const char* cA = (const char*)g.A + (size_t)cur.pm * tstepA + (size_t)cur.ks * (K / cur.nks) * 2; const char* cB = (const char*)g.Bt + (size_t)cur.pn * tstepB + (size_t)cur.ks * (K / cur.nks) * 2;
    S.a_ready(cur);
    if constexpr (SP2) {
        PG8_STAGE(PG8_SB(0, 0), cB, voffB); PG8_STAGE(PG8_SB(0, 1), cB + hstepB, voffB); PG8_STAGE(PG8_SA(0, 0), cA, voffA); PG8_STAGE(PG8_SA(0, 1), cA + hstepA, voffA);
        if (wr == 1) PG8_BAR;
        PG8_WAIT_V(2); PG8_BAR;
        PG8_STAGE(PG8_SB(1, 0), cB + kstep, voffB); PG8_STAGE(PG8_SA(1, 0), cA + kstep, voffA); PG8_STAGE(PG8_SB(1, 1), cB + hstepB + kstep, voffB);
        PG8_WAIT_V(6); PG8_BAR;
    } else {
        PG8_STAGE(PG8_SB(0, 0), cB, voffB); PG8_STAGE(PG8_SA(0, 0), cA, voffA); PG8_STAGE(PG8_SB(0, 1), cB + hstepB, voffB); PG8_STAGE(PG8_SA(0, 1), cA + hstepA, voffA);
        if (wr == 1) PG8_BAR;
        PG8_WAIT_V(4); PG8_BAR;
        PG8_STAGE(PG8_SB(1, 0), cB + kstep, voffB); PG8_STAGE(PG8_SA(1, 0), cA + kstep, voffA); PG8_STAGE(PG8_SB(1, 1), cB + hstepB + kstep, voffB);
        PG8_WAIT_V(6); PG8_BAR;
    }
#ifdef MK_GSTAMP
    unsigned gs_t2 = (unsigned)wall_clock64(), gs_acc = 0;
#endif
    for (;;) {
        const bool has_next = S.next(ui + 1, nxt);
        const char* nA = has_next ? (const char*)g.A + (size_t)nxt.pm * tstepA + (size_t)nxt.ks * (K / nxt.nks) * 2 : cA; const char* nB = has_next ? (const char*)g.Bt + (size_t)nxt.pn * tstepB + (size_t)nxt.ks * (K / nxt.nks) * 2 : cB;
        for (int t = 0; t < nt; t += 2) {
            const bool last = (t == nt - 2);
            const char* a1 = cA + (size_t)(t + 1) * kstep;
            const char* a2 = last ? nA : cA + (size_t)(t + 2) * kstep; const char* b2 = last ? nB : cB + (size_t)(t + 2) * kstep;
            const char* a3 = a2 + kstep; const char* b3 = b2 + kstep;
            if (last && has_next) S.a_ready(nxt);
            if constexpr (SP2) {
            PG8_LDB(B0, 0, 0); PG8_LDB(B1, 0, 1); PG8_SCHED; PG8_LDA(At, 0, 0); PG8_STAGE(PG8_SA(1, 1), a1 + hstepA, voffA);
            PG8_WAIT_V(8); PG8_WAIT_L(0); PG8_BAR; PG8_MMA(0, 0, At, B0); PG8_MMA(0, 1, At, B1); PG8_BAR; PG8_SCHED;
            PG8_LDA(At, 0, 1); PG8_STAGE(PG8_SB(0, 0), b2, voffB); PG8_STAGE(PG8_SB(0, 1), b2 + hstepB, voffB); PG8_STAGE(PG8_SA(0, 0), a2, voffA);
            PG8_WAIT_V(8); PG8_WAIT_L(0); PG8_BAR; PG8_MMA(1, 0, At, B0); PG8_MMA(1, 1, At, B1); PG8_BAR; PG8_SCHED;
            PG8_LDB(B0, 1, 0); PG8_LDB(B1, 1, 1); PG8_SCHED; PG8_LDA(At, 1, 0); PG8_STAGE(PG8_SA(0, 1), a2 + hstepA, voffA);
            PG8_WAIT_V(8); PG8_WAIT_L(0); PG8_BAR; PG8_MMA(0, 0, At, B0); PG8_MMA(0, 1, At, B1); PG8_BAR; PG8_SCHED;
            PG8_LDA(At, 1, 1); PG8_STAGE(PG8_SB(1, 0), b3, voffB); PG8_STAGE(PG8_SB(1, 1), b3 + hstepB, voffB); PG8_STAGE(PG8_SA(1, 0), a3, voffA);
            PG8_WAIT_V(8); PG8_WAIT_L(0); PG8_BAR; PG8_MMA(1, 0, At, B0); PG8_MMA(1, 1, At, B1); PG8_BAR; PG8_SCHED;
            } else {
            PG8_LDB(B0, 0, 0); PG8_SCHED; PG8_LDA(At, 0, 0); PG8_STAGE(PG8_SA(1, 1), a1 + hstepA, voffA);
            PG8_WAIT_L(8); PG8_BAR; PG8_WAIT_L(0); PG8_MMA(0, 0, At, B0); PG8_BAR; PG8_SCHED;
            PG8_LDB(B1, 0, 1); PG8_STAGE(PG8_SB(0, 0), b2, voffB);
            PG8_BAR; PG8_WAIT_L(0); PG8_MMA(0, 1, At, B1); PG8_BAR;
            PG8_LDA(At, 0, 1); PG8_STAGE(PG8_SA(0, 0), a2, voffA);
            PG8_BAR; PG8_WAIT_L(0); PG8_MMA(1, 0, At, B0); PG8_BAR; PG8_SCHED;
            PG8_STAGE(PG8_SB(0, 1), b2 + hstepB, voffB);
            PG8_WAIT_V(6); PG8_BAR; PG8_MMA(1, 1, At, B1); PG8_BAR;
            PG8_LDB(B0, 1, 0); PG8_SCHED; PG8_LDA(At, 1, 0); PG8_STAGE(PG8_SA(0, 1), a2 + hstepA, voffA);
            PG8_WAIT_L(8); PG8_BAR; PG8_WAIT_L(0); PG8_MMA(0, 0, At, B0); PG8_BAR; PG8_SCHED;
            PG8_LDB(B1, 1, 1); PG8_STAGE(PG8_SB(1, 0), b3, voffB);
            PG8_BAR; PG8_WAIT_L(0); PG8_MMA(0, 1, At, B1); PG8_BAR;
            PG8_LDA(At, 1, 1); PG8_STAGE(PG8_SA(1, 0), a3, voffA);
            PG8_BAR; PG8_WAIT_L(0); PG8_MMA(1, 0, At, B0); PG8_BAR; PG8_SCHED;
            PG8_STAGE(PG8_SB(1, 1), b3 + hstepB, voffB);
            PG8_WAIT_V(6); PG8_BAR; PG8_MMA(1, 1, At, B1); PG8_BAR;
            }
        }
#ifdef MK_GSTAMP
        const unsigned gs_t0 = (unsigned)wall_clock64(); if (MK_GSTAMP == 2) gs_acc += gs_t0 - gs_t2;
#endif
        if constexpr (ALIGN_EPI) { if (wr == 0) PG8_BAR; }
        if constexpr (!Epi::AFTER_DRAIN) { E(acc, cur, wr, wc, fr, fq); S.done(cur); }
#ifdef MK_GSTAMP
        const unsigned gs_t1 = (unsigned)wall_clock64(); if (MK_GSTAMP == 0) gs_acc += gs_t1 - gs_t0;
#endif
        if (!has_next) break;
#pragma unroll
        for (int a = 0; a < 2; ++a)
#pragma unroll
            for (int b = 0; b < 2; ++b)
#pragma unroll
                for (int m = 0; m < 4; ++m)
#pragma unroll
                    for (int n = 0; n < 2; ++n) acc[a][b][m][n] = (f32x4){0.f, 0.f, 0.f, 0.f};
        cur = nxt; cA = nA; cB = nB; ++ui; nt = nt_full / cur.nks;
        if constexpr (ALIGN_EPI) { if (wr == 1) PG8_BAR; }
#ifdef MK_GSTAMP
        gs_t2 = (unsigned)wall_clock64(); if (MK_GSTAMP == 1) gs_acc += gs_t2 - gs_t1;
#endif
    }
    PG8_WAIT_V(0);
    if constexpr (!ALIGN_EPI) { if (wr == 0) PG8_BAR; }
    PG8_BAR;
#ifdef MK_GSTAMP
    return gs_acc;
#else
    return 0u;
#endif
#undef PG8_SA
#undef PG8_SB
#undef PG8_STAGE
#undef PG8_LDA
#undef PG8_LDB
#undef PG8_MMA
#undef PG8_WAIT_V
#undef PG8_WAIT_L
#undef PG8_BAR
#undef PG8_SCHED
}
}
#define PG8_SP2 true
#define PG8_ALIGN true

namespace att {
constexpr int D = 128, NW = 8, QBLK = 32, KVBLK = 64;
constexpr float SCALE = 0.088388347648318440f;
constexpr float THR = 8.f;
constexpr size_t SHM_V = KVBLK * D * 2, SHM_K = KVBLK * D * 2, SHM_ATTN = 2 * SHM_V + 2 * SHM_K + NW * 64 * 4;
#define KSWZ(row, colB) ((row) * 256 + ((colB) ^ (((row) & 7) << 4)))
#define SBAR() __builtin_amdgcn_sched_barrier(0)
DEV void partialSM(f32x16& p0, f32x16& p1, float& m_reg, float& mn, float& alpha) {
  constexpr float C = SCALE * 1.4426950408889634f;
  float pmax = p0[0]; for (int r = 1; r < 16; ++r) pmax = fmaxf(pmax, p0[r]); for (int r = 0; r < 16; ++r) pmax = fmaxf(pmax, p1[r]);
  { auto rr = __builtin_amdgcn_permlane32_swap(__float_as_uint(pmax), __float_as_uint(pmax), false, false);
    pmax = fmaxf(__uint_as_float(rr[0]), __uint_as_float(rr[1])); }
  if (__builtin_expect(__all(pmax - m_reg <= THR / SCALE), 1)) { mn = m_reg; alpha = 1.f; }
  else { mn = fmaxf(m_reg, pmax); alpha = __builtin_amdgcn_exp2f((m_reg - mn) * C); m_reg = mn; }
  float mnC = -mn * C;
  for (int r = 0; r < 16; ++r) p0[r] = fmaf(p0[r], C, mnC); for (int r = 0; r < 16; ++r) p1[r] = fmaf(p1[r], C, mnC);
  for (int r = 0; r < 16; ++r) p0[r] = __builtin_amdgcn_exp2f(p0[r]);
}
DEV void finishSM(f32x16& p0, f32x16& p1, float alpha, float& l_reg, bf16x8& pa0, bf16x8& pa1, bf16x8& pa2, bf16x8& pa3) {
  for (int r = 0; r < 16; ++r) p1[r] = __builtin_amdgcn_exp2f(p1[r]);
  float ps = 0; for (int r = 0; r < 16; ++r) ps += p0[r]; for (int r = 0; r < 16; ++r) ps += p1[r];
  { auto rr = __builtin_amdgcn_permlane32_swap(__float_as_uint(ps), __float_as_uint(ps), false, false);
    ps = __uint_as_float(rr[0]) + __uint_as_float(rr[1]); }
  l_reg = l_reg * alpha + ps;
#define PK4(P, BASE, OUT) do { unsigned a0 = pkbf(P[BASE + 0], P[BASE + 1]), a1 = pkbf(P[BASE + 2], P[BASE + 3]);   \
    unsigned b0 = pkbf(P[BASE + 4], P[BASE + 5]), b1 = pkbf(P[BASE + 6], P[BASE + 7]);                              \
    auto r0 = __builtin_amdgcn_permlane32_swap(a0, b0, false, false); auto r1 = __builtin_amdgcn_permlane32_swap(a1, b1, false, false); \
    u32x4 w = {r0[0], r1[0], r0[1], r1[1]}; OUT = __builtin_bit_cast(bf16x8, w); } while (0)
  PK4(p0, 0, pa0); PK4(p0, 8, pa1); PK4(p1, 0, pa2); PK4(p1, 8, pa3);
#undef PK4
}
DEV void qkt(f32x16& p0, f32x16& p1, const bf16* Ks, const bf16x8* qr, int r32, int hi) {
  p0 = f32x16{}; p1 = f32x16{};
  for (int d0 = 0; d0 < 8; ++d0) { int cb = (d0 * 16 + hi * 8) * 2;
    bf16x8 b0 = *reinterpret_cast<const bf16x8*>((const char*)Ks + KSWZ(r32, cb));
    bf16x8 b1 = *reinterpret_cast<const bf16x8*>((const char*)Ks + KSWZ(32 + r32, cb));
    p0 = __builtin_amdgcn_mfma_f32_32x32x16_bf16(b0, qr[d0], p0, 0, 0, 0);
    p1 = __builtin_amdgcn_mfma_f32_32x32x16_bf16(b1, qr[d0], p1, 0, 0, 0); }
}
DEV int v_st(int k, int c) { const int kk = (k & ~0xC) | ((k & 4) << 1) | ((k & 8) >> 1); return ((kk >> 3) * 4 + (c >> 5)) * 512 + ((kk & 7) * 32 + (c & 31)) * 2; }
DEV int v_rd_base(int lane) { return ((lane & 3) << 3) | (((lane >> 2) & 3) << 6) | (((lane >> 4) & 1) << 5) | (((lane >> 5) & 1) << 8); }
constexpr int v_rd_off(int d0, int ks, int half) { return d0 * 512 + ks * 4096 + half * 2048; }
template <int OFF> DEV s16x4 tr_read(int vb) {
  s16x4 r; asm volatile("ds_read_b64_tr_b16 %0, %1 offset:%2" : "=&v"(r) : "v"(vb), "i"(OFF) : "memory"); return r;
}
template <int D0> DEV void pv_one(f32x16& od, int vb, bf16x8 pa0, bf16x8 pa1, bf16x8 pa2, bf16x8 pa3) {
  const s16x4 l0 = tr_read<v_rd_off(D0, 0, 0)>(vb), h0 = tr_read<v_rd_off(D0, 0, 1)>(vb), l1 = tr_read<v_rd_off(D0, 1, 0)>(vb), h1 = tr_read<v_rd_off(D0, 1, 1)>(vb);
  const s16x4 l2 = tr_read<v_rd_off(D0, 2, 0)>(vb), h2 = tr_read<v_rd_off(D0, 2, 1)>(vb), l3 = tr_read<v_rd_off(D0, 3, 0)>(vb), h3 = tr_read<v_rd_off(D0, 3, 1)>(vb);
  asm volatile("s_waitcnt lgkmcnt(0)" ::: "memory"); SBAR();
#define PK(L, H) (bf16x8){L[0], L[1], L[2], L[3], H[0], H[1], H[2], H[3]}
  od = __builtin_amdgcn_mfma_f32_32x32x16_bf16(pa0, PK(l0, h0), od, 0, 0, 0);
  od = __builtin_amdgcn_mfma_f32_32x32x16_bf16(pa1, PK(l1, h1), od, 0, 0, 0);
  od = __builtin_amdgcn_mfma_f32_32x32x16_bf16(pa2, PK(l2, h2), od, 0, 0, 0);
  od = __builtin_amdgcn_mfma_f32_32x32x16_bf16(pa3, PK(l3, h3), od, 0, 0, 0);
#undef PK
}
DEV void pv_d0(f32x16* o, int vb, bf16x8 pa0, bf16x8 pa1, bf16x8 pa2, bf16x8 pa3) {
  pv_one<0>(o[0], vb, pa0, pa1, pa2, pa3); pv_one<1>(o[1], vb, pa0, pa1, pa2, pa3); pv_one<2>(o[2], vb, pa0, pa1, pa2, pa3); pv_one<3>(o[3], vb, pa0, pa1, pa2, pa3);
}
template <int LDQ, int LDK, int LDO>
DEV void attn_dense_body(const bf16* __restrict__ Qb, const bf16* __restrict__ Kh, const bf16* __restrict__ Vh, bf16* __restrict__ Ob, int seq, char* lds) {
  const int tid = threadIdx.x, wid = tid >> 6, lane = tid & 63, r32 = lane & 31, hi = lane >> 5;
  bf16* V_lds = (bf16*)lds; bf16* K_lds = (bf16*)(lds + 2 * SHM_V);
  float* ws = (float*)(lds + 2 * SHM_V + 2 * SHM_K) + wid * 64; float* li_l = ws; float* al_l = ws + 32;
  float m_reg = -1e30f, l_reg = 0; f32x16 o[4] = {}; bf16x8 qr[8];
  const bf16* Qw = Qb + (long)(wid * QBLK + r32) * LDQ + hi * 8;
#pragma unroll
  for (int d0 = 0; d0 < 8; ++d0) qr[d0] = *reinterpret_cast<const bf16x8*>(Qw + d0 * 16);
  const int sr = tid >> 4, sc = (tid & 15) * 8, vst0 = v_st(sr, sc), vst1 = v_st(32 + sr, sc);
  const int vb0 = (int)(uintptr_t)V_lds + v_rd_base(lane);
  struct { bf16x8 vs0, vs1, ks0, ks1; } sr_[2];
#define SLOAD(i, k0) do { sr_[i].vs0 = *reinterpret_cast<const bf16x8*>(&Vh[(long)((k0) + sr) * LDK + sc]); sr_[i].vs1 = *reinterpret_cast<const bf16x8*>(&Vh[(long)((k0) + 32 + sr) * LDK + sc]); \
    sr_[i].ks0 = *reinterpret_cast<const bf16x8*>(&Kh[(long)((k0) + sr) * LDK + sc]); sr_[i].ks1 = *reinterpret_cast<const bf16x8*>(&Kh[(long)((k0) + 32 + sr) * LDK + sc]); } while (0)
#define SWRITE(b, i) do { *(bf16x8*)((char*)V_lds + (b) * SHM_V + vst0) = sr_[i].vs0;          \
    *(bf16x8*)((char*)V_lds + (b) * SHM_V + vst1) = sr_[i].vs1; int kc = sc * 2;               \
    *(bf16x8*)((char*)K_lds + (b) * SHM_K + KSWZ(sr, kc)) = sr_[i].ks0;                       \
    *(bf16x8*)((char*)K_lds + (b) * SHM_K + KSWZ(32 + sr, kc)) = sr_[i].ks1; } while (0)
#define SWAIT() asm volatile("s_waitcnt vmcnt(4)" ::: "memory")
#define RESC(a) do { if (__any((a) < 1.f)) { if (hi == 0) al_l[r32] = (a); asm volatile("s_waitcnt lgkmcnt(0)" ::: "memory"); \
    for (int d = 0; d < 4; ++d) for (int r = 0; r < 16; ++r) o[d][r] *= al_l[crow(r, hi)]; } } while (0)
  f32x16 pA0, pA1, pB0, pB1; float mnA, mnB, alA, alB; bf16x8 pa0, pa1, pa2, pa3; const int NT = seq / KVBLK;
  constexpr int SE = 0, SO = 1;
  SLOAD(SE, 0); asm volatile("s_waitcnt vmcnt(0)" ::: "memory"); SWRITE(0, SE); __syncthreads();
  qkt(pA0, pA1, K_lds, qr, r32, hi); partialSM(pA0, pA1, m_reg, mnA, alA);
  SLOAD(SO, KVBLK); if (2 < NT) SLOAD(SE, 2 * KVBLK);
  SWAIT(); SWRITE(1, SO); __syncthreads();
  for (int j = 1; j + 1 < NT; j += 2) {
    SBAR(); qkt(pB0, pB1, (bf16*)((char*)K_lds + SHM_K), qr, r32, hi);
    finishSM(pA0, pA1, alA, l_reg, pa0, pa1, pa2, pa3); SBAR();
    SLOAD(SO, (j + 2) * KVBLK); SBAR();
    pv_d0(o, vb0, pa0, pa1, pa2, pa3); partialSM(pB0, pB1, m_reg, mnB, alB);
    __syncthreads(); SWAIT(); SWRITE(0, SE);
    RESC(alB); __syncthreads();
    SBAR(); qkt(pA0, pA1, K_lds, qr, r32, hi);
    finishSM(pB0, pB1, alB, l_reg, pa0, pa1, pa2, pa3); SBAR();
    if (j + 3 < NT) SLOAD(SE, (j + 3) * KVBLK); SBAR();
    pv_d0(o, vb0 + (int)SHM_V, pa0, pa1, pa2, pa3); partialSM(pA0, pA1, m_reg, mnA, alA);
    __syncthreads(); SWAIT(); SWRITE(1, SO);
    RESC(alA); __syncthreads();
  }
  SBAR(); qkt(pB0, pB1, (bf16*)((char*)K_lds + SHM_K), qr, r32, hi);
  finishSM(pA0, pA1, alA, l_reg, pa0, pa1, pa2, pa3); SBAR();
  pv_d0(o, vb0, pa0, pa1, pa2, pa3); partialSM(pB0, pB1, m_reg, mnB, alB);
  __syncthreads(); RESC(alB);
  finishSM(pB0, pB1, alB, l_reg, pa0, pa1, pa2, pa3); SBAR();
  pv_d0(o, vb0 + (int)SHM_V, pa0, pa1, pa2, pa3);
  if (hi == 0) li_l[r32] = l_reg; asm volatile("s_waitcnt lgkmcnt(0)" ::: "memory");
  float rli[16];
#pragma unroll
  for (int r = 0; r < 16; ++r) rli[r] = __builtin_amdgcn_rcpf(li_l[crow(r, hi)]);
  bf16* Ow = Ob + (long)(wid * QBLK) * LDO;
#pragma unroll
  for (int r = 0; r < 16; ++r) { int orow = crow(r, hi);
    for (int d0 = 0; d0 < 4; ++d0) Ow[(long)orow * LDO + d0 * 32 + r32] = f2bf(o[d0][r] * rli[r]); }
  __syncthreads();
#undef SLOAD
#undef SWRITE
#undef SWAIT
#undef RESC
}
#undef KSWZ
}

#define XB_TMO      128
#define XB_XCNT(j)  (256  + 64 * (j))
#define XB_XSUB(j)  (1280 + 64 * (j))
#define XB_XGEN(j)  (2304 + 64 * (j))
#define XB_TOP      3328
#define XB_TOPGEN   3392
#define XCD_BAR_WORDS 3456
#define XB_SPIN_CAP (1u << 18)
DEV unsigned xb_ld(unsigned* p)              { return __hip_atomic_load(p, __ATOMIC_RELAXED, __HIP_MEMORY_SCOPE_AGENT); }
DEV unsigned xb_add(unsigned* p, unsigned v) { return __hip_atomic_fetch_add(p, v, __ATOMIC_RELAXED, __HIP_MEMORY_SCOPE_AGENT); }
DEV unsigned xb_xcc_id() { return (unsigned)__builtin_amdgcn_s_getreg((3 << 11) | 20) & 0xFu; }
#define XB_SPIN(cond, bar) do { unsigned _sp = 0; while (cond) { __builtin_amdgcn_s_sleep(1); \
    if ((++_sp & 255u) == 0u) { if (xb_ld(&(bar)[XB_TMO])) break; if (_sp > XB_SPIN_CAP) { atomicAdd(&(bar)[XB_TMO], 1u); break; } } } } while (0)
struct XcdBarrier { unsigned* bar; unsigned x; volatile LAS unsigned* st; };
DEV XcdBarrier xcd_barrier_post(unsigned* bar, volatile LAS unsigned* st) {
    XcdBarrier b; b.bar = bar; b.x = xb_xcc_id(); b.st = st;
    if (threadIdx.x == 0) (void)xb_add(&bar[XB_XCNT(b.x)], 1u);
    return b;
}
DEV void xcd_barrier_complete(unsigned* bar, unsigned x, unsigned& nloc, unsigned& nx) {
    const unsigned G = gridDim.x * gridDim.y * gridDim.z;
    unsigned sum, cnt, mine, sp = 0u;
    for (;;) {
        sum = 0u; cnt = 0u; mine = 0u;
#pragma unroll
        for (unsigned j = 0; j < 16; ++j) { const unsigned c = xb_ld(&bar[XB_XCNT(j)]); sum += c; cnt += (c > 0u) ? 1u : 0u; mine = (j == x) ? c : mine; }
        if (sum == G) break;
        __builtin_amdgcn_s_sleep(1);
        if ((++sp & 255u) == 0u) { if (xb_ld(&bar[XB_TMO])) break; if (sp > XB_SPIN_CAP) { atomicAdd(&bar[XB_TMO], 1u); break; } }
    }
    nloc = mine > 0u ? mine : 1u; nx = cnt > 0u ? cnt : 1u;
}
DEV void xcd_barrier(const XcdBarrier& b) {
    asm volatile("s_waitcnt vmcnt(0)" ::: "memory");
    __syncthreads();
    if (threadIdx.x == 0) {
        unsigned* bar = b.bar;
        __builtin_amdgcn_s_waitcnt(0);
        unsigned nloc = b.st[0], nx = b.st[1];
        if (nloc == 0u) { xcd_barrier_complete(bar, b.x, nloc, nx); b.st[0] = nloc; b.st[1] = nx; }
        const unsigned old = xb_add(&bar[XB_XSUB(b.x)], 1u);
        const unsigned gen = old / nloc;
        if (old + 1u == (gen + 1u) * nloc) {
            __builtin_amdgcn_fence(__ATOMIC_RELEASE, "agent");
            asm volatile("s_waitcnt vmcnt(0)" ::: "memory");
            const unsigned og = xb_add(&bar[XB_TOP], 1u);
            const unsigned tg = og / nx;
            if (og + 1u == (tg + 1u) * nx) xb_add(&bar[XB_TOPGEN], 1u);
            else XB_SPIN(xb_ld(&bar[XB_TOPGEN]) == tg, bar);
            __builtin_amdgcn_fence(__ATOMIC_ACQUIRE, "agent");
            xb_add(&bar[XB_XGEN(b.x)], 1u);
            asm volatile("s_waitcnt vmcnt(0)" ::: "memory");
        } else {
            XB_SPIN(xb_ld(&bar[XB_XGEN(b.x)]) == gen, bar);
            __builtin_amdgcn_fence(__ATOMIC_ACQUIRE, "agent");
            asm volatile("s_waitcnt vmcnt(0)" ::: "memory");
        }
    }
    __syncthreads();
}

struct Args { const float* in[28]; float* out; unsigned char* ws; int ph_lo, ph_hi; };
enum { I_X = 0, I_C, I_CTX, I_CCTX, I_MODW, I_MODB, I_NPRE, I_NPOST, I_FG, I_FU, I_FD, I_EVIN, I_EVOUT, I_CONVW, I_CONVB, I_WA, I_BA, I_WX, I_BX, I_LAM, I_DECAY, I_GN,
       I_ODIN, I_ODOUT, I_POOLW, I_POOLS, I_QN, I_KN };
struct Frame {
    LAS unsigned char* lds; int tid, lane, wave, G, bid;
    const Args* a;
};
#define LDS_WAIT() asm volatile("s_waitcnt lgkmcnt(0)" ::: "memory")

DEV void transpose_item(const float* W, int K, int N, bf16* WT, int drow0, LAS float* scr, int kb, int nb, int lane) {
    const int k0 = 64 * kb, n0 = 32 * nb, lr = lane >> 3, c4 = lane & 7;
    f32x4 v[8];
#pragma unroll
    for (int j = 0; j < 8; ++j) v[j] = *(const f32x4*)(W + (size_t)(k0 + lr + 8 * j) * N + n0 + 4 * c4);
#pragma unroll
    for (int j = 0; j < 8; ++j) { LAS float* d = scr + (lr + 8 * j) * 33 + 4 * c4; d[0] = v[j].x; d[1] = v[j].y; d[2] = v[j].z; d[3] = v[j].w; }
    LDS_WAIT(); asm volatile("" ::: "memory");
    const int c = lane & 7;
    float t[4][8];
#pragma unroll
    for (int j = 0; j < 4; ++j) { const LAS float* sp = scr + (8 * c) * 33 + (lane >> 3) + 8 * j;
#pragma unroll
        for (int i = 0; i < 8; ++i) t[j][i] = sp[i * 33]; }
#pragma unroll
    for (int j = 0; j < 4; ++j) { const int n = (lane >> 3) + 8 * j;
        u32x4 o; o.x = pkbf(t[j][0], t[j][1]); o.y = pkbf(t[j][2], t[j][3]); o.z = pkbf(t[j][4], t[j][5]); o.w = pkbf(t[j][6], t[j][7]);
        *(u32x4*)(WT + (size_t)(drow0 + n) * K + k0 + 8 * c) = o; }
    LDS_WAIT(); asm volatile("" ::: "memory");
}
DEV void p0_prologue(const Frame& F) {
    const Args& A = *F.a; unsigned char* ws = A.ws;
    {
        LAS float* ssc = (LAS float*)F.lds;
        LAS float* red = (LAS float*)(F.lds + 40960);
        for (int i = F.tid; i < 5 * DM; i += 512) { const int r = i / DM, k = i % DM; const float v = (r < 4) ? A.in[I_C][r * DM + k] : A.in[I_CCTX][k]; ssc[i] = fsilu(v); }
        __syncthreads();
        float* MOD = (float*)(ws + WS_MOD);
        for (int it = F.bid; it < 256; it += F.G) {
            const int li = it >> 7, col0 = (it & 127) * 144; const int ln = F.lane < 36 ? F.lane : 35;
            const float* Wp = A.in[I_MODW] + (size_t)li * DM * 18432 + (size_t)(F.wave * 256) * 18432 + col0 + 4 * ln;
            f32x4 acc[5];
#pragma unroll
            for (int r = 0; r < 5; ++r) acc[r] = (f32x4){0.f, 0.f, 0.f, 0.f};
#pragma unroll 8
            for (int kk = 0; kk < 256; ++kk) { const f32x4 wv = *(const f32x4*)(Wp + (size_t)kk * 18432);
#pragma unroll
                for (int r = 0; r < 5; ++r) { const float sv = ssc[r * DM + F.wave * 256 + kk]; acc[r] += wv * sv; } }
            if (F.lane < 36) {
#pragma unroll
                for (int r = 0; r < 5; ++r) *(LAS f32x4*)(red + (F.wave * 5 + r) * 144 + 4 * F.lane) = acc[r]; }
            __syncthreads();
            for (int o = F.tid; o < 720; o += 512) { const int r = o / 144, c = o % 144; float sum = A.in[I_MODB][li * 18432 + col0 + c];
#pragma unroll
                for (int w = 0; w < 8; ++w) sum += red[(w * 5 + r) * 144 + c];
                MOD[(size_t)(li * 5 + r) * 18432 + col0 + c] = sum; }
            __syncthreads();
        }
    }
    {
        LAS float* scr = (LAS float*)(F.lds + F.wave * 16384);
        const int gw = F.bid * 8 + F.wave, NGW = F.G * 8;
        constexpr int I_FFN = 5632, N_FFN = 12 * I_FFN, I_EI = 32 * 192, I_EO = 32 * 64, I_OI = 32 * 96, I_OO = 32 * 64, I_SM = 8 * 36;
        constexpr int NITEMS = N_FFN + I_EI + I_EO + I_OI + I_OO + I_SM;
        for (int it = gw; it < NITEMS; it += NGW) {
            int r = it;
            if (r < N_FFN) { const int idx = r / I_FFN, item = r % I_FFN, lf = idx / 3, kind = idx % 3;
                if (kind < 2) { const float* W = A.in[kind == 0 ? I_FG : I_FU] + (size_t)lf * DM * DFF; const int nb = item % 176, kb = item / 176, n0 = 32 * nb;
                    transpose_item(W, DM, DFF, (bf16*)(ws + WS_WGU + (size_t)lf * 44 * MiB), 256 * (n0 / 128) + 128 * kind + (n0 % 128), scr, kb, nb, F.lane); }
                else { const float* W = A.in[I_FD] + (size_t)lf * DFF * DM; const int nb = item % 64, kb = item / 64;
                    transpose_item(W, DFF, DM, (bf16*)(ws + WS_WD + (size_t)lf * 22 * MiB), 32 * nb, scr, kb, nb, F.lane); }
                continue; }
            r -= N_FFN;
            if (r < I_EI) { const int nb = r % 192, kb = r / 192, n0 = 32 * nb, blk = n0 / 1024;
                const int dblk = (blk == 1) ? 5 : (blk == 5) ? 1 : blk;
                transpose_item(A.in[I_EVIN], DM, EVN, (bf16*)(ws + WS_WEVIN), dblk * 1024 + (n0 % 1024), scr, kb, nb, F.lane); continue; }
            r -= I_EI;
            if (r < I_EO) { const int nb = r % 64, kb = r / 64; transpose_item(A.in[I_EVOUT], DM, DM, (bf16*)(ws + WS_WEVOUT), 32 * nb, scr, kb, nb, F.lane); continue; }
            r -= I_EO;
            if (r < I_OI) { const int nb = r % 96, kb = r / 96; transpose_item(A.in[I_ODIN], DM, ODN, (bf16*)(ws + WS_WODIN), 32 * nb, scr, kb, nb, F.lane); continue; }
            r -= I_OI;
            if (r < I_OO) { const int nb = r % 64, kb = r / 64; transpose_item(A.in[I_ODOUT], DM, DM, (bf16*)(ws + WS_WODOUT), 32 * nb, scr, kb, nb, F.lane); continue; }
            r -= I_OO;
            { const int mat = r / 8, item = r % 8, nb = item % 4, kb = item / 4;
                const float* W; bf16* dst;
                if (mat < 16) { W = A.in[I_WA] + (size_t)mat * 16384; dst = (bf16*)(ws + WS_LRUW) + (size_t)mat * 16384; }
                else if (mat < 32) { W = A.in[I_WX] + (size_t)(mat - 16) * 16384; dst = (bf16*)(ws + WS_LRUW) + (size_t)mat * 16384; }
                else { W = A.in[I_POOLW] + (size_t)(mat - 32) * 16384; dst = (bf16*)(ws + WS_POOLW) + (size_t)(mat - 32) * 16384; }
                transpose_item(W, 128, 128, dst, 32 * nb, scr, kb, nb, F.lane); }
        }
    }
    {
        const int gt = F.bid * 512 + F.tid, NT = F.G * 512;
        float* c1 = (float*)(ws + WS_COS1); float* s1 = (float*)(ws + WS_SIN1); float* c2 = (float*)(ws + WS_COS2); float* s2 = (float*)(ws + WS_SIN2);
        for (int i = gt; i < SEQ * 128 + SEQ * 64; i += NT) {
            float pos, f; float* cd; float* sd;
            if (i < SEQ * 128) { const int t = i >> 7, k = i & 127; pos = (float)t; f = exp2f(-(float)k * (13.287712379549449f / 128.f)); cd = c1 + i; sd = s1 + i; }
            else { const int j = i - SEQ * 128, t = j >> 6, k = j & 63; pos = (k < 32) ? (float)(t >> 6) : (float)(t & 63); f = exp2f(-(float)(k & 31) * (13.287712379549449f / 32.f)); cd = c2 + j; sd = s2 + j; }
            const float ang = pos * f;
            double rev = (double)ang * 0.15915494309189535; rev -= __builtin_rint(rev);
            const float fr = (float)rev;
            *cd = __builtin_amdgcn_cosf(fr); *sd = __builtin_amdgcn_sinf(fr);
        }
    }
}

struct ResCfg { int has_res, has_next, li, sub, li2, sub2, nrows; float wres; const float* xold_l; const float* xold_c; float* xnew_l; float* xnew_c; const float* part; };
DEV void res_rows(const Frame& F, const ResCfg& C, int m0, int cnt, int prow) {
    const Args& A = *F.a; const float* MOD = (const float*)(A.ws + WS_MOD); bf16* H = (bf16*)(A.ws + WS_H);
    f32x4 Ca[8], Cb[8], Cs[8];
    int e0 = 4 * F.lane; asm volatile("" : "+v"(e0));
    if (C.has_res) {
        const float* gate = MOD + (size_t)(C.li * 5 + prow) * 18432 + C.sub * 6144 + 4096; const float* gp = A.in[I_NPOST] + (C.li * 3 + C.sub) * DM;
#pragma unroll
        for (int j = 0; j < 8; ++j) Ca[j] = *(const f32x4*)(gate + 256 * j + e0) * *(const f32x4*)(gp + 256 * j + e0) * C.wres;
    }
    if (C.has_next) {
        const float* sh = MOD + (size_t)(C.li2 * 5 + prow) * 18432 + C.sub2 * 6144; const float* sc = sh + 2048; const float* gp = A.in[I_NPRE] + (C.li2 * 3 + C.sub2) * DM;
#pragma unroll
        for (int j = 0; j < 8; ++j) { Cb[j] = *(const f32x4*)(gp + 256 * j + e0) * (*(const f32x4*)(sc + 256 * j + e0) + 1.f); Cs[j] = *(const f32x4*)(sh + 256 * j + e0); }
    }
    for (int m = m0; m < m0 + cnt; ++m) {
        const float* xo = (m < ML) ? C.xold_l + (size_t)m * DM : C.xold_c + (size_t)(m - ML) * DM;
        f32x4 x[8];
#pragma unroll
        for (int j = 0; j < 8; ++j) x[j] = *(const f32x4*)(xo + 256 * j + e0);
        if (C.has_res) {
            f32x4 yy[8];
            if (C.part && m >= ML) { const float* pr = C.part + (size_t)(m - ML) * DM;
#pragma unroll
                for (int j = 0; j < 8; ++j) yy[j] = (*(const f32x4*)(pr + 256 * j + e0) + *(const f32x4*)(pr + (size_t)MC * DM + 256 * j + e0)) + (*(const f32x4*)(pr + (size_t)2 * MC * DM + 256 * j + e0) + *(const f32x4*)(pr + (size_t)3 * MC * DM + 256 * j + e0)); }
            else { const bf16* yr = H + (size_t)m * DM;
#pragma unroll
                for (int j = 0; j < 8; ++j) { const u32x2 yv = *(const u32x2*)(yr + 256 * j + e0); yy[j] = (f32x4){bflo(yv.x), bfhi(yv.x), bflo(yv.y), bfhi(yv.y)}; } }
            float ss = 0.f;
#pragma unroll
            for (int j = 0; j < 8; ++j) ss += (yy[j].x * yy[j].x + yy[j].y * yy[j].y) + (yy[j].z * yy[j].z + yy[j].w * yy[j].w);
            const float rs = __builtin_amdgcn_rsqf(wave_sum(ss) * (1.f / DM) + EPS);
            float* xn = (m < ML) ? C.xnew_l + (size_t)m * DM : C.xnew_c + (size_t)(m - ML) * DM;
#pragma unroll
            for (int j = 0; j < 8; ++j) { x[j] = x[j] + Ca[j] * (yy[j] * rs); *(f32x4*)(xn + 256 * j + e0) = x[j]; }
        }
        if (C.has_next) {
            float ss = 0.f;
#pragma unroll
            for (int j = 0; j < 8; ++j) ss += (x[j].x * x[j].x + x[j].y * x[j].y) + (x[j].z * x[j].z + x[j].w * x[j].w);
            const float rs = __builtin_amdgcn_rsqf(wave_sum(ss) * (1.f / DM) + EPS);
            bf16* hr = H + (size_t)m * DM;
#pragma unroll
            for (int j = 0; j < 8; ++j) { const f32x4 h = x[j] * rs * Cb[j] + Cs[j]; u32x2 w; w.x = pkbf(h.x, h.y); w.y = pkbf(h.z, h.w); *(u32x2*)(hr + 256 * j + e0) = w; }
        }
    }
}
DEV void res_phase(const Frame& F, const ResCfg& C) {
    const int gw = F.bid * 8 + F.wave, NGW = F.G * 8;
    for (int blk = gw; blk < ML / 16; blk += NGW) res_rows(F, C, blk * 16, 16, (blk * 16) / SEQ);
    if (C.nrows > ML) {
        if (NGW >= 2 * MC) { if ((gw & 1) == 0 && (gw >> 1) < MC) res_rows(F, C, ML + (gw >> 1), 1, 4); }
        else { const int per = (MC + NGW - 1) / NGW, r0 = gw * per, cnt = (MC - r0) < per ? (MC - r0) : per; if (cnt > 0) res_rows(F, C, ML + r0, cnt, 4); }
    }
}

constexpr int LRU_UB = 0, LRU_UB_LD = 272, LRU_ARR = 17408, LRU_ARR_SZ = 32768;
DEV int lru_chunk_row0(int b, int ck) { return (ck < 4) ? ML + b * CTXL + 64 * ck : b * SEQ + 64 * (ck - 4); }
DEV float one_minus_exp(float t) {
    const float ser = -t * (1.f + t * 0.5f * (1.f + t * (1.f / 3.f) * (1.f + t * 0.25f * (1.f + t * 0.2f * (1.f + t * (1.f / 6.f))))));
    return (t > -0.25f) ? ser : 1.f - fexp(t);
}
template <bool FINAL> DEV void lru_phase(const Frame& F, bool dry = false) {
    const Args& A = *F.a; unsigned char* ws = A.ws; bf16* E = (bf16*)(ws + WS_E);
    const int tid = F.tid, wave = F.wave, lane = F.lane, r32 = lane & 31, hh = lane >> 5;
    LAS unsigned char* UB = F.lds + LRU_UB; LAS float* ARR = (LAS float*)(F.lds + LRU_ARR); LAS unsigned char* RS = F.lds + LRU_ARR;
    const int slot = F.bid & 31, n = slot & 7, b = slot >> 3, ck0 = F.bid >> 5, ckst = (F.G + 31) >> 5;
    if (F.bid >= 32 * ckst) return;
    u32x4 rp[3];
#define LRU_LOAD(ck_) do { const int L_ = ((ck_) < 4) ? CTXL : SEQ, p0_ = ((ck_) < 4) ? 64 * (ck_) : 64 * ((ck_) - 4), rb_ = ((ck_) < 4) ? ML + b * CTXL : b * SEQ; \
        _Pragma("unroll") for (int i_ = 0; i_ < 3; ++i_) { const int pc = tid + 512 * i_, rr = pc >> 4, c8 = pc & 15, pos = p0_ - 2 + rr; \
            rp[i_] = (u32x4){0u, 0u, 0u, 0u}; if (pc < 67 * 16 && pos >= 0 && pos < L_) rp[i_] = *(const u32x4*)(E + (size_t)(rb_ + pos) * EVN + EC_R + 128 * n + 8 * c8); } } while (0)
    if (ck0 < NCH64) LRU_LOAD(ck0);
    const int c8t = tid & 15, cht = 128 * n + 8 * c8t;
    float cw[4][8], cb[8];
#pragma unroll
    for (int i = 0; i < 8; ++i) cb[i] = A.in[I_CONVB][cht + i];
#pragma unroll
    for (int k = 0; k < 4; ++k)
#pragma unroll
        for (int i = 0; i < 8; ++i) cw[k][i] = A.in[I_CONVW][k * 1024 + cht + i];
    const int gd = wave >> 2, cq = wave & 3, gcol = 32 * cq + r32, gchn = 128 * n + gcol;
    bf16x8 fa[8], fx[8];
    { const bf16* WA = (const bf16*)(ws + WS_LRUW) + (size_t)(gd * 8 + n) * 16384 + (size_t)gcol * 128 + 8 * hh; const bf16* WX = WA + (size_t)16 * 16384;
#pragma unroll
      for (int ks = 0; ks < 8; ++ks) { fa[ks] = *(const bf16x8*)(WA + 16 * ks); fx[ks] = *(const bf16x8*)(WX + 16 * ks); } }
    const float gba = A.in[I_BA][gd * 1024 + gchn], gbx = A.in[I_BX][gd * 1024 + gchn], sp8 = -8.f * log1pf(expf(-A.in[I_LAM][gd * 1024 + gchn]));
    for (int ck = ck0; ck < NCH64; ck += ckst) {
        const int p0 = (ck < 4) ? 64 * ck : 64 * (ck - 4), rowbase = (ck < 4) ? ML + b * CTXL : b * SEQ;
        const int sd = (tid >> 7) & 1, sc = tid & 127; const size_t gi = ((size_t)(ck * NB + b) * 2 + sd) * 1024 + 128 * n + sc;
        float hcar = 0.f; if (FINAL && tid < 256) hcar = ((const float*)(ws + WS_CAR))[gi];
        u32x4 gv[2];
        if (FINAL) {
#pragma unroll
            for (int i = 0; i < 2; ++i) { const int pc = tid + 512 * i, tt = pc >> 4; gv[i] = *(const u32x4*)(E + (size_t)(rowbase + p0 + tt) * EVN + EC_G + 128 * n + 8 * c8t); } }
#pragma unroll
        for (int i = 0; i < 3; ++i) { const int pc = tid + 512 * i, rr = pc >> 4, c8 = pc & 15; if (pc < 67 * 16) *(LAS u32x4*)(RS + rr * 256 + c8 * 16) = rp[i]; }
        __syncthreads();
#pragma unroll
        for (int i2 = 0; i2 < 2; ++i2) { const int pc = tid + 512 * i2, tt = pc >> 4;
            float u[8];
#pragma unroll
            for (int i = 0; i < 8; ++i) u[i] = cb[i];
#pragma unroll
            for (int k = 0; k < 4; ++k) { const u32x4 rv = *(const LAS u32x4*)(RS + (tt + k) * 256 + c8t * 16);
                u[0] += cw[k][0] * bflo(rv.x); u[1] += cw[k][1] * bfhi(rv.x); u[2] += cw[k][2] * bflo(rv.y); u[3] += cw[k][3] * bfhi(rv.y);
                u[4] += cw[k][4] * bflo(rv.z); u[5] += cw[k][5] * bfhi(rv.z); u[6] += cw[k][6] * bflo(rv.w); u[7] += cw[k][7] * bfhi(rv.w); }
            u32x4 o = {pkbf(u[0], u[1]), pkbf(u[2], u[3]), pkbf(u[4], u[5]), pkbf(u[6], u[7])};
            *(LAS u32x4*)(UB + tt * LRU_UB_LD + c8t * 16) = o; }
        __syncthreads();
        if (ck + ckst < NCH64) LRU_LOAD(ck + ckst);
        {
            f32x16 aa[2] = {f32x16{}, f32x16{}}, ax[2] = {f32x16{}, f32x16{}};
#pragma unroll
            for (int ks = 0; ks < 8; ++ks) {
#pragma unroll
                for (int rt = 0; rt < 2; ++rt) { const bf16x8 af = *(const LAS bf16x8*)(UB + (32 * rt + r32) * LRU_UB_LD + (16 * ks + 8 * hh) * 2);
                    aa[rt] = __builtin_amdgcn_mfma_f32_32x32x16_bf16(af, fa[ks], aa[rt], 0, 0, 0); ax[rt] = __builtin_amdgcn_mfma_f32_32x32x16_bf16(af, fx[ks], ax[rt], 0, 0, 0); }
            }
            LAS float* AO = ARR + (size_t)(gd * 2) * (LRU_ARR_SZ / 4); LAS float* BO = AO + LRU_ARR_SZ / 4;
#pragma unroll
            for (int rt = 0; rt < 2; ++rt)
#pragma unroll
                for (int r = 0; r < 16; ++r) { const int row = 32 * rt + crow(r, hh);
                    const float la = sp8 * fsigmoid(aa[rt][r] + gba), av = fexp(la), mlt = __builtin_amdgcn_sqrtf(one_minus_exp(2.f * la));
                    const float uv = bf2f(*(const LAS bf16*)(UB + row * LRU_UB_LD + gcol * 2));
                    AO[row * 128 + gcol] = av; BO[row * 128 + gcol] = mlt * fsigmoid(ax[rt][r] + gbx) * uv; }
        }
        __syncthreads();
        if (tid < 256) { LAS float* AO = ARR + (size_t)(sd * 2) * (LRU_ARR_SZ / 4); const LAS float* BO = AO + LRU_ARR_SZ / 4;
            if (!FINAL) { float h = 0.f, P = 1.f;
#pragma unroll 8
                for (int s = 0; s < 64; ++s) { const int tt = sd ? 63 - s : s; const float a = AO[tt * 128 + sc]; h = a * h + BO[tt * 128 + sc]; P *= a; }
                ((f32x2*)(ws + WS_AGG))[gi] = (f32x2){P, h}; }
            else { float h = hcar;
#pragma unroll 8
                for (int s = 0; s < 64; ++s) { const int tt = sd ? 63 - s : s; h = AO[tt * 128 + sc] * h + BO[tt * 128 + sc]; AO[tt * 128 + sc] = h; } }
        }
        __syncthreads();
        if (FINAL) {
            const LAS float* H0 = ARR; const LAS float* H1 = ARR + 2 * (LRU_ARR_SZ / 4);
#pragma unroll
            for (int i2 = 0; i2 < 2; ++i2) { const int pc = tid + 512 * i2, tt = pc >> 4;
                const f32x4 h0a = *(const LAS f32x4*)(H0 + tt * 128 + 8 * c8t), h0b = *(const LAS f32x4*)(H0 + tt * 128 + 8 * c8t + 4), h1a = *(const LAS f32x4*)(H1 + tt * 128 + 8 * c8t), h1b = *(const LAS f32x4*)(H1 + tt * 128 + 8 * c8t + 4);
                const f32x4 sa = h0a + h1a, sb = h0b + h1b; const u32x4 g4 = gv[i2];
                u32x4 w = {pkbf(fgelu_tanh(bflo(g4.x)) * sa.x, fgelu_tanh(bfhi(g4.x)) * sa.y), pkbf(fgelu_tanh(bflo(g4.y)) * sa.z, fgelu_tanh(bfhi(g4.y)) * sa.w),
                           pkbf(fgelu_tanh(bflo(g4.z)) * sb.x, fgelu_tanh(bfhi(g4.z)) * sb.y), pkbf(fgelu_tanh(bflo(g4.w)) * sb.z, fgelu_tanh(bfhi(g4.w)) * sb.w)};
                bf16* wp = dry ? (bf16*)(ws + WS_H) + (size_t)(rowbase + p0 + tt) * DM + 128 * n + 8 * c8t : E + (size_t)(rowbase + p0 + tt) * EVN + EC_G + 128 * n + 8 * c8t; *(u32x4*)wp = w; }
            __syncthreads();
        }
    }
#undef LRU_LOAD
}
DEV void lru_carry_phase(const Frame& F) {
    unsigned char* ws = F.a->ws; const f32x2* AGG = (const f32x2*)(ws + WS_AGG); float* CAR = (float*)(ws + WS_CAR);
    const int gw = F.bid * 8 + F.wave, NGW = F.G * 8;
    for (int it = gw; it < NB * 2 * 16; it += NGW) { const int cg = it & 15, d = (it >> 4) & 1, b = it >> 5;
        float h = 0.f;
#pragma unroll 12
        for (int idx = 0; idx < NCH64; ++idx) { const int ck = d ? (idx < 4 ? 3 - idx : NCH64 + 3 - idx) : idx;
            const size_t gi = ((size_t)(ck * NB + b) * 2 + d) * 1024 + 64 * cg + F.lane; const f32x2 v = AGG[gi]; CAR[gi] = h; h = v.x * h + v.y; }
    }
}

DEV int ret_chunk_row0(int b, int cid) { return (cid < 2) ? ML + b * CTXL + 128 * cid : b * SEQ + 128 * (cid - 2); }
DEV int ret_chain(int d, int idx) { return d ? (idx < 2 ? 1 - idx : NCH128 + 1 - idx) : idx; }
DEV float ret_logg(const Args& A, int d, int h) { const float lg = A.in[I_DECAY][d * 4 + h]; return -log1pf(expf(-lg)); }
constexpr int RET_LD = 528, RET_VLD = 80;
DEV void ret_state_phase(const Frame& F) {
    const Args& A = *F.a; unsigned char* ws = A.ws; const bf16* E = (const bf16*)(ws + WS_E); bf16* SB = (bf16*)(ws + WS_SBUF);
    const int tid = F.tid, lane = F.lane, wave = F.wave, r32 = lane & 31, hh = lane >> 5;
    LAS unsigned char* KS = F.lds; LAS unsigned char* VS = F.lds + 128 * RET_LD;
    for (int it = F.bid; it < 256; it += F.G) {
        const int es = it & 7, d = (it >> 3) & 1, h = (it >> 4) & 3, b = it >> 6;
        const float lg = ret_logg(A, d, h), sdec = expf(lg * 128.f);
        const int vrow = tid >> 2, vc4 = tid & 3; const float vw = expf(lg * (float)(d ? vrow : 127 - vrow));
        u32x4 kreg[8], vreg;
        f32x16 acc = f32x16{};
#define RS_LOAD(cid_) do { const int m0_ = ret_chunk_row0(b, cid_); \
            _Pragma("unroll") for (int i = 0; i < 8; ++i) { const int id = tid + 512 * i, row = id >> 5, c16 = id & 31; kreg[i] = *(const u32x4*)(E + (size_t)(m0_ + row) * EVN + EC_K + 256 * h + 8 * c16); } \
            vreg = *(const u32x4*)(E + (size_t)(m0_ + vrow) * EVN + EC_V + 256 * h + 32 * es + 8 * vc4); } while (0)
        RS_LOAD(ret_chain(d, 0));
        for (int idx = 0; idx < NCH128; ++idx) {
            const int cid = ret_chain(d, idx);
#pragma unroll
            for (int i = 0; i < 8; ++i) { const int id = tid + 512 * i, row = id >> 5, c16 = id & 31; *(LAS u32x4*)(KS + row * RET_LD + c16 * 16) = kreg[i]; }
            { u32x4 w; w.x = pkbf(bflo(vreg.x) * vw, bfhi(vreg.x) * vw); w.y = pkbf(bflo(vreg.y) * vw, bfhi(vreg.y) * vw); w.z = pkbf(bflo(vreg.z) * vw, bfhi(vreg.z) * vw); w.w = pkbf(bflo(vreg.w) * vw, bfhi(vreg.w) * vw);
              *(LAS u32x4*)(VS + vrow * RET_VLD + vc4 * 16) = w; }
            __syncthreads();
            if (idx + 1 < NCH128) RS_LOAD(ret_chain(d, idx + 1));
            { bf16* sp = SB + ((size_t)(((b * 4 + h) * 2 + d) * NCH128 + cid) * 256 + 32 * es + r32) * 256 + 32 * wave + 4 * hh;
#pragma unroll
              for (int g = 0; g < 4; ++g) { u32x2 w; w.x = pkbf(acc[4 * g], acc[4 * g + 1]); w.y = pkbf(acc[4 * g + 2], acc[4 * g + 3]); *(u32x2*)(sp + 8 * g) = w; } }
#pragma unroll
            for (int r = 0; r < 16; ++r) acc[r] *= sdec;
#pragma unroll
            for (int ks = 0; ks < 8; ++ks) { const bf16x8 af = tr_frag(KS, RET_LD, 16 * ks, 32 * wave, lane); const bf16x8 bfr = tr_frag(VS, RET_VLD, 16 * ks, 0, lane);
                acc = __builtin_amdgcn_mfma_f32_32x32x16_bf16(af, bfr, acc, 0, 0, 0); }
            __syncthreads();
        }
#undef RS_LOAD
    }
}
DEV void ret_out_phase(const Frame& F, bool dry = false) {
    const Args& A = *F.a; unsigned char* ws = A.ws; bf16* E = (bf16*)(ws + WS_E); const bf16* SB = (const bf16*)(ws + WS_SBUF);
    const int wave = F.wave, ib = wave & 3, eh = wave >> 2;
    LAS unsigned char* RA = F.lds; LAS unsigned char* RB = F.lds + 128 * RET_LD; LAS float* GX = (LAS float*)(F.lds + 2 * 128 * RET_LD);
    constexpr int PLD = 272;
    for (int it = F.bid; it < 16 * NCH128; it += F.G) {
        int tid = F.tid; asm volatile("" : "+v"(tid)); int lane = tid & 63;
        const int r32 = lane & 31, hh = lane >> 5;
        const int cid = it % NCH128, bh = it / NCH128, h = bh & 3, b = bh >> 2, m0 = ret_chunk_row0(b, cid);
        const float lg0 = ret_logg(A, 0, h), lg1 = ret_logg(A, 1, h);
        bf16x8 qf[16];
        { const bf16* qp = E + (size_t)(m0 + 32 * ib + r32) * EVN + EC_Q + 256 * h + 8 * hh;
#pragma unroll
          for (int ks = 0; ks < 16; ++ks) qf[ks] = *(const bf16x8*)(qp + 16 * ks); }
        f32x16 o[4];
#pragma unroll
        for (int et = 0; et < 4; ++et) o[et] = f32x16{};
#pragma unroll 1
        for (int d = 0; d < 2; ++d) {
            const bf16* sp = SB + (size_t)((bh * 2 + d) * NCH128 + cid) * 65536; const float lgd = d ? lg1 : lg0;
            __syncthreads();
#pragma unroll
            for (int hb = 0; hb < 2; ++hb) { u32x4 tmp[8];
#pragma unroll
                for (int i = 0; i < 8; ++i) { const int id = tid + 512 * (8 * hb + i), row = id >> 5, c16 = id & 31; tmp[i] = *(const u32x4*)(sp + (size_t)row * 256 + 8 * c16); }
                asm volatile("" ::: "memory");
#pragma unroll
                for (int i = 0; i < 8; ++i) { const int id = tid + 512 * (8 * hb + i), row = id >> 5, c16 = id & 31; *(LAS u32x4*)(RA + row * RET_LD + c16 * 16) = tmp[i]; }
                asm volatile("" ::: "memory"); }
            __syncthreads();
#pragma unroll
            for (int et = 0; et < 4; ++et) { f32x16 T = f32x16{};
                const LAS unsigned char* bp = RA + (128 * eh + 32 * et + r32) * RET_LD + 16 * hh;
#pragma unroll
                for (int ks = 0; ks < 16; ++ks) { const bf16x8 bfr = *(const LAS bf16x8*)(bp + 32 * ks); T = __builtin_amdgcn_mfma_f32_32x32x16_bf16(qf[ks], bfr, T, 0, 0, 0); }
#pragma unroll
                for (int r = 0; r < 16; ++r) { const int i = 32 * ib + crow(r, hh); const float rs = fexp(lgd * (float)(d ? 128 - i : i + 1)); o[et][r] += T[r] * rs; } }
        }
        __syncthreads();
        int tid2 = tid; asm volatile("" : "+v"(tid2));
#pragma unroll
        for (int kv = 0; kv < 2; ++kv) { u32x4 tmp[8];
#pragma unroll
            for (int i = 0; i < 8; ++i) { const int id = tid2 + 512 * i, row = id >> 5, c16 = id & 31; tmp[i] = *(const u32x4*)(E + (size_t)(m0 + row) * EVN + (kv ? EC_V : EC_K) + 256 * h + 8 * c16); }
            asm volatile("" ::: "memory");
#pragma unroll
            for (int i = 0; i < 8; ++i) { const int id = tid2 + 512 * i, row = id >> 5, c16 = id & 31; *(LAS u32x4*)((kv ? RB : RA) + row * RET_LD + c16 * 16) = tmp[i]; }
            asm volatile("" ::: "memory"); }
        __syncthreads();
        u32x2 pw[2][4];
        { const int i = 32 * ib + r32;
#pragma unroll
          for (int jj = 0; jj < 2; ++jj) { const int jt = 2 * eh + jj;
            f32x16 X = f32x16{};
#pragma unroll
            for (int ks = 0; ks < 16; ++ks) { const bf16x8 af = *(const LAS bf16x8*)(RA + (32 * jt + r32) * RET_LD + (16 * ks + 8 * hh) * 2); X = __builtin_amdgcn_mfma_f32_32x32x16_bf16(af, qf[ks], X, 0, 0, 0); }
#pragma unroll
            for (int g = 0; g < 4; ++g) { float pv[4];
#pragma unroll
                for (int q = 0; q < 4; ++q) { const int j = 32 * jt + 8 * g + 4 * hh + q; const int dl = i - j; const float f = (dl > 0) ? fexp(lg0 * (float)dl) : (dl < 0) ? fexp(-lg1 * (float)dl) : 2.f; pv[q] = X[4 * g + q] * f; }
                pw[jj][g].x = pkbf(pv[0], pv[1]); pw[jj][g].y = pkbf(pv[2], pv[3]); } } }
        __syncthreads();
        { const int i = 32 * ib + r32;
#pragma unroll
          for (int jj = 0; jj < 2; ++jj)
#pragma unroll
            for (int g = 0; g < 4; ++g) *(LAS u32x2*)(RA + i * PLD + (32 * (2 * eh + jj) + 8 * g + 4 * hh) * 2) = pw[jj][g]; }
        __syncthreads();
#pragma unroll
        for (int ks = 0; ks < 8; ++ks) { const bf16x8 pa = *(const LAS bf16x8*)(RA + (32 * ib + r32) * PLD + (16 * ks + 8 * hh) * 2);
#pragma unroll
            for (int et = 0; et < 4; ++et) { const bf16x8 bfr = tr_frag(RB, RET_LD, 16 * ks, 128 * eh + 32 * et, lane); o[et] = __builtin_amdgcn_mfma_f32_32x32x16_bf16(pa, bfr, o[et], 0, 0, 0); } }
#pragma unroll
        for (int r = 0; r < 16; ++r) { float a = 0.f, q = 0.f;
#pragma unroll
            for (int et = 0; et < 4; ++et) { a += o[et][r]; q += o[et][r] * o[et][r]; }
#pragma unroll
            for (int off = 1; off < 32; off <<= 1) { a += __shfl_xor(a, off); q += __shfl_xor(q, off); }
            if (r32 == 0) { GX[(wave * 32 + crow(r, hh)) * 2] = a; GX[(wave * 32 + crow(r, hh)) * 2 + 1] = q; } }
        __syncthreads();
        { const float* gn = A.in[I_GN] + 256 * h + 128 * eh;
#pragma unroll
          for (int r = 0; r < 16; ++r) { const int rw = crow(r, hh); const float a = GX[(wave * 32 + rw) * 2] + GX[((wave ^ 4) * 32 + rw) * 2], q = GX[(wave * 32 + rw) * 2 + 1] + GX[((wave ^ 4) * 32 + rw) * 2 + 1];
            const float mean = a * (1.f / 256.f), var = q * (1.f / 256.f) - mean * mean, rstd = __builtin_amdgcn_rsqf(var + EPS);
            bf16* op = E + (size_t)(m0 + 32 * ib + rw) * EVN + EC_O + 256 * h + 128 * eh + r32;
#pragma unroll
            for (int et = 0; et < 4; ++et) { const float og = bf2f(op[32 * et]); bf16* wp = dry ? (bf16*)(ws + WS_H) + (size_t)(m0 + 32 * ib + rw) * DM + 1024 + 256 * h + 128 * eh + r32 : op;
                wp[32 * et] = f2bf((o[et][r] - mean) * rstd * gn[32 * et + r32] * fsilu(og)); } } }
    }
    __syncthreads();
}
DEV void odd_post_phase(const Frame& F) {
    const Args& A = *F.a; unsigned char* ws = A.ws; const bf16* E2 = (const bf16*)(ws + WS_E2);
    bf16* QB = (bf16*)(ws + WS_QB); bf16* KB = (bf16*)(ws + WS_KB); bf16* VB = (bf16*)(ws + WS_VB); bf16* MIX = (bf16*)(ws + WS_MIX2);
    const float* c2 = (const float*)(ws + WS_COS2); const float* s2 = (const float*)(ws + WS_SIN2);
    const int tid = F.tid, wave = F.wave;
    {
        const int gw = F.bid * 8 + F.wave, NGW = F.G * 8; const int lane0 = F.lane, li0 = lane0 & 15, e0c = 8 * (li0 & 7);
        f32x4 qg[2], kg[2];
        qg[0] = *(const f32x4*)(A.in[I_QN] + 8 * li0); qg[1] = *(const f32x4*)(A.in[I_QN] + 8 * li0 + 4); kg[0] = *(const f32x4*)(A.in[I_KN] + 8 * li0); kg[1] = *(const f32x4*)(A.in[I_KN] + 8 * li0 + 4);
        for (int m = gw; m < MT; m += NGW) {
            int lane = F.lane; asm volatile("" : "+v"(lane));
            const int grp = lane >> 4, li = lane & 15; const bool hi8 = (li & 8) != 0;
            const bool lat = m < ML; const int b = lat ? m / SEQ : (m - ML) / CTXL, t = lat ? m % SEQ : 0, kpos = lat ? CTXL + t : (m - ML) % CTXL;
            const bf16* er = E2 + (size_t)m * ODN;
            f32x4 cs[2] = {(f32x4){1.f, 1.f, 1.f, 1.f}, (f32x4){1.f, 1.f, 1.f, 1.f}}, sn[2] = {(f32x4){0.f, 0.f, 0.f, 0.f}, (f32x4){0.f, 0.f, 0.f, 0.f}};
            if (lat) { cs[0] = *(const f32x4*)(c2 + t * 64 + e0c); cs[1] = *(const f32x4*)(c2 + t * 64 + e0c + 4); sn[0] = *(const f32x4*)(s2 + t * 64 + e0c); sn[1] = *(const f32x4*)(s2 + t * 64 + e0c + 4); }
#pragma unroll
            for (int rd = 0; rd < 4; ++rd) {
                if (rd < 3 && !lat) continue;
                const bool isq = rd < 3; const int hd = isq ? 4 * rd + grp : grp;
                const u32x4 xv = *(const u32x4*)(er + (isq ? 512 : 2048) + 128 * hd + 8 * li);
                float x[8] = {bflo(xv.x), bfhi(xv.x), bflo(xv.y), bfhi(xv.y), bflo(xv.z), bfhi(xv.z), bflo(xv.w), bfhi(xv.w)};
                float ss = 0.f;
#pragma unroll
                for (int i = 0; i < 8; ++i) ss += x[i] * x[i];
                ss += __shfl_xor(ss, 1); ss += __shfl_xor(ss, 2); ss += __shfl_xor(ss, 4); ss += __shfl_xor(ss, 8);
                const float rs = __builtin_amdgcn_rsqf(ss * (1.f / 128.f) + EPS);
                float y[8], yp[8], o[8];
#pragma unroll
                for (int i = 0; i < 8; ++i) y[i] = x[i] * rs * (isq ? qg[i >> 2][i & 3] : kg[i >> 2][i & 3]);
#pragma unroll
                for (int i = 0; i < 8; ++i) yp[i] = __shfl_xor(y[i], 8);
#pragma unroll
                for (int i = 0; i < 8; ++i) { const float c = cs[i >> 2][i & 3], sv = sn[i >> 2][i & 3]; o[i] = hi8 ? (yp[i] * sv + y[i] * c) : (y[i] * c - yp[i] * sv); }
                u32x4 w = {pkbf(o[0], o[1]), pkbf(o[2], o[3]), pkbf(o[4], o[5]), pkbf(o[6], o[7])};
                bf16* dst = isq ? QB + (size_t)m * 1536 + 128 * hd + 8 * li : KB + ((size_t)b * KVL + kpos) * 512 + 128 * hd + 8 * li;
                *(u32x4*)dst = w;
            }
            *(u32x4*)(VB + ((size_t)b * KVL + kpos) * 512 + 8 * lane) = *(const u32x4*)(er + 2560 + 8 * lane);
        }
    }
    {
        const int lane = F.lane, r32 = lane & 31, hh = lane >> 5;
        LAS unsigned char* XS = F.lds; LAS unsigned char* DS = F.lds + 144 * 256; constexpr int DLD = 272;
        for (int it = F.bid; it < (ML / 128) * 4; it += F.G) {
            const int gi = it & 3, rt = it >> 2, b = (rt * 128) / SEQ, t0 = (rt * 128) % SEQ, half = 1 << gi;
            __syncthreads();
            for (int pc = tid; pc < 144 * 16; pc += 512) { const int rr = pc >> 4, c8 = pc & 15, pos = t0 - 8 + rr;
                u32x4 v = {0u, 0u, 0u, 0u}; if (pos >= 0 && pos < SEQ) v = *(const u32x4*)(E2 + (size_t)(b * SEQ + pos) * ODN + 128 * gi + 8 * c8);
                *(LAS u32x4*)(XS + rr * 256 + c8 * 16) = v; }
            __syncthreads();
            for (int pc = tid; pc < 128 * 16; pc += 512) { const int tt = pc >> 4, c8 = pc & 15, t = t0 + tt;
                const int lo = (t - half) < 0 ? 0 : t - half, hi = (t + half) > SEQ ? SEQ : t + half; const float inv = 1.f / (float)(hi - lo);
                float s[8] = {0.f, 0.f, 0.f, 0.f, 0.f, 0.f, 0.f, 0.f};
                for (int p = lo; p < hi; ++p) { const u32x4 v = *(const LAS u32x4*)(XS + (p - t0 + 8) * 256 + c8 * 16);
                    s[0] += bflo(v.x); s[1] += bfhi(v.x); s[2] += bflo(v.y); s[3] += bfhi(v.y); s[4] += bflo(v.z); s[5] += bfhi(v.z); s[6] += bflo(v.w); s[7] += bfhi(v.w); }
                const u32x4 xv = *(const LAS u32x4*)(XS + (tt + 8) * 256 + c8 * 16);
                u32x4 o; o.x = pkbf(s[0] * inv - bflo(xv.x), s[1] * inv - bfhi(xv.x)); o.y = pkbf(s[2] * inv - bflo(xv.y), s[3] * inv - bfhi(xv.y));
                o.z = pkbf(s[4] * inv - bflo(xv.z), s[5] * inv - bfhi(xv.z)); o.w = pkbf(s[6] * inv - bflo(xv.w), s[7] * inv - bfhi(xv.w));
                *(LAS u32x4*)(DS + tt * DLD + c8 * 16) = o; }
            __syncthreads();
            { const int rb = wave & 3, chh = wave >> 2; const bf16* WT = (const bf16*)(ws + WS_POOLW) + (size_t)gi * 16384;
              f32x16 acc[2] = {f32x16{}, f32x16{}};
#pragma unroll
              for (int ks = 0; ks < 8; ++ks) { const bf16x8 af = *(const LAS bf16x8*)(DS + (32 * rb + r32) * DLD + (16 * ks + 8 * hh) * 2);
#pragma unroll
                  for (int ct = 0; ct < 2; ++ct) { const bf16x8 bfr = *(const bf16x8*)(WT + (size_t)(64 * chh + 32 * ct + r32) * 128 + 16 * ks + 8 * hh);
                      acc[ct] = __builtin_amdgcn_mfma_f32_32x32x16_bf16(af, bfr, acc[ct], 0, 0, 0); } }
#pragma unroll
              for (int ct = 0; ct < 2; ++ct) { const int col = 128 * gi + 64 * chh + 32 * ct + r32; const float ps = A.in[I_POOLS][col];
#pragma unroll
                  for (int r = 0; r < 16; ++r) MIX[(size_t)(b * SEQ + t0 + 32 * rb + crow(r, hh)) * DM + col] = f2bf(acc[ct][r] * ps); } }
        }
        __syncthreads();
    }
}
DEV void attn_phase(const Frame& F) {
    unsigned char* ws = F.a->ws; const bf16* QB = (const bf16*)(ws + WS_QB); const bf16* KB = (const bf16*)(ws + WS_KB); const bf16* VB = (const bf16*)(ws + WS_VB); bf16* MIX = (bf16*)(ws + WS_MIX2);
    for (int u = F.bid; u < NB * 12 * (SEQ / 256); u += F.G) {
        const int qb = u & 31, g = (u >> 5) % 3, kvh = ((u >> 5) / 3) & 3, b = (u >> 5) / 12, hq = kvh * 3 + g;
        att::attn_dense_body<1536, 512, DM>(QB + (size_t)(b * SEQ + 256 * qb) * 1536 + 128 * hq, KB + (size_t)b * KVL * 512 + 128 * kvh, VB + (size_t)b * KVL * 512 + 128 * kvh,
                                           MIX + (size_t)(b * SEQ + 256 * qb) * DM + 512 + 128 * hq, KVL, (char*)F.lds);
    }
}

constexpr int NPH = 25;
__global__ void __launch_bounds__(512, 2) mk_fwd(Args args) {
    extern __shared__ __attribute__((aligned(16))) unsigned char lds_raw[];
    Frame F; F.lds = (LAS unsigned char*)lds_raw; F.tid = threadIdx.x; F.lane = F.tid & 63; F.wave = __builtin_amdgcn_readfirstlane(F.tid >> 6); F.G = gridDim.x; F.bid = blockIdx.x; F.a = &args;
    unsigned char* ws = args.ws;
    volatile LAS unsigned* MISC = (volatile LAS unsigned*)(F.lds + MISC_OFF);
    if (F.tid < 64) MISC[F.tid] = 0u;
    __syncthreads();
    XcdBarrier bar; bar.bar = (unsigned*)(ws + WS_CTL) + CW_BAR; bar.x = 0; bar.st = nullptr;
    const int lo = args.ph_lo, hi = args.ph_hi;
    if (hi - lo > 1) bar = xcd_barrier_post((unsigned*)(ws + WS_CTL) + CW_BAR, MISC + 8);
#ifndef MK_MASK
#define MK_MASK 0xFFFFFFFFu
#endif
#define IN(k) (((MK_MASK >> (k)) & 1u) && lo <= (k) && (k) < hi && (k) <= MK_STOP_AFTER)
#define SEAM(k) do { if (IN(k) && (k) + 1 < hi) xcd_barrier(bar); } while (0)
#ifndef MK_DOUBLE
#define MK_DOUBLE 0u
#endif
#ifndef MK_STAMP
#define MK_STAMP (-1)
#endif
#ifndef MK_STAMPMASK
#define MK_STAMPMASK 0u
#endif
#define PHASE(k) do { if ((k) == MK_STAMP || ((MK_STAMPMASK >> (k)) & 1u)) t_stamp0 = wall_clock64(); if (IN(k)) { PH_BODY_##k; if ((MK_DOUBLE >> (k)) & 1u) { xcd_barrier(bar); PH_BODY_##k; } } SEAM(k); if ((k) == MK_STAMP) t_stamp1 = wall_clock64(); if ((MK_STAMPMASK >> (k)) & 1u) t_stamp1 += wall_clock64() - t_stamp0; } while (0)
    bf16* H = (bf16*)(ws + WS_H); bf16* ACT = (bf16*)(ws + WS_ACT); bf16* E = (bf16*)(ws + WS_E); bf16* E2 = (bf16*)(ws + WS_E2); bf16* MIX2 = (bf16*)(ws + WS_MIX2);
    float* XC = (float*)(ws + WS_XC); float* PART = (float*)(ws + WS_PART);
#define GEMM_GU(lf, M_) do { pg8::Gemm g{H, (const bf16*)(ws + WS_WGU + (size_t)(lf) * 44 * MiB), (M_), 2 * DFF, DM, DM}; pg8::StaticOrder S; S.init((M_), 2 * DFF, F.G, F.bid); \
        pg8::EpiSwiGLU Ep{ACT, DFF}; pg8::gemm_phase<pg8::EpiSwiGLU, pg8::StaticOrder, PG8_ALIGN, PG8_SP2>(F.lds, g, S, Ep); } while (0)
#define GEMM_DN(lf, M_) do { pg8::Gemm g{ACT, (const bf16*)(ws + WS_WD + (size_t)(lf) * 22 * MiB), (M_), DM, DFF, DFF}; pg8::TailSplitOrder S; S.init(ML, (M_) - ML, DM, F.G, F.bid, 4); \
        pg8::EpiPlainSplit Ep{H, DM, PART, ML, MC}; pg8::gemm_phase<pg8::EpiPlainSplit, pg8::TailSplitOrder, PG8_ALIGN, PG8_SP2>(F.lds, g, S, Ep); } while (0)
#define RES(hr, hn, li_, sub_, li2_, sub2_, nrows_, w_, xol, xoc, part_) do { ResCfg C{(hr), (hn), (li_), (sub_), (li2_), (sub2_), (nrows_), (w_), (xol), (xoc), args.out, XC, (part_)}; res_phase(F, C); } while (0)

    unsigned long long t_stamp0 = 0, t_stamp1 = 0;
#define PH_BODY_0 p0_prologue(F)
    PHASE(0);
#define PH_BODY_1 RES(0, 1, 0, 0, 0, 0, MT, 0.f, args.in[I_X], args.in[I_CTX], nullptr);
    PHASE(1);
#ifdef MK_GSTAMP
#define PH_BODY_2 { pg8::Gemm g{H, (const bf16*)(ws + WS_WGU), MT, 2 * DFF, DM, DM}; pg8::StaticOrder S; S.init(MT, 2 * DFF, F.G, F.bid); \
        pg8::EpiSwiGLU Ep{ACT, DFF}; const unsigned gstv = pg8::gemm_phase<pg8::EpiSwiGLU, pg8::StaticOrder, PG8_ALIGN, PG8_SP2>(F.lds, g, S, Ep); if (F.bid == 0 && F.tid == 0) ((unsigned*)(ws + WS_CTL))[64] = gstv; }
#else
#define PH_BODY_2 GEMM_GU(0, MT)
#endif
    PHASE(2);
#define PH_BODY_3 GEMM_DN(0, MT)
    PHASE(3);
#define PH_BODY_4 RES(1, 1, 0, 0, 0, 1, MT, 0.5f, args.in[I_X], args.in[I_CTX], PART)
    PHASE(4);
#define PH_BODY_5 { pg8::Gemm g{H, (const bf16*)(ws + WS_WEVIN), MT, EVN, DM, DM}; pg8::StaticOrder S; S.init(MT, EVN, F.G, F.bid); \
        pg8::EpiEvIn Ep{E, (const float*)(ws + WS_COS1), (const float*)(ws + WS_SIN1)}; pg8::gemm_phase<pg8::EpiEvIn, pg8::StaticOrder, PG8_ALIGN, PG8_SP2>(F.lds, g, S, Ep); }
    PHASE(5);
#define PH_BODY_6 lru_phase<false>(F)
    PHASE(6);
#define PH_BODY_7 { lru_carry_phase(F); ret_state_phase(F); }
    PHASE(7);
#ifndef MK_P8
#define MK_P8 3
#endif
#ifndef MK_DRY8
#define MK_DRY8 0
#endif
#define PH_BODY_8 { if (MK_DRY8 & 1) { lru_phase<true>(F, true); xcd_barrier(bar); } if (MK_DRY8 & 2) { ret_out_phase(F, true); xcd_barrier(bar); } if (MK_P8 & 1) lru_phase<true>(F); if (MK_P8 & 2) ret_out_phase(F); }
    PHASE(8);
#define PH_BODY_9 { pg8::Gemm g{E, (const bf16*)(ws + WS_WEVOUT), MT, DM, DM, EVN}; pg8::TailSplitOrder S; S.init(ML, MC, DM, F.G, F.bid, 4); \
        pg8::EpiPlainSplit Ep{H, DM, PART, ML, MC}; pg8::gemm_phase<pg8::EpiPlainSplit, pg8::TailSplitOrder, PG8_ALIGN, PG8_SP2>(F.lds, g, S, Ep); }
    PHASE(9);
#define PH_BODY_10 RES(1, 1, 0, 1, 0, 2, MT, 1.0f, args.out, XC, PART)
    PHASE(10);
#define PH_BODY_11 GEMM_GU(1, MT)
    PHASE(11);
#define PH_BODY_12 GEMM_DN(1, MT)
    PHASE(12);
#define PH_BODY_13 RES(1, 1, 0, 2, 1, 0, MT, 0.5f, args.out, XC, PART)
    PHASE(13);
#define PH_BODY_14 GEMM_GU(2, MT)
    PHASE(14);
#define PH_BODY_15 GEMM_DN(2, MT)
    PHASE(15);
#define PH_BODY_16 RES(1, 1, 1, 0, 1, 1, MT, 0.5f, args.out, XC, PART)
    PHASE(16);
#define PH_BODY_17 { pg8::Gemm g{H, (const bf16*)(ws + WS_WODIN), MT, ODN, DM, DM}; pg8::StaticOrder S; S.init(MT, ODN, F.G, F.bid); \
        pg8::EpiPlain Ep{E2, ODN}; pg8::gemm_phase<pg8::EpiPlain, pg8::StaticOrder, PG8_ALIGN, PG8_SP2>(F.lds, g, S, Ep); }
    PHASE(17);
#define PH_BODY_18 odd_post_phase(F)
    PHASE(18);
#define PH_BODY_19 attn_phase(F)
    PHASE(19);
#define PH_BODY_20 { pg8::Gemm g{MIX2, (const bf16*)(ws + WS_WODOUT), ML, DM, DM, DM}; pg8::StaticOrder S; S.init(ML, DM, F.G, F.bid); \
        pg8::EpiPlain Ep{H, DM}; pg8::gemm_phase<pg8::EpiPlain, pg8::StaticOrder, PG8_ALIGN, PG8_SP2>(F.lds, g, S, Ep); }
    PHASE(20);
#define PH_BODY_21 RES(1, 1, 1, 1, 1, 2, ML, 1.0f, args.out, XC, nullptr)
    PHASE(21);
#define PH_BODY_22 GEMM_GU(3, ML)
    PHASE(22);
#define PH_BODY_23 GEMM_DN(3, ML)
    PHASE(23);
#define PH_BODY_24 RES(1, 0, 1, 2, 0, 0, ML, 0.5f, args.out, XC, nullptr)
    PHASE(24);
#ifdef MK_GSTAMP
    if (F.bid == 0 && F.tid == 0) args.out[0] = 64.f * floorf((float)((const unsigned*)(ws + WS_CTL))[64] * 0.01f / 64.f + 0.5f);
#endif
    if (MK_STAMPMASK != 0u && F.bid == 0 && F.tid == 0) args.out[0] = 512.f * floorf((float)t_stamp1 * 0.01f / 512.f + 0.5f);
    if (MK_STAMP >= 0 && F.bid == 0 && F.tid == 0) args.out[0] = 128.f * floorf((float)(t_stamp1 - t_stamp0) * 0.01f / 128.f + 0.5f);
#undef IN
#undef SEAM
}

extern "C" void kernel_launch(void* const* d_in, const int* in_sizes, int n_in, void* d_out, int out_size, void* d_ws, size_t ws_size, hipStream_t stream) {
    static int grid = 0;
    if (grid == 0) {
        if (n_in != 28 || out_size != ML * DM || ws_size < WS_END) { fprintf(stderr, "kernel_launch: unexpected shapes (n_in %d out %d ws %zu, need ws >= %zu)\n", n_in, out_size, ws_size, (size_t)WS_END); grid = -1; return; }
        int dev = 0, cus = 0, per_cu = 0;
        if (hipGetDevice(&dev) != hipSuccess || hipDeviceGetAttribute(&cus, hipDeviceAttributeMultiprocessorCount, dev) != hipSuccess) { grid = -1; return; }
        if (hipFuncSetAttribute((const void*)mk_fwd, hipFuncAttributeMaxDynamicSharedMemorySize, LDS_BYTES) != hipSuccess) { fprintf(stderr, "kernel_launch: hipFuncSetAttribute failed\n"); grid = -1; return; }
        if (hipOccupancyMaxActiveBlocksPerMultiprocessor(&per_cu, (const void*)mk_fwd, 512, LDS_BYTES) != hipSuccess || per_cu < 1) fprintf(stderr, "kernel_launch: occupancy query says %d\n", per_cu);
        (void)hipGetLastError();
        grid = cus;
    }
    if (grid < 0) return;
    (void)hipMemsetAsync((char*)d_ws + WS_CTL, 0, CTL_ZERO_BYTES, stream);
    Args a{};
    for (int i = 0; i < 28; ++i) a.in[i] = (const float*)d_in[i];
    a.out = (float*)d_out; a.ws = (unsigned char*)d_ws;
#if MK_N_LAUNCHES == 1
    a.ph_lo = 0; a.ph_hi = NPH;
    hipLaunchKernelGGL(mk_fwd, dim3(grid), dim3(512), LDS_BYTES, stream, a);
#else
    for (int p = 0; p < NPH && p <= MK_STOP_AFTER; ++p) { a.ph_lo = p; a.ph_hi = p + 1; hipLaunchKernelGGL(mk_fwd, dim3(grid), dim3(512), LDS_BYTES, stream, a); }
#endif
    const hipError_t le = hipPeekAtLastError();
    if (le != hipSuccess) fprintf(stderr, "kernel_launch: launch failed: %s\n", hipGetErrorName(le));
}
```

```cpp
#include <hip/hip_runtime.h>
#include <cstdio>
#include <cstdint>

#ifndef MK_N_LAUNCHES
#define MK_N_LAUNCHES 1
#endif
#ifndef MK_STOP_AFTER
#define MK_STOP_AFTER 1000
#endif

#define DEV __device__ __forceinline__
#define LAS __attribute__((address_space(3)))
typedef unsigned short bf16;
typedef float f32x4 __attribute__((ext_vector_type(4)));
typedef float f32x2 __attribute__((ext_vector_type(2)));
typedef float f32x16 __attribute__((ext_vector_type(16)));
typedef short bf16x8 __attribute__((ext_vector_type(8)));
typedef short s16x4 __attribute__((ext_vector_type(4)));
typedef unsigned u32x4 __attribute__((ext_vector_type(4)));
typedef unsigned u32x2 __attribute__((ext_vector_type(2)));

constexpr int NB = 4, SEQ = 8192, DM = 2048, CTXL = 256, DFF = 5632;
constexpr int ML = NB * SEQ, MC = NB * CTXL, MT = ML + MC;
constexpr float EPS = 1e-6f;
constexpr int EVN = 6144, ODN = 3072;
constexpr int EC_G = 0, EC_O = 1024, EC_Q = 2048, EC_K = 3072, EC_V = 4096, EC_R = 5120;
constexpr int NCH64 = (CTXL + SEQ) / 64;
constexpr int NCH128 = (CTXL + SEQ) / 128;
constexpr int KVL = CTXL + SEQ;

constexpr size_t MiB = 1u << 20;
constexpr size_t WS_CTL = 0, CTL_ZERO_BYTES = 1 * MiB;
constexpr size_t WS_MOD = 1 * MiB;
constexpr size_t WS_COS1 = 2 * MiB, WS_SIN1 = 6 * MiB;
constexpr size_t WS_COS2 = 10 * MiB, WS_SIN2 = 12 * MiB;
constexpr size_t WS_LRUW = 14 * MiB;
constexpr size_t WS_POOLW = 15 * MiB;
constexpr size_t WS_AGG = 16 * MiB;
constexpr size_t WS_CAR = 25 * MiB;
constexpr size_t WS_XC = 30 * MiB;
constexpr size_t WS_W = 40 * MiB;
constexpr size_t WS_WGU = WS_W;
constexpr size_t WS_WD = WS_W + 176 * MiB;
constexpr size_t WS_WEVIN = WS_W + 264 * MiB;
constexpr size_t WS_WEVOUT = WS_W + 288 * MiB;
constexpr size_t WS_WODIN = WS_W + 296 * MiB;
constexpr size_t WS_WODOUT = WS_W + 308 * MiB;
constexpr size_t WS_H = 356 * MiB;
constexpr size_t WS_BIG = 488 * MiB;
constexpr size_t WS_ACT = WS_BIG;
constexpr size_t WS_E = WS_BIG;
constexpr size_t WS_SBUF = WS_BIG + 396 * MiB;
constexpr size_t WS_PART = WS_BIG + 400 * MiB;
constexpr size_t WS_E2 = WS_BIG;
constexpr size_t WS_QB = WS_BIG + 198 * MiB;
constexpr size_t WS_KB = WS_BIG + 294 * MiB;
constexpr size_t WS_VB = WS_BIG + 327 * MiB;
constexpr size_t WS_MIX2 = WS_BIG + 360 * MiB;
constexpr size_t WS_END = 1148 * MiB;
constexpr int CW_BAR = 4096;

constexpr int LDS_BYTES = 159744;
constexpr int MISC_OFF = LDS_BYTES - 256;

DEV float bflo(unsigned w) { return __uint_as_float(w << 16); }
DEV float bfhi(unsigned w) { return __uint_as_float(w & 0xffff0000u); }
DEV float bf2f(bf16 b) { return __uint_as_float((unsigned)b << 16); }
DEV unsigned pkbf(float lo, float hi) { unsigned r; asm volatile("v_cvt_pk_bf16_f32 %0, %1, %2" : "=v"(r) : "v"(lo), "v"(hi)); return r; }
DEV bf16 f2bf(float f) { return (bf16)(pkbf(f, 0.f) & 0xffffu); }
DEV float fexp(float x) { return __builtin_amdgcn_exp2f(x * 1.4426950408889634f); }
DEV float fsigmoid(float x) { return __builtin_amdgcn_rcpf(1.f + fexp(-x)); }
DEV float fsilu(float x) { return x * fsigmoid(x); }
DEV float fgelu_tanh(float x) { const float z = 0.7978845608028654f * (x + 0.044715f * x * x * x); return x * fsigmoid(2.f * z); }
DEV float wave_sum(float v) {
#pragma unroll
    for (int o = 1; o < 64; o <<= 1) v += __shfl_xor(v, o);
    return v;
}
DEV int crow(int r, int hi) { return (r & 3) + 8 * (r >> 2) + 4 * hi; }
typedef short v4i16_t __attribute__((ext_vector_type(4)));
DEV s16x4 ds_tr(const LAS unsigned char* p) { return __builtin_bit_cast(s16x4, __builtin_amdgcn_ds_read_tr16_b64_v4i16((LAS v4i16_t*)p)); }
DEV bf16x8 tr_frag(const LAS unsigned char* X, int ld, int k0, int n0, int lane) {
    const int h = lane >> 5, blk = (lane >> 4) & 1, q = (lane & 15) >> 2, p = lane & 3;
    const LAS unsigned char* a = X + (k0 + 8 * h + q) * ld + (n0 + 16 * blk + 4 * p) * 2;
    const s16x4 lo = ds_tr(a), hi = ds_tr(a + 4 * ld);
    return (bf16x8){lo[0], lo[1], lo[2], lo[3], hi[0], hi[1], hi[2], hi[3]};
}
DEV bf16x8 pack8(const float* v) { u32x4 w = {pkbf(v[0], v[1]), pkbf(v[2], v[3]), pkbf(v[4], v[5]), pkbf(v[6], v[7])}; return __builtin_bit_cast(bf16x8, w); }

namespace pg8 {
typedef unsigned short bf16_t;
constexpr int BM = 256, BK = 64, HALF = 128, HTB = HALF * BK * 2, STAGE_BYTES = 8 * HTB, NXCD = 8, WGM = 8;
__host__ __device__ __forceinline__ int lds_byte(int r, int c) { const int st = (r >> 4) * 2 + (c >> 5), rr = r & 15, cc = c & 31, ob = rr * 64 + cc * 2; return st * 1024 + (ob ^ (((ob >> 9) & 1) << 5)); }
__host__ __device__ __forceinline__ void stage_rc(int b, int& R, int& C) { const int st = b / 1024, sb = b % 1024, swz = sb ^ (((sb >> 9) & 1) << 5); R = (st >> 1) * 16 + swz / 64; C = (st & 1) * 32 + (swz % 64) / 2; }
__host__ __device__ __forceinline__ int perm32(int rho) { const int n = rho >> 4, i = rho & 15; return 8 * (i >> 2) + 4 * n + (i & 3); }
struct Unit { int pm, pn, ks, nks; };
struct Gemm { const bf16_t* A; const bf16_t* Bt; int M, N, K, lda; };
struct StaticOrder {
    int nM, nN, nwg, G, c;
    __host__ __device__ void init(int M, int N, int G_, int c_) { nM = M / BM; nN = N / BM; nwg = nM * nN; G = G_; c = c_; }
    __host__ __device__ __forceinline__ bool next(int i, Unit& u) const {
        const long L = (long)i * G + c; if (L >= nwg) return false;
        int wgid = (int)L; { const int q = nwg / NXCD, r = nwg % NXCD, xcd = wgid % NXCD, off = wgid / NXCD; wgid = (xcd < r ? xcd * (q + 1) : r * (q + 1) + (xcd - r) * q) + off; }
        const int nig = WGM * nN, gid = wgid / nig, fm = gid * WGM, gsz = (nM - fm) < WGM ? (nM - fm) : WGM;
        u.pm = fm + ((wgid % nig) % gsz); u.pn = (wgid % nig) / gsz; u.ks = 0; u.nks = 1; return true;
    }
    __device__ __forceinline__ void a_ready(const Unit&) const {}
    __device__ __forceinline__ void done(const Unit&) const {}
};
struct TailSplitOrder {
    StaticOrder full; int nMf, nMt, nN, nfull, split;
    __host__ __device__ void init(int Mfull, int Mtail, int N, int G_, int c_, int split_) { full.init(Mfull, N, G_, c_); nMf = Mfull / BM; nMt = Mtail / BM; nN = N / BM; nfull = nMf * nN; split = split_; }
    __host__ __device__ __forceinline__ bool next(int i, Unit& u) const {
        const long L = (long)i * full.G + full.c; int pm = 0, pn = 0, ks = 0, nks = 1; bool ok;
        if (L < nfull) { Unit f; ok = full.next(i, f); pm = f.pm; pn = f.pn; }
        else { const int Lp = (int)(L - nfull); ok = Lp < nMt * nN * split; const int t = Lp / split, d = nMt > 0 ? nMt : 1; ks = Lp % split; nks = split; pm = nMf + t % d; pn = t / d; }
        u.pm = pm; u.pn = pn; u.ks = ks; u.nks = nks; return ok;
    }
    __device__ __forceinline__ void a_ready(const Unit&) const {}
    __device__ __forceinline__ void done(const Unit&) const {}
};
struct EpiPlain {
    static constexpr bool PERM = true, AFTER_DRAIN = false;
    bf16_t* O; int ldc;
    __device__ __forceinline__ void operator()(const f32x4 (&acc)[2][2][4][2], const Unit& u, int wr, int wc, int fr, int fq) const {
        const int row0 = u.pm * BM + wr * 64 + fr, col0 = u.pn * BM + wc * 32 + 8 * fq;
#pragma unroll
        for (int ai = 0; ai < 2; ++ai)
#pragma unroll
            for (int m = 0; m < 4; ++m) { bf16_t* rowp = O + (size_t)(row0 + ai * HALF + m * 16) * ldc + col0;
#pragma unroll
                for (int bj = 0; bj < 2; ++bj) { const f32x4 v0 = acc[ai][bj][m][0], v1 = acc[ai][bj][m][1];
                    u32x4 w; w.x = pkbf(v0[0], v0[1]); w.y = pkbf(v0[2], v0[3]); w.z = pkbf(v1[0], v1[1]); w.w = pkbf(v1[2], v1[3]);
                    *(u32x4*)(rowp + bj * HALF) = w; } }
    }
};
struct EpiPlainSplit {
    static constexpr bool PERM = true, AFTER_DRAIN = false;
    bf16_t* O; int ldc; float* P; int prow0, prow_cnt;
    __device__ __forceinline__ void operator()(const f32x4 (&acc)[2][2][4][2], const Unit& u, int wr, int wc, int fr, int fq) const {
        const int row0 = u.pm * BM + wr * 64 + fr, col0 = u.pn * BM + wc * 32 + 8 * fq;
        if (u.nks == 1) {
#pragma unroll
            for (int ai = 0; ai < 2; ++ai)
#pragma unroll
                for (int m = 0; m < 4; ++m) { bf16_t* rowp = O + (size_t)(row0 + ai * HALF + m * 16) * ldc + col0;
#pragma unroll
                    for (int bj = 0; bj < 2; ++bj) { const f32x4 v0 = acc[ai][bj][m][0], v1 = acc[ai][bj][m][1];
                        u32x4 w; w.x = pkbf(v0[0], v0[1]); w.y = pkbf(v0[2], v0[3]); w.z = pkbf(v1[0], v1[1]); w.w = pkbf(v1[2], v1[3]);
                        *(u32x4*)(rowp + bj * HALF) = w; } }
        } else {
#pragma unroll
            for (int ai = 0; ai < 2; ++ai)
#pragma unroll
                for (int m = 0; m < 4; ++m) { float* rowp = P + ((size_t)u.ks * prow_cnt + (row0 + ai * HALF + m * 16 - prow0)) * ldc + col0;
#pragma unroll
                    for (int bj = 0; bj < 2; ++bj) { *(f32x4*)(rowp + bj * HALF) = acc[ai][bj][m][0]; *(f32x4*)(rowp + bj * HALF + 4) = acc[ai][bj][m][1]; } }
        }
    }
};
struct EpiSwiGLU {
    static constexpr bool PERM = true, AFTER_DRAIN = false;
    bf16_t* O; int ldc;
    __device__ __forceinline__ void operator()(const f32x4 (&acc)[2][2][4][2], const Unit& u, int wr, int wc, int fr, int fq) const {
        const int row0 = u.pm * BM + wr * 64 + fr, col0 = u.pn * HALF + wc * 32 + 8 * fq;
#pragma unroll
        for (int ai = 0; ai < 2; ++ai)
#pragma unroll
            for (int m = 0; m < 4; ++m) { bf16_t* rowp = O + (size_t)(row0 + ai * HALF + m * 16) * ldc + col0;
                f32x4 a0, a1;
#pragma unroll
                for (int j = 0; j < 4; ++j) { a0[j] = fsilu(acc[ai][0][m][0][j]) * acc[ai][1][m][0][j]; a1[j] = fsilu(acc[ai][0][m][1][j]) * acc[ai][1][m][1][j]; }
                u32x4 w; w.x = pkbf(a0[0], a0[1]); w.y = pkbf(a0[2], a0[3]); w.z = pkbf(a1[0], a1[1]); w.w = pkbf(a1[2], a1[3]);
                *(u32x4*)rowp = w; }
    }
};
struct EpiEvIn {
    static constexpr bool PERM = true, AFTER_DRAIN = false;
    bf16_t* O; const float* cs; const float* sn;
    __device__ __forceinline__ void operator()(const f32x4 (&acc)[2][2][4][2], const Unit& u, int wr, int wc, int fr, int fq) const {
        const int ldc = EVN; const int row0 = u.pm * BM + wr * 64 + fr, col0 = u.pn * BM + wc * 32 + 8 * fq;
        const bool qk = (u.pn >= 8 && u.pn < 16), rot = qk && (u.pm < ML / BM); const float ksc = (u.pn >= 12 && u.pn < 16) ? 0.0625f : 1.f;
#pragma unroll
        for (int ai = 0; ai < 2; ++ai)
#pragma unroll
            for (int m = 0; m < 4; ++m) { const int row = row0 + ai * HALF + m * 16; bf16_t* rowp = O + (size_t)row * ldc + col0;
                f32x4 o1[2], o2[2];
#pragma unroll
                for (int n = 0; n < 2; ++n) { const f32x4 x1 = acc[ai][0][m][n], x2 = acc[ai][1][m][n];
                    if (rot) { const int t = row & (SEQ - 1); const int i0 = wc * 32 + 8 * fq + 4 * n;
                        const f32x4 c4 = *(const f32x4*)(cs + (size_t)t * 128 + i0), s4 = *(const f32x4*)(sn + (size_t)t * 128 + i0);
                        o1[n] = (x1 * c4 - x2 * s4) * ksc; o2[n] = (x1 * s4 + x2 * c4) * ksc; }
                    else { o1[n] = x1 * ksc; o2[n] = x2 * ksc; } }
                u32x4 w; w.x = pkbf(o1[0][0], o1[0][1]); w.y = pkbf(o1[0][2], o1[0][3]); w.z = pkbf(o1[1][0], o1[1][1]); w.w = pkbf(o1[1][2], o1[1][3]);
                *(u32x4*)rowp = w;
                w.x = pkbf(o2[0][0], o2[0][1]); w.y = pkbf(o2[0][2], o2[0][3]); w.z = pkbf(o2[1][0], o2[1][1]); w.w = pkbf(o2[1][2], o2[1][3]);
                *(u32x4*)(rowp + HALF) = w; }
    }
};

template <class Epi, class Sched, bool ALIGN_EPI = false, bool SP2 = false>
__device__ __forceinline__ unsigned gemm_phase(LAS unsigned char* lds, const Gemm g, const Sched& S, const Epi& E) {
    const int tid = threadIdx.x, wid = __builtin_amdgcn_readfirstlane(tid >> 6), lane = tid & 63, wr = wid >> 2, wc = wid & 3, fr = lane & 15, fq = lane >> 4;
    const int K = g.K, nt_full = K / BK, lda = g.lda;
    unsigned voffA[2], voffB[2];
#pragma unroll
    for (int i = 0; i < 2; ++i) { int R, C; stage_rc(tid * 16 + i * 8192, R, C); const int Rb = Epi::PERM ? ((R & ~31) + perm32(R & 31)) : R;
        voffA[i] = (unsigned)(R * lda + C) * 2u; voffB[i] = (unsigned)(Rb * K + C) * 2u; }
    const size_t kstep = (size_t)(BK * 2);
    const size_t hstepA = (size_t)HALF * lda * 2, hstepB = (size_t)HALF * K * 2;
    const size_t tstepA = 2 * hstepA, tstepB = 2 * hstepB;
    const unsigned ldsw = (unsigned)wid * 1024u;
    const int aoff = lds_byte(wr * 64 + fr, fq * 8), boff = lds_byte(wc * 32 + fr, fq * 8);
#define PG8_SA(b, h) (((b) * 2 + (h)) * HTB)
#define PG8_SB(b, h) ((4 + (b) * 2 + (h)) * HTB)
#define PG8_STAGE(bufoff, gbase, voff) do { _Pragma("unroll") for (int _i = 0; _i < 2; ++_i) \
        __builtin_amdgcn_global_load_lds((const unsigned*)((const char*)(gbase) + (voff)[_i]), (LAS unsigned*)(lds + (bufoff) + ldsw + _i * 8192), 16, 0, 0); } while (0)
#define PG8_LDA(dst, b, h) do { _Pragma("unroll") for (int m = 0; m < 4; ++m) _Pragma("unroll") for (int k = 0; k < 2; ++k) dst[m][k] = *(const LAS bf16x8*)(lds + PG8_SA(b, h) + aoff + m * 2048 + k * 1024); } while (0)
#define PG8_LDB(dst, b, h) do { _Pragma("unroll") for (int n = 0; n < 2; ++n) _Pragma("unroll") for (int k = 0; k < 2; ++k) dst[n][k] = *(const LAS bf16x8*)(lds + PG8_SB(b, h) + boff + n * 2048 + k * 1024); } while (0)
#define PG8_MMA(ai, bj, At, Bt) do { __builtin_amdgcn_s_setprio(1); _Pragma("unroll") for (int m = 0; m < 4; ++m) _Pragma("unroll") for (int n = 0; n < 2; ++n) _Pragma("unroll") for (int k = 0; k < 2; ++k) \
        acc[ai][bj][m][n] = __builtin_amdgcn_mfma_f32_16x16x32_bf16(Bt[n][k], At[m][k], acc[ai][bj][m][n], 0, 0, 0); __builtin_amdgcn_s_setprio(0); } while (0)
#define PG8_WAIT_V(n) asm volatile("s_waitcnt vmcnt(" #n ")" ::: "memory")
#define PG8_WAIT_L(n) asm volatile("s_waitcnt lgkmcnt(" #n ")" ::: "memory")
#define PG8_BAR __builtin_amdgcn_s_barrier()
#define PG8_SCHED __builtin_amdgcn_sched_barrier(0)
    Unit cur, nxt; int ui = 0;
    if (!S.next(0, cur)) return 0u;
    f32x4 acc[2][2][4][2];
#pragma unroll
    for (int a = 0; a < 2; ++a)
#pragma unroll
        for (int b = 0; b < 2; ++b)
#pragma unroll
            for (int m = 0; m < 4; ++m)
#pragma unroll
                for (int n = 0; n < 2; ++n) acc[a][b][m][n] = (f32x4){0.f, 0.f, 0.f, 0.f};
    bf16x8 At[4][2], B0[2][2], B1[2][2];
    int nt = nt_full / cur.nks;
    const char* cA = (const char*)g.A + (size_t)cur.pm * tstepA + (size_t)cur.ks * (K / cur.nks) * 2; const char* cB = (const char*)g.Bt + (size_t)cur.pn * tstepB + (size_t)cur.ks * (K / cur.nks) * 2;
    S.a_ready(cur);
    if constexpr (SP2) {
        PG8_STAGE(PG8_SB(0, 0), cB, voffB); PG8_STAGE(PG8_SB(0, 1), cB + hstepB, voffB); PG8_STAGE(PG8_SA(0, 0), cA, voffA); PG8_STAGE(PG8_SA(0, 1), cA + hstepA, voffA);
        if (wr == 1) PG8_BAR;
        PG8_WAIT_V(2); PG8_BAR;
        PG8_STAGE(PG8_SB(1, 0), cB + kstep, voffB); PG8_STAGE(PG8_SA(1, 0), cA + kstep, voffA); PG8_STAGE(PG8_SB(1, 1), cB + hstepB + kstep, voffB);
        PG8_WAIT_V(6); PG8_BAR;
    } else {
        PG8_STAGE(PG8_SB(0, 0), cB, voffB); PG8_STAGE(PG8_SA(0, 0), cA, voffA); PG8_STAGE(PG8_SB(0, 1), cB + hstepB, voffB); PG8_STAGE(PG8_SA(0, 1), cA + hstepA, voffA);
        if (wr == 1) PG8_BAR;
        PG8_WAIT_V(4); PG8_BAR;
        PG8_STAGE(PG8_SB(1, 0), cB + kstep, voffB); PG8_STAGE(PG8_SA(1, 0), cA + kstep, voffA); PG8_STAGE(PG8_SB(1, 1), cB + hstepB + kstep, voffB);
        PG8_WAIT_V(6); PG8_BAR;
    }
#ifdef MK_GSTAMP
    unsigned gs_t2 = (unsigned)wall_clock64(), gs_acc = 0;
#endif
    for (;;) {
        const bool has_next = S.next(ui + 1, nxt);
        const char* nA = has_next ? (const char*)g.A + (size_t)nxt.pm * tstepA + (size_t)nxt.ks * (K / nxt.nks) * 2 : cA; const char* nB = has_next ? (const char*)g.Bt + (size_t)nxt.pn * tstepB + (size_t)nxt.ks * (K / nxt.nks) * 2 : cB;
        for (int t = 0; t < nt; t += 2) {
            const bool last = (t == nt - 2);
            const char* a1 = cA + (size_t)(t + 1) * kstep;
            const char* a2 = last ? nA : cA + (size_t)(t + 2) * kstep; const char* b2 = last ? nB : cB + (size_t)(t + 2) * kstep;
            const char* a3 = a2 + kstep; const char* b3 = b2 + kstep;
            if (last && has_next) S.a_ready(nxt);
            if constexpr (SP2) {
            PG8_LDB(B0, 0, 0); PG8_LDB(B1, 0, 1); PG8_SCHED; PG8_LDA(At, 0, 0); PG8_STAGE(PG8_SA(1, 1), a1 + hstepA, voffA);
            PG8_WAIT_V(8); PG8_WAIT_L(0); PG8_BAR; PG8_MMA(0, 0, At, B0); PG8_MMA(0, 1, At, B1); PG8_BAR; PG8_SCHED;
            PG8_LDA(At, 0, 1); PG8_STAGE(PG8_SB(0, 0), b2, voffB); PG8_STAGE(PG8_SB(0, 1), b2 + hstepB, voffB); PG8_STAGE(PG8_SA(0, 0), a2, voffA);
            PG8_WAIT_V(8); PG8_WAIT_L(0); PG8_BAR; PG8_MMA(1, 0, At, B0); PG8_MMA(1, 1, At, B1); PG8_BAR; PG8_SCHED;
            PG8_LDB(B0, 1, 0); PG8_LDB(B1, 1, 1); PG8_SCHED; PG8_LDA(At, 1, 0); PG8_STAGE(PG8_SA(0, 1), a2 + hstepA, voffA);
            PG8_WAIT_V(8); PG8_WAIT_L(0); PG8_BAR; PG8_MMA(0, 0, At, B0); PG8_MMA(0, 1, At, B1); PG8_BAR; PG8_SCHED;
            PG8_LDA(At, 1, 1); PG8_STAGE(PG8_SB(1, 0), b3, voffB); PG8_STAGE(PG8_SB(1, 1), b3 + hstepB, voffB); PG8_STAGE(PG8_SA(1, 0), a3, voffA);
            PG8_WAIT_V(8); PG8_WAIT_L(0); PG8_BAR; PG8_MMA(1, 0, At, B0); PG8_MMA(1, 1, At, B1); PG8_BAR; PG8_SCHED;
            } else {
            PG8_LDB(B0, 0, 0); PG8_SCHED; PG8_LDA(At, 0, 0); PG8_STAGE(PG8_SA(1, 1), a1 + hstepA, voffA);
            PG8_WAIT_L(8); PG8_BAR; PG8_WAIT_L(0); PG8_MMA(0, 0, At, B0); PG8_BAR; PG8_SCHED;
            PG8_LDB(B1, 0, 1); PG8_STAGE(PG8_SB(0, 0), b2, voffB);
            PG8_BAR; PG8_WAIT_L(0); PG8_MMA(0, 1, At, B1); PG8_BAR;
            PG8_LDA(At, 0, 1); PG8_STAGE(PG8_SA(0, 0), a2, voffA);
            PG8_BAR; PG8_WAIT_L(0); PG8_MMA(1, 0, At, B0); PG8_BAR; PG8_SCHED;
            PG8_STAGE(PG8_SB(0, 1), b2 + hstepB, voffB);
            PG8_WAIT_V(6); PG8_BAR; PG8_MMA(1, 1, At, B1); PG8_BAR;
            PG8_LDB(B0, 1, 0); PG8_SCHED; PG8_LDA(At, 1, 0); PG8_STAGE(PG8_SA(0, 1), a2 + hstepA, voffA);
            PG8_WAIT_L(8); PG8_BAR; PG8_WAIT_L(0); PG8_MMA(0, 0, At, B0); PG8_BAR; PG8_SCHED;
            PG8_LDB(B1, 1, 1); PG8_STAGE(PG8_SB(1, 0), b3, voffB);
            PG8_BAR; PG8_WAIT_L(0); PG8_MMA(0, 1, At, B1); PG8_BAR;
            PG8_LDA(At, 1, 1); PG8_STAGE(PG8_SA(1, 0), a3, voffA);
            PG8_BAR; PG8_WAIT_L(0); PG8_MMA(1, 0, At, B0); PG8_BAR; PG8_SCHED;
            PG8_STAGE(PG8_SB(1, 1), b3 + hstepB, voffB);
            PG8_WAIT_V(6); PG8_BAR; PG8_MMA(1, 1, At, B1); PG8_BAR;
            }
        }
#ifdef MK_GSTAMP
        const unsigned gs_t0 = (unsigned)wall_clock64(); if (MK_GSTAMP == 2) gs_acc += gs_t0 - gs_t2;
#endif
        if constexpr (ALIGN_EPI) { if (wr == 0) PG8_BAR; }
        if constexpr (!Epi::AFTER_DRAIN) { E(acc, cur, wr, wc, fr, fq); S.done(cur); }
#ifdef MK_GSTAMP
        const unsigned gs_t1 = (unsigned)wall_clock64(); if (MK_GSTAMP == 0) gs_acc += gs_t1 - gs_t0;
#endif
        if (!has_next) break;
#pragma unroll
        for (int a = 0; a < 2; ++a)
#pragma unroll
            for (int b = 0; b < 2; ++b)
#pragma unroll
                for (int m = 0; m < 4; ++m)
#pragma unroll
                    for (int n = 0; n < 2; ++n) acc[a][b][m][n] = (f32x4){0.f, 0.f, 0.f, 0.f};
        cur = nxt; cA = nA; cB = nB; ++ui; nt = nt_full / cur.nks;
        if constexpr (ALIGN_EPI) { if (wr == 1) PG8_BAR; }
#ifdef MK_GSTAMP
        gs_t2 = (unsigned)wall_clock64(); if (MK_GSTAMP == 1) gs_acc += gs_t2 - gs_t1;
#endif
    }
    PG8_WAIT_V(0);
    if constexpr (!ALIGN_EPI) { if (wr == 0) PG8_BAR; }
    PG8_BAR;
#ifdef MK_GSTAMP
    return gs_acc;
#else
    return 0u;
#endif
#undef PG8_SA
#undef PG8_SB
#undef PG8_STAGE
#undef PG8_LDA
#undef PG8_LDB
#undef PG8_MMA
#undef PG8_WAIT_V
#undef PG8_WAIT_L
#undef PG8_BAR
#undef PG8_SCHED
}
}
#define PG8_SP2 true
#define PG8_ALIGN true

namespace att {
constexpr int D = 128, NW = 8, QBLK = 32, KVBLK = 64;
constexpr float SCALE = 0.088388347648318440f;
constexpr float THR = 8.f;
constexpr size_t SHM_V = KVBLK * D * 2, SHM_K = KVBLK * D * 2, SHM_ATTN = 2 * SHM_V + 2 * SHM_K + NW * 64 * 4;
#define KSWZ(row, colB) ((row) * 256 + ((colB) ^ (((row) & 7) << 4)))
#define SBAR() __builtin_amdgcn_sched_barrier(0)
DEV void partialSM(f32x16& p0, f32x16& p1, float& m_reg, float& mn, float& alpha) {
  constexpr float C = SCALE * 1.4426950408889634f;
  float pmax = p0[0]; for (int r = 1; r < 16; ++r) pmax = fmaxf(pmax, p0[r]); for (int r = 0; r < 16; ++r) pmax = fmaxf(pmax, p1[r]);
  { auto rr = __builtin_amdgcn_permlane32_swap(__float_as_uint(pmax), __float_as_uint(pmax), false, false);
    pmax = fmaxf(__uint_as_float(rr[0]), __uint_as_float(rr[1])); }
  if (__builtin_expect(__all(pmax - m_reg <= THR / SCALE), 1)) { mn = m_reg; alpha = 1.f; }
  else { mn = fmaxf(m_reg, pmax); alpha = __builtin_amdgcn_exp2f((m_reg - mn) * C); m_reg = mn; }
  float mnC = -mn * C;
  for (int r = 0; r < 16; ++r) p0[r] = fmaf(p0[r], C, mnC); for (int r = 0; r < 16; ++r) p1[r] = fmaf(p1[r], C, mnC);
  for (int r = 0; r < 16; ++r) p0[r] = __builtin_amdgcn_exp2f(p0[r]);
}
DEV void finishSM(f32x16& p0, f32x16& p1, float alpha, float& l_reg, bf16x8& pa0, bf16x8& pa1, bf16x8& pa2, bf16x8& pa3) {
  for (int r = 0; r < 16; ++r) p1[r] = __builtin_amdgcn_exp2f(p1[r]);
  float ps = 0; for (int r = 0; r < 16; ++r) ps += p0[r]; for (int r = 0; r < 16; ++r) ps += p1[r];
  { auto rr = __builtin_amdgcn_permlane32_swap(__float_as_uint(ps), __float_as_uint(ps), false, false);
    ps = __uint_as_float(rr[0]) + __uint_as_float(rr[1]); }
  l_reg = l_reg * alpha + ps;
#define PK4(P, BASE, OUT) do { unsigned a0 = pkbf(P[BASE + 0], P[BASE + 1]), a1 = pkbf(P[BASE + 2], P[BASE + 3]);   \
    unsigned b0 = pkbf(P[BASE + 4], P[BASE + 5]), b1 = pkbf(P[BASE + 6], P[BASE + 7]);                              \
    auto r0 = __builtin_amdgcn_permlane32_swap(a0, b0, false, false); auto r1 = __builtin_amdgcn_permlane32_swap(a1, b1, false, false); \
    u32x4 w = {r0[0], r1[0], r0[1], r1[1]}; OUT = __builtin_bit_cast(bf16x8, w); } while (0)
  PK4(p0, 0, pa0); PK4(p0, 8, pa1); PK4(p1, 0, pa2); PK4(p1, 8, pa3);
#undef PK4
}
DEV void qkt(f32x16& p0, f32x16& p1, const bf16* Ks, const bf16x8* qr, int r32, int hi) {
  p0 = f32x16{}; p1 = f32x16{};
  for (int d0 = 0; d0 < 8; ++d0) { int cb = (d0 * 16 + hi * 8) * 2;
    bf16x8 b0 = *reinterpret_cast<const bf16x8*>((const char*)Ks + KSWZ(r32, cb));
    bf16x8 b1 = *reinterpret_cast<const bf16x8*>((const char*)Ks + KSWZ(32 + r32, cb));
    p0 = __builtin_amdgcn_mfma_f32_32x32x16_bf16(b0, qr[d0], p0, 0, 0, 0);
    p1 = __builtin_amdgcn_mfma_f32_32x32x16_bf16(b1, qr[d0], p1, 0, 0, 0); }
}
DEV int v_st(int k, int c) { const int kk = (k & ~0xC) | ((k & 4) << 1) | ((k & 8) >> 1); return ((kk >> 3) * 4 + (c >> 5)) * 512 + ((kk & 7) * 32 + (c & 31)) * 2; }
DEV int v_rd_base(int lane) { return ((lane & 3) << 3) | (((lane >> 2) & 3) << 6) | (((lane >> 4) & 1) << 5) | (((lane >> 5) & 1) << 8); }
constexpr int v_rd_off(int d0, int ks, int half) { return d0 * 512 + ks * 4096 + half * 2048; }
template <int OFF> DEV s16x4 tr_read(int vb) {
  s16x4 r; asm volatile("ds_read_b64_tr_b16 %0, %1 offset:%2" : "=&v"(r) : "v"(vb), "i"(OFF) : "memory"); return r;
}
template <int D0> DEV void pv_one(f32x16& od, int vb, bf16x8 pa0, bf16x8 pa1, bf16x8 pa2, bf16x8 pa3) {
  const s16x4 l0 = tr_read<v_rd_off(D0, 0, 0)>(vb), h0 = tr_read<v_rd_off(D0, 0, 1)>(vb), l1 = tr_read<v_rd_off(D0, 1, 0)>(vb), h1 = tr_read<v_rd_off(D0, 1, 1)>(vb);
  const s16x4 l2 = tr_read<v_rd_off(D0, 2, 0)>(vb), h2 = tr_read<v_rd_off(D0, 2, 1)>(vb), l3 = tr_read<v_rd_off(D0, 3, 0)>(vb), h3 = tr_read<v_rd_off(D0, 3, 1)>(vb);
  asm volatile("s_waitcnt lgkmcnt(0)" ::: "memory"); SBAR();
#define PK(L, H) (bf16x8){L[0], L[1], L[2], L[3], H[0], H[1], H[2], H[3]}
  od = __builtin_amdgcn_mfma_f32_32x32x16_bf16(pa0, PK(l0, h0), od, 0, 0, 0);
  od = __builtin_amdgcn_mfma_f32_32x32x16_bf16(pa1, PK(l1, h1), od, 0, 0, 0);
  od = __builtin_amdgcn_mfma_f32_32x32x16_bf16(pa2, PK(l2, h2), od, 0, 0, 0);
  od = __builtin_amdgcn_mfma_f32_32x32x16_bf16(pa3, PK(l3, h3), od, 0, 0, 0);
#undef PK
}
DEV void pv_d0(f32x16* o, int vb, bf16x8 pa0, bf16x8 pa1, bf16x8 pa2, bf16x8 pa3) {
  pv_one<0>(o[0], vb, pa0, pa1, pa2, pa3); pv_one<1>(o[1], vb, pa0, pa1, pa2, pa3); pv_one<2>(o[2], vb, pa0, pa1, pa2, pa3); pv_one<3>(o[3], vb, pa0, pa1, pa2, pa3);
}
template <int LDQ, int LDK, int LDO>
DEV void attn_dense_body(const bf16* __restrict__ Qb, const bf16* __restrict__ Kh, const bf16* __restrict__ Vh, bf16* __restrict__ Ob, int seq, char* lds) {
  const int tid = threadIdx.x, wid = tid >> 6, lane = tid & 63, r32 = lane & 31, hi = lane >> 5;
  bf16* V_lds = (bf16*)lds; bf16* K_lds = (bf16*)(lds + 2 * SHM_V);
  float* ws = (float*)(lds + 2 * SHM_V + 2 * SHM_K) + wid * 64; float* li_l = ws; float* al_l = ws + 32;
  float m_reg = -1e30f, l_reg = 0; f32x16 o[4] = {}; bf16x8 qr[8];
  const bf16* Qw = Qb + (long)(wid * QBLK + r32) * LDQ + hi * 8;
#pragma unroll
  for (int d0 = 0; d0 < 8; ++d0) qr[d0] = *reinterpret_cast<const bf16x8*>(Qw + d0 * 16);
  const int sr = tid >> 4, sc = (tid & 15) * 8, vst0 = v_st(sr, sc), vst1 = v_st(32 + sr, sc);
  const int vb0 = (int)(uintptr_t)V_lds + v_rd_base(lane);
  struct { bf16x8 vs0, vs1, ks0, ks1; } sr_[2];
#define SLOAD(i, k0) do { sr_[i].vs0 = *reinterpret_cast<const bf16x8*>(&Vh[(long)((k0) + sr) * LDK + sc]); sr_[i].vs1 = *reinterpret_cast<const bf16x8*>(&Vh[(long)((k0) + 32 + sr) * LDK + sc]); \
    sr_[i].ks0 = *reinterpret_cast<const bf16x8*>(&Kh[(long)((k0) + sr) * LDK + sc]); sr_[i].ks1 = *reinterpret_cast<const bf16x8*>(&Kh[(long)((k0) + 32 + sr) * LDK + sc]); } while (0)
#define SWRITE(b, i) do { *(bf16x8*)((char*)V_lds + (b) * SHM_V + vst0) = sr_[i].vs0;          \
    *(bf16x8*)((char*)V_lds + (b) * SHM_V + vst1) = sr_[i].vs1; int kc = sc * 2;               \
    *(bf16x8*)((char*)K_lds + (b) * SHM_K + KSWZ(sr, kc)) = sr_[i].ks0;                       \
    *(bf16x8*)((char*)K_lds + (b) * SHM_K + KSWZ(32 + sr, kc)) = sr_[i].ks1; } while (0)
#define SWAIT() asm volatile("s_waitcnt vmcnt(4)" ::: "memory")
#define RESC(a) do { if (__any((a) < 1.f)) { if (hi == 0) al_l[r32] = (a); asm volatile("s_waitcnt lgkmcnt(0)" ::: "memory"); \
    for (int d = 0; d < 4; ++d) for (int r = 0; r < 16; ++r) o[d][r] *= al_l[crow(r, hi)]; } } while (0)
  f32x16 pA0, pA1, pB0, pB1; float mnA, mnB, alA, alB; bf16x8 pa0, pa1, pa2, pa3; const int NT = seq / KVBLK;
  constexpr int SE = 0, SO = 1;
  SLOAD(SE, 0); asm volatile("s_waitcnt vmcnt(0)" ::: "memory"); SWRITE(0, SE); __syncthreads();
  qkt(pA0, pA1, K_lds, qr, r32, hi); partialSM(pA0, pA1, m_reg, mnA, alA);
  SLOAD(SO, KVBLK); if (2 < NT) SLOAD(SE, 2 * KVBLK);
  SWAIT(); SWRITE(1, SO); __syncthreads();
  for (int j = 1; j + 1 < NT; j += 2) {
    SBAR(); qkt(pB0, pB1, (bf16*)((char*)K_lds + SHM_K), qr, r32, hi);
    finishSM(pA0, pA1, alA, l_reg, pa0, pa1, pa2, pa3); SBAR();
    SLOAD(SO, (j + 2) * KVBLK); SBAR();
    pv_d0(o, vb0, pa0, pa1, pa2, pa3); partialSM(pB0, pB1, m_reg, mnB, alB);
    __syncthreads(); SWAIT(); SWRITE(0, SE);
    RESC(alB); __syncthreads();
    SBAR(); qkt(pA0, pA1, K_lds, qr, r32, hi);
    finishSM(pB0, pB1, alB, l_reg, pa0, pa1, pa2, pa3); SBAR();
    if (j + 3 < NT) SLOAD(SE, (j + 3) * KVBLK); SBAR();
    pv_d0(o, vb0 + (int)SHM_V, pa0, pa1, pa2, pa3); partialSM(pA0, pA1, m_reg, mnA, alA);
    __syncthreads(); SWAIT(); SWRITE(1, SO);
    RESC(alA); __syncthreads();
  }
  SBAR(); qkt(pB0, pB1, (bf16*)((char*)K_lds + SHM_K), qr, r32, hi);
  finishSM(pA0, pA1, alA, l_reg, pa0, pa1, pa2, pa3); SBAR();
  pv_d0(o, vb0, pa0, pa1, pa2, pa3); partialSM(pB0, pB1, m_reg, mnB, alB);
  __syncthreads(); RESC(alB);
  finishSM(pB0, pB1, alB, l_reg, pa0, pa1, pa2, pa3); SBAR();
  pv_d0(o, vb0 + (int)SHM_V, pa0, pa1, pa2, pa3);
  if (hi == 0) li_l[r32] = l_reg; asm volatile("s_waitcnt lgkmcnt(0)" ::: "memory");
  float rli[16];
#pragma unroll
  for (int r = 0; r < 16; ++r) rli[r] = __builtin_amdgcn_rcpf(li_l[crow(r, hi)]);
  bf16* Ow = Ob + (long)(wid * QBLK) * LDO;
#pragma unroll
  for (int r = 0; r < 16; ++r) { int orow = crow(r, hi);
    for (int d0 = 0; d0 < 4; ++d0) Ow[(long)orow * LDO + d0 * 32 + r32] = f2bf(o[d0][r] * rli[r]); }
  __syncthreads();
#undef SLOAD
#undef SWRITE
#undef SWAIT
#undef RESC
}
#undef KSWZ
}

#define XB_TMO      128
#define XB_XCNT(j)  (256  + 64 * (j))
#define XB_XSUB(j)  (1280 + 64 * (j))
#define XB_XGEN(j)  (2304 + 64 * (j))
#define XB_TOP      3328
#define XB_TOPGEN   3392
#define XCD_BAR_WORDS 3456
#define XB_SPIN_CAP (1u << 18)
DEV unsigned xb_ld(unsigned* p)              { return __hip_atomic_load(p, __ATOMIC_RELAXED, __HIP_MEMORY_SCOPE_AGENT); }
DEV unsigned xb_add(unsigned* p, unsigned v) { return __hip_atomic_fetch_add(p, v, __ATOMIC_RELAXED, __HIP_MEMORY_SCOPE_AGENT); }
DEV unsigned xb_xcc_id() { return (unsigned)__builtin_amdgcn_s_getreg((3 << 11) | 20) & 0xFu; }
#define XB_SPIN(cond, bar) do { unsigned _sp = 0; while (cond) { __builtin_amdgcn_s_sleep(1); \
    if ((++_sp & 255u) == 0u) { if (xb_ld(&(bar)[XB_TMO])) break; if (_sp > XB_SPIN_CAP) { atomicAdd(&(bar)[XB_TMO], 1u); break; } } } } while (0)
struct XcdBarrier { unsigned* bar; unsigned x; volatile LAS unsigned* st; };
DEV XcdBarrier xcd_barrier_post(unsigned* bar, volatile LAS unsigned* st) {
    XcdBarrier b; b.bar = bar; b.x = xb_xcc_id(); b.st = st;
    if (threadIdx.x == 0) (void)xb_add(&bar[XB_XCNT(b.x)], 1u);
    return b;
}
DEV void xcd_barrier_complete(unsigned* bar, unsigned x, unsigned& nloc, unsigned& nx) {
    const unsigned G = gridDim.x * gridDim.y * gridDim.z;
    unsigned sum, cnt, mine, sp = 0u;
    for (;;) {
        sum = 0u; cnt = 0u; mine = 0u;
#pragma unroll
        for (unsigned j = 0; j < 16; ++j) { const unsigned c = xb_ld(&bar[XB_XCNT(j)]); sum += c; cnt += (c > 0u) ? 1u : 0u; mine = (j == x) ? c : mine; }
        if (sum == G) break;
        __builtin_amdgcn_s_sleep(1);
        if ((++sp & 255u) == 0u) { if (xb_ld(&bar[XB_TMO])) break; if (sp > XB_SPIN_CAP) { atomicAdd(&bar[XB_TMO], 1u); break; } }
    }
    nloc = mine > 0u ? mine : 1u; nx = cnt > 0u ? cnt : 1u;
}
DEV void xcd_barrier(const XcdBarrier& b) {
    asm volatile("s_waitcnt vmcnt(0)" ::: "memory");
    __syncthreads();
    if (threadIdx.x == 0) {
        unsigned* bar = b.bar;
        __builtin_amdgcn_s_waitcnt(0);
        unsigned nloc = b.st[0], nx = b.st[1];
        if (nloc == 0u) { xcd_barrier_complete(bar, b.x, nloc, nx); b.st[0] = nloc; b.st[1] = nx; }
        const unsigned old = xb_add(&bar[XB_XSUB(b.x)], 1u);
        const unsigned gen = old / nloc;
        if (old + 1u == (gen + 1u) * nloc) {
            __builtin_amdgcn_fence(__ATOMIC_RELEASE, "agent");
            asm volatile("s_waitcnt vmcnt(0)" ::: "memory");
            const unsigned og = xb_add(&bar[XB_TOP], 1u);
            const unsigned tg = og / nx;
            if (og + 1u == (tg + 1u) * nx) xb_add(&bar[XB_TOPGEN], 1u);
            else XB_SPIN(xb_ld(&bar[XB_TOPGEN]) == tg, bar);
            __builtin_amdgcn_fence(__ATOMIC_ACQUIRE, "agent");
            xb_add(&bar[XB_XGEN(b.x)], 1u);
            asm volatile("s_waitcnt vmcnt(0)" ::: "memory");
        } else {
            XB_SPIN(xb_ld(&bar[XB_XGEN(b.x)]) == gen, bar);
            __builtin_amdgcn_fence(__ATOMIC_ACQUIRE, "agent");
            asm volatile("s_waitcnt vmcnt(0)" ::: "memory");
        }
    }
    __syncthreads();
}

struct Args { const float* in[28]; float* out; unsigned char* ws; int ph_lo, ph_hi; };
enum { I_X = 0, I_C, I_CTX, I_CCTX, I_MODW, I_MODB, I_NPRE, I_NPOST, I_FG, I_FU, I_FD, I_EVIN, I_EVOUT, I_CONVW, I_CONVB, I_WA, I_BA, I_WX, I_BX, I_LAM, I_DECAY, I_GN,
       I_ODIN, I_ODOUT, I_POOLW, I_POOLS, I_QN, I_KN };
struct Frame {
    LAS unsigned char* lds; int tid, lane, wave, G, bid;
    const Args* a;
};
#define LDS_WAIT() asm volatile("s_waitcnt lgkmcnt(0)" ::: "memory")

DEV void transpose_item(const float* W, int K, int N, bf16* WT, int drow0, LAS float* scr, int kb, int nb, int lane) {
    const int k0 = 64 * kb, n0 = 32 * nb, lr = lane >> 3, c4 = lane & 7;
    f32x4 v[8];
#pragma unroll
    for (int j = 0; j < 8; ++j) v[j] = *(const f32x4*)(W + (size_t)(k0 + lr + 8 * j) * N + n0 + 4 * c4);
#pragma unroll
    for (int j = 0; j < 8; ++j) { LAS float* d = scr + (lr + 8 * j) * 33 + 4 * c4; d[0] = v[j].x; d[1] = v[j].y; d[2] = v[j].z; d[3] = v[j].w; }
    LDS_WAIT(); asm volatile("" ::: "memory");
    const int c = lane & 7;
    float t[4][8];
#pragma unroll
    for (int j = 0; j < 4; ++j) { const LAS float* sp = scr + (8 * c) * 33 + (lane >> 3) + 8 * j;
#pragma unroll
        for (int i = 0; i < 8; ++i) t[j][i] = sp[i * 33]; }
#pragma unroll
    for (int j = 0; j < 4; ++j) { const int n = (lane >> 3) + 8 * j;
        u32x4 o; o.x = pkbf(t[j][0], t[j][1]); o.y = pkbf(t[j][2], t[j][3]); o.z = pkbf(t[j][4], t[j][5]); o.w = pkbf(t[j][6], t[j][7]);
        *(u32x4*)(WT + (size_t)(drow0 + n) * K + k0 + 8 * c) = o; }
    LDS_WAIT(); asm volatile("" ::: "memory");
}
constexpr int CV_IFFN = 5632, CV_LF1 = 3 * CV_IFFN, CV_LF2 = 6 * CV_IFFN, CV_LF3 = 9 * CV_IFFN, CV_EI = 12 * CV_IFFN, CV_EO = CV_EI + 32 * 192, CV_OI = CV_EO + 32 * 64, CV_OO = CV_OI + 32 * 96, CV_SM = CV_OO + 32 * 64, CV_END = CV_SM + 8 * 36;
DEV void conv_item(const Frame& F, int it) {
    const Args& A = *F.a; unsigned char* ws = A.ws; LAS float* scr = (LAS float*)(F.lds + F.wave * 16384);
    int r = it;
    if (r < CV_EI) { const int idx = r / CV_IFFN, item = r % CV_IFFN, lf = idx / 3, kind = idx % 3;
        if (kind < 2) { const float* W = A.in[kind == 0 ? I_FG : I_FU] + (size_t)lf * DM * DFF; const int nb = item % 176, kb = item / 176, n0 = 32 * nb;
            transpose_item(W, DM, DFF, (bf16*)(ws + WS_WGU + (size_t)lf * 44 * MiB), 256 * (n0 / 128) + 128 * kind + (n0 % 128), scr, kb, nb, F.lane); }
        else { const float* W = A.in[I_FD] + (size_t)lf * DFF * DM; const int nb = item % 64, kb = item / 64;
            transpose_item(W, DFF, DM, (bf16*)(ws + WS_WD + (size_t)lf * 22 * MiB), 32 * nb, scr, kb, nb, F.lane); }
        return; }
    if (r < CV_EO) { r -= CV_EI; const int nb = r % 192, kb = r / 192, n0 = 32 * nb, blk = n0 / 1024;
        const int dblk = (blk == 1) ? 5 : (blk == 5) ? 1 : blk;
        transpose_item(A.in[I_EVIN], DM, EVN, (bf16*)(ws + WS_WEVIN), dblk * 1024 + (n0 % 1024), scr, kb, nb, F.lane); return; }
    if (r < CV_OI) { r -= CV_EO; const int nb = r % 64, kb = r / 64; transpose_item(A.in[I_EVOUT], DM, DM, (bf16*)(ws + WS_WEVOUT), 32 * nb, scr, kb, nb, F.lane); return; }
    if (r < CV_OO) { r -= CV_OI; const int nb = r % 96, kb = r / 96; transpose_item(A.in[I_ODIN], DM, ODN, (bf16*)(ws + WS_WODIN), 32 * nb, scr, kb, nb, F.lane); return; }
    if (r < CV_SM) { r -= CV_OO; const int nb = r % 64, kb = r / 64; transpose_item(A.in[I_ODOUT], DM, DM, (bf16*)(ws + WS_WODOUT), 32 * nb, scr, kb, nb, F.lane); return; }
    { r -= CV_SM; const int mat = r / 8, item = r % 8, nb = item % 4, kb = item / 4;
        const float* W; bf16* dst;
        if (mat < 16) { W = A.in[I_WA] + (size_t)mat * 16384; dst = (bf16*)(ws + WS_LRUW) + (size_t)mat * 16384; }
        else if (mat < 32) { W = A.in[I_WX] + (size_t)(mat - 16) * 16384; dst = (bf16*)(ws + WS_LRUW) + (size_t)mat * 16384; }
        else { W = A.in[I_POOLW] + (size_t)(mat - 32) * 16384; dst = (bf16*)(ws + WS_POOLW) + (size_t)(mat - 32) * 16384; }
        transpose_item(W, 128, 128, dst, 32 * nb, scr, kb, nb, F.lane); }
}
DEV void deferred_convert(const Frame& F, int lo, int hi, int total) {
    const int G = F.G, mx = (total + G - 1) / G, first_idle = total - (mx - 1) * G;
    int rank = F.bid, n = G;
    if (first_idle < G) { if (F.bid < first_idle) return; rank = F.bid - first_idle; n = G - first_idle; }
    for (int it = lo + rank * 8 + F.wave; it < hi; it += n * 8) conv_item(F, it);
}
DEV void p0_prologue(const Frame& F) {
    const Args& A = *F.a; unsigned char* ws = A.ws;
    {
        LAS float* ssc = (LAS float*)F.lds;
        LAS float* red = (LAS float*)(F.lds + 40960);
        for (int i = F.tid; i < 5 * DM; i += 512) { const int r = i / DM, k = i % DM; const float v = (r < 4) ? A.in[I_C][r * DM + k] : A.in[I_CCTX][k]; ssc[i] = fsilu(v); }
        __syncthreads();
        float* MOD = (float*)(ws + WS_MOD);
        for (int it = F.bid; it < 256; it += F.G) {
            const int li = it >> 7, col0 = (it & 127) * 144; const int ln = F.lane < 36 ? F.lane : 35;
            const float* Wp = A.in[I_MODW] + (size_t)li * DM * 18432 + (size_t)(F.wave * 256) * 18432 + col0 + 4 * ln;
            f32x4 acc[5];
#pragma unroll
            for (int r = 0; r < 5; ++r) acc[r] = (f32x4){0.f, 0.f, 0.f, 0.f};
#pragma unroll 8
            for (int kk = 0; kk < 256; ++kk) { const f32x4 wv = *(const f32x4*)(Wp + (size_t)kk * 18432);
#pragma unroll
                for (int r = 0; r < 5; ++r) { const float sv = ssc[r * DM + F.wave * 256 + kk]; acc[r] += wv * sv; } }
            if (F.lane < 36) {
#pragma unroll
                for (int r = 0; r < 5; ++r) *(LAS f32x4*)(red + (F.wave * 5 + r) * 144 + 4 * F.lane) = acc[r]; }
            __syncthreads();
            for (int o = F.tid; o < 720; o += 512) { const int r = o / 144, c = o % 144; float sum = A.in[I_MODB][li * 18432 + col0 + c];
#pragma unroll
                for (int w = 0; w < 8; ++w) sum += red[(w * 5 + r) * 144 + c];
                MOD[(size_t)(li * 5 + r) * 18432 + col0 + c] = sum; }
            __syncthreads();
        }
    }
    {
        const int gw = F.bid * 8 + F.wave, NGW = F.G * 8;
        for (int it = gw; it < CV_LF1; it += NGW) conv_item(F, it);
        for (int it = CV_SM + gw; it < CV_END; it += NGW) conv_item(F, it);
    }
    {
        const int gt = F.bid * 512 + F.tid, NT = F.G * 512;
        float* c1 = (float*)(ws + WS_COS1); float* s1 = (float*)(ws + WS_SIN1); float* c2 = (float*)(ws + WS_COS2); float* s2 = (float*)(ws + WS_SIN2);
        for (int i = gt; i < SEQ * 128 + SEQ * 64; i += NT) {
            float pos, f; float* cd; float* sd;
            if (i < SEQ * 128) { const int t = i >> 7, k = i & 127; pos = (float)t; f = exp2f(-(float)k * (13.287712379549449f / 128.f)); cd = c1 + i; sd = s1 + i; }
            else { const int j = i - SEQ * 128, t = j >> 6, k = j & 63; pos = (k < 32) ? (float)(t >> 6) : (float)(t & 63); f = exp2f(-(float)(k & 31) * (13.287712379549449f / 32.f)); cd = c2 + j; sd = s2 + j; }
            const float ang = pos * f;
            double rev = (double)ang * 0.15915494309189535; rev -= __builtin_rint(rev);
            const float fr = (float)rev;
            *cd = __builtin_amdgcn_cosf(fr); *sd = __builtin_amdgcn_sinf(fr);
        }
    }
}

struct ResCfg { int has_res, has_next, li, sub, li2, sub2, nrows; float wres; const float* xold_l; const float* xold_c; float* xnew_l; float* xnew_c; const float* part; };
DEV void res_rows(const Frame& F, const ResCfg& C, int m0, int cnt, int prow) {
    const Args& A = *F.a; const float* MOD = (const float*)(A.ws + WS_MOD); bf16* H = (bf16*)(A.ws + WS_H);
    f32x4 Ca[8], Cb[8], Cs[8];
    int e0 = 4 * F.lane; asm volatile("" : "+v"(e0));
    if (C.has_res) {
        const float* gate = MOD + (size_t)(C.li * 5 + prow) * 18432 + C.sub * 6144 + 4096; const float* gp = A.in[I_NPOST] + (C.li * 3 + C.sub) * DM;
#pragma unroll
        for (int j = 0; j < 8; ++j) Ca[j] = *(const f32x4*)(gate + 256 * j + e0) * *(const f32x4*)(gp + 256 * j + e0) * C.wres;
    }
    if (C.has_next) {
        const float* sh = MOD + (size_t)(C.li2 * 5 + prow) * 18432 + C.sub2 * 6144; const float* sc = sh + 2048; const float* gp = A.in[I_NPRE] + (C.li2 * 3 + C.sub2) * DM;
#pragma unroll
        for (int j = 0; j < 8; ++j) { Cb[j] = *(const f32x4*)(gp + 256 * j + e0) * (*(const f32x4*)(sc + 256 * j + e0) + 1.f); Cs[j] = *(const f32x4*)(sh + 256 * j + e0); }
    }
    for (int m = m0; m < m0 + cnt; ++m) {
        const float* xo = (m < ML) ? C.xold_l + (size_t)m * DM : C.xold_c + (size_t)(m - ML) * DM;
        f32x4 x[8];
#pragma unroll
        for (int j = 0; j < 8; ++j) x[j] = *(const f32x4*)(xo + 256 * j + e0);
        if (C.has_res) {
            f32x4 yy[8];
            if (C.part && m >= ML) { const float* pr = C.part + (size_t)(m - ML) * DM;
#pragma unroll
                for (int j = 0; j < 8; ++j) yy[j] = (*(const f32x4*)(pr + 256 * j + e0) + *(const f32x4*)(pr + (size_t)MC * DM + 256 * j + e0)) + (*(const f32x4*)(pr + (size_t)2 * MC * DM + 256 * j + e0) + *(const f32x4*)(pr + (size_t)3 * MC * DM + 256 * j + e0)); }
            else { const bf16* yr = H + (size_t)m * DM;
#pragma unroll
                for (int j = 0; j < 8; ++j) { const u32x2 yv = *(const u32x2*)(yr + 256 * j + e0); yy[j] = (f32x4){bflo(yv.x), bfhi(yv.x), bflo(yv.y), bfhi(yv.y)}; } }
            float ss = 0.f;
#pragma unroll
            for (int j = 0; j < 8; ++j) ss += (yy[j].x * yy[j].x + yy[j].y * yy[j].y) + (yy[j].z * yy[j].z + yy[j].w * yy[j].w);
            const float rs = __builtin_amdgcn_rsqf(wave_sum(ss) * (1.f / DM) + EPS);
            float* xn = (m < ML) ? C.xnew_l + (size_t)m * DM : C.xnew_c + (size_t)(m - ML) * DM;
#pragma unroll
            for (int j = 0; j < 8; ++j) { x[j] = x[j] + Ca[j] * (yy[j] * rs); *(f32x4*)(xn + 256 * j + e0) = x[j]; }
        }
        if (C.has_next) {
            float ss = 0.f;
#pragma unroll
            for (int j = 0; j < 8; ++j) ss += (x[j].x * x[j].x + x[j].y * x[j].y) + (x[j].z * x[j].z + x[j].w * x[j].w);
            const float rs = __builtin_amdgcn_rsqf(wave_sum(ss) * (1.f / DM) + EPS);
            bf16* hr = H + (size_t)m * DM;
#pragma unroll
            for (int j = 0; j < 8; ++j) { const f32x4 h = x[j] * rs * Cb[j] + Cs[j]; u32x2 w; w.x = pkbf(h.x, h.y); w.y = pkbf(h.z, h.w); *(u32x2*)(hr + 256 * j + e0) = w; }
        }
    }
}
DEV void res_phase(const Frame& F, const ResCfg& C) {
    const int gw = F.bid * 8 + F.wave, NGW = F.G * 8;
    for (int blk = gw; blk < ML / 16; blk += NGW) res_rows(F, C, blk * 16, 16, (blk * 16) / SEQ);
    if (C.nrows > ML) {
        if (NGW >= 2 * MC) { if ((gw & 1) == 0 && (gw >> 1) < MC) res_rows(F, C, ML + (gw >> 1), 1, 4); }
        else { const int per = (MC + NGW - 1) / NGW, r0 = gw * per, cnt = (MC - r0) < per ? (MC - r0) : per; if (cnt > 0) res_rows(F, C, ML + r0, cnt, 4); }
    }
}

constexpr int LRU_UB = 0, LRU_UB_LD = 272, LRU_ARR = 17408, LRU_ARR_SZ = 32768;
DEV int lru_chunk_row0(int b, int ck) { return (ck < 4) ? ML + b * CTXL + 64 * ck : b * SEQ + 64 * (ck - 4); }
DEV float one_minus_exp(float t) {
    const float ser = -t * (1.f + t * 0.5f * (1.f + t * (1.f / 3.f) * (1.f + t * 0.25f * (1.f + t * 0.2f * (1.f + t * (1.f / 6.f))))));
    return (t > -0.25f) ? ser : 1.f - fexp(t);
}
template <bool FINAL> DEV void lru_phase(const Frame& F, bool dry = false) {
    const Args& A = *F.a; unsigned char* ws = A.ws; bf16* E = (bf16*)(ws + WS_E);
    const int tid = F.tid, wave = F.wave, lane = F.lane, r32 = lane & 31, hh = lane >> 5;
    LAS unsigned char* UB = F.lds + LRU_UB; LAS float* ARR = (LAS float*)(F.lds + LRU_ARR); LAS unsigned char* RS = F.lds + LRU_ARR;
    const int slot = F.bid & 31, n = slot & 7, b = slot >> 3, ck0 = F.bid >> 5, ckst = (F.G + 31) >> 5;
    if (F.bid >= 32 * ckst) return;
    u32x4 rp[3];
#define LRU_LOAD(ck_) do { const int L_ = ((ck_) < 4) ? CTXL : SEQ, p0_ = ((ck_) < 4) ? 64 * (ck_) : 64 * ((ck_) - 4), rb_ = ((ck_) < 4) ? ML + b * CTXL : b * SEQ; \
        _Pragma("unroll") for (int i_ = 0; i_ < 3; ++i_) { const int pc = tid + 512 * i_, rr = pc >> 4, c8 = pc & 15, pos = p0_ - 2 + rr; \
            rp[i_] = (u32x4){0u, 0u, 0u, 0u}; if (pc < 67 * 16 && pos >= 0 && pos < L_) rp[i_] = *(const u32x4*)(E + (size_t)(rb_ + pos) * EVN + EC_R + 128 * n + 8 * c8); } } while (0)
    if (ck0 < NCH64) LRU_LOAD(ck0);
    const int c8t = tid & 15, cht = 128 * n + 8 * c8t;
    float cw[4][8], cb[8];
#pragma unroll
    for (int i = 0; i < 8; ++i) cb[i] = A.in[I_CONVB][cht + i];
#pragma unroll
    for (int k = 0; k < 4; ++k)
#pragma unroll
        for (int i = 0; i < 8; ++i) cw[k][i] = A.in[I_CONVW][k * 1024 + cht + i];
    const int gd = wave >> 2, cq = wave & 3, gcol = 32 * cq + r32, gchn = 128 * n + gcol;
    bf16x8 fa[8], fx[8];
    { const bf16* WA = (const bf16*)(ws + WS_LRUW) + (size_t)(gd * 8 + n) * 16384 + (size_t)gcol * 128 + 8 * hh; const bf16* WX = WA + (size_t)16 * 16384;
#pragma unroll
      for (int ks = 0; ks < 8; ++ks) { fa[ks] = *(const bf16x8*)(WA + 16 * ks); fx[ks] = *(const bf16x8*)(WX + 16 * ks); } }
    const float gba = A.in[I_BA][gd * 1024 + gchn], gbx = A.in[I_BX][gd * 1024 + gchn], sp8 = -8.f * log1pf(expf(-A.in[I_LAM][gd * 1024 + gchn]));
    for (int ck = ck0; ck < NCH64; ck += ckst) {
        const int p0 = (ck < 4) ? 64 * ck : 64 * (ck - 4), rowbase = (ck < 4) ? ML + b * CTXL : b * SEQ;
        const int sd = (tid >> 7) & 1, sc = tid & 127; const size_t gi = ((size_t)(ck * NB + b) * 2 + sd) * 1024 + 128 * n + sc;
        float hcar = 0.f; if (FINAL && tid < 256) hcar = ((const float*)(ws + WS_CAR))[gi];
        u32x4 gv[2];
        if (FINAL) {
#pragma unroll
            for (int i = 0; i < 2; ++i) { const int pc = tid + 512 * i, tt = pc >> 4; gv[i] = *(const u32x4*)(E + (size_t)(rowbase + p0 + tt) * EVN + EC_G + 128 * n + 8 * c8t); } }
#pragma unroll
        for (int i = 0; i < 3; ++i) { const int pc = tid + 512 * i, rr = pc >> 4, c8 = pc & 15; if (pc < 67 * 16) *(LAS u32x4*)(RS + rr * 256 + c8 * 16) = rp[i]; }
        __syncthreads();
#pragma unroll
        for (int i2 = 0; i2 < 2; ++i2) { const int pc = tid + 512 * i2, tt = pc >> 4;
            float u[8];
#pragma unroll
            for (int i = 0; i < 8; ++i) u[i] = cb[i];
#pragma unroll
            for (int k = 0; k < 4; ++k) { const u32x4 rv = *(const LAS u32x4*)(RS + (tt + k) * 256 + c8t * 16);
                u[0] += cw[k][0] * bflo(rv.x); u[1] += cw[k][1] * bfhi(rv.x); u[2] += cw[k][2] * bflo(rv.y); u[3] += cw[k][3] * bfhi(rv.y);
                u[4] += cw[k][4] * bflo(rv.z); u[5] += cw[k][5] * bfhi(rv.z); u[6] += cw[k][6] * bflo(rv.w); u[7] += cw[k][7] * bfhi(rv.w); }
            u32x4 o = {pkbf(u[0], u[1]), pkbf(u[2], u[3]), pkbf(u[4], u[5]), pkbf(u[6], u[7])};
            *(LAS u32x4*)(UB + tt * LRU_UB_LD + c8t * 16) = o; }
        __syncthreads();
        if (ck + ckst < NCH64) LRU_LOAD(ck + ckst);
        {
            f32x16 aa[2] = {f32x16{}, f32x16{}}, ax[2] = {f32x16{}, f32x16{}};
#pragma unroll
            for (int ks = 0; ks < 8; ++ks) {
#pragma unroll
                for (int rt = 0; rt < 2; ++rt) { const bf16x8 af = *(const LAS bf16x8*)(UB + (32 * rt + r32) * LRU_UB_LD + (16 * ks + 8 * hh) * 2);
                    aa[rt] = __builtin_amdgcn_mfma_f32_32x32x16_bf16(af, fa[ks], aa[rt], 0, 0, 0); ax[rt] = __builtin_amdgcn_mfma_f32_32x32x16_bf16(af, fx[ks], ax[rt], 0, 0, 0); }
            }
            LAS float* AO = ARR + (size_t)(gd * 2) * (LRU_ARR_SZ / 4); LAS float* BO = AO + LRU_ARR_SZ / 4;
#pragma unroll
            for (int rt = 0; rt < 2; ++rt)
#pragma unroll
                for (int r = 0; r < 16; ++r) { const int row = 32 * rt + crow(r, hh);
                    const float la = sp8 * fsigmoid(aa[rt][r] + gba), av = fexp(la), mlt = __builtin_amdgcn_sqrtf(one_minus_exp(2.f * la));
                    const float uv = bf2f(*(const LAS bf16*)(UB + row * LRU_UB_LD + gcol * 2));
                    AO[row * 128 + gcol] = av; BO[row * 128 + gcol] = mlt * fsigmoid(ax[rt][r] + gbx) * uv; }
        }
        __syncthreads();
        if (tid < 256) { LAS float* AO = ARR + (size_t)(sd * 2) * (LRU_ARR_SZ / 4); const LAS float* BO = AO + LRU_ARR_SZ / 4;
            if (!FINAL) { float h = 0.f, P = 1.f;
#pragma unroll 8
                for (int s = 0; s < 64; ++s) { const int tt = sd ? 63 - s : s; const float a = AO[tt * 128 + sc]; h = a * h + BO[tt * 128 + sc]; P *= a; }
                ((f32x2*)(ws + WS_AGG))[gi] = (f32x2){P, h}; }
            else { float h = hcar;
#pragma unroll 8
                for (int s = 0; s < 64; ++s) { const int tt = sd ? 63 - s : s; h = AO[tt * 128 + sc] * h + BO[tt * 128 + sc]; AO[tt * 128 + sc] = h; } }
        }
        __syncthreads();
        if (FINAL) {
            const LAS float* H0 = ARR; const LAS float* H1 = ARR + 2 * (LRU_ARR_SZ / 4);
#pragma unroll
            for (int i2 = 0; i2 < 2; ++i2) { const int pc = tid + 512 * i2, tt = pc >> 4;
                const f32x4 h0a = *(const LAS f32x4*)(H0 + tt * 128 + 8 * c8t), h0b = *(const LAS f32x4*)(H0 + tt * 128 + 8 * c8t + 4), h1a = *(const LAS f32x4*)(H1 + tt * 128 + 8 * c8t), h1b = *(const LAS f32x4*)(H1 + tt * 128 + 8 * c8t + 4);
                const f32x4 sa = h0a + h1a, sb = h0b + h1b; const u32x4 g4 = gv[i2];
                u32x4 w = {pkbf(fgelu_tanh(bflo(g4.x)) * sa.x, fgelu_tanh(bfhi(g4.x)) * sa.y), pkbf(fgelu_tanh(bflo(g4.y)) * sa.z, fgelu_tanh(bfhi(g4.y)) * sa.w),
                           pkbf(fgelu_tanh(bflo(g4.z)) * sb.x, fgelu_tanh(bfhi(g4.z)) * sb.y), pkbf(fgelu_tanh(bflo(g4.w)) * sb.z, fgelu_tanh(bfhi(g4.w)) * sb.w)};
                bf16* wp = dry ? (bf16*)(ws + WS_H) + (size_t)(rowbase + p0 + tt) * DM + 128 * n + 8 * c8t : E + (size_t)(rowbase + p0 + tt) * EVN + EC_G + 128 * n + 8 * c8t; *(u32x4*)wp = w; }
            __syncthreads();
        }
    }
#undef LRU_LOAD
}
DEV void lru_carry_phase(const Frame& F) {
    unsigned char* ws = F.a->ws; const f32x2* AGG = (const f32x2*)(ws + WS_AGG); float* CAR = (float*)(ws + WS_CAR);
    const int gw = F.bid * 8 + F.wave, NGW = F.G * 8;
    for (int it = gw; it < NB * 2 * 16; it += NGW) { const int cg = it & 15, d = (it >> 4) & 1, b = it >> 5;
        float h = 0.f;
#pragma unroll 12
        for (int idx = 0; idx < NCH64; ++idx) { const int ck = d ? (idx < 4 ? 3 - idx : NCH64 + 3 - idx) : idx;
            const size_t gi = ((size_t)(ck * NB + b) * 2 + d) * 1024 + 64 * cg + F.lane; const f32x2 v = AGG[gi]; CAR[gi] = h; h = v.x * h + v.y; }
    }
}

DEV int ret_chunk_row0(int b, int cid) { return (cid < 2) ? ML + b * CTXL + 128 * cid : b * SEQ + 128 * (cid - 2); }
DEV int ret_chain(int d, int idx) { return d ? (idx < 2 ? 1 - idx : NCH128 + 1 - idx) : idx; }
DEV float ret_logg(const Args& A, int d, int h) { const float lg = A.in[I_DECAY][d * 4 + h]; return -log1pf(expf(-lg)); }
constexpr int RET_LD = 528, RET_VLD = 80;
DEV void ret_state_phase(const Frame& F) {
    const Args& A = *F.a; unsigned char* ws = A.ws; const bf16* E = (const bf16*)(ws + WS_E); bf16* SB = (bf16*)(ws + WS_SBUF);
    const int tid = F.tid, lane = F.lane, wave = F.wave, r32 = lane & 31, hh = lane >> 5;
    LAS unsigned char* KS = F.lds; LAS unsigned char* VS = F.lds + 128 * RET_LD;
    for (int it = F.bid; it < 256; it += F.G) {
        const int es = it & 7, d = (it >> 3) & 1, h = (it >> 4) & 3, b = it >> 6;
        const float lg = ret_logg(A, d, h), sdec = expf(lg * 128.f);
        const int vrow = tid >> 2, vc4 = tid & 3; const float vw = expf(lg * (float)(d ? vrow : 127 - vrow));
        u32x4 kreg[8], vreg;
        f32x16 acc = f32x16{};
#define RS_LOAD(cid_) do { const int m0_ = ret_chunk_row0(b, cid_); \
            _Pragma("unroll") for (int i = 0; i < 8; ++i) { const int id = tid + 512 * i, row = id >> 5, c16 = id & 31; kreg[i] = *(const u32x4*)(E + (size_t)(m0_ + row) * EVN + EC_K + 256 * h + 8 * c16); } \
            vreg = *(const u32x4*)(E + (size_t)(m0_ + vrow) * EVN + EC_V + 256 * h + 32 * es + 8 * vc4); } while (0)
        RS_LOAD(ret_chain(d, 0));
        for (int idx = 0; idx < NCH128; ++idx) {
            const int cid = ret_chain(d, idx);
#pragma unroll
            for (int i = 0; i < 8; ++i) { const int id = tid + 512 * i, row = id >> 5, c16 = id & 31; *(LAS u32x4*)(KS + row * RET_LD + c16 * 16) = kreg[i]; }
            { u32x4 w; w.x = pkbf(bflo(vreg.x) * vw, bfhi(vreg.x) * vw); w.y = pkbf(bflo(vreg.y) * vw, bfhi(vreg.y) * vw); w.z = pkbf(bflo(vreg.z) * vw, bfhi(vreg.z) * vw); w.w = pkbf(bflo(vreg.w) * vw, bfhi(vreg.w) * vw);
              *(LAS u32x4*)(VS + vrow * RET_VLD + vc4 * 16) = w; }
            __syncthreads();
            if (idx + 1 < NCH128) RS_LOAD(ret_chain(d, idx + 1));
            { bf16* sp = SB + ((size_t)(((b * 4 + h) * 2 + d) * NCH128 + cid) * 256 + 32 * es + r32) * 256 + 32 * wave + 4 * hh;
#pragma unroll
              for (int g = 0; g < 4; ++g) { u32x2 w; w.x = pkbf(acc[4 * g], acc[4 * g + 1]); w.y = pkbf(acc[4 * g + 2], acc[4 * g + 3]); *(u32x2*)(sp + 8 * g) = w; } }
#pragma unroll
            for (int r = 0; r < 16; ++r) acc[r] *= sdec;
#pragma unroll
            for (int ks = 0; ks < 8; ++ks) { const bf16x8 af = tr_frag(KS, RET_LD, 16 * ks, 32 * wave, lane); const bf16x8 bfr = tr_frag(VS, RET_VLD, 16 * ks, 0, lane);
                acc = __builtin_amdgcn_mfma_f32_32x32x16_bf16(af, bfr, acc, 0, 0, 0); }
            __syncthreads();
        }
#undef RS_LOAD
    }
}
DEV void ret_out_phase(const Frame& F, bool dry = false) {
    const Args& A = *F.a; unsigned char* ws = A.ws; bf16* E = (bf16*)(ws + WS_E); const bf16* SB = (const bf16*)(ws + WS_SBUF);
    const int wave = F.wave, ib = wave & 3, eh = wave >> 2;
    LAS unsigned char* RA = F.lds; LAS unsigned char* RB = F.lds + 128 * RET_LD; LAS float* GX = (LAS float*)(F.lds + 2 * 128 * RET_LD);
    constexpr int PLD = 272;
    for (int it = F.bid; it < 16 * NCH128; it += F.G) {
        int tid = F.tid; asm volatile("" : "+v"(tid)); int lane = tid & 63;
        const int r32 = lane & 31, hh = lane >> 5;
        const int cid = it % NCH128, bh = it / NCH128, h = bh & 3, b = bh >> 2, m0 = ret_chunk_row0(b, cid);
        const float lg0 = ret_logg(A, 0, h), lg1 = ret_logg(A, 1, h);
        bf16x8 qf[16];
        { const bf16* qp = E + (size_t)(m0 + 32 * ib + r32) * EVN + EC_Q + 256 * h + 8 * hh;
#pragma unroll
          for (int ks = 0; ks < 16; ++ks) qf[ks] = *(const bf16x8*)(qp + 16 * ks); }
        f32x16 o[4];
#pragma unroll
        for (int et = 0; et < 4; ++et) o[et] = f32x16{};
#pragma unroll 1
        for (int d = 0; d < 2; ++d) {
            const bf16* sp = SB + (size_t)((bh * 2 + d) * NCH128 + cid) * 65536; const float lgd = d ? lg1 : lg0;
            __syncthreads();
#pragma unroll
            for (int hb = 0; hb < 2; ++hb) { u32x4 tmp[8];
#pragma unroll
                for (int i = 0; i < 8; ++i) { const int id = tid + 512 * (8 * hb + i), row = id >> 5, c16 = id & 31; tmp[i] = *(const u32x4*)(sp + (size_t)row * 256 + 8 * c16); }
                asm volatile("" ::: "memory");
#pragma unroll
                for (int i = 0; i < 8; ++i) { const int id = tid + 512 * (8 * hb + i), row = id >> 5, c16 = id & 31; *(LAS u32x4*)(RA + row * RET_LD + c16 * 16) = tmp[i]; }
                asm volatile("" ::: "memory"); }
            __syncthreads();
#pragma unroll
            for (int et = 0; et < 4; ++et) { f32x16 T = f32x16{};
                const LAS unsigned char* bp = RA + (128 * eh + 32 * et + r32) * RET_LD + 16 * hh;
#pragma unroll
                for (int ks = 0; ks < 16; ++ks) { const bf16x8 bfr = *(const LAS bf16x8*)(bp + 32 * ks); T = __builtin_amdgcn_mfma_f32_32x32x16_bf16(qf[ks], bfr, T, 0, 0, 0); }
#pragma unroll
                for (int r = 0; r < 16; ++r) { const int i = 32 * ib + crow(r, hh); const float rs = fexp(lgd * (float)(d ? 128 - i : i + 1)); o[et][r] += T[r] * rs; } }
        }
        __syncthreads();
        int tid2 = tid; asm volatile("" : "+v"(tid2));
#pragma unroll
        for (int kv = 0; kv < 2; ++kv) { u32x4 tmp[8];
#pragma unroll
            for (int i = 0; i < 8; ++i) { const int id = tid2 + 512 * i, row = id >> 5, c16 = id & 31; tmp[i] = *(const u32x4*)(E + (size_t)(m0 + row) * EVN + (kv ? EC_V : EC_K) + 256 * h + 8 * c16); }
            asm volatile("" ::: "memory");
#pragma unroll
            for (int i = 0; i < 8; ++i) { const int id = tid2 + 512 * i, row = id >> 5, c16 = id & 31; *(LAS u32x4*)((kv ? RB : RA) + row * RET_LD + c16 * 16) = tmp[i]; }
            asm volatile("" ::: "memory"); }
        __syncthreads();
        u32x2 pw[2][4];
        { const int i = 32 * ib + r32;
#pragma unroll
          for (int jj = 0; jj < 2; ++jj) { const int jt = 2 * eh + jj;
            f32x16 X = f32x16{};
#pragma unroll
            for (int ks = 0; ks < 16; ++ks) { const bf16x8 af = *(const LAS bf16x8*)(RA + (32 * jt + r32) * RET_LD + (16 * ks + 8 * hh) * 2); X = __builtin_amdgcn_mfma_f32_32x32x16_bf16(af, qf[ks], X, 0, 0, 0); }
#pragma unroll
            for (int g = 0; g < 4; ++g) { float pv[4];
#pragma unroll
                for (int q = 0; q < 4; ++q) { const int j = 32 * jt + 8 * g + 4 * hh + q; const int dl = i - j; const float f = (dl > 0) ? fexp(lg0 * (float)dl) : (dl < 0) ? fexp(-lg1 * (float)dl) : 2.f; pv[q] = X[4 * g + q] * f; }
                pw[jj][g].x = pkbf(pv[0], pv[1]); pw[jj][g].y = pkbf(pv[2], pv[3]); } } }
        __syncthreads();
        { const int i = 32 * ib + r32;
#pragma unroll
          for (int jj = 0; jj < 2; ++jj)
#pragma unroll
            for (int g = 0; g < 4; ++g) *(LAS u32x2*)(RA + i * PLD + (32 * (2 * eh + jj) + 8 * g + 4 * hh) * 2) = pw[jj][g]; }
        __syncthreads();
#pragma unroll
        for (int ks = 0; ks < 8; ++ks) { const bf16x8 pa = *(const LAS bf16x8*)(RA + (32 * ib + r32) * PLD + (16 * ks + 8 * hh) * 2);
#pragma unroll
            for (int et = 0; et < 4; ++et) { const bf16x8 bfr = tr_frag(RB, RET_LD, 16 * ks, 128 * eh + 32 * et, lane); o[et] = __builtin_amdgcn_mfma_f32_32x32x16_bf16(pa, bfr, o[et], 0, 0, 0); } }
#pragma unroll
        for (int r = 0; r < 16; ++r) { float a = 0.f, q = 0.f;
#pragma unroll
            for (int et = 0; et < 4; ++et) { a += o[et][r]; q += o[et][r] * o[et][r]; }
#pragma unroll
            for (int off = 1; off < 32; off <<= 1) { a += __shfl_xor(a, off); q += __shfl_xor(q, off); }
            if (r32 == 0) { GX[(wave * 32 + crow(r, hh)) * 2] = a; GX[(wave * 32 + crow(r, hh)) * 2 + 1] = q; } }
        __syncthreads();
        { const float* gn = A.in[I_GN] + 256 * h + 128 * eh;
#pragma unroll
          for (int r = 0; r < 16; ++r) { const int rw = crow(r, hh); const float a = GX[(wave * 32 + rw) * 2] + GX[((wave ^ 4) * 32 + rw) * 2], q = GX[(wave * 32 + rw) * 2 + 1] + GX[((wave ^ 4) * 32 + rw) * 2 + 1];
            const float mean = a * (1.f / 256.f), var = q * (1.f / 256.f) - mean * mean, rstd = __builtin_amdgcn_rsqf(var + EPS);
            bf16* op = E + (size_t)(m0 + 32 * ib + rw) * EVN + EC_O + 256 * h + 128 * eh + r32;
#pragma unroll
            for (int et = 0; et < 4; ++et) { const float og = bf2f(op[32 * et]); bf16* wp = dry ? (bf16*)(ws + WS_H) + (size_t)(m0 + 32 * ib + rw) * DM + 1024 + 256 * h + 128 * eh + r32 : op;
                wp[32 * et] = f2bf((o[et][r] - mean) * rstd * gn[32 * et + r32] * fsilu(og)); } } }
    }
    __syncthreads();
}
DEV void odd_post_phase(const Frame& F) {
    const Args& A = *F.a; unsigned char* ws = A.ws; const bf16* E2 = (const bf16*)(ws + WS_E2);
    bf16* QB = (bf16*)(ws + WS_QB); bf16* KB = (bf16*)(ws + WS_KB); bf16* VB = (bf16*)(ws + WS_VB); bf16* MIX = (bf16*)(ws + WS_MIX2);
    const float* c2 = (const float*)(ws + WS_COS2); const float* s2 = (const float*)(ws + WS_SIN2);
    const int tid = F.tid, wave = F.wave;
    {
        const int gw = F.bid * 8 + F.wave, NGW = F.G * 8; const int lane0 = F.lane, li0 = lane0 & 15, e0c = 8 * (li0 & 7);
        f32x4 qg[2], kg[2];
        qg[0] = *(const f32x4*)(A.in[I_QN] + 8 * li0); qg[1] = *(const f32x4*)(A.in[I_QN] + 8 * li0 + 4); kg[0] = *(const f32x4*)(A.in[I_KN] + 8 * li0); kg[1] = *(const f32x4*)(A.in[I_KN] + 8 * li0 + 4);
        for (int m = gw; m < MT; m += NGW) {
            int lane = F.lane; asm volatile("" : "+v"(lane));
            const int grp = lane >> 4, li = lane & 15; const bool hi8 = (li & 8) != 0;
            const bool lat = m < ML; const int b = lat ? m / SEQ : (m - ML) / CTXL, t = lat ? m % SEQ : 0, kpos = lat ? CTXL + t : (m - ML) % CTXL;
            const bf16* er = E2 + (size_t)m * ODN;
            f32x4 cs[2] = {(f32x4){1.f, 1.f, 1.f, 1.f}, (f32x4){1.f, 1.f, 1.f, 1.f}}, sn[2] = {(f32x4){0.f, 0.f, 0.f, 0.f}, (f32x4){0.f, 0.f, 0.f, 0.f}};
            if (lat) { cs[0] = *(const f32x4*)(c2 + t * 64 + e0c); cs[1] = *(const f32x4*)(c2 + t * 64 + e0c + 4); sn[0] = *(const f32x4*)(s2 + t * 64 + e0c); sn[1] = *(const f32x4*)(s2 + t * 64 + e0c + 4); }
#pragma unroll
            for (int rd = 0; rd < 4; ++rd) {
                if (rd < 3 && !lat) continue;
                const bool isq = rd < 3; const int hd = isq ? 4 * rd + grp : grp;
                const u32x4 xv = *(const u32x4*)(er + (isq ? 512 : 2048) + 128 * hd + 8 * li);
                float x[8] = {bflo(xv.x), bfhi(xv.x), bflo(xv.y), bfhi(xv.y), bflo(xv.z), bfhi(xv.z), bflo(xv.w), bfhi(xv.w)};
                float ss = 0.f;
#pragma unroll
                for (int i = 0; i < 8; ++i) ss += x[i] * x[i];
                ss += __shfl_xor(ss, 1); ss += __shfl_xor(ss, 2); ss += __shfl_xor(ss, 4); ss += __shfl_xor(ss, 8);
                const float rs = __builtin_amdgcn_rsqf(ss * (1.f / 128.f) + EPS);
                float y[8], yp[8], o[8];
#pragma unroll
                for (int i = 0; i < 8; ++i) y[i] = x[i] * rs * (isq ? qg[i >> 2][i & 3] : kg[i >> 2][i & 3]);
#pragma unroll
                for (int i = 0; i < 8; ++i) yp[i] = __shfl_xor(y[i], 8);
#pragma unroll
                for (int i = 0; i < 8; ++i) { const float c = cs[i >> 2][i & 3], sv = sn[i >> 2][i & 3]; o[i] = hi8 ? (yp[i] * sv + y[i] * c) : (y[i] * c - yp[i] * sv); }
                u32x4 w = {pkbf(o[0], o[1]), pkbf(o[2], o[3]), pkbf(o[4], o[5]), pkbf(o[6], o[7])};
                bf16* dst = isq ? QB + (size_t)m * 1536 + 128 * hd + 8 * li : KB + ((size_t)b * KVL + kpos) * 512 + 128 * hd + 8 * li;
                *(u32x4*)dst = w;
            }
            *(u32x4*)(VB + ((size_t)b * KVL + kpos) * 512 + 8 * lane) = *(const u32x4*)(er + 2560 + 8 * lane);
        }
    }
    {
        const int lane = F.lane, r32 = lane & 31, hh = lane >> 5;
        LAS unsigned char* XS = F.lds; LAS unsigned char* DS = F.lds + 144 * 256; constexpr int DLD = 272;
        for (int it = F.bid; it < (ML / 128) * 4; it += F.G) {
            const int gi = it & 3, rt = it >> 2, b = (rt * 128) / SEQ, t0 = (rt * 128) % SEQ, half = 1 << gi;
            __syncthreads();
            { u32x4 tv[5];
#pragma unroll
              for (int i = 0; i < 5; ++i) { const int pc = tid + 512 * i, rr = pc >> 4, c8 = pc & 15, pos = t0 - 8 + rr;
                  tv[i] = (u32x4){0u, 0u, 0u, 0u}; if (pc < 144 * 16 && pos >= 0 && pos < SEQ) tv[i] = *(const u32x4*)(E2 + (size_t)(b * SEQ + pos) * ODN + 128 * gi + 8 * c8); }
              asm volatile("" ::: "memory");
#pragma unroll
              for (int i = 0; i < 5; ++i) { const int pc = tid + 512 * i, rr = pc >> 4, c8 = pc & 15; if (pc < 144 * 16) *(LAS u32x4*)(XS + rr * 256 + c8 * 16) = tv[i]; } }
            __syncthreads();
            for (int pc = tid; pc < 128 * 16; pc += 512) { const int tt = pc >> 4, c8 = pc & 15, t = t0 + tt;
                const int lo = (t - half) < 0 ? 0 : t - half, hi = (t + half) > SEQ ? SEQ : t + half; const float inv = 1.f / (float)(hi - lo);
                float s[8] = {0.f, 0.f, 0.f, 0.f, 0.f, 0.f, 0.f, 0.f};
                for (int p = lo; p < hi; ++p) { const u32x4 v = *(const LAS u32x4*)(XS + (p - t0 + 8) * 256 + c8 * 16);
                    s[0] += bflo(v.x); s[1] += bfhi(v.x); s[2] += bflo(v.y); s[3] += bfhi(v.y); s[4] += bflo(v.z); s[5] += bfhi(v.z); s[6] += bflo(v.w); s[7] += bfhi(v.w); }
                const u32x4 xv = *(const LAS u32x4*)(XS + (tt + 8) * 256 + c8 * 16);
                u32x4 o; o.x = pkbf(s[0] * inv - bflo(xv.x), s[1] * inv - bfhi(xv.x)); o.y = pkbf(s[2] * inv - bflo(xv.y), s[3] * inv - bfhi(xv.y));
                o.z = pkbf(s[4] * inv - bflo(xv.z), s[5] * inv - bfhi(xv.z)); o.w = pkbf(s[6] * inv - bflo(xv.w), s[7] * inv - bfhi(xv.w));
                *(LAS u32x4*)(DS + tt * DLD + c8 * 16) = o; }
            __syncthreads();
            { const int rb = wave & 3, chh = wave >> 2; const bf16* WT = (const bf16*)(ws + WS_POOLW) + (size_t)gi * 16384;
              f32x16 acc[2] = {f32x16{}, f32x16{}};
#pragma unroll
              for (int ks = 0; ks < 8; ++ks) { const bf16x8 af = *(const LAS bf16x8*)(DS + (32 * rb + r32) * DLD + (16 * ks + 8 * hh) * 2);
#pragma unroll
                  for (int ct = 0; ct < 2; ++ct) { const bf16x8 bfr = *(const bf16x8*)(WT + (size_t)(64 * chh + 32 * ct + r32) * 128 + 16 * ks + 8 * hh);
                      acc[ct] = __builtin_amdgcn_mfma_f32_32x32x16_bf16(af, bfr, acc[ct], 0, 0, 0); } }
#pragma unroll
              for (int ct = 0; ct < 2; ++ct) { const int col = 128 * gi + 64 * chh + 32 * ct + r32; const float ps = A.in[I_POOLS][col];
#pragma unroll
                  for (int r = 0; r < 16; ++r) MIX[(size_t)(b * SEQ + t0 + 32 * rb + crow(r, hh)) * DM + col] = f2bf(acc[ct][r] * ps); } }
        }
        __syncthreads();
    }
}
DEV void attn_phase(const Frame& F) {
    unsigned char* ws = F.a->ws; const bf16* QB = (const bf16*)(ws + WS_QB); const bf16* KB = (const bf16*)(ws + WS_KB); const bf16* VB = (const bf16*)(ws + WS_VB); bf16* MIX = (bf16*)(ws + WS_MIX2);
    for (int u = F.bid; u < NB * 12 * (SEQ / 256); u += F.G) {
        const int qb = u & 31, g = (u >> 5) % 3, kvh = ((u >> 5) / 3) & 3, b = (u >> 5) / 12, hq = kvh * 3 + g;
        att::attn_dense_body<1536, 512, DM>(QB + (size_t)(b * SEQ + 256 * qb) * 1536 + 128 * hq, KB + (size_t)b * KVL * 512 + 128 * kvh, VB + (size_t)b * KVL * 512 + 128 * kvh,
                                           MIX + (size_t)(b * SEQ + 256 * qb) * DM + 512 + 128 * hq, KVL, (char*)F.lds);
    }
}

constexpr int NPH = 25;
__global__ void __launch_bounds__(512, 2) mk_fwd(Args args) {
    extern __shared__ __attribute__((aligned(16))) unsigned char lds_raw[];
    Frame F; F.lds = (LAS unsigned char*)lds_raw; F.tid = threadIdx.x; F.lane = F.tid & 63; F.wave = __builtin_amdgcn_readfirstlane(F.tid >> 6); F.G = gridDim.x; F.bid = blockIdx.x; F.a = &args;
    unsigned char* ws = args.ws;
    volatile LAS unsigned* MISC = (volatile LAS unsigned*)(F.lds + MISC_OFF);
    if (F.tid < 64) MISC[F.tid] = 0u;
    __syncthreads();
    XcdBarrier bar; bar.bar = (unsigned*)(ws + WS_CTL) + CW_BAR; bar.x = 0; bar.st = nullptr;
    const int lo = args.ph_lo, hi = args.ph_hi;
    if (hi - lo > 1) bar = xcd_barrier_post((unsigned*)(ws + WS_CTL) + CW_BAR, MISC + 8);
#ifndef MK_MASK
#define MK_MASK 0xFFFFFFFFu
#endif
#define IN(k) (((MK_MASK >> (k)) & 1u) && lo <= (k) && (k) < hi && (k) <= MK_STOP_AFTER)
#define SEAM(k) do { if (IN(k) && (k) + 1 < hi) xcd_barrier(bar); } while (0)
#ifndef MK_DOUBLE
#define MK_DOUBLE 0u
#endif
#ifndef MK_STAMP
#define MK_STAMP (-1)
#endif
#ifndef MK_STAMPMASK
#define MK_STAMPMASK 0u
#endif
#define PHASE(k) do { if ((k) == MK_STAMP || ((MK_STAMPMASK >> (k)) & 1u)) t_stamp0 = wall_clock64(); if (IN(k)) { PH_BODY_##k; if ((MK_DOUBLE >> (k)) & 1u) { xcd_barrier(bar); PH_BODY_##k; } } SEAM(k); if ((k) == MK_STAMP) t_stamp1 = wall_clock64(); if ((MK_STAMPMASK >> (k)) & 1u) t_stamp1 += wall_clock64() - t_stamp0; } while (0)
    bf16* H = (bf16*)(ws + WS_H); bf16* ACT = (bf16*)(ws + WS_ACT); bf16* E = (bf16*)(ws + WS_E); bf16* E2 = (bf16*)(ws + WS_E2); bf16* MIX2 = (bf16*)(ws + WS_MIX2);
    float* XC = (float*)(ws + WS_XC); float* PART = (float*)(ws + WS_PART);
#define GEMM_GU(lf, M_) do { pg8::Gemm g{H, (const bf16*)(ws + WS_WGU + (size_t)(lf) * 44 * MiB), (M_), 2 * DFF, DM, DM}; pg8::StaticOrder S; S.init((M_), 2 * DFF, F.G, F.bid); \
        pg8::EpiSwiGLU Ep{ACT, DFF}; pg8::gemm_phase<pg8::EpiSwiGLU, pg8::StaticOrder, PG8_ALIGN, PG8_SP2>(F.lds, g, S, Ep); } while (0)
#define GEMM_DN(lf, M_) do { pg8::Gemm g{ACT, (const bf16*)(ws + WS_WD + (size_t)(lf) * 22 * MiB), (M_), DM, DFF, DFF}; pg8::TailSplitOrder S; S.init(ML, (M_) - ML, DM, F.G, F.bid, 4); \
        pg8::EpiPlainSplit Ep{H, DM, PART, ML, MC}; pg8::gemm_phase<pg8::EpiPlainSplit, pg8::TailSplitOrder, PG8_ALIGN, PG8_SP2>(F.lds, g, S, Ep); } while (0)
#define RES(hr, hn, li_, sub_, li2_, sub2_, nrows_, w_, xol, xoc, part_) do { ResCfg C{(hr), (hn), (li_), (sub_), (li2_), (sub2_), (nrows_), (w_), (xol), (xoc), args.out, XC, (part_)}; res_phase(F, C); } while (0)

    unsigned long long t_stamp0 = 0, t_stamp1 = 0;
#define PH_BODY_0 p0_prologue(F)
    PHASE(0);
#define PH_BODY_1 RES(0, 1, 0, 0, 0, 0, MT, 0.f, args.in[I_X], args.in[I_CTX], nullptr);
    PHASE(1);
#ifdef MK_GSTAMP
#define PH_BODY_2 { pg8::Gemm g{H, (const bf16*)(ws + WS_WGU), MT, 2 * DFF, DM, DM}; pg8::StaticOrder S; S.init(MT, 2 * DFF, F.G, F.bid); \
        pg8::EpiSwiGLU Ep{ACT, DFF}; const unsigned gstv = pg8::gemm_phase<pg8::EpiSwiGLU, pg8::StaticOrder, PG8_ALIGN, PG8_SP2>(F.lds, g, S, Ep); if (F.bid == 0 && F.tid == 0) ((unsigned*)(ws + WS_CTL))[64] = gstv; deferred_convert(F, CV_EI, CV_OI, (MT / 256) * (2 * DFF / 256)); }
#else
#define PH_BODY_2 { GEMM_GU(0, MT); deferred_convert(F, CV_EI, CV_OI, (MT / 256) * (2 * DFF / 256)); }
#endif
    PHASE(2);
#define PH_BODY_3 { GEMM_DN(0, MT); deferred_convert(F, CV_LF1, CV_LF2, (ML / 256) * (DM / 256) + (MC / 256) * (DM / 256) * 4); }
    PHASE(3);
#define PH_BODY_4 RES(1, 1, 0, 0, 0, 1, MT, 0.5f, args.in[I_X], args.in[I_CTX], PART)
    PHASE(4);
#define PH_BODY_5 { pg8::Gemm g{H, (const bf16*)(ws + WS_WEVIN), MT, EVN, DM, DM}; pg8::StaticOrder S; S.init(MT, EVN, F.G, F.bid); \
        pg8::EpiEvIn Ep{E, (const float*)(ws + WS_COS1), (const float*)(ws + WS_SIN1)}; pg8::gemm_phase<pg8::EpiEvIn, pg8::StaticOrder, PG8_ALIGN, PG8_SP2>(F.lds, g, S, Ep); }
    PHASE(5);
#define PH_BODY_6 lru_phase<false>(F)
    PHASE(6);
#define PH_BODY_7 { lru_carry_phase(F); ret_state_phase(F); }
    PHASE(7);
#ifndef MK_P8
#define MK_P8 3
#endif
#ifndef MK_DRY8
#define MK_DRY8 0
#endif
#define PH_BODY_8 { if (MK_DRY8 & 1) { lru_phase<true>(F, true); xcd_barrier(bar); } if (MK_DRY8 & 2) { ret_out_phase(F, true); xcd_barrier(bar); } if (MK_P8 & 1) lru_phase<true>(F); if (MK_P8 & 2) ret_out_phase(F); }
    PHASE(8);
#define PH_BODY_9 { pg8::Gemm g{E, (const bf16*)(ws + WS_WEVOUT), MT, DM, DM, EVN}; pg8::TailSplitOrder S; S.init(ML, MC, DM, F.G, F.bid, 4); \
        pg8::EpiPlainSplit Ep{H, DM, PART, ML, MC}; pg8::gemm_phase<pg8::EpiPlainSplit, pg8::TailSplitOrder, PG8_ALIGN, PG8_SP2>(F.lds, g, S, Ep); }
    PHASE(9);
#define PH_BODY_10 RES(1, 1, 0, 1, 0, 2, MT, 1.0f, args.out, XC, PART)
    PHASE(10);
#define PH_BODY_11 { GEMM_GU(1, MT); deferred_convert(F, CV_LF2, CV_LF3, (MT / 256) * (2 * DFF / 256)); }
    PHASE(11);
#define PH_BODY_12 { GEMM_DN(1, MT); deferred_convert(F, CV_LF3, CV_EI, (ML / 256) * (DM / 256) + (MC / 256) * (DM / 256) * 4); }
    PHASE(12);
#define PH_BODY_13 RES(1, 1, 0, 2, 1, 0, MT, 0.5f, args.out, XC, PART)
    PHASE(13);
#define PH_BODY_14 { GEMM_GU(2, MT); deferred_convert(F, CV_OI, CV_SM, (MT / 256) * (2 * DFF / 256)); }
    PHASE(14);
#define PH_BODY_15 GEMM_DN(2, MT)
    PHASE(15);
#define PH_BODY_16 RES(1, 1, 1, 0, 1, 1, MT, 0.5f, args.out, XC, PART)
    PHASE(16);
#define PH_BODY_17 { pg8::Gemm g{H, (const bf16*)(ws + WS_WODIN), MT, ODN, DM, DM}; pg8::StaticOrder S; S.init(MT, ODN, F.G, F.bid); \
        pg8::EpiPlain Ep{E2, ODN}; pg8::gemm_phase<pg8::EpiPlain, pg8::StaticOrder, PG8_ALIGN, PG8_SP2>(F.lds, g, S, Ep); }
    PHASE(17);
#define PH_BODY_18 odd_post_phase(F)
    PHASE(18);
#define PH_BODY_19 attn_phase(F)
    PHASE(19);
#define PH_BODY_20 { pg8::Gemm g{MIX2, (const bf16*)(ws + WS_WODOUT), ML, DM, DM, DM}; pg8::StaticOrder S; S.init(ML, DM, F.G, F.bid); \
        pg8::EpiPlain Ep{H, DM}; pg8::gemm_phase<pg8::EpiPlain, pg8::StaticOrder, PG8_ALIGN, PG8_SP2>(F.lds, g, S, Ep); }
    PHASE(20);
#define PH_BODY_21 RES(1, 1, 1, 1, 1, 2, ML, 1.0f, args.out, XC, nullptr)
    PHASE(21);
#define PH_BODY_22 GEMM_GU(3, ML)
    PHASE(22);
#define PH_BODY_23 GEMM_DN(3, ML)
    PHASE(23);
#define PH_BODY_24 RES(1, 0, 1, 2, 0, 0, ML, 0.5f, args.out, XC, nullptr)
    PHASE(24);
#ifdef MK_GSTAMP
    if (F.bid == 0 && F.tid == 0) args.out[0] = 64.f * floorf((float)((const unsigned*)(ws + WS_CTL))[64] * 0.01f / 64.f + 0.5f);
#endif
    if (MK_STAMPMASK != 0u && F.bid == 0 && F.tid == 0) args.out[0] = 512.f * floorf((float)t_stamp1 * 0.01f / 512.f + 0.5f);
    if (MK_STAMP >= 0 && F.bid == 0 && F.tid == 0) args.out[0] = 32.f * floorf((float)(t_stamp1 - t_stamp0) * 0.01f / 32.f + 0.5f);
#undef IN
#undef SEAM
}

extern "C" void kernel_launch(void* const* d_in, const int* in_sizes, int n_in, void* d_out, int out_size, void* d_ws, size_t ws_size, hipStream_t stream) {
    static int grid = 0;
    if (grid == 0) {
        if (n_in != 28 || out_size != ML * DM || ws_size < WS_END) { fprintf(stderr, "kernel_launch: unexpected shapes (n_in %d out %d ws %zu, need ws >= %zu)\n", n_in, out_size, ws_size, (size_t)WS_END); grid = -1; return; }
        int dev = 0, cus = 0, per_cu = 0;
        if (hipGetDevice(&dev) != hipSuccess || hipDeviceGetAttribute(&cus, hipDeviceAttributeMultiprocessorCount, dev) != hipSuccess) { grid = -1; return; }
        if (hipFuncSetAttribute((const void*)mk_fwd, hipFuncAttributeMaxDynamicSharedMemorySize, LDS_BYTES) != hipSuccess) { fprintf(stderr, "kernel_launch: hipFuncSetAttribute failed\n"); grid = -1; return; }
        if (hipOccupancyMaxActiveBlocksPerMultiprocessor(&per_cu, (const void*)mk_fwd, 512, LDS_BYTES) != hipSuccess || per_cu < 1) fprintf(stderr, "kernel_launch: occupancy query says %d\n", per_cu);
        (void)hipGetLastError();
        grid = cus;
    }
    if (grid < 0) return;
    (void)hipMemsetAsync((char*)d_ws + WS_CTL, 0, CTL_ZERO_BYTES, stream);
    Args a{};
    for (int i = 0; i < 28; ++i) a.in[i] = (const float*)d_in[i];
    a.out = (float*)d_out; a.ws = (unsigned char*)d_ws;
#if MK_N_LAUNCHES == 1
    a.ph_lo = 0; a.ph_hi = NPH;
    hipLaunchKernelGGL(mk_fwd, dim3(grid), dim3(512), LDS_BYTES, stream, a);
#else
    for (int p = 0; p < NPH && p <= MK_STOP_AFTER; ++p) { a.ph_lo = p; a.ph_hi = p + 1; hipLaunchKernelGGL(mk_fwd, dim3(grid), dim3(512), LDS_BYTES, stream, a); }
#endif
    const hipError_t le = hipPeekAtLastError();
    if (le != hipSuccess) fprintf(stderr, "kernel_launch: launch failed: %s\n", hipGetErrorName(le));
}
```

```cpp
#include <hip/hip_runtime.h>
#include <cstdio>
#include <cstdint>

#ifndef MK_N_LAUNCHES
#define MK_N_LAUNCHES 1
#endif
#ifndef MK_STOP_AFTER
#define MK_STOP_AFTER 1000
#endif

#define DEV __device__ __forceinline__
#define LAS __attribute__((address_space(3)))
typedef unsigned short bf16;
typedef float f32x4 __attribute__((ext_vector_type(4)));
typedef float f32x2 __attribute__((ext_vector_type(2)));
typedef float f32x16 __attribute__((ext_vector_type(16)));
typedef short bf16x8 __attribute__((ext_vector_type(8)));
typedef short s16x4 __attribute__((ext_vector_type(4)));
typedef unsigned u32x4 __attribute__((ext_vector_type(4)));
typedef unsigned u32x2 __attribute__((ext_vector_type(2)));

constexpr int NB = 4, SEQ = 8192, DM = 2048, CTXL = 256, DFF = 5632;
constexpr int ML = NB * SEQ, MC = NB * CTXL, MT = ML + MC;
constexpr float EPS = 1e-6f;
constexpr int EVN = 6144, ODN = 3072;
constexpr int EC_G = 0, EC_O = 1024, EC_Q = 2048, EC_K = 3072, EC_V = 4096, EC_R = 5120;
constexpr int NCH64 = (CTXL + SEQ) / 64;
constexpr int NCH128 = (CTXL + SEQ) / 128;
constexpr int KVL = CTXL + SEQ;

constexpr size_t MiB = 1u << 20;
constexpr size_t WS_CTL = 0, CTL_ZERO_BYTES = 1 * MiB;
constexpr size_t WS_MOD = 1 * MiB;
constexpr size_t WS_COS1 = 2 * MiB, WS_SIN1 = 6 * MiB;
constexpr size_t WS_COS2 = 10 * MiB, WS_SIN2 = 12 * MiB;
constexpr size_t WS_LRUW = 14 * MiB;
constexpr size_t WS_POOLW = 15 * MiB;
constexpr size_t WS_AGG = 16 * MiB;
constexpr size_t WS_CAR = 25 * MiB;
constexpr size_t WS_XC = 30 * MiB;
constexpr size_t WS_W = 40 * MiB;
constexpr size_t WS_WGU = WS_W;
constexpr size_t WS_WD = WS_W + 176 * MiB;
constexpr size_t WS_WEVIN = WS_W + 264 * MiB;
constexpr size_t WS_WEVOUT = WS_W + 288 * MiB;
constexpr size_t WS_WODIN = WS_W + 296 * MiB;
constexpr size_t WS_WODOUT = WS_W + 308 * MiB;
constexpr size_t WS_H = 356 * MiB;
constexpr size_t WS_BIG = 488 * MiB;
constexpr size_t WS_ACT = WS_BIG;
constexpr size_t WS_E = WS_BIG;
constexpr size_t WS_SBUF = WS_BIG + 396 * MiB;
constexpr size_t WS_PART = WS_BIG + 400 * MiB;
constexpr size_t WS_E2 = WS_BIG;
constexpr size_t WS_QB = WS_BIG + 198 * MiB;
constexpr size_t WS_KB = WS_BIG + 294 * MiB;
constexpr size_t WS_VB = WS_BIG + 327 * MiB;
constexpr size_t WS_MIX2 = WS_BIG + 360 * MiB;
constexpr size_t WS_END = 1148 * MiB;
constexpr int CW_BAR = 4096;

constexpr int LDS_BYTES = 159744;
constexpr int MISC_OFF = LDS_BYTES - 256;

DEV float bflo(unsigned w) { return __uint_as_float(w << 16); }
DEV float bfhi(unsigned w) { return __uint_as_float(w & 0xffff0000u); }
DEV float bf2f(bf16 b) { return __uint_as_float((unsigned)b << 16); }
DEV unsigned pkbf(float lo, float hi) { unsigned r; asm volatile("v_cvt_pk_bf16_f32 %0, %1, %2" : "=v"(r) : "v"(lo), "v"(hi)); return r; }
DEV bf16 f2bf(float f) { return (bf16)(pkbf(f, 0.f) & 0xffffu); }
DEV float fexp(float x) { return __builtin_amdgcn_exp2f(x * 1.4426950408889634f); }
DEV float fsigmoid(float x) { return __builtin_amdgcn_rcpf(1.f + fexp(-x)); }
DEV float fsilu(float x) { return x * fsigmoid(x); }
DEV float fgelu_tanh(float x) { const float z = 0.7978845608028654f * (x + 0.044715f * x * x * x); return x * fsigmoid(2.f * z); }
DEV float wave_sum(float v) {
#pragma unroll
    for (int o = 1; o < 64; o <<= 1) v += __shfl_xor(v, o);
    return v;
}
DEV int crow(int r, int hi) { return (r & 3) + 8 * (r >> 2) + 4 * hi; }
typedef short v4i16_t __attribute__((ext_vector_type(4)));
DEV s16x4 ds_tr(const LAS unsigned char* p) { return __builtin_bit_cast(s16x4, __builtin_amdgcn_ds_read_tr16_b64_v4i16((LAS v4i16_t*)p)); }
DEV bf16x8 tr_frag(const LAS unsigned char* X, int ld, int k0, int n0, int lane) {
    const int h = lane >> 5, blk = (lane >> 4) & 1, q = (lane & 15) >> 2, p = lane & 3;
    const LAS unsigned char* a = X + (k0 + 8 * h + q) * ld + (n0 + 16 * blk + 4 * p) * 2;
    const s16x4 lo = ds_tr(a), hi = ds_tr(a + 4 * ld);
    return (bf16x8){lo[0], lo[1], lo[2], lo[3], hi[0], hi[1], hi[2], hi[3]};
}
DEV bf16x8 pack8(const float* v) { u32x4 w = {pkbf(v[0], v[1]), pkbf(v[2], v[3]), pkbf(v[4], v[5]), pkbf(v[6], v[7])}; return __builtin_bit_cast(bf16x8, w); }

namespace pg8 {
typedef unsigned short bf16_t;
constexpr int BM = 256, BK = 64, HALF = 128, HTB = HALF * BK * 2, STAGE_BYTES = 8 * HTB, NXCD = 8, WGM = 4;
__host__ __device__ __forceinline__ int lds_byte(int r, int c) { const int st = (r >> 4) * 2 + (c >> 5), rr = r & 15, cc = c & 31, ob = rr * 64 + cc * 2; return st * 1024 + (ob ^ (((ob >> 9) & 1) << 5)); }
__host__ __device__ __forceinline__ void stage_rc(int b, int& R, int& C) { const int st = b / 1024, sb = b % 1024, swz = sb ^ (((sb >> 9) & 1) << 5); R = (st >> 1) * 16 + swz / 64; C = (st & 1) * 32 + (swz % 64) / 2; }
__host__ __device__ __forceinline__ int perm32(int rho) { const int n = rho >> 4, i = rho & 15; return 8 * (i >> 2) + 4 * n + (i & 3); }
struct Unit { int pm, pn, ks, nks; };
struct Gemm { const bf16_t* A; const bf16_t* Bt; int M, N, K, lda; };
struct StaticOrder {
    int nM, nN, nwg, G, c;
    __host__ __device__ void init(int M, int N, int G_, int c_) { nM = M / BM; nN = N / BM; nwg = nM * nN; G = G_; c = c_; }
    __host__ __device__ __forceinline__ bool next(int i, Unit& u) const {
        const long L = (long)i * G + c; if (L >= nwg) return false;
        int wgid = (int)L; { const int q = nwg / NXCD, r = nwg % NXCD, xcd = wgid % NXCD, off = wgid / NXCD; wgid = (xcd < r ? xcd * (q + 1) : r * (q + 1) + (xcd - r) * q) + off; }
        const int nig = WGM * nN, gid = wgid / nig, fm = gid * WGM, gsz = (nM - fm) < WGM ? (nM - fm) : WGM;
        u.pm = fm + ((wgid % nig) % gsz); u.pn = (wgid % nig) / gsz; u.ks = 0; u.nks = 1; return true;
    }
    __device__ __forceinline__ void a_ready(const Unit&) const {}
    __device__ __forceinline__ void done(const Unit&) const {}
};
struct TailSplitOrder {
    StaticOrder full; int nMf, nMt, nN, nfull, split;
    __host__ __device__ void init(int Mfull, int Mtail, int N, int G_, int c_, int split_) { full.init(Mfull, N, G_, c_); nMf = Mfull / BM; nMt = Mtail / BM; nN = N / BM; nfull = nMf * nN; split = split_; }
    __host__ __device__ __forceinline__ bool next(int i, Unit& u) const {
        const long L = (long)i * full.G + full.c; int pm = 0, pn = 0, ks = 0, nks = 1; bool ok;
        if (L < nfull) { Unit f; ok = full.next(i, f); pm = f.pm; pn = f.pn; }
        else { const int Lp = (int)(L - nfull); ok = Lp < nMt * nN * split; const int t = Lp / split, d = nMt > 0 ? nMt : 1; ks = Lp % split; nks = split; pm = nMf + t % d; pn = t / d; }
        u.pm = pm; u.pn = pn; u.ks = ks; u.nks = nks; return ok;
    }
    __device__ __forceinline__ void a_ready(const Unit&) const {}
    __device__ __forceinline__ void done(const Unit&) const {}
};
struct EpiPlain {
    static constexpr bool PERM = true, AFTER_DRAIN = false;
    bf16_t* O; int ldc;
    __device__ __forceinline__ void operator()(const f32x4 (&acc)[2][2][4][2], const Unit& u, int wr, int wc, int fr, int fq) const {
        const int row0 = u.pm * BM + wr * 64 + fr, col0 = u.pn * BM + wc * 32 + 8 * fq;
#pragma unroll
        for (int ai = 0; ai < 2; ++ai)
#pragma unroll
            for (int m = 0; m < 4; ++m) { bf16_t* rowp = O + (size_t)(row0 + ai * HALF + m * 16) * ldc + col0;
#pragma unroll
                for (int bj = 0; bj < 2; ++bj) { const f32x4 v0 = acc[ai][bj][m][0], v1 = acc[ai][bj][m][1];
                    u32x4 w; w.x = pkbf(v0[0], v0[1]); w.y = pkbf(v0[2], v0[3]); w.z = pkbf(v1[0], v1[1]); w.w = pkbf(v1[2], v1[3]);
                    *(u32x4*)(rowp + bj * HALF) = w; } }
    }
};
struct EpiPlainSplit {
    static constexpr bool PERM = true, AFTER_DRAIN = false;
    bf16_t* O; int ldc; float* P; int prow0, prow_cnt;
    __device__ __forceinline__ void operator()(const f32x4 (&acc)[2][2][4][2], const Unit& u, int wr, int wc, int fr, int fq) const {
        const int row0 = u.pm * BM + wr * 64 + fr, col0 = u.pn * BM + wc * 32 + 8 * fq;
        if (u.nks == 1) {
#pragma unroll
            for (int ai = 0; ai < 2; ++ai)
#pragma unroll
                for (int m = 0; m < 4; ++m) { bf16_t* rowp = O + (size_t)(row0 + ai * HALF + m * 16) * ldc + col0;
#pragma unroll
                    for (int bj = 0; bj < 2; ++bj) { const f32x4 v0 = acc[ai][bj][m][0], v1 = acc[ai][bj][m][1];
                        u32x4 w; w.x = pkbf(v0[0], v0[1]); w.y = pkbf(v0[2], v0[3]); w.z = pkbf(v1[0], v1[1]); w.w = pkbf(v1[2], v1[3]);
                        *(u32x4*)(rowp + bj * HALF) = w; } }
        } else {
#pragma unroll
            for (int ai = 0; ai < 2; ++ai)
#pragma unroll
                for (int m = 0; m < 4; ++m) { float* rowp = P + ((size_t)u.ks * prow_cnt + (row0 + ai * HALF + m * 16 - prow0)) * ldc + col0;
#pragma unroll
                    for (int bj = 0; bj < 2; ++bj) { *(f32x4*)(rowp + bj * HALF) = acc[ai][bj][m][0]; *(f32x4*)(rowp + bj * HALF + 4) = acc[ai][bj][m][1]; } }
        }
    }
};
struct EpiSwiGLU {
    static constexpr bool PERM = true, AFTER_DRAIN = false;
    bf16_t* O; int ldc;
    __device__ __forceinline__ void operator()(const f32x4 (&acc)[2][2][4][2], const Unit& u, int wr, int wc, int fr, int fq) const {
        const int row0 = u.pm * BM + wr * 64 + fr, col0 = u.pn * HALF + wc * 32 + 8 * fq;
#pragma unroll
        for (int ai = 0; ai < 2; ++ai)
#pragma unroll
            for (int m = 0; m < 4; ++m) { bf16_t* rowp = O + (size_t)(row0 + ai * HALF + m * 16) * ldc + col0;
                f32x4 a0, a1;
#pragma unroll
                for (int j = 0; j < 4; ++j) { a0[j] = fsilu(acc[ai][0][m][0][j]) * acc[ai][1][m][0][j]; a1[j] = fsilu(acc[ai][0][m][1][j]) * acc[ai][1][m][1][j]; }
                u32x4 w; w.x = pkbf(a0[0], a0[1]); w.y = pkbf(a0[2], a0[3]); w.z = pkbf(a1[0], a1[1]); w.w = pkbf(a1[2], a1[3]);
                *(u32x4*)rowp = w; }
    }
};
struct EpiEvIn {
    static constexpr bool PERM = true, AFTER_DRAIN = false;
    bf16_t* O; const float* cs; const float* sn;
    __device__ __forceinline__ void operator()(const f32x4 (&acc)[2][2][4][2], const Unit& u, int wr, int wc, int fr, int fq) const {
        const int ldc = EVN; const int row0 = u.pm * BM + wr * 64 + fr, col0 = u.pn * BM + wc * 32 + 8 * fq;
        const bool qk = (u.pn >= 8 && u.pn < 16), rot = qk && (u.pm < ML / BM); const float ksc = (u.pn >= 12 && u.pn < 16) ? 0.0625f : 1.f;
#pragma unroll
        for (int ai = 0; ai < 2; ++ai)
#pragma unroll
            for (int m = 0; m < 4; ++m) { const int row = row0 + ai * HALF + m * 16; bf16_t* rowp = O + (size_t)row * ldc + col0;
                f32x4 o1[2], o2[2];
#pragma unroll
                for (int n = 0; n < 2; ++n) { const f32x4 x1 = acc[ai][0][m][n], x2 = acc[ai][1][m][n];
                    if (rot) { const int t = row & (SEQ - 1); const int i0 = wc * 32 + 8 * fq + 4 * n;
                        const f32x4 c4 = *(const f32x4*)(cs + (size_t)t * 128 + i0), s4 = *(const f32x4*)(sn + (size_t)t * 128 + i0);
                        o1[n] = (x1 * c4 - x2 * s4) * ksc; o2[n] = (x1 * s4 + x2 * c4) * ksc; }
                    else { o1[n] = x1 * ksc; o2[n] = x2 * ksc; } }
                u32x4 w; w.x = pkbf(o1[0][0], o1[0][1]); w.y = pkbf(o1[0][2], o1[0][3]); w.z = pkbf(o1[1][0], o1[1][1]); w.w = pkbf(o1[1][2], o1[1][3]);
                *(u32x4*)rowp = w;
                w.x = pkbf(o2[0][0], o2[0][1]); w.y = pkbf(o2[0][2], o2[0][3]); w.z = pkbf(o2[1][0], o2[1][1]); w.w = pkbf(o2[1][2], o2[1][3]);
                *(u32x4*)(rowp + HALF) = w; }
    }
};

template <class Epi, class Sched, bool ALIGN_EPI = false, bool SP2 = false>
__device__ __forceinline__ unsigned gemm_phase(LAS unsigned char* lds, const Gemm g, const Sched& S, const Epi& E) {
    const int tid = threadIdx.x, wid = __builtin_amdgcn_readfirstlane(tid >> 6), lane = tid & 63, wr = wid >> 2, wc = wid & 3, fr = lane & 15, fq = lane >> 4;
    const int K = g.K, nt_full = K / BK, lda = g.lda;
    unsigned voffA[2], voffB[2];
#pragma unroll
    for (int i = 0; i < 2; ++i) { int R, C; stage_rc(tid * 16 + i * 8192, R, C); const int Rb = Epi::PERM ? ((R & ~31) + perm32(R & 31)) : R;
        voffA[i] = (unsigned)(R * lda + C) * 2u; voffB[i] = (unsigned)(Rb * K + C) * 2u; }
    const size_t kstep = (size_t)(BK * 2);
    const size_t hstepA = (size_t)HALF * lda * 2, hstepB = (size_t)HALF * K * 2;
    const size_t tstepA = 2 * hstepA, tstepB = 2 * hstepB;
    const unsigned ldsw = (unsigned)wid * 1024u;
    const int aoff = lds_byte(wr * 64 + fr, fq * 8), boff = lds_byte(wc * 32 + fr, fq * 8);
#define PG8_SA(b, h) (((b) * 2 + (h)) * HTB)
#define PG8_SB(b, h) ((4 + (b) * 2 + (h)) * HTB)
#define PG8_STAGE(bufoff, gbase, voff) do { _Pragma("unroll") for (int _i = 0; _i < 2; ++_i) \
        __builtin_amdgcn_global_load_lds((const unsigned*)((const char*)(gbase) + (voff)[_i]), (LAS unsigned*)(lds + (bufoff) + ldsw + _i * 8192), 16, 0, 0); } while (0)
#define PG8_LDA(dst, b, h) do { _Pragma("unroll") for (int m = 0; m < 4; ++m) _Pragma("unroll") for (int k = 0; k < 2; ++k) dst[m][k] = *(const LAS bf16x8*)(lds + PG8_SA(b, h) + aoff + m * 2048 + k * 1024); } while (0)
#define PG8_LDB(dst, b, h) do { _Pragma("unroll") for (int n = 0; n < 2; ++n) _Pragma("unroll") for (int k = 0; k < 2; ++k) dst[n][k] = *(const LAS bf16x8*)(lds + PG8_SB(b, h) + boff + n * 2048 + k * 1024); } while (0)
#define PG8_MMA(ai, bj, At, Bt) do { __builtin_amdgcn_s_setprio(1); _Pragma("unroll") for (int m = 0; m < 4; ++m) _Pragma("unroll") for (int n = 0; n < 2; ++n) _Pragma("unroll") for (int k = 0; k < 2; ++k) \
        acc[ai][bj][m][n] = __builtin_amdgcn_mfma_f32_16x16x32_bf16(Bt[n][k], At[m][k], acc[ai][bj][m][n], 0, 0, 0); __builtin_amdgcn_s_setprio(0); } while (0)
#define PG8_WAIT_V(n) asm volatile("s_waitcnt vmcnt(" #n ")" ::: "memory")
#define PG8_WAIT_L(n) asm volatile("s_waitcnt lgkmcnt(" #n ")" ::: "memory")
#define PG8_BAR __builtin_amdgcn_s_barrier()
#define PG8_SCHED __builtin_amdgcn_sched_barrier(0)
    Unit cur, nxt; int ui = 0;
    if (!S.next(0, cur)) return 0u;
    f32x4 acc[2][2][4][2];
#pragma unroll
    for (int a = 0; a < 2; ++a)
#pragma unroll
        for (int b = 0; b < 2; ++b)
#pragma unroll
            for (int m = 0; m < 4; ++m)
#pragma unroll
                for (int n = 0; n < 2; ++n) acc[a][b][m][n] = (f32x4){0.f, 0.f, 0.f, 0.f};
    bf16x8 At[4][2], B0[2][2], B1[2][2];
    int nt = nt_full / cur.nks;
    const char* cA = (const char*)g.A + (size_t)cur.pm * tstepA + (size_t)cur.ks * (K / cur.nks) * 2; const char* cB = (const char*)g.Bt + (size_t)cur.pn * tstepB + (size_t)cur.ks * (K / cur.nks) * 2;
    S.a_ready(cur);
    if constexpr (SP2) {
        PG8_STAGE(PG8_SB(0, 0), cB, voffB); PG8_STAGE(PG8_SB(0, 1), cB + hstepB, voffB); PG8_STAGE(PG8_SA(0, 0), cA, voffA); PG8_STAGE(PG8_SA(0, 1), cA + hstepA, voffA);
        if (wr == 1) PG8_BAR;
        PG8_WAIT_V(2); PG8_BAR;
        PG8_STAGE(PG8_SB(1, 0), cB + kstep, voffB); PG8_STAGE(PG8_SA(1, 0), cA + kstep, voffA); PG8_STAGE(PG8_SB(1, 1), cB + hstepB + kstep, voffB);
        PG8_WAIT_V(6); PG8_BAR;
    } else {
        PG8_STAGE(PG8_SB(0, 0), cB, voffB); PG8_STAGE(PG8_SA(0, 0), cA, voffA); PG8_STAGE(PG8_SB(0, 1), cB + hstepB, voffB); PG8_STAGE(PG8_SA(0, 1), cA + hstepA, voffA);
        if (wr == 1) PG8_BAR;
        PG8_WAIT_V(4); PG8_BAR;
        PG8_STAGE(PG8_SB(1, 0), cB + kstep, voffB); PG8_STAGE(PG8_SA(1, 0), cA + kstep, voffA); PG8_STAGE(PG8_SB(1, 1), cB + hstepB + kstep, voffB);
        PG8_WAIT_V(6); PG8_BAR;
    }
#ifdef MK_GSTAMP
    unsigned gs_t2 = (unsigned)wall_clock64(), gs_acc = 0;
#endif
    for (;;) {
        const bool has_next = S.next(ui + 1, nxt);
        const char* nA = has_next ? (const char*)g.A + (size_t)nxt.pm * tstepA + (size_t)nxt.ks * (K / nxt.nks) * 2 : cA; const char* nB = has_next ? (const char*)g.Bt + (size_t)nxt.pn * tstepB + (size_t)nxt.ks * (K / nxt.nks) * 2 : cB;
        for (int t = 0; t < nt; t += 2) {
            const bool last = (t == nt - 2);
            const char* a1 = cA + (size_t)(t + 1) * kstep;
            const char* a2 = last ? nA : cA + (size_t)(t + 2) * kstep; const char* b2 = last ? nB : cB + (size_t)(t + 2) * kstep;
            const char* a3 = a2 + kstep; const char* b3 = b2 + kstep;
            if (last && has_next) S.a_ready(nxt);
            if constexpr (SP2) {
            PG8_LDB(B0, 0, 0); PG8_LDB(B1, 0, 1); PG8_SCHED; PG8_LDA(At, 0, 0); PG8_STAGE(PG8_SA(1, 1), a1 + hstepA, voffA);
            PG8_WAIT_V(8); PG8_WAIT_L(0); PG8_BAR; PG8_MMA(0, 0, At, B0); PG8_MMA(0, 1, At, B1); PG8_BAR; PG8_SCHED;
            PG8_LDA(At, 0, 1); PG8_STAGE(PG8_SB(0, 0), b2, voffB); PG8_STAGE(PG8_SB(0, 1), b2 + hstepB, voffB); PG8_STAGE(PG8_SA(0, 0), a2, voffA);
            PG8_WAIT_V(8); PG8_WAIT_L(0); PG8_BAR; PG8_MMA(1, 0, At, B0); PG8_MMA(1, 1, At, B1); PG8_BAR; PG8_SCHED;
            PG8_LDB(B0, 1, 0); PG8_LDB(B1, 1, 1); PG8_SCHED; PG8_LDA(At, 1, 0); PG8_STAGE(PG8_SA(0, 1), a2 + hstepA, voffA);
            PG8_WAIT_V(8); PG8_WAIT_L(0); PG8_BAR; PG8_MMA(0, 0, At, B0); PG8_MMA(0, 1, At, B1); PG8_BAR; PG8_SCHED;
            PG8_LDA(At, 1, 1); PG8_STAGE(PG8_SB(1, 0), b3, voffB); PG8_STAGE(PG8_SB(1, 1), b3 + hstepB, voffB); PG8_STAGE(PG8_SA(1, 0), a3, voffA);
            PG8_WAIT_V(8); PG8_WAIT_L(0); PG8_BAR; PG8_MMA(1, 0, At, B0); PG8_MMA(1, 1, At, B1); PG8_BAR; PG8_SCHED;
            } else {
            PG8_LDB(B0, 0, 0); PG8_SCHED; PG8_LDA(At, 0, 0); PG8_STAGE(PG8_SA(1, 1), a1 + hstepA, voffA);
            PG8_WAIT_L(8); PG8_BAR; PG8_WAIT_L(0); PG8_MMA(0, 0, At, B0); PG8_BAR; PG8_SCHED;
            PG8_LDB(B1, 0, 1); PG8_STAGE(PG8_SB(0, 0), b2, voffB);
            PG8_BAR; PG8_WAIT_L(0); PG8_MMA(0, 1, At, B1); PG8_BAR;
            PG8_LDA(At, 0, 1); PG8_STAGE(PG8_SA(0, 0), a2, voffA);
            PG8_BAR; PG8_WAIT_L(0); PG8_MMA(1, 0, At, B0); PG8_BAR; PG8_SCHED;
            PG8_STAGE(PG8_SB(0, 1), b2 + hstepB, voffB);
            PG8_WAIT_V(6); PG8_BAR; PG8_MMA(1, 1, At, B1); PG8_BAR;
            PG8_LDB(B0, 1, 0); PG8_SCHED; PG8_LDA(At, 1, 0); PG8_STAGE(PG8_SA(0, 1), a2 + hstepA, voffA);
            PG8_WAIT_L(8); PG8_BAR; PG8_WAIT_L(0); PG8_MMA(0, 0, At, B0); PG8_BAR; PG8_SCHED;
            PG8_LDB(B1, 1, 1); PG8_STAGE(PG8_SB(1, 0), b3, voffB);
            PG8_BAR; PG8_WAIT_L(0); PG8_MMA(0, 1, At, B1); PG8_BAR;
            PG8_LDA(At, 1, 1); PG8_STAGE(PG8_SA(1, 0), a3, voffA);
            PG8_BAR; PG8_WAIT_L(0); PG8_MMA(1, 0, At, B0); PG8_BAR; PG8_SCHED;
            PG8_STAGE(PG8_SB(1, 1), b3 + hstepB, voffB);
            PG8_WAIT_V(6); PG8_BAR; PG8_MMA(1, 1, At, B1); PG8_BAR;
            }
        }
#ifdef MK_GSTAMP
        const unsigned gs_t0 = (unsigned)wall_clock64(); if (MK_GSTAMP == 2) gs_acc += gs_t0 - gs_t2;
#endif
        if constexpr (ALIGN_EPI) { if (wr == 0) PG8_BAR; }
        if constexpr (!Epi::AFTER_DRAIN) { E(acc, cur, wr, wc, fr, fq); S.done(cur); }
#ifdef MK_GSTAMP
        const unsigned gs_t1 = (unsigned)wall_clock64(); if (MK_GSTAMP == 0) gs_acc += gs_t1 - gs_t0;
#endif
        if (!has_next) break;
#pragma unroll
        for (int a = 0; a < 2; ++a)
#pragma unroll
            for (int b = 0; b < 2; ++b)
#pragma unroll
                for (int m = 0; m < 4; ++m)
#pragma unroll
                    for (int n = 0; n < 2; ++n) acc[a][b][m][n] = (f32x4){0.f, 0.f, 0.f, 0.f};
        cur = nxt; cA = nA; cB = nB; ++ui; nt = nt_full / cur.nks;
        if constexpr (ALIGN_EPI) { if (wr == 1) PG8_BAR; }
#ifdef MK_GSTAMP
        gs_t2 = (unsigned)wall_clock64(); if (MK_GSTAMP == 1) gs_acc += gs_t2 - gs_t1;
#endif
    }
    PG8_WAIT_V(0);
    if constexpr (!ALIGN_EPI) { if (wr == 0) PG8_BAR; }
    PG8_BAR;
#ifdef MK_GSTAMP
    return gs_acc;
#else
    return 0u;
#endif
#undef PG8_SA
#undef PG8_SB
#undef PG8_STAGE
#undef PG8_LDA
#undef PG8_LDB
#undef PG8_MMA
#undef PG8_WAIT_V
#undef PG8_WAIT_L
#undef PG8_BAR
#undef PG8_SCHED
}
}
#define PG8_SP2 true
#define PG8_ALIGN true

namespace att {
constexpr int D = 128, NW = 8, QBLK = 32, KVBLK = 64;
constexpr float SCALE = 0.088388347648318440f;
constexpr float THR = 8.f;
constexpr size_t SHM_V = KVBLK * D * 2, SHM_K = KVBLK * D * 2, SHM_ATTN = 2 * SHM_V + 2 * SHM_K + NW * 64 * 4;
#define KSWZ(row, colB) ((row) * 256 + ((colB) ^ (((row) & 7) << 4)))
#define SBAR() __builtin_amdgcn_sched_barrier(0)
DEV void partialSM(f32x16& p0, f32x16& p1, float& m_reg, float& mn, float& alpha) {
  constexpr float C = SCALE * 1.4426950408889634f;
  float pmax = p0[0]; for (int r = 1; r < 16; ++r) pmax = fmaxf(pmax, p0[r]); for (int r = 0; r < 16; ++r) pmax = fmaxf(pmax, p1[r]);
  { auto rr = __builtin_amdgcn_permlane32_swap(__float_as_uint(pmax), __float_as_uint(pmax), false, false);
    pmax = fmaxf(__uint_as_float(rr[0]), __uint_as_float(rr[1])); }
  if (__builtin_expect(__all(pmax - m_reg <= THR / SCALE), 1)) { mn = m_reg; alpha = 1.f; }
  else { mn = fmaxf(m_reg, pmax); alpha = __builtin_amdgcn_exp2f((m_reg - mn) * C); m_reg = mn; }
  float mnC = -mn * C;
  for (int r = 0; r < 16; ++r) p0[r] = fmaf(p0[r], C, mnC); for (int r = 0; r < 16; ++r) p1[r] = fmaf(p1[r], C, mnC);
  for (int r = 0; r < 16; ++r) p0[r] = __builtin_amdgcn_exp2f(p0[r]);
}
DEV void finishSM(f32x16& p0, f32x16& p1, float alpha, float& l_reg, bf16x8& pa0, bf16x8& pa1, bf16x8& pa2, bf16x8& pa3) {
  for (int r = 0; r < 16; ++r) p1[r] = __builtin_amdgcn_exp2f(p1[r]);
  float ps = 0; for (int r = 0; r < 16; ++r) ps += p0[r]; for (int r = 0; r < 16; ++r) ps += p1[r];
  { auto rr = __builtin_amdgcn_permlane32_swap(__float_as_uint(ps), __float_as_uint(ps), false, false);
    ps = __uint_as_float(rr[0]) + __uint_as_float(rr[1]); }
  l_reg = l_reg * alpha + ps;
#define PK4(P, BASE, OUT) do { unsigned a0 = pkbf(P[BASE + 0], P[BASE + 1]), a1 = pkbf(P[BASE + 2], P[BASE + 3]);   \
    unsigned b0 = pkbf(P[BASE + 4], P[BASE + 5]), b1 = pkbf(P[BASE + 6], P[BASE + 7]);                              \
    auto r0 = __builtin_amdgcn_permlane32_swap(a0, b0, false, false); auto r1 = __builtin_amdgcn_permlane32_swap(a1, b1, false, false); \
    u32x4 w = {r0[0], r1[0], r0[1], r1[1]}; OUT = __builtin_bit_cast(bf16x8, w); } while (0)
  PK4(p0, 0, pa0); PK4(p0, 8, pa1); PK4(p1, 0, pa2); PK4(p1, 8, pa3);
#undef PK4
}
DEV void qkt(f32x16& p0, f32x16& p1, const bf16* Ks, const bf16x8* qr, int r32, int hi) {
  p0 = f32x16{}; p1 = f32x16{};
  for (int d0 = 0; d0 < 8; ++d0) { int cb = (d0 * 16 + hi * 8) * 2;
    bf16x8 b0 = *reinterpret_cast<const bf16x8*>((const char*)Ks + KSWZ(r32, cb));
    bf16x8 b1 = *reinterpret_cast<const bf16x8*>((const char*)Ks + KSWZ(32 + r32, cb));
    p0 = __builtin_amdgcn_mfma_f32_32x32x16_bf16(b0, qr[d0], p0, 0, 0, 0);
    p1 = __builtin_amdgcn_mfma_f32_32x32x16_bf16(b1, qr[d0], p1, 0, 0, 0); }
}
DEV int v_st(int k, int c) { const int kk = (k & ~0xC) | ((k & 4) << 1) | ((k & 8) >> 1); return ((kk >> 3) * 4 + (c >> 5)) * 512 + ((kk & 7) * 32 + (c & 31)) * 2; }
DEV int v_rd_base(int lane) { return ((lane & 3) << 3) | (((lane >> 2) & 3) << 6) | (((lane >> 4) & 1) << 5) | (((lane >> 5) & 1) << 8); }
constexpr int v_rd_off(int d0, int ks, int half) { return d0 * 512 + ks * 4096 + half * 2048; }
template <int OFF> DEV s16x4 tr_read(int vb) {
  s16x4 r; asm volatile("ds_read_b64_tr_b16 %0, %1 offset:%2" : "=&v"(r) : "v"(vb), "i"(OFF) : "memory"); return r;
}
template <int D0> DEV void pv_one(f32x16& od, int vb, bf16x8 pa0, bf16x8 pa1, bf16x8 pa2, bf16x8 pa3) {
  const s16x4 l0 = tr_read<v_rd_off(D0, 0, 0)>(vb), h0 = tr_read<v_rd_off(D0, 0, 1)>(vb), l1 = tr_read<v_rd_off(D0, 1, 0)>(vb), h1 = tr_read<v_rd_off(D0, 1, 1)>(vb);
  const s16x4 l2 = tr_read<v_rd_off(D0, 2, 0)>(vb), h2 = tr_read<v_rd_off(D0, 2, 1)>(vb), l3 = tr_read<v_rd_off(D0, 3, 0)>(vb), h3 = tr_read<v_rd_off(D0, 3, 1)>(vb);
  asm volatile("s_waitcnt lgkmcnt(0)" ::: "memory"); SBAR();
#define PK(L, H) (bf16x8){L[0], L[1], L[2], L[3], H[0], H[1], H[2], H[3]}
  od = __builtin_amdgcn_mfma_f32_32x32x16_bf16(pa0, PK(l0, h0), od, 0, 0, 0);
  od = __builtin_amdgcn_mfma_f32_32x32x16_bf16(pa1, PK(l1, h1), od, 0, 0, 0);
  od = __builtin_amdgcn_mfma_f32_32x32x16_bf16(pa2, PK(l2, h2), od, 0, 0, 0);
  od = __builtin_amdgcn_mfma_f32_32x32x16_bf16(pa3, PK(l3, h3), od, 0, 0, 0);
#undef PK
}
DEV void pv_d0(f32x16* o, int vb, bf16x8 pa0, bf16x8 pa1, bf16x8 pa2, bf16x8 pa3) {
  pv_one<0>(o[0], vb, pa0, pa1, pa2, pa3); pv_one<1>(o[1], vb, pa0, pa1, pa2, pa3); pv_one<2>(o[2], vb, pa0, pa1, pa2, pa3); pv_one<3>(o[3], vb, pa0, pa1, pa2, pa3);
}
template <int LDQ, int LDK, int LDO>
DEV void attn_dense_body(const bf16* __restrict__ Qb, const bf16* __restrict__ Kh, const bf16* __restrict__ Vh, bf16* __restrict__ Ob, int seq, char* lds) {
  const int tid = threadIdx.x, wid = tid >> 6, lane = tid & 63, r32 = lane & 31, hi = lane >> 5;
  bf16* V_lds = (bf16*)lds; bf16* K_lds = (bf16*)(lds + 2 * SHM_V);
  float* ws = (float*)(lds + 2 * SHM_V + 2 * SHM_K) + wid * 64; float* li_l = ws; float* al_l = ws + 32;
  float m_reg = -1e30f, l_reg = 0; f32x16 o[4] = {}; bf16x8 qr[8];
  const bf16* Qw = Qb + (long)(wid * QBLK + r32) * LDQ + hi * 8;
#pragma unroll
  for (int d0 = 0; d0 < 8; ++d0) qr[d0] = *reinterpret_cast<const bf16x8*>(Qw + d0 * 16);
  const int sr = tid >> 4, sc = (tid & 15) * 8, vst0 = v_st(sr, sc), vst1 = v_st(32 + sr, sc);
  const int vb0 = (int)(uintptr_t)V_lds + v_rd_base(lane);
  struct { bf16x8 vs0, vs1, ks0, ks1; } sr_[2];
#define SLOAD(i, k0) do { sr_[i].vs0 = *reinterpret_cast<const bf16x8*>(&Vh[(long)((k0) + sr) * LDK + sc]); sr_[i].vs1 = *reinterpret_cast<const bf16x8*>(&Vh[(long)((k0) + 32 + sr) * LDK + sc]); \
    sr_[i].ks0 = *reinterpret_cast<const bf16x8*>(&Kh[(long)((k0) + sr) * LDK + sc]); sr_[i].ks1 = *reinterpret_cast<const bf16x8*>(&Kh[(long)((k0) + 32 + sr) * LDK + sc]); } while (0)
#define SWRITE(b, i) do { *(bf16x8*)((char*)V_lds + (b) * SHM_V + vst0) = sr_[i].vs0;          \
    *(bf16x8*)((char*)V_lds + (b) * SHM_V + vst1) = sr_[i].vs1; int kc = sc * 2;               \
    *(bf16x8*)((char*)K_lds + (b) * SHM_K + KSWZ(sr, kc)) = sr_[i].ks0;                       \
    *(bf16x8*)((char*)K_lds + (b) * SHM_K + KSWZ(32 + sr, kc)) = sr_[i].ks1; } while (0)
#define SWAIT() asm volatile("s_waitcnt vmcnt(4)" ::: "memory")
#define RESC(a) do { if (__any((a) < 1.f)) { if (hi == 0) al_l[r32] = (a); asm volatile("s_waitcnt lgkmcnt(0)" ::: "memory"); \
    for (int d = 0; d < 4; ++d) for (int r = 0; r < 16; ++r) o[d][r] *= al_l[crow(r, hi)]; } } while (0)
  f32x16 pA0, pA1, pB0, pB1; float mnA, mnB, alA, alB; bf16x8 pa0, pa1, pa2, pa3; const int NT = seq / KVBLK;
  constexpr int SE = 0, SO = 1;
  SLOAD(SE, 0); asm volatile("s_waitcnt vmcnt(0)" ::: "memory"); SWRITE(0, SE); __syncthreads();
  qkt(pA0, pA1, K_lds, qr, r32, hi); partialSM(pA0, pA1, m_reg, mnA, alA);
  SLOAD(SO, KVBLK); if (2 < NT) SLOAD(SE, 2 * KVBLK);
  SWAIT(); SWRITE(1, SO); __syncthreads();
  for (int j = 1; j + 1 < NT; j += 2) {
    SBAR(); qkt(pB0, pB1, (bf16*)((char*)K_lds + SHM_K), qr, r32, hi);
    finishSM(pA0, pA1, alA, l_reg, pa0, pa1, pa2, pa3); SBAR();
    SLOAD(SO, (j + 2) * KVBLK); SBAR();
    pv_d0(o, vb0, pa0, pa1, pa2, pa3); partialSM(pB0, pB1, m_reg, mnB, alB);
    __syncthreads(); SWAIT(); SWRITE(0, SE);
    RESC(alB); __syncthreads();
    SBAR(); qkt(pA0, pA1, K_lds, qr, r32, hi);
    finishSM(pB0, pB1, alB, l_reg, pa0, pa1, pa2, pa3); SBAR();
    if (j + 3 < NT) SLOAD(SE, (j + 3) * KVBLK); SBAR();
    pv_d0(o, vb0 + (int)SHM_V, pa0, pa1, pa2, pa3); partialSM(pA0, pA1, m_reg, mnA, alA);
    __syncthreads(); SWAIT(); SWRITE(1, SO);
    RESC(alA); __syncthreads();
  }
  SBAR(); qkt(pB0, pB1, (bf16*)((char*)K_lds + SHM_K), qr, r32, hi);
  finishSM(pA0, pA1, alA, l_reg, pa0, pa1, pa2, pa3); SBAR();
  pv_d0(o, vb0, pa0, pa1, pa2, pa3); partialSM(pB0, pB1, m_reg, mnB, alB);
  __syncthreads(); RESC(alB);
  finishSM(pB0, pB1, alB, l_reg, pa0, pa1, pa2, pa3); SBAR();
  pv_d0(o, vb0 + (int)SHM_V, pa0, pa1, pa2, pa3);
  if (hi == 0) li_l[r32] = l_reg; asm volatile("s_waitcnt lgkmcnt(0)" ::: "memory");
  float rli[16];
#pragma unroll
  for (int r = 0; r < 16; ++r) rli[r] = __builtin_amdgcn_rcpf(li_l[crow(r, hi)]);
  bf16* Ow = Ob + (long)(wid * QBLK) * LDO;
#pragma unroll
  for (int r = 0; r < 16; ++r) { int orow = crow(r, hi);
    for (int d0 = 0; d0 < 4; ++d0) Ow[(long)orow * LDO + d0 * 32 + r32] = f2bf(o[d0][r] * rli[r]); }
  __syncthreads();
#undef SLOAD
#undef SWRITE
#undef SWAIT
#undef RESC
}
#undef KSWZ
}

#define XB_TMO      128
#define XB_XCNT(j)  (256  + 64 * (j))
#define XB_XSUB(j)  (1280 + 64 * (j))
#define XB_XGEN(j)  (2304 + 64 * (j))
#define XB_TOP      3328
#define XB_TOPGEN   3392
#define XCD_BAR_WORDS 3456
#define XB_SPIN_CAP (1u << 18)
DEV unsigned xb_ld(unsigned* p)              { return __hip_atomic_load(p, __ATOMIC_RELAXED, __HIP_MEMORY_SCOPE_AGENT); }
DEV unsigned xb_add(unsigned* p, unsigned v) { return __hip_atomic_fetch_add(p, v, __ATOMIC_RELAXED, __HIP_MEMORY_SCOPE_AGENT); }
DEV unsigned xb_xcc_id() { return (unsigned)__builtin_amdgcn_s_getreg((3 << 11) | 20) & 0xFu; }
#define XB_SPIN(cond, bar) do { unsigned _sp = 0; while (cond) { __builtin_amdgcn_s_sleep(1); \
    if ((++_sp & 255u) == 0u) { if (xb_ld(&(bar)[XB_TMO])) break; if (_sp > XB_SPIN_CAP) { atomicAdd(&(bar)[XB_TMO], 1u); break; } } } } while (0)
struct XcdBarrier { unsigned* bar; unsigned x; volatile LAS unsigned* st; };
DEV XcdBarrier xcd_barrier_post(unsigned* bar, volatile LAS unsigned* st) {
    XcdBarrier b; b.bar = bar; b.x = xb_xcc_id(); b.st = st;
    if (threadIdx.x == 0) (void)xb_add(&bar[XB_XCNT(b.x)], 1u);
    return b;
}
DEV void xcd_barrier_complete(unsigned* bar, unsigned x, unsigned& nloc, unsigned& nx) {
    const unsigned G = gridDim.x * gridDim.y * gridDim.z;
    unsigned sum, cnt, mine, sp = 0u;
    for (;;) {
        sum = 0u; cnt = 0u; mine = 0u;
#pragma unroll
        for (unsigned j = 0; j < 16; ++j) { const unsigned c = xb_ld(&bar[XB_XCNT(j)]); sum += c; cnt += (c > 0u) ? 1u : 0u; mine = (j == x) ? c : mine; }
        if (sum == G) break;
        __builtin_amdgcn_s_sleep(1);
        if ((++sp & 255u) == 0u) { if (xb_ld(&bar[XB_TMO])) break; if (sp > XB_SPIN_CAP) { atomicAdd(&bar[XB_TMO], 1u); break; } }
    }
    nloc = mine > 0u ? mine : 1u; nx = cnt > 0u ? cnt : 1u;
}
DEV void xcd_barrier(const XcdBarrier& b) {
    asm volatile("s_waitcnt vmcnt(0)" ::: "memory");
    __syncthreads();
    if (threadIdx.x == 0) {
        unsigned* bar = b.bar;
        __builtin_amdgcn_s_waitcnt(0);
        unsigned nloc = b.st[0], nx = b.st[1];
        if (nloc == 0u) { xcd_barrier_complete(bar, b.x, nloc, nx); b.st[0] = nloc; b.st[1] = nx; }
        const unsigned old = xb_add(&bar[XB_XSUB(b.x)], 1u);
        const unsigned gen = old / nloc;
        if (old + 1u == (gen + 1u) * nloc) {
            __builtin_amdgcn_fence(__ATOMIC_RELEASE, "agent");
            asm volatile("s_waitcnt vmcnt(0)" ::: "memory");
            const unsigned og = xb_add(&bar[XB_TOP], 1u);
            const unsigned tg = og / nx;
            if (og + 1u == (tg + 1u) * nx) xb_add(&bar[XB_TOPGEN], 1u);
            else XB_SPIN(xb_ld(&bar[XB_TOPGEN]) == tg, bar);
            __builtin_amdgcn_fence(__ATOMIC_ACQUIRE, "agent");
            xb_add(&bar[XB_XGEN(b.x)], 1u);
            asm volatile("s_waitcnt vmcnt(0)" ::: "memory");
        } else {
            XB_SPIN(xb_ld(&bar[XB_XGEN(b.x)]) == gen, bar);
            __builtin_amdgcn_fence(__ATOMIC_ACQUIRE, "agent");
            asm volatile("s_waitcnt vmcnt(0)" ::: "memory");
        }
    }
    __syncthreads();
}

struct Args { const float* in[28]; float* out; unsigned char* ws; int ph_lo, ph_hi; };
enum { I_X = 0, I_C, I_CTX, I_CCTX, I_MODW, I_MODB, I_NPRE, I_NPOST, I_FG, I_FU, I_FD, I_EVIN, I_EVOUT, I_CONVW, I_CONVB, I_WA, I_BA, I_WX, I_BX, I_LAM, I_DECAY, I_GN,
       I_ODIN, I_ODOUT, I_POOLW, I_POOLS, I_QN, I_KN };
struct Frame {
    LAS unsigned char* lds; int tid, lane, wave, G, bid;
    const Args* a;
};
#define LDS_WAIT() asm volatile("s_waitcnt lgkmcnt(0)" ::: "memory")

DEV void transpose_item(const float* W, int K, int N, bf16* WT, int drow0, LAS float* scr, int kb, int nb, int lane) {
    const int k0 = 64 * kb, n0 = 32 * nb, lr = lane >> 3, c4 = lane & 7;
    f32x4 v[8];
#pragma unroll
    for (int j = 0; j < 8; ++j) v[j] = *(const f32x4*)(W + (size_t)(k0 + lr + 8 * j) * N + n0 + 4 * c4);
#pragma unroll
    for (int j = 0; j < 8; ++j) { LAS float* d = scr + (lr + 8 * j) * 33 + 4 * c4; d[0] = v[j].x; d[1] = v[j].y; d[2] = v[j].z; d[3] = v[j].w; }
    LDS_WAIT(); asm volatile("" ::: "memory");
    const int c = lane & 7;
    float t[4][8];
#pragma unroll
    for (int j = 0; j < 4; ++j) { const LAS float* sp = scr + (8 * c) * 33 + (lane >> 3) + 8 * j;
#pragma unroll
        for (int i = 0; i < 8; ++i) t[j][i] = sp[i * 33]; }
#pragma unroll
    for (int j = 0; j < 4; ++j) { const int n = (lane >> 3) + 8 * j;
        u32x4 o; o.x = pkbf(t[j][0], t[j][1]); o.y = pkbf(t[j][2], t[j][3]); o.z = pkbf(t[j][4], t[j][5]); o.w = pkbf(t[j][6], t[j][7]);
        *(u32x4*)(WT + (size_t)(drow0 + n) * K + k0 + 8 * c) = o; }
    LDS_WAIT(); asm volatile("" ::: "memory");
}
DEV void mod_items(const Frame& F, int lo, int hi, int rank, int n) {
    const Args& A = *F.a; unsigned char* ws = A.ws;
    LAS float* ssc = (LAS float*)F.lds;
    LAS float* red = (LAS float*)(F.lds + 40960);
    if (lo + rank >= hi) return;
    for (int i = F.tid; i < 5 * DM; i += 512) { const int r = i / DM, k = i % DM; const float v = (r < 4) ? A.in[I_C][r * DM + k] : A.in[I_CCTX][k]; ssc[i] = fsilu(v); }
    __syncthreads();
    float* MOD = (float*)(ws + WS_MOD);
    for (int it = lo + rank; it < hi; it += n) {
        const int li = it >> 7, col0 = (it & 127) * 144; const int ln = F.lane < 36 ? F.lane : 35;
        const float* Wp = A.in[I_MODW] + (size_t)li * DM * 18432 + (size_t)(F.wave * 256) * 18432 + col0 + 4 * ln;
        f32x4 acc[5];
#pragma unroll
        for (int r = 0; r < 5; ++r) acc[r] = (f32x4){0.f, 0.f, 0.f, 0.f};
#pragma unroll 8
        for (int kk = 0; kk < 256; ++kk) { const f32x4 wv = *(const f32x4*)(Wp + (size_t)kk * 18432);
#pragma unroll
            for (int r = 0; r < 5; ++r) { const float sv = ssc[r * DM + F.wave * 256 + kk]; acc[r] += wv * sv; } }
        if (F.lane < 36) {
#pragma unroll
            for (int r = 0; r < 5; ++r) *(LAS f32x4*)(red + (F.wave * 5 + r) * 144 + 4 * F.lane) = acc[r]; }
        __syncthreads();
        for (int o = F.tid; o < 720; o += 512) { const int r = o / 144, c = o % 144; float sum = A.in[I_MODB][li * 18432 + col0 + c];
#pragma unroll
            for (int w = 0; w < 8; ++w) sum += red[(w * 5 + r) * 144 + c];
            MOD[(size_t)(li * 5 + r) * 18432 + col0 + c] = sum; }
        __syncthreads();
    }
}
constexpr int CV_IFFN = 5632, CV_LF1 = 3 * CV_IFFN, CV_LF2 = 6 * CV_IFFN, CV_LF3 = 9 * CV_IFFN, CV_EI = 12 * CV_IFFN, CV_EO = CV_EI + 32 * 192, CV_OI = CV_EO + 32 * 64, CV_OO = CV_OI + 32 * 96, CV_SM = CV_OO + 32 * 64, CV_END = CV_SM + 8 * 36;
DEV void conv_item(const Frame& F, int it) {
    const Args& A = *F.a; unsigned char* ws = A.ws; LAS float* scr = (LAS float*)(F.lds + F.wave * 16384);
    int r = it;
    if (r < CV_EI) { const int idx = r / CV_IFFN, item = r % CV_IFFN, lf = idx / 3, kind = idx % 3;
        if (kind < 2) { const float* W = A.in[kind == 0 ? I_FG : I_FU] + (size_t)lf * DM * DFF; const int nb = item % 176, kb = item / 176, n0 = 32 * nb;
            transpose_item(W, DM, DFF, (bf16*)(ws + WS_WGU + (size_t)lf * 44 * MiB), 256 * (n0 / 128) + 128 * kind + (n0 % 128), scr, kb, nb, F.lane); }
        else { const float* W = A.in[I_FD] + (size_t)lf * DFF * DM; const int nb = item % 64, kb = item / 64;
            transpose_item(W, DFF, DM, (bf16*)(ws + WS_WD + (size_t)lf * 22 * MiB), 32 * nb, scr, kb, nb, F.lane); }
        return; }
    if (r < CV_EO) { r -= CV_EI; const int nb = r % 192, kb = r / 192, n0 = 32 * nb, blk = n0 / 1024;
        const int dblk = (blk == 1) ? 5 : (blk == 5) ? 1 : blk;
        transpose_item(A.in[I_EVIN], DM, EVN, (bf16*)(ws + WS_WEVIN), dblk * 1024 + (n0 % 1024), scr, kb, nb, F.lane); return; }
    if (r < CV_OI) { r -= CV_EO; const int nb = r % 64, kb = r / 64; transpose_item(A.in[I_EVOUT], DM, DM, (bf16*)(ws + WS_WEVOUT), 32 * nb, scr, kb, nb, F.lane); return; }
    if (r < CV_OO) { r -= CV_OI; const int nb = r % 96, kb = r / 96; transpose_item(A.in[I_ODIN], DM, ODN, (bf16*)(ws + WS_WODIN), 32 * nb, scr, kb, nb, F.lane); return; }
    if (r < CV_SM) { r -= CV_OO; const int nb = r % 64, kb = r / 64; transpose_item(A.in[I_ODOUT], DM, DM, (bf16*)(ws + WS_WODOUT), 32 * nb, scr, kb, nb, F.lane); return; }
    { r -= CV_SM; const int mat = r / 8, item = r % 8, nb = item % 4, kb = item / 4;
        const float* W; bf16* dst;
        if (mat < 16) { W = A.in[I_WA] + (size_t)mat * 16384; dst = (bf16*)(ws + WS_LRUW) + (size_t)mat * 16384; }
        else if (mat < 32) { W = A.in[I_WX] + (size_t)(mat - 16) * 16384; dst = (bf16*)(ws + WS_LRUW) + (size_t)mat * 16384; }
        else { W = A.in[I_POOLW] + (size_t)(mat - 32) * 16384; dst = (bf16*)(ws + WS_POOLW) + (size_t)(mat - 32) * 16384; }
        transpose_item(W, 128, 128, dst, 32 * nb, scr, kb, nb, F.lane); }
}
DEV void deferred_convert(const Frame& F, int lo, int hi, int total) {
    const int G = F.G, mx = (total + G - 1) / G, first_idle = total - (mx - 1) * G;
    int rank = F.bid, n = G;
    if (first_idle < G) { if (F.bid < first_idle) return; rank = F.bid - first_idle; n = G - first_idle; }
    for (int it = lo + rank * 8 + F.wave; it < hi; it += n * 8) conv_item(F, it);
}
DEV void deferred_mod(const Frame& F, int lo, int hi, int total) {
    const int G = F.G, mx = (total + G - 1) / G, first_idle = total - (mx - 1) * G;
    int rank = F.bid, n = G;
    if (first_idle < G) { if (F.bid < first_idle) return; rank = F.bid - first_idle; n = G - first_idle; }
    mod_items(F, lo, hi, rank, n);
}
DEV void p0_prologue(const Frame& F) {
    const Args& A = *F.a; unsigned char* ws = A.ws;
    mod_items(F, 0, 128, F.bid, F.G);
    __syncthreads();
    {
        const int gw = F.bid * 8 + F.wave, NGW = F.G * 8, nlo = (F.G > 128 ? 128 : F.G) * 8, NSH = nlo + 2 * (NGW - nlo);
        const int sh0 = gw < nlo ? gw : nlo + 2 * (gw - nlo), nsh = gw < nlo ? 1 : 2;
        for (int q = 0; q < nsh; ++q) for (int it = sh0 + q; it < CV_LF1; it += NSH) conv_item(F, it);
        for (int it = CV_SM + gw; it < CV_END; it += NGW) conv_item(F, it);
    }
    {
        const int gt = F.bid * 512 + F.tid, NT = F.G * 512;
        float* c1 = (float*)(ws + WS_COS1); float* s1 = (float*)(ws + WS_SIN1); float* c2 = (float*)(ws + WS_COS2); float* s2 = (float*)(ws + WS_SIN2);
        for (int i = gt; i < SEQ * 128 + SEQ * 64; i += NT) {
            float pos, f; float* cd; float* sd;
            if (i < SEQ * 128) { const int t = i >> 7, k = i & 127; pos = (float)t; f = exp2f(-(float)k * (13.287712379549449f / 128.f)); cd = c1 + i; sd = s1 + i; }
            else { const int j = i - SEQ * 128, t = j >> 6, k = j & 63; pos = (k < 32) ? (float)(t >> 6) : (float)(t & 63); f = exp2f(-(float)(k & 31) * (13.287712379549449f / 32.f)); cd = c2 + j; sd = s2 + j; }
            const float ang = pos * f;
            double rev = (double)ang * 0.15915494309189535; rev -= __builtin_rint(rev);
            const float fr = (float)rev;
            *cd = __builtin_amdgcn_cosf(fr); *sd = __builtin_amdgcn_sinf(fr);
        }
    }
}

struct ResCfg { int has_res, has_next, li, sub, li2, sub2, nrows; float wres; const float* xold_l; const float* xold_c; float* xnew_l; float* xnew_c; const float* part; };
DEV void res_rows(const Frame& F, const ResCfg& C, int m0, int cnt, int prow) {
    const Args& A = *F.a; const float* MOD = (const float*)(A.ws + WS_MOD); bf16* H = (bf16*)(A.ws + WS_H);
    f32x4 Ca[8], Cb[8], Cs[8];
    int e0 = 4 * F.lane; asm volatile("" : "+v"(e0));
    if (C.has_res) {
        const float* gate = MOD + (size_t)(C.li * 5 + prow) * 18432 + C.sub * 6144 + 4096; const float* gp = A.in[I_NPOST] + (C.li * 3 + C.sub) * DM;
#pragma unroll
        for (int j = 0; j < 8; ++j) Ca[j] = *(const f32x4*)(gate + 256 * j + e0) * *(const f32x4*)(gp + 256 * j + e0) * C.wres;
    }
    if (C.has_next) {
        const float* sh = MOD + (size_t)(C.li2 * 5 + prow) * 18432 + C.sub2 * 6144; const float* sc = sh + 2048; const float* gp = A.in[I_NPRE] + (C.li2 * 3 + C.sub2) * DM;
#pragma unroll
        for (int j = 0; j < 8; ++j) { Cb[j] = *(const f32x4*)(gp + 256 * j + e0) * (*(const f32x4*)(sc + 256 * j + e0) + 1.f); Cs[j] = *(const f32x4*)(sh + 256 * j + e0); }
    }
    for (int m = m0; m < m0 + cnt; ++m) {
        const float* xo = (m < ML) ? C.xold_l + (size_t)m * DM : C.xold_c + (size_t)(m - ML) * DM;
        f32x4 x[8];
#pragma unroll
        for (int j = 0; j < 8; ++j) x[j] = *(const f32x4*)(xo + 256 * j + e0);
        if (C.has_res) {
            f32x4 yy[8];
            if (C.part && m >= ML) { const float* pr = C.part + (size_t)(m - ML) * DM;
#pragma unroll
                for (int j = 0; j < 8; ++j) yy[j] = (*(const f32x4*)(pr + 256 * j + e0) + *(const f32x4*)(pr + (size_t)MC * DM + 256 * j + e0)) + (*(const f32x4*)(pr + (size_t)2 * MC * DM + 256 * j + e0) + *(const f32x4*)(pr + (size_t)3 * MC * DM + 256 * j + e0)); }
            else { const bf16* yr = H + (size_t)m * DM;
#pragma unroll
                for (int j = 0; j < 8; ++j) { const u32x2 yv = *(const u32x2*)(yr + 256 * j + e0); yy[j] = (f32x4){bflo(yv.x), bfhi(yv.x), bflo(yv.y), bfhi(yv.y)}; } }
            float ss = 0.f;
#pragma unroll
            for (int j = 0; j < 8; ++j) ss += (yy[j].x * yy[j].x + yy[j].y * yy[j].y) + (yy[j].z * yy[j].z + yy[j].w * yy[j].w);
            const float rs = __builtin_amdgcn_rsqf(wave_sum(ss) * (1.f / DM) + EPS);
            float* xn = (m < ML) ? C.xnew_l + (size_t)m * DM : C.xnew_c + (size_t)(m - ML) * DM;
#pragma unroll
            for (int j = 0; j < 8; ++j) { x[j] = x[j] + Ca[j] * (yy[j] * rs); *(f32x4*)(xn + 256 * j + e0) = x[j]; }
        }
        if (C.has_next) {
            float ss = 0.f;
#pragma unroll
            for (int j = 0; j < 8; ++j) ss += (x[j].x * x[j].x + x[j].y * x[j].y) + (x[j].z * x[j].z + x[j].w * x[j].w);
            const float rs = __builtin_amdgcn_rsqf(wave_sum(ss) * (1.f / DM) + EPS);
            bf16* hr = H + (size_t)m * DM;
#pragma unroll
            for (int j = 0; j < 8; ++j) { const f32x4 h = x[j] * rs * Cb[j] + Cs[j]; u32x2 w; w.x = pkbf(h.x, h.y); w.y = pkbf(h.z, h.w); *(u32x2*)(hr + 256 * j + e0) = w; }
        }
    }
}
DEV void res_phase(const Frame& F, const ResCfg& C) {
    const int gw = F.bid * 8 + F.wave, NGW = F.G * 8;
    for (int blk = gw; blk < ML / 16; blk += NGW) res_rows(F, C, blk * 16, 16, (blk * 16) / SEQ);
    if (C.nrows > ML) {
        if (NGW >= 2 * MC) { if ((gw & 1) == 0 && (gw >> 1) < MC) res_rows(F, C, ML + (gw >> 1), 1, 4); }
        else { const int per = (MC + NGW - 1) / NGW, r0 = gw * per, cnt = (MC - r0) < per ? (MC - r0) : per; if (cnt > 0) res_rows(F, C, ML + r0, cnt, 4); }
    }
}

constexpr int LRU_UB = 0, LRU_UB_LD = 272, LRU_ARR = 17408, LRU_ARR_SZ = 32768;
DEV int lru_chunk_row0(int b, int ck) { return (ck < 4) ? ML + b * CTXL + 64 * ck : b * SEQ + 64 * (ck - 4); }
DEV float one_minus_exp(float t) {
    const float ser = -t * (1.f + t * 0.5f * (1.f + t * (1.f / 3.f) * (1.f + t * 0.25f * (1.f + t * 0.2f * (1.f + t * (1.f / 6.f))))));
    return (t > -0.25f) ? ser : 1.f - fexp(t);
}
template <bool FINAL> DEV void lru_phase(const Frame& F, bool dry = false) {
    const Args& A = *F.a; unsigned char* ws = A.ws; bf16* E = (bf16*)(ws + WS_E);
    const int tid = F.tid, wave = F.wave, lane = F.lane, r32 = lane & 31, hh = lane >> 5;
    LAS unsigned char* UB = F.lds + LRU_UB; LAS float* ARR = (LAS float*)(F.lds + LRU_ARR); LAS unsigned char* RS = F.lds + LRU_ARR;
    const int slot = F.bid & 31, n = slot & 7, b = slot >> 3, ck0 = F.bid >> 5, ckst = (F.G + 31) >> 5;
    if (F.bid >= 32 * ckst) return;
    u32x4 rp[3];
#define LRU_LOAD(ck_) do { const int L_ = ((ck_) < 4) ? CTXL : SEQ, p0_ = ((ck_) < 4) ? 64 * (ck_) : 64 * ((ck_) - 4), rb_ = ((ck_) < 4) ? ML + b * CTXL : b * SEQ; \
        _Pragma("unroll") for (int i_ = 0; i_ < 3; ++i_) { const int pc = tid + 512 * i_, rr = pc >> 4, c8 = pc & 15, pos = p0_ - 2 + rr; \
            rp[i_] = (u32x4){0u, 0u, 0u, 0u}; if (pc < 67 * 16 && pos >= 0 && pos < L_) rp[i_] = *(const u32x4*)(E + (size_t)(rb_ + pos) * EVN + EC_R + 128 * n + 8 * c8); } } while (0)
    if (ck0 < NCH64) LRU_LOAD(ck0);
    const int c8t = tid & 15, cht = 128 * n + 8 * c8t;
    float cw[4][8], cb[8];
#pragma unroll
    for (int i = 0; i < 8; ++i) cb[i] = A.in[I_CONVB][cht + i];
#pragma unroll
    for (int k = 0; k < 4; ++k)
#pragma unroll
        for (int i = 0; i < 8; ++i) cw[k][i] = A.in[I_CONVW][k * 1024 + cht + i];
    const int gd = wave >> 2, cq = wave & 3, gcol = 32 * cq + r32, gchn = 128 * n + gcol;
    bf16x8 fa[8], fx[8];
    { const bf16* WA = (const bf16*)(ws + WS_LRUW) + (size_t)(gd * 8 + n) * 16384 + (size_t)gcol * 128 + 8 * hh; const bf16* WX = WA + (size_t)16 * 16384;
#pragma unroll
      for (int ks = 0; ks < 8; ++ks) { fa[ks] = *(const bf16x8*)(WA + 16 * ks); fx[ks] = *(const bf16x8*)(WX + 16 * ks); } }
    const float gba = A.in[I_BA][gd * 1024 + gchn], gbx = A.in[I_BX][gd * 1024 + gchn], sp8 = -8.f * log1pf(expf(-A.in[I_LAM][gd * 1024 + gchn]));
    for (int ck = ck0; ck < NCH64; ck += ckst) {
        const int p0 = (ck < 4) ? 64 * ck : 64 * (ck - 4), rowbase = (ck < 4) ? ML + b * CTXL : b * SEQ;
        const int sd = (tid >> 7) & 1, sc = tid & 127; const size_t gi = ((size_t)(ck * NB + b) * 2 + sd) * 1024 + 128 * n + sc;
        float hcar = 0.f; if (FINAL && tid < 256) hcar = ((const float*)(ws + WS_CAR))[gi];
        u32x4 gv[2];
        if (FINAL) {
#pragma unroll
            for (int i = 0; i < 2; ++i) { const int pc = tid + 512 * i, tt = pc >> 4; gv[i] = *(const u32x4*)(E + (size_t)(rowbase + p0 + tt) * EVN + EC_G + 128 * n + 8 * c8t); } }
#pragma unroll
        for (int i = 0; i < 3; ++i) { const int pc = tid + 512 * i, rr = pc >> 4, c8 = pc & 15; if (pc < 67 * 16) *(LAS u32x4*)(RS + rr * 256 + c8 * 16) = rp[i]; }
        __syncthreads();
#pragma unroll
        for (int i2 = 0; i2 < 2; ++i2) { const int pc = tid + 512 * i2, tt = pc >> 4;
            float u[8];
#pragma unroll
            for (int i = 0; i < 8; ++i) u[i] = cb[i];
#pragma unroll
            for (int k = 0; k < 4; ++k) { const u32x4 rv = *(const LAS u32x4*)(RS + (tt + k) * 256 + c8t * 16);
                u[0] += cw[k][0] * bflo(rv.x); u[1] += cw[k][1] * bfhi(rv.x); u[2] += cw[k][2] * bflo(rv.y); u[3] += cw[k][3] * bfhi(rv.y);
                u[4] += cw[k][4] * bflo(rv.z); u[5] += cw[k][5] * bfhi(rv.z); u[6] += cw[k][6] * bflo(rv.w); u[7] += cw[k][7] * bfhi(rv.w); }
            u32x4 o = {pkbf(u[0], u[1]), pkbf(u[2], u[3]), pkbf(u[4], u[5]), pkbf(u[6], u[7])};
            *(LAS u32x4*)(UB + tt * LRU_UB_LD + c8t * 16) = o; }
        __syncthreads();
        if (ck + ckst < NCH64) LRU_LOAD(ck + ckst);
        {
            f32x16 aa[2] = {f32x16{}, f32x16{}}, ax[2] = {f32x16{}, f32x16{}};
#pragma unroll
            for (int ks = 0; ks < 8; ++ks) {
#pragma unroll
                for (int rt = 0; rt < 2; ++rt) { const bf16x8 af = *(const LAS bf16x8*)(UB + (32 * rt + r32) * LRU_UB_LD + (16 * ks + 8 * hh) * 2);
                    aa[rt] = __builtin_amdgcn_mfma_f32_32x32x16_bf16(af, fa[ks], aa[rt], 0, 0, 0); ax[rt] = __builtin_amdgcn_mfma_f32_32x32x16_bf16(af, fx[ks], ax[rt], 0, 0, 0); }
            }
            LAS float* AO = ARR + (size_t)(gd * 2) * (LRU_ARR_SZ / 4); LAS float* BO = AO + LRU_ARR_SZ / 4;
#pragma unroll
            for (int rt = 0; rt < 2; ++rt)
#pragma unroll
                for (int r = 0; r < 16; ++r) { const int row = 32 * rt + crow(r, hh);
                    const float la = sp8 * fsigmoid(aa[rt][r] + gba), av = fexp(la), mlt = __builtin_amdgcn_sqrtf(one_minus_exp(2.f * la));
                    const float uv = bf2f(*(const LAS bf16*)(UB + row * LRU_UB_LD + gcol * 2));
                    AO[row * 128 + gcol] = av; BO[row * 128 + gcol] = mlt * fsigmoid(ax[rt][r] + gbx) * uv; }
        }
        __syncthreads();
        if (tid < 256) { LAS float* AO = ARR + (size_t)(sd * 2) * (LRU_ARR_SZ / 4); const LAS float* BO = AO + LRU_ARR_SZ / 4;
            if (!FINAL) { float h = 0.f, P = 1.f;
#pragma unroll 8
                for (int s = 0; s < 64; ++s) { const int tt = sd ? 63 - s : s; const float a = AO[tt * 128 + sc]; h = a * h + BO[tt * 128 + sc]; P *= a; }
                ((f32x2*)(ws + WS_AGG))[gi] = (f32x2){P, h}; }
            else { float h = hcar;
#pragma unroll 8
                for (int s = 0; s < 64; ++s) { const int tt = sd ? 63 - s : s; h = AO[tt * 128 + sc] * h + BO[tt * 128 + sc]; AO[tt * 128 + sc] = h; } }
        }
        __syncthreads();
        if (FINAL) {
            const LAS float* H0 = ARR; const LAS float* H1 = ARR + 2 * (LRU_ARR_SZ / 4);
#pragma unroll
            for (int i2 = 0; i2 < 2; ++i2) { const int pc = tid + 512 * i2, tt = pc >> 4;
                const f32x4 h0a = *(const LAS f32x4*)(H0 + tt * 128 + 8 * c8t), h0b = *(const LAS f32x4*)(H0 + tt * 128 + 8 * c8t + 4), h1a = *(const LAS f32x4*)(H1 + tt * 128 + 8 * c8t), h1b = *(const LAS f32x4*)(H1 + tt * 128 + 8 * c8t + 4);
                const f32x4 sa = h0a + h1a, sb = h0b + h1b; const u32x4 g4 = gv[i2];
                u32x4 w = {pkbf(fgelu_tanh(bflo(g4.x)) * sa.x, fgelu_tanh(bfhi(g4.x)) * sa.y), pkbf(fgelu_tanh(bflo(g4.y)) * sa.z, fgelu_tanh(bfhi(g4.y)) * sa.w),
                           pkbf(fgelu_tanh(bflo(g4.z)) * sb.x, fgelu_tanh(bfhi(g4.z)) * sb.y), pkbf(fgelu_tanh(bflo(g4.w)) * sb.z, fgelu_tanh(bfhi(g4.w)) * sb.w)};
                bf16* wp = dry ? (bf16*)(ws + WS_H) + (size_t)(rowbase + p0 + tt) * DM + 128 * n + 8 * c8t : E + (size_t)(rowbase + p0 + tt) * EVN + EC_G + 128 * n + 8 * c8t; *(u32x4*)wp = w; }
            __syncthreads();
        }
    }
#undef LRU_LOAD
}
DEV void lru_carry_phase(const Frame& F) {
    unsigned char* ws = F.a->ws; const f32x2* AGG = (const f32x2*)(ws + WS_AGG); float* CAR = (float*)(ws + WS_CAR);
    const int gw = F.bid * 8 + F.wave, NGW = F.G * 8;
    for (int it = gw; it < NB * 2 * 16; it += NGW) { const int cg = it & 15, d = (it >> 4) & 1, b = it >> 5;
        float h = 0.f;
#pragma unroll 12
        for (int idx = 0; idx < NCH64; ++idx) { const int ck = d ? (idx < 4 ? 3 - idx : NCH64 + 3 - idx) : idx;
            const size_t gi = ((size_t)(ck * NB + b) * 2 + d) * 1024 + 64 * cg + F.lane; const f32x2 v = AGG[gi]; CAR[gi] = h; h = v.x * h + v.y; }
    }
}

DEV int ret_chunk_row0(int b, int cid) { return (cid < 2) ? ML + b * CTXL + 128 * cid : b * SEQ + 128 * (cid - 2); }
DEV int ret_chain(int d, int idx) { return d ? (idx < 2 ? 1 - idx : NCH128 + 1 - idx) : idx; }
DEV float ret_logg(const Args& A, int d, int h) { const float lg = A.in[I_DECAY][d * 4 + h]; return -log1pf(expf(-lg)); }
constexpr int RET_LD = 528, RET_VLD = 80;
DEV void ret_state_phase(const Frame& F) {
    const Args& A = *F.a; unsigned char* ws = A.ws; const bf16* E = (const bf16*)(ws + WS_E); bf16* SB = (bf16*)(ws + WS_SBUF);
    const int tid = F.tid, lane = F.lane, wave = F.wave, r32 = lane & 31, hh = lane >> 5;
    LAS unsigned char* KS = F.lds; LAS unsigned char* VS = F.lds + 128 * RET_LD;
    for (int it = F.bid; it < 256; it += F.G) {
        const int es = it & 7, d = (it >> 3) & 1, h = (it >> 4) & 3, b = it >> 6;
        const float lg = ret_logg(A, d, h), sdec = expf(lg * 128.f);
        const int vrow = tid >> 2, vc4 = tid & 3; const float vw = expf(lg * (float)(d ? vrow : 127 - vrow));
        u32x4 kreg[8], vreg;
        f32x16 acc = f32x16{};
#define RS_LOAD(cid_) do { const int m0_ = ret_chunk_row0(b, cid_); \
            _Pragma("unroll") for (int i = 0; i < 8; ++i) { const int id = tid + 512 * i, row = id >> 5, c16 = id & 31; kreg[i] = *(const u32x4*)(E + (size_t)(m0_ + row) * EVN + EC_K + 256 * h + 8 * c16); } \
            vreg = *(const u32x4*)(E + (size_t)(m0_ + vrow) * EVN + EC_V + 256 * h + 32 * es + 8 * vc4); } while (0)
        RS_LOAD(ret_chain(d, 0));
        for (int idx = 0; idx < NCH128; ++idx) {
            const int cid = ret_chain(d, idx);
#pragma unroll
            for (int i = 0; i < 8; ++i) { const int id = tid + 512 * i, row = id >> 5, c16 = id & 31; *(LAS u32x4*)(KS + row * RET_LD + c16 * 16) = kreg[i]; }
            { u32x4 w; w.x = pkbf(bflo(vreg.x) * vw, bfhi(vreg.x) * vw); w.y = pkbf(bflo(vreg.y) * vw, bfhi(vreg.y) * vw); w.z = pkbf(bflo(vreg.z) * vw, bfhi(vreg.z) * vw); w.w = pkbf(bflo(vreg.w) * vw, bfhi(vreg.w) * vw);
              *(LAS u32x4*)(VS + vrow * RET_VLD + vc4 * 16) = w; }
            __syncthreads();
            if (idx + 1 < NCH128) RS_LOAD(ret_chain(d, idx + 1));
            { bf16* sp = SB + ((size_t)(((b * 4 + h) * 2 + d) * NCH128 + cid) * 256 + 32 * es + r32) * 256 + 32 * wave + 4 * hh;
#pragma unroll
              for (int g = 0; g < 4; ++g) { u32x2 w; w.x = pkbf(acc[4 * g], acc[4 * g + 1]); w.y = pkbf(acc[4 * g + 2], acc[4 * g + 3]); *(u32x2*)(sp + 8 * g) = w; } }
#pragma unroll
            for (int r = 0; r < 16; ++r) acc[r] *= sdec;
#pragma unroll
            for (int ks = 0; ks < 8; ++ks) { const bf16x8 af = tr_frag(KS, RET_LD, 16 * ks, 32 * wave, lane); const bf16x8 bfr = tr_frag(VS, RET_VLD, 16 * ks, 0, lane);
                acc = __builtin_amdgcn_mfma_f32_32x32x16_bf16(af, bfr, acc, 0, 0, 0); }
            __syncthreads();
        }
#undef RS_LOAD
    }
}
DEV void ret_out_phase(const Frame& F, bool dry = false) {
    const Args& A = *F.a; unsigned char* ws = A.ws; bf16* E = (bf16*)(ws + WS_E); const bf16* SB = (const bf16*)(ws + WS_SBUF);
    const int wave = F.wave, ib = wave & 3, eh = wave >> 2;
    LAS unsigned char* RA = F.lds; LAS unsigned char* RB = F.lds + 128 * RET_LD; LAS float* GX = (LAS float*)(F.lds + 2 * 128 * RET_LD);
    constexpr int PLD = 272;
    for (int it = F.bid; it < 16 * NCH128; it += F.G) {
        int tid = F.tid; asm volatile("" : "+v"(tid)); int lane = tid & 63;
        const int r32 = lane & 31, hh = lane >> 5;
        const int cid = it % NCH128, bh = it / NCH128, h = bh & 3, b = bh >> 2, m0 = ret_chunk_row0(b, cid);
        const float lg0 = ret_logg(A, 0, h), lg1 = ret_logg(A, 1, h);
        bf16x8 qf[16];
        { const bf16* qp = E + (size_t)(m0 + 32 * ib + r32) * EVN + EC_Q + 256 * h + 8 * hh;
#pragma unroll
          for (int ks = 0; ks < 16; ++ks) qf[ks] = *(const bf16x8*)(qp + 16 * ks); }
        f32x16 o[4];
#pragma unroll
        for (int et = 0; et < 4; ++et) o[et] = f32x16{};
#pragma unroll 1
        for (int d = 0; d < 2; ++d) {
            const bf16* sp = SB + (size_t)((bh * 2 + d) * NCH128 + cid) * 65536; const float lgd = d ? lg1 : lg0;
            __syncthreads();
#pragma unroll
            for (int hb = 0; hb < 2; ++hb) { u32x4 tmp[8];
#pragma unroll
                for (int i = 0; i < 8; ++i) { const int id = tid + 512 * (8 * hb + i), row = id >> 5, c16 = id & 31; tmp[i] = *(const u32x4*)(sp + (size_t)row * 256 + 8 * c16); }
                asm volatile("" ::: "memory");
#pragma unroll
                for (int i = 0; i < 8; ++i) { const int id = tid + 512 * (8 * hb + i), row = id >> 5, c16 = id & 31; *(LAS u32x4*)(RA + row * RET_LD + c16 * 16) = tmp[i]; }
                asm volatile("" ::: "memory"); }
            __syncthreads();
#pragma unroll
            for (int et = 0; et < 4; ++et) { f32x16 T = f32x16{};
                const LAS unsigned char* bp = RA + (128 * eh + 32 * et + r32) * RET_LD + 16 * hh;
#pragma unroll
                for (int ks = 0; ks < 16; ++ks) { const bf16x8 bfr = *(const LAS bf16x8*)(bp + 32 * ks); T = __builtin_amdgcn_mfma_f32_32x32x16_bf16(qf[ks], bfr, T, 0, 0, 0); }
#pragma unroll
                for (int r = 0; r < 16; ++r) { const int i = 32 * ib + crow(r, hh); const float rs = fexp(lgd * (float)(d ? 128 - i : i + 1)); o[et][r] += T[r] * rs; } }
        }
        __syncthreads();
        int tid2 = tid; asm volatile("" : "+v"(tid2));
#pragma unroll
        for (int kv = 0; kv < 2; ++kv) { u32x4 tmp[8];
#pragma unroll
            for (int i = 0; i < 8; ++i) { const int id = tid2 + 512 * i, row = id >> 5, c16 = id & 31; tmp[i] = *(const u32x4*)(E + (size_t)(m0 + row) * EVN + (kv ? EC_V : EC_K) + 256 * h + 8 * c16); }
            asm volatile("" ::: "memory");
#pragma unroll
            for (int i = 0; i < 8; ++i) { const int id = tid2 + 512 * i, row = id >> 5, c16 = id & 31; *(LAS u32x4*)((kv ? RB : RA) + row * RET_LD + c16 * 16) = tmp[i]; }
            asm volatile("" ::: "memory"); }
        __syncthreads();
        u32x2 pw[2][4];
        { const int i = 32 * ib + r32;
#pragma unroll
          for (int jj = 0; jj < 2; ++jj) { const int jt = 2 * eh + jj;
            f32x16 X = f32x16{};
#pragma unroll
            for (int ks = 0; ks < 16; ++ks) { const bf16x8 af = *(const LAS bf16x8*)(RA + (32 * jt + r32) * RET_LD + (16 * ks + 8 * hh) * 2); X = __builtin_amdgcn_mfma_f32_32x32x16_bf16(af, qf[ks], X, 0, 0, 0); }
#pragma unroll
            for (int g = 0; g < 4; ++g) { float pv[4];
#pragma unroll
                for (int q = 0; q < 4; ++q) { const int j = 32 * jt + 8 * g + 4 * hh + q; const int dl = i - j; const float f = (dl > 0) ? fexp(lg0 * (float)dl) : (dl < 0) ? fexp(-lg1 * (float)dl) : 2.f; pv[q] = X[4 * g + q] * f; }
                pw[jj][g].x = pkbf(pv[0], pv[1]); pw[jj][g].y = pkbf(pv[2], pv[3]); } } }
        __syncthreads();
        { const int i = 32 * ib + r32;
#pragma unroll
          for (int jj = 0; jj < 2; ++jj)
#pragma unroll
            for (int g = 0; g < 4; ++g) *(LAS u32x2*)(RA + i * PLD + (32 * (2 * eh + jj) + 8 * g + 4 * hh) * 2) = pw[jj][g]; }
        __syncthreads();
#pragma unroll
        for (int ks = 0; ks < 8; ++ks) { const bf16x8 pa = *(const LAS bf16x8*)(RA + (32 * ib + r32) * PLD + (16 * ks + 8 * hh) * 2);
#pragma unroll
            for (int et = 0; et < 4; ++et) { const bf16x8 bfr = tr_frag(RB, RET_LD, 16 * ks, 128 * eh + 32 * et, lane); o[et] = __builtin_amdgcn_mfma_f32_32x32x16_bf16(pa, bfr, o[et], 0, 0, 0); } }
#pragma unroll
        for (int r = 0; r < 16; ++r) { float a = 0.f, q = 0.f;
#pragma unroll
            for (int et = 0; et < 4; ++et) { a += o[et][r]; q += o[et][r] * o[et][r]; }
#pragma unroll
            for (int off = 1; off < 32; off <<= 1) { a += __shfl_xor(a, off); q += __shfl_xor(q, off); }
            if (r32 == 0) { GX[(wave * 32 + crow(r, hh)) * 2] = a; GX[(wave * 32 + crow(r, hh)) * 2 + 1] = q; } }
        __syncthreads();
        { const float* gn = A.in[I_GN] + 256 * h + 128 * eh;
#pragma unroll
          for (int r = 0; r < 16; ++r) { const int rw = crow(r, hh); const float a = GX[(wave * 32 + rw) * 2] + GX[((wave ^ 4) * 32 + rw) * 2], q = GX[(wave * 32 + rw) * 2 + 1] + GX[((wave ^ 4) * 32 + rw) * 2 + 1];
            const float mean = a * (1.f / 256.f), var = q * (1.f / 256.f) - mean * mean, rstd = __builtin_amdgcn_rsqf(var + EPS);
            bf16* op = E + (size_t)(m0 + 32 * ib + rw) * EVN + EC_O + 256 * h + 128 * eh + r32;
#pragma unroll
            for (int et = 0; et < 4; ++et) { const float og = bf2f(op[32 * et]); bf16* wp = dry ? (bf16*)(ws + WS_H) + (size_t)(m0 + 32 * ib + rw) * DM + 1024 + 256 * h + 128 * eh + r32 : op;
                wp[32 * et] = f2bf((o[et][r] - mean) * rstd * gn[32 * et + r32] * fsilu(og)); } } }
    }
    __syncthreads();
}
DEV void odd_post_phase(const Frame& F) {
    const Args& A = *F.a; unsigned char* ws = A.ws; const bf16* E2 = (const bf16*)(ws + WS_E2);
    bf16* QB = (bf16*)(ws + WS_QB); bf16* KB = (bf16*)(ws + WS_KB); bf16* VB = (bf16*)(ws + WS_VB); bf16* MIX = (bf16*)(ws + WS_MIX2);
    const float* c2 = (const float*)(ws + WS_COS2); const float* s2 = (const float*)(ws + WS_SIN2);
    const int tid = F.tid, wave = F.wave;
    {
        const int gw = F.bid * 8 + F.wave, NGW = F.G * 8; const int lane0 = F.lane, li0 = lane0 & 15, e0c = 8 * (li0 & 7);
        f32x4 qg[2], kg[2];
        qg[0] = *(const f32x4*)(A.in[I_QN] + 8 * li0); qg[1] = *(const f32x4*)(A.in[I_QN] + 8 * li0 + 4); kg[0] = *(const f32x4*)(A.in[I_KN] + 8 * li0); kg[1] = *(const f32x4*)(A.in[I_KN] + 8 * li0 + 4);
        for (int m = gw; m < MT; m += NGW) {
            int lane = F.lane; asm volatile("" : "+v"(lane));
            const int grp = lane >> 4, li = lane & 15; const bool hi8 = (li & 8) != 0;
            const bool lat = m < ML; const int b = lat ? m / SEQ : (m - ML) / CTXL, t = lat ? m % SEQ : 0, kpos = lat ? CTXL + t : (m - ML) % CTXL;
            const bf16* er = E2 + (size_t)m * ODN;
            f32x4 cs[2] = {(f32x4){1.f, 1.f, 1.f, 1.f}, (f32x4){1.f, 1.f, 1.f, 1.f}}, sn[2] = {(f32x4){0.f, 0.f, 0.f, 0.f}, (f32x4){0.f, 0.f, 0.f, 0.f}};
            if (lat) { cs[0] = *(const f32x4*)(c2 + t * 64 + e0c); cs[1] = *(const f32x4*)(c2 + t * 64 + e0c + 4); sn[0] = *(const f32x4*)(s2 + t * 64 + e0c); sn[1] = *(const f32x4*)(s2 + t * 64 + e0c + 4); }
#pragma unroll
            for (int rd = 0; rd < 4; ++rd) {
                if (rd < 3 && !lat) continue;
                const bool isq = rd < 3; const int hd = isq ? 4 * rd + grp : grp;
                const u32x4 xv = *(const u32x4*)(er + (isq ? 512 : 2048) + 128 * hd + 8 * li);
                float x[8] = {bflo(xv.x), bfhi(xv.x), bflo(xv.y), bfhi(xv.y), bflo(xv.z), bfhi(xv.z), bflo(xv.w), bfhi(xv.w)};
                float ss = 0.f;
#pragma unroll
                for (int i = 0; i < 8; ++i) ss += x[i] * x[i];
                ss += __shfl_xor(ss, 1); ss += __shfl_xor(ss, 2); ss += __shfl_xor(ss, 4); ss += __shfl_xor(ss, 8);
                const float rs = __builtin_amdgcn_rsqf(ss * (1.f / 128.f) + EPS);
                float y[8], yp[8], o[8];
#pragma unroll
                for (int i = 0; i < 8; ++i) y[i] = x[i] * rs * (isq ? qg[i >> 2][i & 3] : kg[i >> 2][i & 3]);
#pragma unroll
                for (int i = 0; i < 8; ++i) yp[i] = __shfl_xor(y[i], 8);
#pragma unroll
                for (int i = 0; i < 8; ++i) { const float c = cs[i >> 2][i & 3], sv = sn[i >> 2][i & 3]; o[i] = hi8 ? (yp[i] * sv + y[i] * c) : (y[i] * c - yp[i] * sv); }
                u32x4 w = {pkbf(o[0], o[1]), pkbf(o[2], o[3]), pkbf(o[4], o[5]), pkbf(o[6], o[7])};
                bf16* dst = isq ? QB + (size_t)m * 1536 + 128 * hd + 8 * li : KB + ((size_t)b * KVL + kpos) * 512 + 128 * hd + 8 * li;
                *(u32x4*)dst = w;
            }
            *(u32x4*)(VB + ((size_t)b * KVL + kpos) * 512 + 8 * lane) = *(const u32x4*)(er + 2560 + 8 * lane);
        }
    }
    {
        const int lane = F.lane, r32 = lane & 31, hh = lane >> 5;
        LAS unsigned char* XS = F.lds; LAS unsigned char* DS = F.lds + 144 * 256; constexpr int DLD = 272;
        for (int it = F.bid; it < (ML / 128) * 4; it += F.G) {
            const int gi = it & 3, rt = it >> 2, b = (rt * 128) / SEQ, t0 = (rt * 128) % SEQ, half = 1 << gi;
            __syncthreads();
            { u32x4 tv[5];
#pragma unroll
              for (int i = 0; i < 5; ++i) { const int pc = tid + 512 * i, rr = pc >> 4, c8 = pc & 15, pos = t0 - 8 + rr;
                  tv[i] = (u32x4){0u, 0u, 0u, 0u}; if (pc < 144 * 16 && pos >= 0 && pos < SEQ) tv[i] = *(const u32x4*)(E2 + (size_t)(b * SEQ + pos) * ODN + 128 * gi + 8 * c8); }
              asm volatile("" ::: "memory");
#pragma unroll
              for (int i = 0; i < 5; ++i) { const int pc = tid + 512 * i, rr = pc >> 4, c8 = pc & 15; if (pc < 144 * 16) *(LAS u32x4*)(XS + rr * 256 + c8 * 16) = tv[i]; } }
            __syncthreads();
            for (int pc = tid; pc < 128 * 16; pc += 512) { const int tt = pc >> 4, c8 = pc & 15, t = t0 + tt;
                const int lo = (t - half) < 0 ? 0 : t - half, hi = (t + half) > SEQ ? SEQ : t + half; const float inv = 1.f / (float)(hi - lo);
                float s[8] = {0.f, 0.f, 0.f, 0.f, 0.f, 0.f, 0.f, 0.f};
                for (int p = lo; p < hi; ++p) { const u32x4 v = *(const LAS u32x4*)(XS + (p - t0 + 8) * 256 + c8 * 16);
                    s[0] += bflo(v.x); s[1] += bfhi(v.x); s[2] += bflo(v.y); s[3] += bfhi(v.y); s[4] += bflo(v.z); s[5] += bfhi(v.z); s[6] += bflo(v.w); s[7] += bfhi(v.w); }
                const u32x4 xv = *(const LAS u32x4*)(XS + (tt + 8) * 256 + c8 * 16);
                u32x4 o; o.x = pkbf(s[0] * inv - bflo(xv.x), s[1] * inv - bfhi(xv.x)); o.y = pkbf(s[2] * inv - bflo(xv.y), s[3] * inv - bfhi(xv.y));
                o.z = pkbf(s[4] * inv - bflo(xv.z), s[5] * inv - bfhi(xv.z)); o.w = pkbf(s[6] * inv - bflo(xv.w), s[7] * inv - bfhi(xv.w));
                *(LAS u32x4*)(DS + tt * DLD + c8 * 16) = o; }
            __syncthreads();
            { const int rb = wave & 3, chh = wave >> 2; const bf16* WT = (const bf16*)(ws + WS_POOLW) + (size_t)gi * 16384;
              f32x16 acc[2] = {f32x16{}, f32x16{}};
#pragma unroll
              for (int ks = 0; ks < 8; ++ks) { const bf16x8 af = *(const LAS bf16x8*)(DS + (32 * rb + r32) * DLD + (16 * ks + 8 * hh) * 2);
#pragma unroll
                  for (int ct = 0; ct < 2; ++ct) { const bf16x8 bfr = *(const bf16x8*)(WT + (size_t)(64 * chh + 32 * ct + r32) * 128 + 16 * ks + 8 * hh);
                      acc[ct] = __builtin_amdgcn_mfma_f32_32x32x16_bf16(af, bfr, acc[ct], 0, 0, 0); } }
#pragma unroll
              for (int ct = 0; ct < 2; ++ct) { const int col = 128 * gi + 64 * chh + 32 * ct + r32; const float ps = A.in[I_POOLS][col];
#pragma unroll
                  for (int r = 0; r < 16; ++r) MIX[(size_t)(b * SEQ + t0 + 32 * rb + crow(r, hh)) * DM + col] = f2bf(acc[ct][r] * ps); } }
        }
        __syncthreads();
    }
}
DEV void attn_phase(const Frame& F) {
    unsigned char* ws = F.a->ws; const bf16* QB = (const bf16*)(ws + WS_QB); const bf16* KB = (const bf16*)(ws + WS_KB); const bf16* VB = (const bf16*)(ws + WS_VB); bf16* MIX = (bf16*)(ws + WS_MIX2);
    for (int u = F.bid; u < NB * 12 * (SEQ / 256); u += F.G) {
        const int qb = u & 31, g = (u >> 5) % 3, kvh = ((u >> 5) / 3) & 3, b = (u >> 5) / 12, hq = kvh * 3 + g;
        att::attn_dense_body<1536, 512, DM>(QB + (size_t)(b * SEQ + 256 * qb) * 1536 + 128 * hq, KB + (size_t)b * KVL * 512 + 128 * kvh, VB + (size_t)b * KVL * 512 + 128 * kvh,
                                           MIX + (size_t)(b * SEQ + 256 * qb) * DM + 512 + 128 * hq, KVL, (char*)F.lds);
    }
}

constexpr int NPH = 25;
__global__ void __launch_bounds__(512, 2) mk_fwd(Args args) {
    extern __shared__ __attribute__((aligned(16))) unsigned char lds_raw[];
    Frame F; F.lds = (LAS unsigned char*)lds_raw; F.tid = threadIdx.x; F.lane = F.tid & 63; F.wave = __builtin_amdgcn_readfirstlane(F.tid >> 6); F.G = gridDim.x; F.bid = blockIdx.x; F.a = &args;
    unsigned char* ws = args.ws;
    volatile LAS unsigned* MISC = (volatile LAS unsigned*)(F.lds + MISC_OFF);
    if (F.tid < 64) MISC[F.tid] = 0u;
    __syncthreads();
    XcdBarrier bar; bar.bar = (unsigned*)(ws + WS_CTL) + CW_BAR; bar.x = 0; bar.st = nullptr;
    const int lo = args.ph_lo, hi = args.ph_hi;
    if (hi - lo > 1) bar = xcd_barrier_post((unsigned*)(ws + WS_CTL) + CW_BAR, MISC + 8);
#ifndef MK_MASK
#define MK_MASK 0xFFFFFFFFu
#endif
#define IN(k) (((MK_MASK >> (k)) & 1u) && lo <= (k) && (k) < hi && (k) <= MK_STOP_AFTER)
#define SEAM(k) do { if (IN(k) && (k) + 1 < hi) xcd_barrier(bar); } while (0)
#ifndef MK_DOUBLE
#define MK_DOUBLE 0u
#endif
#ifndef MK_STAMP
#define MK_STAMP (-1)
#endif
#ifndef MK_STAMPMASK
#define MK_STAMPMASK 0u
#endif
#define PHASE(k) do { if ((k) == MK_STAMP || ((MK_STAMPMASK >> (k)) & 1u)) t_stamp0 = wall_clock64(); if (IN(k)) { PH_BODY_##k; if ((MK_DOUBLE >> (k)) & 1u) { xcd_barrier(bar); PH_BODY_##k; } } SEAM(k); if ((k) == MK_STAMP) t_stamp1 = wall_clock64(); if ((MK_STAMPMASK >> (k)) & 1u) t_stamp1 += wall_clock64() - t_stamp0; } while (0)
    bf16* H = (bf16*)(ws + WS_H); bf16* ACT = (bf16*)(ws + WS_ACT); bf16* E = (bf16*)(ws + WS_E); bf16* E2 = (bf16*)(ws + WS_E2); bf16* MIX2 = (bf16*)(ws + WS_MIX2);
    float* XC = (float*)(ws + WS_XC); float* PART = (float*)(ws + WS_PART);
#define GEMM_GU(lf, M_) do { pg8::Gemm g{H, (const bf16*)(ws + WS_WGU + (size_t)(lf) * 44 * MiB), (M_), 2 * DFF, DM, DM}; pg8::StaticOrder S; S.init((M_), 2 * DFF, F.G, F.bid); \
        pg8::EpiSwiGLU Ep{ACT, DFF}; pg8::gemm_phase<pg8::EpiSwiGLU, pg8::StaticOrder, PG8_ALIGN, PG8_SP2>(F.lds, g, S, Ep); } while (0)
#define GEMM_DN(lf, M_) do { pg8::Gemm g{ACT, (const bf16*)(ws + WS_WD + (size_t)(lf) * 22 * MiB), (M_), DM, DFF, DFF}; pg8::TailSplitOrder S; S.init(ML, (M_) - ML, DM, F.G, F.bid, 4); \
        pg8::EpiPlainSplit Ep{H, DM, PART, ML, MC}; pg8::gemm_phase<pg8::EpiPlainSplit, pg8::TailSplitOrder, PG8_ALIGN, PG8_SP2>(F.lds, g, S, Ep); } while (0)
#define RES(hr, hn, li_, sub_, li2_, sub2_, nrows_, w_, xol, xoc, part_) do { ResCfg C{(hr), (hn), (li_), (sub_), (li2_), (sub2_), (nrows_), (w_), (xol), (xoc), args.out, XC, (part_)}; res_phase(F, C); } while (0)

    unsigned long long t_stamp0 = 0, t_stamp1 = 0;
#define PH_BODY_0 p0_prologue(F)
    PHASE(0);
#define PH_BODY_1 RES(0, 1, 0, 0, 0, 0, MT, 0.f, args.in[I_X], args.in[I_CTX], nullptr);
    PHASE(1);
#ifdef MK_GSTAMP
#define PH_BODY_2 { pg8::Gemm g{H, (const bf16*)(ws + WS_WGU), MT, 2 * DFF, DM, DM}; pg8::StaticOrder S; S.init(MT, 2 * DFF, F.G, F.bid); \
        pg8::EpiSwiGLU Ep{ACT, DFF}; const unsigned gstv = pg8::gemm_phase<pg8::EpiSwiGLU, pg8::StaticOrder, PG8_ALIGN, PG8_SP2>(F.lds, g, S, Ep); if (F.bid == 0 && F.tid == 0) ((unsigned*)(ws + WS_CTL))[64] = gstv; deferred_convert(F, CV_EI, CV_OI, (MT / 256) * (2 * DFF / 256)); }
#else
#define PH_BODY_2 { GEMM_GU(0, MT); deferred_convert(F, CV_EI, CV_OI, (MT / 256) * (2 * DFF / 256)); }
#endif
    PHASE(2);
#define PH_BODY_3 { GEMM_DN(0, MT); deferred_convert(F, CV_LF1, CV_LF2, (ML / 256) * (DM / 256) + (MC / 256) * (DM / 256) * 4); }
    PHASE(3);
#define PH_BODY_4 RES(1, 1, 0, 0, 0, 1, MT, 0.5f, args.in[I_X], args.in[I_CTX], PART)
    PHASE(4);
#define PH_BODY_5 { pg8::Gemm g{H, (const bf16*)(ws + WS_WEVIN), MT, EVN, DM, DM}; pg8::StaticOrder S; S.init(MT, EVN, F.G, F.bid); \
        pg8::EpiEvIn Ep{E, (const float*)(ws + WS_COS1), (const float*)(ws + WS_SIN1)}; pg8::gemm_phase<pg8::EpiEvIn, pg8::StaticOrder, PG8_ALIGN, PG8_SP2>(F.lds, g, S, Ep); \
        deferred_mod(F, 128, 256, (MT / 256) * (EVN / 256)); }
    PHASE(5);
#define PH_BODY_6 lru_phase<false>(F)
    PHASE(6);
#define PH_BODY_7 { lru_carry_phase(F); ret_state_phase(F); }
    PHASE(7);
#ifndef MK_P8
#define MK_P8 3
#endif
#ifndef MK_DRY8
#define MK_DRY8 0
#endif
#define PH_BODY_8 { if (MK_DRY8 & 1) { lru_phase<true>(F, true); xcd_barrier(bar); } if (MK_DRY8 & 2) { ret_out_phase(F, true); xcd_barrier(bar); } if (MK_P8 & 1) lru_phase<true>(F); if (MK_P8 & 2) ret_out_phase(F); }
    PHASE(8);
#define PH_BODY_9 { pg8::Gemm g{E, (const bf16*)(ws + WS_WEVOUT), MT, DM, DM, EVN}; pg8::TailSplitOrder S; S.init(ML, MC, DM, F.G, F.bid, 4); \
        pg8::EpiPlainSplit Ep{H, DM, PART, ML, MC}; pg8::gemm_phase<pg8::EpiPlainSplit, pg8::TailSplitOrder, PG8_ALIGN, PG8_SP2>(F.lds, g, S, Ep); }
    PHASE(9);
#define PH_BODY_10 RES(1, 1, 0, 1, 0, 2, MT, 1.0f, args.out, XC, PART)
    PHASE(10);
#define PH_BODY_11 { GEMM_GU(1, MT); deferred_convert(F, CV_LF2, CV_LF3, (MT / 256) * (2 * DFF / 256)); }
    PHASE(11);
#define PH_BODY_12 { GEMM_DN(1, MT); deferred_convert(F, CV_LF3, CV_EI, (ML / 256) * (DM / 256) + (MC / 256) * (DM / 256) * 4); }
    PHASE(12);
#define PH_BODY_13 RES(1, 1, 0, 2, 1, 0, MT, 0.5f, args.out, XC, PART)
    PHASE(13);
#define PH_BODY_14 { GEMM_GU(2, MT); deferred_convert(F, CV_OI, CV_SM, (MT / 256) * (2 * DFF / 256)); }
    PHASE(14);
#define PH_BODY_15 GEMM_DN(2, MT)
    PHASE(15);
#define PH_BODY_16 RES(1, 1, 1, 0, 1, 1, MT, 0.5f, args.out, XC, PART)
    PHASE(16);
#define PH_BODY_17 { pg8::Gemm g{H, (const bf16*)(ws + WS_WODIN), MT, ODN, DM, DM}; pg8::StaticOrder S; S.init(MT, ODN, F.G, F.bid); \
        pg8::EpiPlain Ep{E2, ODN}; pg8::gemm_phase<pg8::EpiPlain, pg8::StaticOrder, PG8_ALIGN, PG8_SP2>(F.lds, g, S, Ep); }
    PHASE(17);
#define PH_BODY_18 odd_post_phase(F)
    PHASE(18);
#define PH_BODY_19 attn_phase(F)
    PHASE(19);
#define PH_BODY_20 { pg8::Gemm g{MIX2, (const bf16*)(ws + WS_WODOUT), ML, DM, DM, DM}; pg8::StaticOrder S; S.init(ML, DM, F.G, F.bid); \
        pg8::EpiPlain Ep{H, DM}; pg8::gemm_phase<pg8::EpiPlain, pg8::StaticOrder, PG8_ALIGN, PG8_SP2>(F.lds, g, S, Ep); }
    PHASE(20);
#define PH_BODY_21 RES(1, 1, 1, 1, 1, 2, ML, 1.0f, args.out, XC, nullptr)
    PHASE(21);
#define PH_BODY_22 GEMM_GU(3, ML)
    PHASE(22);
#define PH_BODY_23 GEMM_DN(3, ML)
    PHASE(23);
#define PH_BODY_24 RES(1, 0, 1, 2, 0, 0, ML, 0.5f, args.out, XC, nullptr)
    PHASE(24);
#ifdef MK_GSTAMP
    if (F.bid == 0 && F.tid == 0) args.out[0] = 64.f * floorf((float)((const unsigned*)(ws + WS_CTL))[64] * 0.01f / 64.f + 0.5f);
#endif
    if (MK_STAMPMASK != 0u && F.bid == 0 && F.tid == 0) args.out[0] = 512.f * floorf((float)t_stamp1 * 0.01f / 512.f + 0.5f);
    if (MK_STAMP >= 0 && F.bid == 0 && F.tid == 0) args.out[0] = 32.f * floorf((float)(t_stamp1 - t_stamp0) * 0.01f / 32.f + 0.5f);
#undef IN
#undef SEAM
}

extern "C" void kernel_launch(void* const* d_in, const int* in_sizes, int n_in, void* d_out, int out_size, void* d_ws, size_t ws_size, hipStream_t stream) {
    static int grid = 0;
    if (grid == 0) {
        if (n_in != 28 || out_size != ML * DM || ws_size < WS_END) { fprintf(stderr, "kernel_launch: unexpected shapes (n_in %d out %d ws %zu, need ws >= %zu)\n", n_in, out_size, ws_size, (size_t)WS_END); grid = -1; return; }
        int dev = 0, cus = 0, per_cu = 0;
        if (hipGetDevice(&dev) != hipSuccess || hipDeviceGetAttribute(&cus, hipDeviceAttributeMultiprocessorCount, dev) != hipSuccess) { grid = -1; return; }
        if (hipFuncSetAttribute((const void*)mk_fwd, hipFuncAttributeMaxDynamicSharedMemorySize, LDS_BYTES) != hipSuccess) { fprintf(stderr, "kernel_launch: hipFuncSetAttribute failed\n"); grid = -1; return; }
        if (hipOccupancyMaxActiveBlocksPerMultiprocessor(&per_cu, (const void*)mk_fwd, 512, LDS_BYTES) != hipSuccess || per_cu < 1) fprintf(stderr, "kernel_launch: occupancy query says %d\n", per_cu);
        (void)hipGetLastError();
        grid = cus;
    }
    if (grid < 0) return;
    (void)hipMemsetAsync((char*)d_ws + WS_CTL, 0, CTL_ZERO_BYTES, stream);
    Args a{};
    for (int i = 0; i < 28; ++i) a.in[i] = (const float*)d_in[i];
    a.out = (float*)d_out; a.ws = (unsigned char*)d_ws;
#if MK_N_LAUNCHES == 1
    a.ph_lo = 0; a.ph_hi = NPH;
    hipLaunchKernelGGL(mk_fwd, dim3(grid), dim3(512), LDS_BYTES, stream, a);
#else
    for (int p = 0; p < NPH && p <= MK_STOP_AFTER; ++p) { a.ph_lo = p; a.ph_hi = p + 1; hipLaunchKernelGGL(mk_fwd, dim3(grid), dim3(512), LDS_BYTES, stream, a); }
#endif
    const hipError_t le = hipPeekAtLastError();
    if (le != hipSuccess) fprintf(stderr, "kernel_launch: launch failed: %s\n", hipGetErrorName(le));
}
```
